# Optimizing an MI355X kernel written in HIP

```python
import jax, jax.numpy as jnp
from jax import lax
import numpy as np

D_MODEL = 2048
BATCH = 2
SEQ = 16384
DEPTH = 1

PE_DIM = 256
MIX_WIDTH = D_MODEL
ML_WIDTH = MIX_WIDTH // 2
ML_HEADS = 4
ML_DV = ML_WIDTH // ML_HEADS
ML_DQK = ML_DV // 2
ML_QK = ML_HEADS * ML_DQK
ML_CONV = 4
ML_CHUNK = 64
HG_WIDTH = MIX_WIDTH - ML_WIDTH
HG_EXPAND = 128
HG_HEADS = HG_WIDTH // HG_EXPAND
HG_DV = HG_WIDTH // HG_HEADS
HG_FDIM = HG_HEADS * HG_EXPAND
HG_CHUNK = 64
EPS = 1e-6

SPLIT_SIZES = (ML_QK, ML_QK, ML_WIDTH, ML_WIDTH, ML_WIDTH, ML_HEADS, ML_HEADS,
               HG_FDIM, HG_FDIM, HG_WIDTH, HG_WIDTH)
IN_COLS = sum(SPLIT_SIZES)

kernel_name = "hymba_mlstm_hgrn2_block"


def rmsnorm(x, w):
    xf = x.astype(jnp.float32)
    return xf * lax.rsqrt(jnp.mean(xf * xf, axis=-1, keepdims=True) + EPS) * w.astype(jnp.float32)


def causal_dwconv(x, w, b):
    K = w.shape[0]
    S = x.shape[1]
    xp = jnp.pad(x, ((0, 0), (K - 1, 0), (0, 0)))
    y = xp[:, 0:S, :] * w[0]
    for k in range(1, K):
        y = y + xp[:, k:k + S, :] * w[k]
    return y + b


def to_chunks(x, L):
    Bn, S = x.shape[0], x.shape[1]
    x = x.reshape((Bn, S // L, L) + x.shape[2:])
    perm = (1, 0, 3, 2) + tuple(range(4, x.ndim))
    return x.transpose(perm)


def from_chunks(y):
    NC, Bn, H, L, d = y.shape
    return y.transpose(1, 0, 3, 2, 4).reshape(Bn, NC * L, H, d)


def mlstm_chunkwise(q, k, v, i_pre, f_pre):
    L = ML_CHUNK
    Bn, S, H, dqk = q.shape
    dv = v.shape[-1]
    k = k * (dqk ** -0.5)
    logf = jax.nn.log_sigmoid(f_pre)
    xs = (to_chunks(q, L), to_chunks(k, L), to_chunks(v, L), to_chunks(i_pre, L), to_chunks(logf, L))
    causal = jnp.tril(jnp.ones((L, L), dtype=bool))

    def step(carry, inp):
        C, n, m = carry
        qc, kc, vc, ig, lf = inp
        b = jnp.cumsum(lf, axis=-1)
        logD = jnp.where(causal, b[..., :, None] - b[..., None, :] + ig[..., None, :], -jnp.inf)
        inter_log = b + m[..., None]
        m_t = jnp.maximum(inter_log, jnp.max(logD, axis=-1))
        scores = jnp.einsum('bhtd,bhjd->bhtj', qc, kc) * jnp.exp(logD - m_t[..., None])
        w_inter = jnp.exp(inter_log - m_t)
        num = (jnp.einsum('bhtj,bhjv->bhtv', scores, vc)
               + w_inter[..., None] * jnp.einsum('bhtd,bhdv->bhtv', qc, C))
        den = jnp.sum(scores, axis=-1) + w_inter * jnp.einsum('bhtd,bhd->bht', qc, n)
        h = num / jnp.maximum(jnp.abs(den), jnp.exp(-m_t))[..., None]
        g = b[..., -1]
        a = g[..., None] - b + ig
        m_new = jnp.maximum(g + m, jnp.max(a, axis=-1))
        wa = jnp.exp(a - m_new[..., None])
        ws = jnp.exp(g + m - m_new)
        C_new = ws[..., None, None] * C + jnp.einsum('bhj,bhjd,bhjv->bhdv', wa, kc, vc)
        n_new = ws[..., None] * n + jnp.einsum('bhj,bhjd->bhd', wa, kc)
        return (C_new, n_new, m_new), h

    init = (jnp.zeros((Bn, H, dqk, dv), jnp.float32),
            jnp.zeros((Bn, H, dqk), jnp.float32),
            jnp.zeros((Bn, H), jnp.float32))
    _, hs = lax.scan(step, init, xs)
    return from_chunks(hs)


def hgrn2_chunkwise(q, k, logf, iv):
    L = HG_CHUNK
    Bn, S, H, E = q.shape
    dv = iv.shape[-1]
    xs = (to_chunks(q, L), to_chunks(k, L), to_chunks(logf, L), to_chunks(iv, L))
    causal = jnp.tril(jnp.ones((L, L), dtype=bool))[:, :, None]

    def step(Sst, inp):
        qc, kc, lf, vc = inp
        b = jnp.cumsum(lf, axis=2)
        decay = jnp.exp(jnp.where(causal, b[:, :, :, None, :] - b[:, :, None, :, :], -jnp.inf))
        A = jnp.einsum('bhte,bhje,bhtje->bhtj', qc, kc, decay)
        o = (jnp.einsum('bhtj,bhjv->bhtv', A, vc)
             + jnp.einsum('bhte,bhev->bhtv', qc * jnp.exp(b), Sst))
        g = b[:, :, -1, :]
        S_new = (jnp.exp(g)[..., None] * Sst
                 + jnp.einsum('bhje,bhjv->bhev', kc * jnp.exp(g[:, :, None, :] - b), vc))
        return S_new, o

    _, os_ = lax.scan(step, jnp.zeros((Bn, H, E, dv), jnp.float32), xs)
    return from_chunks(os_)


def setup_inputs(seed: int = 0) -> dict:
    key = jax.random.key(seed)
    ks = jax.random.split(key, 16)
    f32 = jnp.float32
    nrm = lambda k, shape, s: jax.random.normal(k, shape, f32) * s
    x = jax.random.normal(ks[0], (BATCH, SEQ, D_MODEL), f32)
    p = jax.random.normal(ks[1], (DEPTH, BATCH, SEQ, PE_DIM), f32)
    norm_w = 1.0 + nrm(ks[2], (DEPTH, D_MODEL), 0.05)
    w_in = nrm(ks[3], (DEPTH, D_MODEL, IN_COLS), D_MODEL ** -0.5)
    conv_w = nrm(ks[4], (DEPTH, ML_CONV, 2 * ML_QK), ML_CONV ** -0.5)
    conv_b = nrm(ks[5], (DEPTH, 2 * ML_QK), 0.02)
    ml_b_i = nrm(ks[6], (DEPTH, ML_HEADS), 0.1)
    ml_b_f = jnp.linspace(3.0, 6.0, ML_HEADS, dtype=f32)[None, :] + nrm(ks[7], (DEPTH, ML_HEADS), 0.1)
    ml_norm_w = 1.0 + nrm(ks[8], (DEPTH, ML_WIDTH), 0.05)
    hg_lb = nrm(ks[9], (DEPTH + 1, HG_FDIM), 0.1)
    hg_norm_w = 1.0 + nrm(ks[10], (DEPTH, HG_WIDTH), 0.05)
    w_out = nrm(ks[11], (DEPTH, MIX_WIDTH, D_MODEL), MIX_WIDTH ** -0.5)
    pe_norm_w = 1.0 + nrm(ks[12], (DEPTH, D_MODEL), 0.05)
    w_pg = nrm(ks[13], (DEPTH, D_MODEL, D_MODEL), D_MODEL ** -0.5)
    w_pe = nrm(ks[14], (DEPTH, PE_DIM, D_MODEL), PE_DIM ** -0.5)
    final_norm_w = 1.0 + nrm(ks[15], (D_MODEL,), 0.05)
    return {"x": x, "p": p, "norm_w": norm_w, "w_in": w_in, "conv_w": conv_w,
            "conv_b": conv_b, "ml_b_i": ml_b_i, "ml_b_f": ml_b_f, "ml_norm_w": ml_norm_w,
            "hg_lb": hg_lb, "hg_norm_w": hg_norm_w, "w_out": w_out, "pe_norm_w": pe_norm_w,
            "w_pg": w_pg, "w_pe": w_pe, "final_norm_w": final_norm_w}


def reference(x, p, norm_w, w_in, conv_w, conv_b, ml_b_i, ml_b_f, ml_norm_w,
              hg_lb, hg_norm_w, w_out, pe_norm_w, w_pg, w_pe, final_norm_w):
    Bn, S, _ = x.shape
    split_points = [int(s) for s in np.cumsum(SPLIT_SIZES)[:-1]]
    lb_all = jnp.cumsum(jax.nn.softmax(hg_lb.astype(jnp.float32), axis=0), axis=0)
    h = x.astype(jnp.float32)
    for l in range(DEPTH):
        u = rmsnorm(h, norm_w[l])
        proj = jnp.einsum('bsd,dc->bsc', u, w_in[l].astype(jnp.float32))
        (ml_q, ml_k, ml_v, ml_o, ml_z, ml_i, ml_f,
         hg_q, hg_f, hg_i, hg_g) = jnp.split(proj, split_points, axis=-1)

        qk = jax.nn.silu(causal_dwconv(jnp.concatenate([ml_q, ml_k], axis=-1),
                                       conv_w[l].astype(jnp.float32), conv_b[l].astype(jnp.float32)))
        q_a = qk[..., :ML_QK].reshape(Bn, S, ML_HEADS, ML_DQK)
        k_a = qk[..., ML_QK:].reshape(Bn, S, ML_HEADS, ML_DQK)
        v_a = ml_v.reshape(Bn, S, ML_HEADS, ML_DV)
        i_pre = ml_i + ml_b_i[l].astype(jnp.float32)
        f_pre = ml_f + ml_b_f[l].astype(jnp.float32)
        h_a = mlstm_chunkwise(q_a, k_a, v_a, i_pre, f_pre)
        h_a = rmsnorm(h_a, ml_norm_w[l].reshape(ML_HEADS, ML_DV)).reshape(Bn, S, ML_WIDTH)
        y_a = jax.nn.sigmoid(ml_o) * h_a * jax.nn.silu(ml_z)

        lb = lb_all[l]
        f_b = lb + (1.0 - lb) * jax.nn.sigmoid(hg_f)
        logf_b = jnp.log(f_b).reshape(Bn, S, HG_HEADS, HG_EXPAND)
        k_b = ((1.0 - lb) * jax.nn.sigmoid(-hg_f)).reshape(Bn, S, HG_HEADS, HG_EXPAND)
        q_b = hg_q.reshape(Bn, S, HG_HEADS, HG_EXPAND)
        i_b = hg_i.reshape(Bn, S, HG_HEADS, HG_DV)
        h_b = hgrn2_chunkwise(q_b, k_b, logf_b, i_b)
        h_b = rmsnorm(h_b, hg_norm_w[l].reshape(HG_HEADS, HG_DV)).reshape(Bn, S, HG_WIDTH)
        y_b = h_b * jax.nn.silu(hg_g)

        y = jnp.concatenate([y_a, y_b], axis=-1)
        h = h + jnp.einsum('bsc,cd->bsd', y, w_out[l].astype(jnp.float32))

        e = jnp.einsum('bsr,rd->bsd', p[l].astype(jnp.float32), w_pe[l].astype(jnp.float32))
        gate = jax.nn.sigmoid(jnp.einsum('bsd,de->bse', rmsnorm(h, pe_norm_w[l]), w_pg[l].astype(jnp.float32)))
        h = h + gate * e
    out = rmsnorm(h, final_norm_w)
    return out.astype(x.dtype)
```

```cpp
#include <hip/hip_runtime.h>
#include <cstdio>
#include <cstdint>
namespace pg8 {
#define PG8_LAS __attribute__((address_space(3)))
typedef unsigned short bf16_t;
typedef short bf16x8 __attribute__((ext_vector_type(8)));
typedef float f32x4 __attribute__((ext_vector_type(4)));
typedef unsigned u32x4 __attribute__((ext_vector_type(4)));
constexpr int BM = 256, BK = 64, HALF = 128, HTB = HALF * BK * 2  , STAGE_BYTES = 8 * HTB, NXCD = 8, WGM = 8;

__host__ __device__ __forceinline__ int lds_byte(int r, int c) { const int st = (r >> 4) * 2 + (c >> 5), rr = r & 15, cc = c & 31, ob = rr * 64 + cc * 2; return st * 1024 + (ob ^ (((ob >> 9) & 1) << 5)); }
__host__ __device__ __forceinline__ void stage_rc(int b, int& R, int& C) { const int st = b / 1024, sb = b % 1024, swz = sb ^ (((sb >> 9) & 1) << 5); R = (st >> 1) * 16 + swz / 64; C = (st & 1) * 32 + (swz % 64) / 2; }
__host__ __device__ __forceinline__ int perm32(int rho) { const int n = rho >> 4, i = rho & 15; return 8 * (i >> 2) + 4 * n + (i & 3); }

struct Unit { int pm, pn; };
struct Gemm { const bf16_t* A; const bf16_t* Bt; int M, N, K; };

struct StaticOrder {
    int nM, nN, nwg, G, c;
    __host__ __device__ void init(int M, int N, int G_, int c_) { nM = M / BM; nN = N / BM; nwg = nM * nN; G = G_; c = c_; }
    __host__ __device__ bool next(int i, Unit& u) const {
        const long L = (long)i * G + c; if (L >= nwg) return false;
        int wgid = (int)L; { const int q = nwg / NXCD, r = nwg % NXCD, xcd = wgid % NXCD, off = wgid / NXCD; wgid = (xcd < r ? xcd * (q + 1) : r * (q + 1) + (xcd - r) * q) + off; }
        const int nig = WGM * nN, gid = wgid / nig, fm = gid * WGM, gsz = (nM - fm) < WGM ? (nM - fm) : WGM;
        u.pm = fm + ((wgid % nig) % gsz); u.pn = (wgid % nig) / gsz; return true;
    }
    __device__ __forceinline__ void a_ready(const Unit&) const {}
    __device__ __forceinline__ void done(const Unit&) const {}
};

__device__ __forceinline__ unsigned cvt_pk_bf16(float lo, float hi) { unsigned r; asm volatile("v_cvt_pk_bf16_f32 %0, %1, %2" : "=v"(r) : "v"(lo), "v"(hi)); return r; }
typedef float f32x2 __attribute__((ext_vector_type(2)));
__device__ __forceinline__ f32x2 gelu_pk(f32x2 v) {
    const f32x2 av = __builtin_elementwise_abs(v), d = av * 0.2316418882f + 1.0f;
    f32x2 t; t.x = __builtin_amdgcn_rcpf(d.x); t.y = __builtin_amdgcn_rcpf(d.y);
    f32x2 q = t * 0.5307027145f + (-0.7265760135f); q = q * t + 0.7107068705f; q = q * t + (-0.142248368f); q = q * t + 0.127414796f; q = q * t;
    const f32x2 s = (v * v) * (-0.72134752044f);
    f32x2 e; e.x = __builtin_amdgcn_exp2f(s.x); e.y = __builtin_amdgcn_exp2f(s.y);
    const f32x2 m = v * (q * e), r = v - m;
    f32x2 o; o.x = v.x < 0.f ? m.x : r.x; o.y = v.y < 0.f ? m.y : r.y; return o;
}

template <int ACT  > struct EpiBf16 {
    static constexpr bool PERM = true, AFTER_DRAIN = false; static_assert(ACT == 0 || ACT == 1, "EpiBf16: ACT is 0 (none) or 1 (gelu_pk)");
    bf16_t* O; int ldc; const float* bias; int split_cols; size_t split_stride; float scale0;
    __device__ __forceinline__ void operator()(const f32x4 (&acc)[2][2][4][2], const Unit& u, int wr, int wc, int fr, int fq) const {
        const int row0 = u.pm * BM + wr * 64 + fr; int colt = u.pn * BM; bf16_t* base = O;
        float sc = 1.f; if (split_cols) { const int t = colt / split_cols; base += (size_t)t * split_stride; colt -= t * split_cols; if (t == 0) sc = scale0; }
        const int col0 = colt + wc * 32 + 8 * fq, bcol0 = u.pn * BM + wc * 32 + 8 * fq;
        f32x4 bv[2][2];
#pragma unroll
        for (int bj = 0; bj < 2; ++bj)
#pragma unroll
            for (int n = 0; n < 2; ++n) bv[bj][n] = bias ? *(const f32x4*)(bias + bcol0 + bj * HALF + 4 * n) : (f32x4){0.f, 0.f, 0.f, 0.f};
#pragma unroll
        for (int ai = 0; ai < 2; ++ai)
#pragma unroll
            for (int m = 0; m < 4; ++m) { bf16_t* rowp = base + (size_t)(row0 + ai * HALF + m * 16) * ldc + col0;
#pragma unroll
                for (int bj = 0; bj < 2; ++bj) { f32x4 v0 = acc[ai][bj][m][0] + bv[bj][0], v1 = acc[ai][bj][m][1] + bv[bj][1];
                    if (ACT == 1) { f32x2 a = gelu_pk((f32x2){v0[0], v0[1]}), b = gelu_pk((f32x2){v0[2], v0[3]}), c = gelu_pk((f32x2){v1[0], v1[1]}), d = gelu_pk((f32x2){v1[2], v1[3]});
                        v0 = (f32x4){a.x, a.y, b.x, b.y}; v1 = (f32x4){c.x, c.y, d.x, d.y}; }
                    v0 = v0 * sc; v1 = v1 * sc; u32x4 w; w.x = cvt_pk_bf16(v0[0], v0[1]); w.y = cvt_pk_bf16(v0[2], v0[3]); w.z = cvt_pk_bf16(v1[0], v1[1]); w.w = cvt_pk_bf16(v1[2], v1[3]);
                    *(u32x4*)(rowp + bj * HALF) = w; } }
    }
};
__device__ __forceinline__ float bf_lo(unsigned w) { return __uint_as_float(w << 16); }
__device__ __forceinline__ float bf_hi(unsigned w) { return __uint_as_float(w & 0xffff0000u); }
__device__ __forceinline__ float fast_sigmoid(float x) { return __builtin_amdgcn_rcpf(1.0f + __expf(-x)); }
struct EpiRes {
    static constexpr bool PERM = true, AFTER_DRAIN = false;
    const float* x; float* out; bf16_t* hb; float* ssq; int ldc;
    __device__ __forceinline__ void operator()(const f32x4 (&acc)[2][2][4][2], const Unit& u, int wr, int wc, int fr, int fq) const {
        const int row0 = u.pm * BM + wr * 64 + fr, col0 = u.pn * BM + wc * 32 + 8 * fq;
#pragma unroll
        for (int ai = 0; ai < 2; ++ai)
#pragma unroll
            for (int m = 0; m < 4; ++m) { const int row = row0 + ai * HALF + m * 16; const size_t off = (size_t)row * ldc + col0; float ss = 0.f;
#pragma unroll
                for (int bj = 0; bj < 2; ++bj) {
                    const f32x4 x0 = *(const f32x4*)(x + off + bj * HALF), x1 = *(const f32x4*)(x + off + bj * HALF + 4);
                    const f32x4 h0 = x0 + acc[ai][bj][m][0], h1 = x1 + acc[ai][bj][m][1];
                    *(f32x4*)(out + off + bj * HALF) = h0; *(f32x4*)(out + off + bj * HALF + 4) = h1;
                    ss += (h0[0] * h0[0] + h0[1] * h0[1]) + (h0[2] * h0[2] + h0[3] * h0[3]) + (h1[0] * h1[0] + h1[1] * h1[1]) + (h1[2] * h1[2] + h1[3] * h1[3]);
                    u32x4 w; w.x = cvt_pk_bf16(h0[0], h0[1]); w.y = cvt_pk_bf16(h0[2], h0[3]); w.z = cvt_pk_bf16(h1[0], h1[1]); w.w = cvt_pk_bf16(h1[2], h1[3]);
                    *(u32x4*)(hb + off + bj * HALF) = w; }
                ss += __shfl_xor(ss, 16); ss += __shfl_xor(ss, 32);
                if (fq == 0) atomicAdd(ssq + row, ss); }
    }
};
struct EpiGate {
    static constexpr bool PERM = true, AFTER_DRAIN = false;
    float* out; const bf16_t* e; float* ssq_h; float* ssq2; int ldc; float inv_n, eps;
    __device__ __forceinline__ void operator()(const f32x4 (&acc)[2][2][4][2], const Unit& u, int wr, int wc, int fr, int fq) const {
        const int row0 = u.pm * BM + wr * 64 + fr, col0 = u.pn * BM + wc * 32 + 8 * fq;
#pragma unroll
        for (int ai = 0; ai < 2; ++ai)
#pragma unroll
            for (int m = 0; m < 4; ++m) { const int row = row0 + ai * HALF + m * 16; const size_t off = (size_t)row * ldc + col0; float ss = 0.f;
                const float sq = __hip_atomic_load(ssq_h + row, __ATOMIC_RELAXED, __HIP_MEMORY_SCOPE_AGENT);
                const float rstd = 1.0f / sqrtf(sq * inv_n + eps);
#pragma unroll
                for (int bj = 0; bj < 2; ++bj) {
                    const f32x4 h0 = *(const f32x4*)(out + off + bj * HALF), h1 = *(const f32x4*)(out + off + bj * HALF + 4);
                    const u32x4 ev = *(const u32x4*)(e + off + bj * HALF);
                    const f32x4 a0 = acc[ai][bj][m][0] * rstd, a1 = acc[ai][bj][m][1] * rstd;
                    f32x4 o0, o1;
                    o0[0] = h0[0] + fast_sigmoid(a0[0]) * bf_lo(ev.x); o0[1] = h0[1] + fast_sigmoid(a0[1]) * bf_hi(ev.x);
                    o0[2] = h0[2] + fast_sigmoid(a0[2]) * bf_lo(ev.y); o0[3] = h0[3] + fast_sigmoid(a0[3]) * bf_hi(ev.y);
                    o1[0] = h1[0] + fast_sigmoid(a1[0]) * bf_lo(ev.z); o1[1] = h1[1] + fast_sigmoid(a1[1]) * bf_hi(ev.z);
                    o1[2] = h1[2] + fast_sigmoid(a1[2]) * bf_lo(ev.w); o1[3] = h1[3] + fast_sigmoid(a1[3]) * bf_hi(ev.w);
                    *(f32x4*)(out + off + bj * HALF) = o0; *(f32x4*)(out + off + bj * HALF + 4) = o1;
                    ss += (o0[0] * o0[0] + o0[1] * o0[1]) + (o0[2] * o0[2] + o0[3] * o0[3]) + (o1[0] * o1[0] + o1[1] * o1[1]) + (o1[2] * o1[2] + o1[3] * o1[3]); }
                ss += __shfl_xor(ss, 16); ss += __shfl_xor(ss, 32);
                if (fq == 0) atomicAdd(ssq2 + row, ss); }
    }
};
template <class Epi, class Sched, bool ALIGN_EPI = false, bool SP2 = false>
__device__ __forceinline__ void gemm_phase(PG8_LAS unsigned char* lds, const Gemm g, const Sched& S, const Epi& E) {
    const int tid = threadIdx.x, wid = __builtin_amdgcn_readfirstlane(tid >> 6), lane = tid & 63, wr = wid >> 2, wc = wid & 3, fr = lane & 15, fq = lane >> 4;
    const int K = g.K, nt = K / BK;
    unsigned voffA[2], voffB[2];
#pragma unroll
    for (int i = 0; i < 2; ++i) { int R, C; stage_rc(tid * 16 + i * 8192, R, C); const int Rb = Epi::PERM ? ((R & ~31) + perm32(R & 31)) : R;
        voffA[i] = (unsigned)(R * K + C) * 2u; voffB[i] = (unsigned)(Rb * K + C) * 2u; }
    const size_t kstep = (size_t)(BK * 2);
    const size_t hstep = (size_t)HALF * K * 2;
    const size_t tstep = 2 * hstep;
    const unsigned ldsw = (unsigned)wid * 1024u;
    const int aoff = lds_byte(wr * 64 + fr, fq * 8), boff = lds_byte(wc * 32 + fr, fq * 8);
#define PG8_SA(b, h) (((b) * 2 + (h)) * HTB)
#define PG8_SB(b, h) ((4 + (b) * 2 + (h)) * HTB)
#define PG8_STAGE(bufoff, gbase, voff) do { _Pragma("unroll") for (int _i = 0; _i < 2; ++_i) \
        __builtin_amdgcn_global_load_lds((const unsigned*)((const char*)(gbase) + (voff)[_i]), (PG8_LAS unsigned*)(lds + (bufoff) + ldsw + _i * 8192), 16, 0, 0); } while (0)
#define PG8_LDA(dst, b, h) do { _Pragma("unroll") for (int m = 0; m < 4; ++m) _Pragma("unroll") for (int k = 0; k < 2; ++k) dst[m][k] = *(const PG8_LAS bf16x8*)(lds + PG8_SA(b, h) + aoff + m * 2048 + k * 1024); } while (0)
#define PG8_LDB(dst, b, h) do { _Pragma("unroll") for (int n = 0; n < 2; ++n) _Pragma("unroll") for (int k = 0; k < 2; ++k) dst[n][k] = *(const PG8_LAS bf16x8*)(lds + PG8_SB(b, h) + boff + n * 2048 + k * 1024); } while (0)
#define PG8_MMA(ai, bj, At, Bt) do { __builtin_amdgcn_s_setprio(1); _Pragma("unroll") for (int m = 0; m < 4; ++m) _Pragma("unroll") for (int n = 0; n < 2; ++n) _Pragma("unroll") for (int k = 0; k < 2; ++k) \
        acc[ai][bj][m][n] = __builtin_amdgcn_mfma_f32_16x16x32_bf16(Bt[n][k], At[m][k], acc[ai][bj][m][n], 0, 0, 0); __builtin_amdgcn_s_setprio(0); } while (0)
#define PG8_WAIT_V(n) asm volatile("s_waitcnt vmcnt(" #n ")" ::: "memory")
#define PG8_WAIT_L(n) asm volatile("s_waitcnt lgkmcnt(" #n ")" ::: "memory")
#define PG8_BAR __builtin_amdgcn_s_barrier()
#define PG8_SCHED __builtin_amdgcn_sched_barrier(0)
    Unit cur, nxt; int ui = 0;
    if (!S.next(0, cur)) return;
    f32x4 acc[2][2][4][2];
#pragma unroll
    for (int a = 0; a < 2; ++a)
#pragma unroll
        for (int b = 0; b < 2; ++b)
#pragma unroll
            for (int m = 0; m < 4; ++m)
#pragma unroll
                for (int n = 0; n < 2; ++n) acc[a][b][m][n] = (f32x4){0.f, 0.f, 0.f, 0.f};
    bf16x8 At[4][2], B0[2][2], B1[2][2];
    const char* cA = (const char*)g.A + (size_t)cur.pm * tstep; const char* cB = (const char*)g.Bt + (size_t)cur.pn * tstep;
    S.a_ready(cur);
    if constexpr (SP2) {
        PG8_STAGE(PG8_SB(0, 0), cB, voffB); PG8_STAGE(PG8_SB(0, 1), cB + hstep, voffB); PG8_STAGE(PG8_SA(0, 0), cA, voffA); PG8_STAGE(PG8_SA(0, 1), cA + hstep, voffA);
        if (wr == 1) PG8_BAR;
        PG8_WAIT_V(2); PG8_BAR;
        PG8_STAGE(PG8_SB(1, 0), cB + kstep, voffB); PG8_STAGE(PG8_SA(1, 0), cA + kstep, voffA); PG8_STAGE(PG8_SB(1, 1), cB + hstep + kstep, voffB);
        PG8_WAIT_V(6); PG8_BAR;
    } else {
        PG8_STAGE(PG8_SB(0, 0), cB, voffB); PG8_STAGE(PG8_SA(0, 0), cA, voffA); PG8_STAGE(PG8_SB(0, 1), cB + hstep, voffB); PG8_STAGE(PG8_SA(0, 1), cA + hstep, voffA);
        if (wr == 1) PG8_BAR;
        PG8_WAIT_V(4); PG8_BAR;
        PG8_STAGE(PG8_SB(1, 0), cB + kstep, voffB); PG8_STAGE(PG8_SA(1, 0), cA + kstep, voffA); PG8_STAGE(PG8_SB(1, 1), cB + hstep + kstep, voffB);
        PG8_WAIT_V(6); PG8_BAR;
    }
    for (;;) {
        const bool has_next = S.next(ui + 1, nxt);
        const char* nA = has_next ? (const char*)g.A + (size_t)nxt.pm * tstep : cA; const char* nB = has_next ? (const char*)g.Bt + (size_t)nxt.pn * tstep : cB;
        for (int t = 0; t < nt; t += 2) {
            const bool last = (t == nt - 2);
            const char* a1 = cA + (size_t)(t + 1) * kstep;
            const char* a2 = last ? nA : cA + (size_t)(t + 2) * kstep; const char* b2 = last ? nB : cB + (size_t)(t + 2) * kstep;
            const char* a3 = a2 + kstep; const char* b3 = b2 + kstep;
            if (last && has_next) S.a_ready(nxt);
            if constexpr (SP2) {
            PG8_LDB(B0, 0, 0); PG8_LDB(B1, 0, 1); PG8_SCHED; PG8_LDA(At, 0, 0); PG8_STAGE(PG8_SA(1, 1), a1 + hstep, voffA);
            PG8_WAIT_V(8); PG8_WAIT_L(0); PG8_BAR; PG8_MMA(0, 0, At, B0); PG8_MMA(0, 1, At, B1); PG8_BAR; PG8_SCHED;
            PG8_LDA(At, 0, 1); PG8_STAGE(PG8_SB(0, 0), b2, voffB); PG8_STAGE(PG8_SB(0, 1), b2 + hstep, voffB); PG8_STAGE(PG8_SA(0, 0), a2, voffA);
            PG8_WAIT_V(8); PG8_WAIT_L(0); PG8_BAR; PG8_MMA(1, 0, At, B0); PG8_MMA(1, 1, At, B1); PG8_BAR; PG8_SCHED;
            PG8_LDB(B0, 1, 0); PG8_LDB(B1, 1, 1); PG8_SCHED; PG8_LDA(At, 1, 0); PG8_STAGE(PG8_SA(0, 1), a2 + hstep, voffA);
            PG8_WAIT_V(8); PG8_WAIT_L(0); PG8_BAR; PG8_MMA(0, 0, At, B0); PG8_MMA(0, 1, At, B1); PG8_BAR; PG8_SCHED;
            PG8_LDA(At, 1, 1); PG8_STAGE(PG8_SB(1, 0), b3, voffB); PG8_STAGE(PG8_SB(1, 1), b3 + hstep, voffB); PG8_STAGE(PG8_SA(1, 0), a3, voffA);
            PG8_WAIT_V(8); PG8_WAIT_L(0); PG8_BAR; PG8_MMA(1, 0, At, B0); PG8_MMA(1, 1, At, B1); PG8_BAR; PG8_SCHED;
            } else {
            PG8_LDB(B0, 0, 0); PG8_SCHED; PG8_LDA(At, 0, 0); PG8_STAGE(PG8_SA(1, 1), a1 + hstep, voffA);
            PG8_WAIT_L(8); PG8_BAR; PG8_WAIT_L(0); PG8_MMA(0, 0, At, B0); PG8_BAR; PG8_SCHED;
            PG8_LDB(B1, 0, 1); PG8_STAGE(PG8_SB(0, 0), b2, voffB);
            PG8_BAR; PG8_WAIT_L(0); PG8_MMA(0, 1, At, B1); PG8_BAR;
            PG8_LDA(At, 0, 1); PG8_STAGE(PG8_SA(0, 0), a2, voffA);
            PG8_BAR; PG8_WAIT_L(0); PG8_MMA(1, 0, At, B0); PG8_BAR; PG8_SCHED;
            PG8_STAGE(PG8_SB(0, 1), b2 + hstep, voffB);
            PG8_WAIT_V(6); PG8_BAR; PG8_MMA(1, 1, At, B1); PG8_BAR;
            PG8_LDB(B0, 1, 0); PG8_SCHED; PG8_LDA(At, 1, 0); PG8_STAGE(PG8_SA(0, 1), a2 + hstep, voffA);
            PG8_WAIT_L(8); PG8_BAR; PG8_WAIT_L(0); PG8_MMA(0, 0, At, B0); PG8_BAR; PG8_SCHED;
            PG8_LDB(B1, 1, 1); PG8_STAGE(PG8_SB(1, 0), b3, voffB);
            PG8_BAR; PG8_WAIT_L(0); PG8_MMA(0, 1, At, B1); PG8_BAR;
            PG8_LDA(At, 1, 1); PG8_STAGE(PG8_SA(1, 0), a3, voffA);
            PG8_BAR; PG8_WAIT_L(0); PG8_MMA(1, 0, At, B0); PG8_BAR; PG8_SCHED;
            PG8_STAGE(PG8_SB(1, 1), b3 + hstep, voffB);
            PG8_WAIT_V(6); PG8_BAR; PG8_MMA(1, 1, At, B1); PG8_BAR;
            }
        }
        if constexpr (ALIGN_EPI) { if (wr == 0) PG8_BAR; }
        if constexpr (!Epi::AFTER_DRAIN) { E(acc, cur, wr, wc, fr, fq); S.done(cur); }
        if (!has_next) break;
#pragma unroll
        for (int a = 0; a < 2; ++a)
#pragma unroll
            for (int b = 0; b < 2; ++b)
#pragma unroll
                for (int m = 0; m < 4; ++m)
#pragma unroll
                    for (int n = 0; n < 2; ++n) acc[a][b][m][n] = (f32x4){0.f, 0.f, 0.f, 0.f};
        cur = nxt; cA = nA; cB = nB; ++ui;
        if constexpr (ALIGN_EPI) { if (wr == 1) PG8_BAR; }
    }
    PG8_WAIT_V(0);
    if constexpr (!ALIGN_EPI) { if (wr == 0) PG8_BAR; }
    PG8_BAR;
    if constexpr (Epi::AFTER_DRAIN) { E.fused(acc, cur, wr, wc, fr, fq, lds, wid, lane); S.done(cur); }
#undef PG8_SA
#undef PG8_SB
#undef PG8_STAGE
#undef PG8_LDA
#undef PG8_LDB
#undef PG8_MMA
#undef PG8_WAIT_V
#undef PG8_WAIT_L
#undef PG8_BAR
#undef PG8_SCHED
}
}
constexpr int NWAVES = 8, NTHR = 512;
#ifndef MK_N_LAUNCHES
#define MK_N_LAUNCHES 8
#endif
constexpr int N_LAUNCHES = MK_N_LAUNCHES;
constexpr int PER_PHASE = 8;
constexpr int BATCH = 2, SEQ = 16384, DM = 2048, M = BATCH * SEQ, NCH = SEQ / 64;
constexpr int IN_COLS = 8200, PE = 256, NNAT = 6144, NTR = 2048;
constexpr float EPS = 1e-6f;
constexpr int PC_Q = 0, PC_K = 512, PC_O = 1024, PC_Z = 2048, PC_HQ = 3072, PC_HF = 4096, PC_HG = 5120;
constexpr size_t MiB = 1u << 20;
constexpr size_t WS_CTL = 0, CTL_ZERO_BYTES = 1 * MiB;
constexpr size_t WS_SSQH = 256 * 1024, WS_SSQ2 = 512 * 1024;
constexpr size_t WS_WIN = 2 * MiB, WS_WO = 34 * MiB, WS_WG = 42 * MiB, WS_WE = 50 * MiB;
constexpr size_t WS_GATES = 52 * MiB;
constexpr size_t WS_BCUM = 53 * MiB;
constexpr size_t WS_MSC = 54 * MiB;
constexpr size_t WS_NST = 55 * MiB;
constexpr size_t WS_GDEC = 56 * MiB;
constexpr size_t WS_PB = 64 * MiB;
constexpr size_t WS_U = 80 * MiB;
constexpr size_t WS_PROJ = 208 * MiB;
constexpr size_t WS_VT = 592 * MiB;
constexpr size_t WS_END = 720 * MiB;
constexpr int CW_TMO = 0, CW_BAR = 4096;
constexpr int RING_BYTES = 131072, LDSCTL_OFF = RING_BYTES, MISC_OFF = LDSCTL_OFF + 320, LDS_BYTES = 147456;

#define GAS __attribute__((address_space(1)))
#define LAS __attribute__((address_space(3)))
typedef unsigned short bf16;
typedef unsigned v4u __attribute__((ext_vector_type(4)));
typedef unsigned v2u __attribute__((ext_vector_type(2)));
typedef float f32x4 __attribute__((ext_vector_type(4)));
typedef float f32x16 __attribute__((ext_vector_type(16)));
typedef short bf16x8 __attribute__((ext_vector_type(8)));
typedef GAS unsigned gu32;
#define RLX_AGENT __ATOMIC_RELAXED, __HIP_MEMORY_SCOPE_AGENT
#define LDS_WAIT() asm volatile("s_waitcnt lgkmcnt(0)" ::: "memory")
#define VM_WAIT() asm volatile("s_waitcnt vmcnt(0)" ::: "memory")
typedef __bf16 bf16x2_t __attribute__((ext_vector_type(2)));
__device__ __forceinline__ unsigned pk2(float lo, float hi) { bf16x2_t v; v[0] = (__bf16)lo; v[1] = (__bf16)hi; return __builtin_bit_cast(unsigned, v); }
__device__ __forceinline__ float bf2f(bf16 v) { return __uint_as_float((unsigned)v << 16); }
__device__ __forceinline__ float blo(unsigned w) { return __uint_as_float(w << 16); }
__device__ __forceinline__ float bhi(unsigned w) { return __uint_as_float(w & 0xffff0000u); }
__device__ __forceinline__ float sigm(float x) { return 1.0f / (1.0f + __expf(-x)); }

#define XB_TMO      128
#define XB_XCNT(j)  (256  + 64 * (j))
#define XB_XSUB(j)  (1280 + 64 * (j))
#define XB_XGEN(j)  (2304 + 64 * (j))
#define XB_TOP      3328
#define XB_TOPGEN   3392
#define XCD_BAR_WORDS 3456
#define XB_SPIN_CAP (1u << 18)
__device__ __forceinline__ unsigned xb_ld(unsigned* p)              { return __hip_atomic_load(p, __ATOMIC_RELAXED, __HIP_MEMORY_SCOPE_AGENT); }
__device__ __forceinline__ unsigned xb_add(unsigned* p, unsigned v) { return __hip_atomic_fetch_add(p, v, __ATOMIC_RELAXED, __HIP_MEMORY_SCOPE_AGENT); }
__device__ __forceinline__ unsigned xb_xcc_id() { return (unsigned)__builtin_amdgcn_s_getreg((3 << 11) | 20) & 0xFu; }
#define XB_SPIN(cond, bar) do { unsigned _sp = 0; while (cond) { __builtin_amdgcn_s_sleep(1); \
    if ((++_sp & 255u) == 0u) { if (xb_ld(&(bar)[XB_TMO])) break; if (_sp > XB_SPIN_CAP) { atomicAdd(&(bar)[XB_TMO], 1u); break; } } } } while (0)
struct XcdBarrier { unsigned* bar; unsigned x; volatile LAS unsigned* st; };
__device__ __forceinline__ XcdBarrier xcd_barrier_post(unsigned* bar, volatile LAS unsigned* st) {
    XcdBarrier b; b.bar = bar; b.x = xb_xcc_id(); b.st = st;
    if (threadIdx.x == 0) (void)xb_add(&bar[XB_XCNT(b.x)], 1u);
    return b;
}
__device__ __forceinline__ void xcd_barrier_complete(unsigned* bar, unsigned x, unsigned& nloc, unsigned& nx) {
    const unsigned G = gridDim.x * gridDim.y * gridDim.z;
    unsigned sum, cnt, mine, sp = 0u;
    for (;;) {
        sum = 0u; cnt = 0u; mine = 0u;
#pragma unroll
        for (unsigned j = 0; j < 16; ++j) { const unsigned c = xb_ld(&bar[XB_XCNT(j)]); sum += c; cnt += (c > 0u) ? 1u : 0u; mine = (j == x) ? c : mine; }
        if (sum == G) break;
        __builtin_amdgcn_s_sleep(1);
        if ((++sp & 255u) == 0u) { if (xb_ld(&bar[XB_TMO])) break; if (sp > XB_SPIN_CAP) { atomicAdd(&bar[XB_TMO], 1u); break; } }
    }
    nloc = mine > 0u ? mine : 1u; nx = cnt > 0u ? cnt : 1u;
}
__device__ __forceinline__ void xcd_barrier(const XcdBarrier& b) {
    asm volatile("s_waitcnt vmcnt(0)" ::: "memory");
    __syncthreads();
    if (threadIdx.x == 0) {
        unsigned* bar = b.bar;
        __builtin_amdgcn_s_waitcnt(0);
        unsigned nloc = b.st[0], nx = b.st[1];
        if (nloc == 0u) { xcd_barrier_complete(bar, b.x, nloc, nx); b.st[0] = nloc; b.st[1] = nx; }
        const unsigned old = xb_add(&bar[XB_XSUB(b.x)], 1u);
        const unsigned gen = old / nloc;
        if (old + 1u == (gen + 1u) * nloc) {
            __builtin_amdgcn_fence(__ATOMIC_RELEASE, "agent");
            asm volatile("s_waitcnt vmcnt(0)" ::: "memory");
            const unsigned og = xb_add(&bar[XB_TOP], 1u);
            const unsigned tg = og / nx;
            if (og + 1u == (tg + 1u) * nx) xb_add(&bar[XB_TOPGEN], 1u);
            else XB_SPIN(xb_ld(&bar[XB_TOPGEN]) == tg, bar);
            __builtin_amdgcn_fence(__ATOMIC_ACQUIRE, "agent");
            xb_add(&bar[XB_XGEN(b.x)], 1u);
            asm volatile("s_waitcnt vmcnt(0)" ::: "memory");
        } else {
            XB_SPIN(xb_ld(&bar[XB_XGEN(b.x)]) == gen, bar);
            __builtin_amdgcn_fence(__ATOMIC_ACQUIRE, "agent");
            asm volatile("s_waitcnt vmcnt(0)" ::: "memory");
        }
    }
    __syncthreads();
}

struct Frame {
    LAS unsigned char* lds;
    int tid, lane, wave, G, bid;
    const float *x, *p, *norm_w, *w_in, *conv_w, *conv_b, *b_i, *b_f, *ml_nw, *hg_lb, *hg_nw, *w_out, *pe_nw, *w_pg, *w_pe, *fin_nw;
    float* out;
    bf16 *Wt_in, *WoT, *WgT, *WeT, *PB, *U, *Y, *PROJ, *HB, *EB, *VT, *Cm, *Ch;
    float *gates, *bcum, *msc, *nst, *gdec, *ssqh, *ssq2;
};
__device__ __forceinline__ float wave_sum(float v) {
#pragma unroll
    for (int o = 1; o < 64; o <<= 1) v += __shfl_xor(v, o);
    return v;
}
__device__ __forceinline__ float wave_max(float v) {
#pragma unroll
    for (int o = 1; o < 64; o <<= 1) v = fmaxf(v, __shfl_xor(v, o));
    return v;
}
__device__ __forceinline__ float wave_scan_sum(float v, int lane) {
#pragma unroll
    for (int o = 1; o < 64; o <<= 1) { const float y = __shfl_up(v, o); if (lane >= o) v += y; }
    return v;
}
__device__ __forceinline__ float wave_scan_max(float v, int lane) {
#pragma unroll
    for (int o = 1; o < 64; o <<= 1) { const float y = __shfl_up(v, o); if (lane >= o) v = fmaxf(v, y); }
    return v;
}
__device__ __forceinline__ f32x16 mfma32(bf16x8 a, bf16x8 b, f32x16 c) { return __builtin_amdgcn_mfma_f32_32x32x16_bf16(a, b, c, 0, 0, 0); }
__device__ __forceinline__ f32x16 zero16() { f32x16 z;
#pragma unroll
    for (int i = 0; i < 16; ++i) z[i] = 0.f;
    return z; }

__device__ __forceinline__ void p0_transpose_item(const float* W, int ldw, int src_col, int K, bf16* WT, int dst_row, const float* kscale, LAS float* scr, int k0, int lane) {
#pragma unroll 8
    for (int i = 0; i < 32; ++i) { const int kk = 2 * i + (lane >> 5); float v = W[(size_t)(k0 + kk) * ldw + src_col + (lane & 31)]; if (kscale) v *= kscale[k0 + kk]; scr[kk * 33 + (lane & 31)] = v; }
    LDS_WAIT(); asm volatile("" ::: "memory");
    const int c = lane & 7;
#pragma unroll
    for (int j = 0; j < 4; ++j) { const int n = (lane >> 3) + 8 * j; const LAS float* s = scr + (8 * c) * 33 + n;
        v4u o; o.x = pk2(s[0 * 33], s[1 * 33]); o.y = pk2(s[2 * 33], s[3 * 33]); o.z = pk2(s[4 * 33], s[5 * 33]); o.w = pk2(s[6 * 33], s[7 * 33]);
        *(v4u*)(WT + (size_t)(dst_row + n) * K + k0 + 8 * c) = o; }
    LDS_WAIT(); asm volatile("" ::: "memory");
}
__device__ __forceinline__ int win_src_col(int r) { return r < 1024 ? r : r < 3072 ? r + 1024 : r < 5120 ? r + 1032 : r < 6144 ? r + 2056 : r < 7168 ? r - 5120 : r - 1016; }
__device__ __forceinline__ void p0_prologue(const Frame& F) {
    LAS float* scr = (LAS float*)(F.lds + F.wave * 16384);
    const int gw = F.bid * NWAVES + F.wave, NGW = F.G * NWAVES, lane = F.lane;
    for (int it = gw; it < 12544; it += NGW) {
        int r = it;
        if (r < 8192) { const int kb = r >> 8, nb = r & 255; p0_transpose_item(F.w_in, IN_COLS, win_src_col(nb * 32), DM, F.Wt_in, nb * 32, nullptr, scr, kb * 64, lane); continue; } r -= 8192;
        if (r < 2048) { const int kb = r >> 6, nb = r & 63; p0_transpose_item(F.w_out, DM, nb * 32, DM, F.WoT, nb * 32, nullptr, scr, kb * 64, lane); continue; } r -= 2048;
        if (r < 2048) { const int kb = r >> 6, nb = r & 63; p0_transpose_item(F.w_pg, DM, nb * 32, DM, F.WgT, nb * 32, F.pe_nw, scr, kb * 64, lane); continue; } r -= 2048;
        { const int kb = r >> 6, nb = r & 63; p0_transpose_item(F.w_pe, DM, nb * 32, PE, F.WeT, nb * 32, nullptr, scr, kb * 64, lane); }
    }
    for (int idx = F.bid * NTHR + F.tid; idx < M * PE / 4; idx += F.G * NTHR) { const f32x4 v = ((const f32x4*)F.p)[idx]; v2u o; o.x = pk2(v[0], v[1]); o.y = pk2(v[2], v[3]); ((v2u*)F.PB)[idx] = o; }
    __syncthreads();
    LAS float* Wg = (LAS float*)F.lds;
    for (int k = F.tid; k < DM; k += NTHR) { const f32x4 a = *(const f32x4*)(F.w_in + (size_t)k * IN_COLS + 4096), b = *(const f32x4*)(F.w_in + (size_t)k * IN_COLS + 4100);
        Wg[0 * DM + k] = a[0]; Wg[1 * DM + k] = a[1]; Wg[2 * DM + k] = a[2]; Wg[3 * DM + k] = a[3]; Wg[4 * DM + k] = b[0]; Wg[5 * DM + k] = b[1]; Wg[6 * DM + k] = b[2]; Wg[7 * DM + k] = b[3]; }
    __syncthreads();
    const f32x4* nwp = (const f32x4*)F.norm_w + lane;
    const float gbias = lane < 4 ? F.b_i[lane & 3] : F.b_f[lane & 3];
    for (int m = gw; m < M; m += NGW) {
        asm volatile("" ::: "memory");
        const f32x4* xr = (const f32x4*)(F.x + (size_t)m * DM) + lane;
        f32x4 t[8]; float ss = 0.f; float ga[8];
#pragma unroll
        for (int c = 0; c < 8; ++c) ga[c] = 0.f;
#pragma unroll
        for (int j = 0; j < 8; ++j) { const f32x4 v = xr[64 * j]; ss += (v[0] * v[0] + v[1] * v[1]) + (v[2] * v[2] + v[3] * v[3]); t[j] = v * nwp[64 * j]; }
#pragma unroll
        for (int j = 0; j < 8; ++j)
#pragma unroll
            for (int c = 0; c < 8; ++c) { const f32x4 w = *(const LAS f32x4*)(Wg + c * DM + 4 * lane + 256 * j); ga[c] += (t[j][0] * w[0] + t[j][1] * w[1]) + (t[j][2] * w[2] + t[j][3] * w[3]); }
        ss = wave_sum(ss); const float rstd = 1.0f / sqrtf(ss * (1.0f / DM) + EPS);
#pragma unroll
        for (int c = 0; c < 8; ++c) ga[c] = wave_sum(ga[c]) * rstd;
        v2u* uo = (v2u*)(F.U + (size_t)m * DM) + lane;
#pragma unroll
        for (int j = 0; j < 8; ++j) { const f32x4 q = t[j] * rstd; v2u o; o.x = pk2(q[0], q[1]); o.y = pk2(q[2], q[3]); uo[64 * j] = o; }
        float gv = ga[0];
        gv = lane == 1 ? ga[1] : gv; gv = lane == 2 ? ga[2] : gv; gv = lane == 3 ? ga[3] : gv; gv = lane == 4 ? ga[4] : gv; gv = lane == 5 ? ga[5] : gv; gv = lane == 6 ? ga[6] : gv; gv = lane == 7 ? ga[7] : gv;
        if (lane < 8) F.gates[(size_t)m * 8 + lane] = gv + gbias;
    }
}
__device__ __forceinline__ void conv_silu_16(const Frame& F, const bf16* src, int ch, bool has_halo, float scale, float (&out)[16]) {
    const float w0 = F.conv_w[ch], w1 = F.conv_w[1024 + ch], w2 = F.conv_w[2048 + ch], w3 = F.conv_w[3072 + ch], cb = F.conv_b[ch];
    float r0 = 0.f, r1 = 0.f, r2 = 0.f;
    if (has_halo) { r0 = bf2f(src[-3 * NNAT]); r1 = bf2f(src[-2 * NNAT]); r2 = bf2f(src[-1 * NNAT]); }
#pragma unroll
    for (int jj = 0; jj < 16; ++jj) { const float xv = bf2f(src[jj * NNAT]); const float cv = cb + w0 * r0 + w1 * r1 + w2 * r2 + w3 * xv; r0 = r1; r1 = r2; r2 = xv; out[jj] = cv * sigm(cv) * scale; }
}
__device__ __forceinline__ void pa_mlstm(const Frame& F, int bh, int c) {
    const int b = bh >> 2, h = bh & 3, m0 = b * SEQ + c * 64, unit = bh * NCH + c, tid = F.tid, lane = F.lane, wave = F.wave;
    LAS bf16* kT = (LAS bf16*)F.lds;
    LAS float* wl = (LAS float*)(F.lds + 18432);
    LAS float* nsum = wl + 64;
    if (wave == 0) {
        const float ig = F.gates[(size_t)(m0 + lane) * 8 + h], fp = F.gates[(size_t)(m0 + lane) * 8 + 4 + h];
        const float lf = fminf(fp, 0.f) - log1pf(expf(-fabsf(fp)));
        const float bc = wave_scan_sum(lf, lane);
        const float g = __shfl(bc, 63);
        const float a = g - bc + ig;
        const float ml = wave_max(a);
        wl[lane] = expf(a - ml);
        F.bcum[(size_t)bh * SEQ + c * 64 + lane] = bc;
        if (lane == 0) { F.msc[unit * 4 + 0] = g; F.msc[unit * 4 + 1] = ml; }
    }
    __syncthreads();
    {
        const int d = tid & 127, jq = tid >> 7;
        float kv[16];
        conv_silu_16(F, F.PROJ + (size_t)(m0 + 16 * jq) * NNAT + PC_K + h * 128 + d, 512 + h * 128 + d, (c | jq) != 0, 0.08838834764831845f, kv);
        float ns = 0.f; unsigned pk[8];
#pragma unroll
        for (int jj = 0; jj < 16; ++jj) { kv[jj] *= wl[16 * jq + jj]; ns += kv[jj]; }
#pragma unroll
        for (int i = 0; i < 8; ++i) pk[i] = pk2(kv[2 * i], kv[2 * i + 1]);
        LAS v4u* dst = (LAS v4u*)(kT + d * 72 + 16 * jq);
        dst[0] = (v4u){pk[0], pk[1], pk[2], pk[3]}; dst[1] = (v4u){pk[4], pk[5], pk[6], pk[7]};
        nsum[jq * 128 + d] = ns;
    }
    __syncthreads();
    if (tid < 128) F.nst[(size_t)unit * 128 + tid] = (nsum[tid] + nsum[128 + tid]) + (nsum[256 + tid] + nsum[384 + tid]);
    {
        const int r32 = lane & 31, hi = lane >> 5;
        f32x16 acc[4];
#pragma unroll
        for (int i = 0; i < 4; ++i) acc[i] = zero16();
        const bf16* vt = F.VT + (size_t)(h * 256 + 32 * wave + r32) * M + m0 + 8 * hi;
#pragma unroll
        for (int ks = 0; ks < 4; ++ks) { const bf16x8 bfr = *(const bf16x8*)(vt + 16 * ks);
#pragma unroll
            for (int dt = 0; dt < 4; ++dt) { const bf16x8 afr = *(const LAS bf16x8*)(kT + (32 * dt + r32) * 72 + 16 * ks + 8 * hi); acc[dt] = mfma32(afr, bfr, acc[dt]); } }
        bf16* dst = F.Cm + ((size_t)unit * 256 + 32 * wave + r32) * 128 + 4 * hi;
#pragma unroll
        for (int dt = 0; dt < 4; ++dt)
#pragma unroll
            for (int q = 0; q < 4; ++q) { v2u w; w.x = pk2(acc[dt][4 * q], acc[dt][4 * q + 1]); w.y = pk2(acc[dt][4 * q + 2], acc[dt][4 * q + 3]); *(v2u*)(dst + 32 * dt + 8 * q) = w; }
    }
    __syncthreads();
}
__device__ __forceinline__ float hg_forget_16(const bf16* srcf, float lb, float (&sg)[16], float (&cum)[16]) {
    float run = 0.f;
#pragma unroll
    for (int jj = 0; jj < 16; ++jj) { const float xv = bf2f(srcf[jj * NNAT]); const float s = sigm(xv); const float f = lb + (1.0f - lb) * s; run += logf(f); sg[jj] = s; cum[jj] = run; }
    return run;
}
__device__ __forceinline__ void pa_hgrn2(const Frame& F, int bh, int c) {
    const int b = bh >> 3, h = bh & 7, m0 = b * SEQ + c * 64, unit = bh * NCH + c, tid = F.tid, lane = F.lane, wave = F.wave;
    LAS bf16* kT = (LAS bf16*)F.lds;
    LAS float* seg = (LAS float*)(F.lds + 18432);
    const int e = tid & 127, jq = tid >> 7;
    const float lb = 1.0f / (1.0f + expf(F.hg_lb[1024 + h * 128 + e] - F.hg_lb[h * 128 + e]));
    float sg[16], cum[16];
    const float run = hg_forget_16(F.PROJ + (size_t)(m0 + 16 * jq) * NNAT + PC_HF + h * 128 + e, lb, sg, cum);
    seg[jq * 128 + e] = run;
    __syncthreads();
    {
        const float s0 = seg[e], s1 = seg[128 + e], s2 = seg[256 + e], s3 = seg[384 + e];
        const float off = jq == 0 ? 0.f : jq == 1 ? s0 : jq == 2 ? s0 + s1 : s0 + s1 + s2;
        const float g = (s0 + s1) + (s2 + s3);
        unsigned pk[8];
#pragma unroll
        for (int i = 0; i < 8; ++i) { const float k0 = (1.0f - lb) * (1.0f - sg[2 * i]) * expf(g - (off + cum[2 * i])), k1 = (1.0f - lb) * (1.0f - sg[2 * i + 1]) * expf(g - (off + cum[2 * i + 1])); pk[i] = pk2(k0, k1); }
        LAS v4u* dst = (LAS v4u*)(kT + e * 72 + 16 * jq);
        dst[0] = (v4u){pk[0], pk[1], pk[2], pk[3]}; dst[1] = (v4u){pk[4], pk[5], pk[6], pk[7]};
        if (jq == 0) F.gdec[(size_t)unit * 128 + e] = expf(g);
    }
    __syncthreads();
    {
        const int r32 = lane & 31, hi = lane >> 5, vt_i = wave & 3, et0 = 2 * (wave >> 2);
        f32x16 acc[2]; acc[0] = zero16(); acc[1] = zero16();
        const bf16* vt = F.VT + (size_t)(1024 + h * 128 + 32 * vt_i + r32) * M + m0 + 8 * hi;
#pragma unroll
        for (int ks = 0; ks < 4; ++ks) { const bf16x8 bfr = *(const bf16x8*)(vt + 16 * ks);
#pragma unroll
            for (int i = 0; i < 2; ++i) { const bf16x8 afr = *(const LAS bf16x8*)(kT + (32 * (et0 + i) + r32) * 72 + 16 * ks + 8 * hi); acc[i] = mfma32(afr, bfr, acc[i]); } }
        bf16* dst = F.Ch + ((size_t)unit * 128 + 32 * vt_i + r32) * 128 + 4 * hi;
#pragma unroll
        for (int i = 0; i < 2; ++i)
#pragma unroll
            for (int q = 0; q < 4; ++q) { v2u w; w.x = pk2(acc[i][4 * q], acc[i][4 * q + 1]); w.y = pk2(acc[i][4 * q + 2], acc[i][4 * q + 3]); *(v2u*)(dst + 32 * (et0 + i) + 8 * q) = w; }
    }
    __syncthreads();
}
__device__ __forceinline__ void unpack8(const v4u k, float (&o)[8]) { o[0] = blo(k.x); o[1] = bhi(k.x); o[2] = blo(k.y); o[3] = bhi(k.y); o[4] = blo(k.z); o[5] = bhi(k.z); o[6] = blo(k.w); o[7] = bhi(k.w); }
__device__ __forceinline__ v4u pack8(const float (&s)[8]) { v4u o; o.x = pk2(s[0], s[1]); o.y = pk2(s[2], s[3]); o.z = pk2(s[4], s[5]); o.w = pk2(s[6], s[7]); return o; }
__device__ __forceinline__ void scan_phase(const Frame& F) {
    const int gt = F.bid * NTHR + F.tid;
    if (gt < 32768) {
        const int bh = gt >> 12, v = (gt >> 4) & 255, dg = gt & 15;
        bf16* ptr = F.Cm + ((size_t)(bh * NCH) * 256 + v) * 128 + dg * 8;
        float* ms = F.msc + (size_t)bh * NCH * 4;
        float* np = F.nst + (size_t)bh * NCH * 128 + dg * 8;
        const bool nth = (v == 0);
        float C[8], n[8]; float m = 0.f;
#pragma unroll
        for (int i = 0; i < 8; ++i) { C[i] = 0.f; n[i] = 0.f; }
        for (int c0 = 0; c0 < NCH; c0 += 4) {
            v4u K[4];
#pragma unroll
            for (int i = 0; i < 4; ++i) K[i] = *(const v4u*)(ptr + (size_t)(c0 + i) * 32768);
#pragma unroll
            for (int i = 0; i < 4; ++i) { const int c = c0 + i;
                const float g = ms[c * 4], ml = ms[c * 4 + 1];
                const float mn = fmaxf(g + m, ml), ws = expf(g + m - mn), fl = expf(ml - mn);
                *(v4u*)(ptr + (size_t)c * 32768) = pack8(C);
                float kf[8]; unpack8(K[i], kf);
#pragma unroll
                for (int q = 0; q < 8; ++q) C[q] = ws * C[q] + fl * kf[q];
                if (nth) {
                    const f32x4 a = *(const f32x4*)(np + c * 128), bq = *(const f32x4*)(np + c * 128 + 4);
                    *(f32x4*)(np + c * 128) = (f32x4){n[0], n[1], n[2], n[3]}; *(f32x4*)(np + c * 128 + 4) = (f32x4){n[4], n[5], n[6], n[7]};
                    n[0] = ws * n[0] + fl * a[0]; n[1] = ws * n[1] + fl * a[1]; n[2] = ws * n[2] + fl * a[2]; n[3] = ws * n[3] + fl * a[3];
                    n[4] = ws * n[4] + fl * bq[0]; n[5] = ws * n[5] + fl * bq[1]; n[6] = ws * n[6] + fl * bq[2]; n[7] = ws * n[7] + fl * bq[3];
                    if (dg == 0) ms[c * 4 + 2] = m;
                }
                m = mn; }
        }
    } else if (gt < 65536) {
        const int g2 = gt - 32768, bh = g2 >> 11, v = (g2 >> 4) & 127, eg = g2 & 15;
        bf16* ptr = F.Ch + ((size_t)(bh * NCH) * 128 + v) * 128 + eg * 8;
        const float* gd = F.gdec + (size_t)bh * NCH * 128 + eg * 8;
        float S[8];
#pragma unroll
        for (int i = 0; i < 8; ++i) S[i] = 0.f;
        for (int c0 = 0; c0 < NCH; c0 += 4) {
            v4u K[4]; f32x4 D0[4], D1[4];
#pragma unroll
            for (int i = 0; i < 4; ++i) { K[i] = *(const v4u*)(ptr + (size_t)(c0 + i) * 16384); D0[i] = *(const f32x4*)(gd + (c0 + i) * 128); D1[i] = *(const f32x4*)(gd + (c0 + i) * 128 + 4); }
#pragma unroll
            for (int i = 0; i < 4; ++i) { const int c = c0 + i;
                *(v4u*)(ptr + (size_t)c * 16384) = pack8(S);
                float kf[8]; unpack8(K[i], kf);
                S[0] = D0[i][0] * S[0] + kf[0]; S[1] = D0[i][1] * S[1] + kf[1]; S[2] = D0[i][2] * S[2] + kf[2]; S[3] = D0[i][3] * S[3] + kf[3];
                S[4] = D1[i][0] * S[4] + kf[4]; S[5] = D1[i][1] * S[5] + kf[5]; S[6] = D1[i][2] * S[6] + kf[6]; S[7] = D1[i][3] * S[7] + kf[7]; }
        }
    }
}
constexpr int R_QS = 0, R_KS = 17408, R_QW = 34816, R_SC = 52224, R_F32 = 61440;
__device__ __forceinline__ void st_bf(LAS bf16* p, float v) { *p = (bf16)(pk2(v, v) & 0xffffu); }
template <int MODE>
__device__ __forceinline__ void score_tiles(const Frame& F, const LAS bf16* Kt, const LAS bf16* Qt, LAS bf16* Sc, const LAS float* bm, const LAS float* uu, LAS float* dnA, LAS float* dnB) {
    const int wave = F.wave, lane = F.lane, r32 = lane & 31, hi = lane >> 5;
    if (wave < 3) {
        const int jt = (wave == 2) ? 1 : 0, tt = (wave >= 1) ? 1 : 0;
        f32x16 acc = zero16();
#pragma unroll
        for (int ks = 0; ks < 8; ++ks) { const bf16x8 a = *(const LAS bf16x8*)(Kt + (32 * jt + r32) * 136 + 16 * ks + 8 * hi), bq = *(const LAS bf16x8*)(Qt + (32 * tt + r32) * 136 + 16 * ks + 8 * hi); acc = mfma32(a, bq, acc); }
        const int t = 32 * tt + r32; float rs = 0.f; float bmt = 0.f; if (MODE == 1) bmt = bm[t];
#pragma unroll
        for (int q = 0; q < 4; ++q) { const int j0 = 32 * jt + 8 * q + 4 * hi; float vv[4];
            f32x4 u4 = (f32x4){0.f, 0.f, 0.f, 0.f}; if (MODE == 1) u4 = *(const LAS f32x4*)(uu + j0);
#pragma unroll
            for (int i = 0; i < 4; ++i) { float val = acc[4 * q + i]; if (MODE == 1) val *= __expf(fminf(bmt + u4[i], 0.f)); val = (j0 + i <= t) ? val : 0.f; vv[i] = val; rs += val; }
            v2u w; w.x = pk2(vv[0], vv[1]); w.y = pk2(vv[2], vv[3]); *(LAS v2u*)(Sc + t * 72 + j0) = w; }
        if (MODE == 1) { rs += __shfl_xor(rs, 32); if (hi == 0) { if (jt == 0) dnA[t] = rs; else dnB[t] = rs; } }
    } else if (wave == 3) {
        for (int idx = lane; idx < 128; idx += 64) { const int t = idx >> 2, part = idx & 3; *(LAS v4u*)(Sc + t * 72 + 32 + 8 * part) = (v4u){0u, 0u, 0u, 0u}; }
        if (MODE == 1 && lane < 32) dnB[lane] = 0.f;
    }
}
__device__ __forceinline__ void r2_mlstm(const Frame& F, int bh, int c) {
    const int b = bh >> 2, h = bh & 3, m0 = b * SEQ + c * 64, unit = bh * NCH + c, tid = F.tid, lane = F.lane, wave = F.wave, r32 = lane & 31, hi = lane >> 5;
    LAS bf16* Qs = (LAS bf16*)(F.lds + R_QS); LAS bf16* Ks = (LAS bf16*)(F.lds + R_KS); LAS bf16* Qw = (LAS bf16*)(F.lds + R_QW); LAS bf16* Sc = (LAS bf16*)(F.lds + R_SC);
    LAS float* fb = (LAS float*)(F.lds + R_F32);
    LAS float *bm = fb, *uu = fb + 64, *wi = fb + 128, *emt = fb + 192, *qn = fb + 256, *dnA = fb + 320, *dnB = fb + 384, *nc = fb + 448, *hn = fb + 576;
    if (wave == 0) {
        const float bj = F.bcum[(size_t)bh * SEQ + c * 64 + lane], ig = F.gates[(size_t)(m0 + lane) * 8 + h], mc = F.msc[unit * 4 + 2];
        const float uj = ig - bj, pm = wave_scan_max(uj, lane), mt = bj + fmaxf(mc, pm);
        bm[lane] = bj - mt; uu[lane] = uj; wi[lane] = expf(bj + mc - mt); emt[lane] = expf(-mt);
    } else if (wave < 3) { const int i = tid - 64; nc[i] = F.nst[(size_t)unit * 128 + i]; }
    {
        const int d = tid & 127, jq = tid >> 7; float v[16];
        conv_silu_16(F, F.PROJ + (size_t)(m0 + 16 * jq) * NNAT + PC_Q + h * 128 + d, h * 128 + d, (c | jq) != 0, 1.0f, v);
#pragma unroll
        for (int jj = 0; jj < 16; ++jj) st_bf(Qs + (16 * jq + jj) * 136 + d, v[jj]);
        conv_silu_16(F, F.PROJ + (size_t)(m0 + 16 * jq) * NNAT + PC_K + h * 128 + d, 512 + h * 128 + d, (c | jq) != 0, 0.08838834764831845f, v);
#pragma unroll
        for (int jj = 0; jj < 16; ++jj) st_bf(Ks + (16 * jq + jj) * 136 + d, v[jj]);
    }
    __syncthreads();
    if (wave < 4) score_tiles<1>(F, Ks, Qs, Sc, bm, uu, dnA, dnB);
    else {
        const int lt = tid - 256, t = lt >> 2, part = lt & 3; const float wt = wi[t]; float dot = 0.f;
#pragma unroll
        for (int i = 0; i < 4; ++i) { const int d0 = 32 * part + 8 * i; const v4u qv = *(const LAS v4u*)(Qs + t * 136 + d0); float qf[8]; unpack8(qv, qf);
#pragma unroll
            for (int k = 0; k < 8; ++k) dot += qf[k] * nc[d0 + k];
            v4u o; o.x = pk2(qf[0] * wt, qf[1] * wt); o.y = pk2(qf[2] * wt, qf[3] * wt); o.z = pk2(qf[4] * wt, qf[5] * wt); o.w = pk2(qf[6] * wt, qf[7] * wt); *(LAS v4u*)(Qw + t * 136 + d0) = o; }
        dot += __shfl_xor(dot, 1); dot += __shfl_xor(dot, 2); if (part == 0) qn[t] = dot;
    }
    __syncthreads();
    f32x16 acc2[2]; acc2[0] = zero16(); acc2[1] = zero16();
    {
        const bf16* vt = F.VT + (size_t)(h * 256 + 32 * wave + r32) * M + m0 + 8 * hi;
#pragma unroll
        for (int ks = 0; ks < 4; ++ks) { const bf16x8 a = *(const bf16x8*)(vt + 16 * ks);
#pragma unroll
            for (int tt = 0; tt < 2; ++tt) { const bf16x8 bq = *(const LAS bf16x8*)(Sc + (32 * tt + r32) * 72 + 16 * ks + 8 * hi); acc2[tt] = mfma32(a, bq, acc2[tt]); } }
        const bf16* cs = F.Cm + ((size_t)unit * 256 + 32 * wave + r32) * 128 + 8 * hi;
#pragma unroll
        for (int ks = 0; ks < 8; ++ks) { const bf16x8 a = *(const bf16x8*)(cs + 16 * ks);
#pragma unroll
            for (int tt = 0; tt < 2; ++tt) { const bf16x8 bq = *(const LAS bf16x8*)(Qw + (32 * tt + r32) * 136 + 16 * ks + 8 * hi); acc2[tt] = mfma32(a, bq, acc2[tt]); } }
    }
#pragma unroll
    for (int tt = 0; tt < 2; ++tt) { const int t = 32 * tt + r32; const float den = dnA[t] + dnB[t] + wi[t] * qn[t]; const float inv = 1.0f / fmaxf(fabsf(den), emt[t]); float ssp = 0.f;
#pragma unroll
        for (int r = 0; r < 16; ++r) { acc2[tt][r] *= inv; ssp += acc2[tt][r] * acc2[tt][r]; }
        ssp += __shfl_xor(ssp, 32); if (hi == 0) hn[wave * 64 + t] = ssp; }
    __syncthreads();
#pragma unroll
    for (int tt = 0; tt < 2; ++tt) { const int t = 32 * tt + r32; float tot = 0.f;
#pragma unroll
        for (int w = 0; w < 8; ++w) tot += hn[w * 64 + t];
        const float rstd = 1.0f / sqrtf(tot * (1.0f / 256.0f) + EPS);
        const bf16* prow = F.PROJ + (size_t)(m0 + t) * NNAT + h * 256 + 32 * wave + 4 * hi;
        bf16* yrow = F.Y + (size_t)(m0 + t) * DM + h * 256 + 32 * wave + 4 * hi;
        const float* nwp = F.ml_nw + h * 256 + 32 * wave + 4 * hi;
#pragma unroll
        for (int q = 0; q < 4; ++q) { const v2u o4 = *(const v2u*)(prow + PC_O + 8 * q), z4 = *(const v2u*)(prow + PC_Z + 8 * q); const f32x4 nw = *(const f32x4*)(nwp + 8 * q);
            const float o0 = blo(o4.x), o1 = bhi(o4.x), o2 = blo(o4.y), o3 = bhi(o4.y), z0 = blo(z4.x), z1 = bhi(z4.x), z2 = blo(z4.y), z3 = bhi(z4.y);
            const float y0 = acc2[tt][4 * q] * rstd * nw[0] * sigm(o0) * z0 * sigm(z0), y1 = acc2[tt][4 * q + 1] * rstd * nw[1] * sigm(o1) * z1 * sigm(z1);
            const float y2 = acc2[tt][4 * q + 2] * rstd * nw[2] * sigm(o2) * z2 * sigm(z2), y3 = acc2[tt][4 * q + 3] * rstd * nw[3] * sigm(o3) * z3 * sigm(z3);
            v2u w; w.x = pk2(y0, y1); w.y = pk2(y2, y3); *(v2u*)(yrow + 8 * q) = w; } }
    __syncthreads();
}
__device__ __forceinline__ void r2_hgrn2(const Frame& F, int bh, int c) {
    const int b = bh >> 3, h = bh & 7, m0 = b * SEQ + c * 64, unit = bh * NCH + c, tid = F.tid, lane = F.lane, wave = F.wave, r32 = lane & 31, hi = lane >> 5;
    LAS bf16* Qt = (LAS bf16*)(F.lds + R_QS); LAS bf16* Kt = (LAS bf16*)(F.lds + R_KS); LAS bf16* Q2 = (LAS bf16*)(F.lds + R_QW); LAS bf16* Sc = (LAS bf16*)(F.lds + R_SC);
    LAS float* fb = (LAS float*)(F.lds + R_F32);
    LAS float *seg = fb, *hn = fb + 512;
    {
        const int e = tid & 127, jq = tid >> 7;
        const float lb = 1.0f / (1.0f + expf(F.hg_lb[1024 + h * 128 + e] - F.hg_lb[h * 128 + e]));
        float sg[16], cum[16];
        const float run = hg_forget_16(F.PROJ + (size_t)(m0 + 16 * jq) * NNAT + PC_HF + h * 128 + e, lb, sg, cum);
        seg[jq * 128 + e] = run;
        __syncthreads();
        const float s0 = seg[e], s1 = seg[128 + e], s2 = seg[256 + e];
        const float off = jq == 0 ? 0.f : jq == 1 ? s0 : jq == 2 ? s0 + s1 : s0 + s1 + s2;
        const float bref = s0 + s1;
        const bf16* srcq = F.PROJ + (size_t)(m0 + 16 * jq) * NNAT + PC_HQ + h * 128 + e;
#pragma unroll
        for (int jj = 0; jj < 16; ++jj) { const int j = 16 * jq + jj; const float bj = off + cum[jj]; const float qv = bf2f(srcq[jj * NNAT]);
            st_bf(Qt + j * 136 + e, qv * expf(bj - bref)); st_bf(Kt + j * 136 + e, (1.0f - lb) * (1.0f - sg[jj]) * expf(bref - bj)); st_bf(Q2 + j * 136 + e, qv * expf(bj)); }
    }
    __syncthreads();
    if (wave < 4) score_tiles<0>(F, Kt, Qt, Sc, nullptr, nullptr, nullptr, nullptr);
    __syncthreads();
    const int vt_i = wave & 3, tt = wave >> 2, t = 32 * tt + r32;
    f32x16 acc = zero16();
    {
        const bf16* vt = F.VT + (size_t)(1024 + h * 128 + 32 * vt_i + r32) * M + m0 + 8 * hi;
#pragma unroll
        for (int ks = 0; ks < 4; ++ks) { const bf16x8 a = *(const bf16x8*)(vt + 16 * ks); const bf16x8 bq = *(const LAS bf16x8*)(Sc + t * 72 + 16 * ks + 8 * hi); acc = mfma32(a, bq, acc); }
        const bf16* cs = F.Ch + ((size_t)unit * 128 + 32 * vt_i + r32) * 128 + 8 * hi;
#pragma unroll
        for (int ks = 0; ks < 8; ++ks) { const bf16x8 a = *(const bf16x8*)(cs + 16 * ks); const bf16x8 bq = *(const LAS bf16x8*)(Q2 + t * 136 + 16 * ks + 8 * hi); acc = mfma32(a, bq, acc); }
    }
    { float ssp = 0.f;
#pragma unroll
      for (int r = 0; r < 16; ++r) ssp += acc[r] * acc[r];
      ssp += __shfl_xor(ssp, 32); if (hi == 0) hn[vt_i * 64 + t] = ssp; }
    __syncthreads();
    {
        const float tot = (hn[t] + hn[64 + t]) + (hn[128 + t] + hn[192 + t]);
        const float rstd = 1.0f / sqrtf(tot * (1.0f / 128.0f) + EPS);
        const bf16* prow = F.PROJ + (size_t)(m0 + t) * NNAT + PC_HG + h * 128 + 32 * vt_i + 4 * hi;
        bf16* yrow = F.Y + (size_t)(m0 + t) * DM + 1024 + h * 128 + 32 * vt_i + 4 * hi;
        const float* nwp = F.hg_nw + h * 128 + 32 * vt_i + 4 * hi;
#pragma unroll
        for (int q = 0; q < 4; ++q) { const v2u g4 = *(const v2u*)(prow + 8 * q); const f32x4 nw = *(const f32x4*)(nwp + 8 * q);
            const float g0 = blo(g4.x), g1 = bhi(g4.x), g2 = blo(g4.y), g3 = bhi(g4.y);
            const float y0 = acc[4 * q] * rstd * nw[0] * g0 * sigm(g0), y1 = acc[4 * q + 1] * rstd * nw[1] * g1 * sigm(g1);
            const float y2 = acc[4 * q + 2] * rstd * nw[2] * g2 * sigm(g2), y3 = acc[4 * q + 3] * rstd * nw[3] * g3 * sigm(g3);
            v2u w; w.x = pk2(y0, y1); w.y = pk2(y2, y3); *(v2u*)(yrow + 8 * q) = w; }
    }
    __syncthreads();
}
__device__ __forceinline__ void final_norm(const Frame& F) {
    const int gw = F.bid * NWAVES + F.wave, NGW = F.G * NWAVES, lane = F.lane;
    const f32x4* nwp = (const f32x4*)F.fin_nw + lane;
    for (int m = gw; m < M; m += NGW) {
        const float sq = __hip_atomic_load(F.ssq2 + m, RLX_AGENT);
        const float rstd = 1.0f / sqrtf(sq * (1.0f / DM) + EPS);
        f32x4* xr = (f32x4*)(F.out + (size_t)m * DM) + lane;
#pragma unroll
        for (int j = 0; j < 8; ++j) xr[64 * j] = xr[64 * j] * rstd * nwp[64 * j];
    }
}
struct Args { const float* in[16]; float* out; unsigned char* ws; int ph_lo, ph_hi, li, pad; };
__global__ void __launch_bounds__(NWAVES * 64, 2) hymba_fwd(Args args) {
    extern __shared__ __attribute__((aligned(16))) unsigned char lds[];
    Frame F;
    F.lds = (LAS unsigned char*)lds;
    F.tid = threadIdx.x; F.lane = F.tid & 63; F.wave = __builtin_amdgcn_readfirstlane(F.tid >> 6); F.G = gridDim.x; F.bid = blockIdx.x;
    unsigned char* ws = args.ws;
    gu32* ctl = (gu32*)(ws + WS_CTL);
    F.x = args.in[0]; F.p = args.in[1]; F.norm_w = args.in[2]; F.w_in = args.in[3]; F.conv_w = args.in[4]; F.conv_b = args.in[5]; F.b_i = args.in[6]; F.b_f = args.in[7];
    F.ml_nw = args.in[8]; F.hg_lb = args.in[9]; F.hg_nw = args.in[10]; F.w_out = args.in[11]; F.pe_nw = args.in[12]; F.w_pg = args.in[13]; F.w_pe = args.in[14]; F.fin_nw = args.in[15];
    F.out = args.out;
    F.Wt_in = (bf16*)(ws + WS_WIN); F.WoT = (bf16*)(ws + WS_WO); F.WgT = (bf16*)(ws + WS_WG); F.WeT = (bf16*)(ws + WS_WE); F.PB = (bf16*)(ws + WS_PB);
    F.U = (bf16*)(ws + WS_U); F.Y = (bf16*)(ws + WS_U); F.PROJ = (bf16*)(ws + WS_PROJ); F.HB = (bf16*)(ws + WS_PROJ); F.EB = (bf16*)(ws + WS_PROJ + 128 * MiB); F.VT = (bf16*)(ws + WS_VT);
    F.Cm = (bf16*)args.out; F.Ch = (bf16*)args.out + (size_t)64 * MiB;
    F.gates = (float*)(ws + WS_GATES); F.bcum = (float*)(ws + WS_BCUM); F.msc = (float*)(ws + WS_MSC); F.nst = (float*)(ws + WS_NST); F.gdec = (float*)(ws + WS_GDEC);
    F.ssqh = (float*)(ws + WS_SSQH); F.ssq2 = (float*)(ws + WS_SSQ2);
    for (int u = F.tid; u < (LDS_BYTES - LDSCTL_OFF) / 4; u += NWAVES * 64) ((LAS unsigned*)(F.lds + LDSCTL_OFF))[u] = 0u;
    __syncthreads();
    XcdBarrier bar; bar.bar = (unsigned*)(ctl + CW_BAR); bar.x = 0; bar.st = nullptr;
    if (N_LAUNCHES != PER_PHASE) bar = xcd_barrier_post((unsigned*)(ctl + CW_BAR), (volatile LAS unsigned*)(F.lds + MISC_OFF) + 8);
#define GRID_BAR() do { if (N_LAUNCHES == PER_PHASE) { if (F.tid == 0) __hip_atomic_store(ctl + CW_TMO, 0xBADBA0u, RLX_AGENT); } else { xcd_barrier(bar); } } while (0)
    const int lo = args.ph_lo, hi = args.ph_hi;
#define IN(k) (lo <= (k) && (k) < hi)
#define BOTH(k) (IN(k) && IN((k) + 1))
    if (IN(0)) { p0_prologue(F); if (BOTH(0)) GRID_BAR(); }
    if (IN(1)) {
        { pg8::Gemm g{F.U, F.Wt_in, M, NNAT, DM}; pg8::StaticOrder S; S.init(M, NNAT, F.G, F.bid);
          pg8::EpiBf16<0> E{F.PROJ, NNAT, nullptr, 0, 0, 1.f};
          pg8::gemm_phase<pg8::EpiBf16<0>, pg8::StaticOrder, true, true>(F.lds, g, S, E); }
        { pg8::Gemm g{F.Wt_in + (size_t)NNAT * DM, F.U, NTR, M, DM}; pg8::StaticOrder S; S.init(NTR, M, F.G, F.bid);
          pg8::EpiBf16<0> E{F.VT, M, nullptr, 0, 0, 1.f};
          pg8::gemm_phase<pg8::EpiBf16<0>, pg8::StaticOrder, true, true>(F.lds, g, S, E); }
        if (BOTH(1)) GRID_BAR();
    }
    if (IN(2)) {
        for (int u = F.bid; u < 6144; u += F.G) { const int k3 = u / 3, r3 = u - 3 * k3; if (r3 == 0) pa_mlstm(F, k3 >> 8, k3 & 255); else { const int id = 2 * k3 + r3 - 1; pa_hgrn2(F, id >> 8, id & 255); } }
        if (BOTH(2)) GRID_BAR();
    }
    if (IN(3)) { scan_phase(F); if (BOTH(3)) GRID_BAR(); }
    if (IN(4)) {
        for (int u = F.bid; u < 6144; u += F.G) { const int k3 = u / 3, r3 = u - 3 * k3; if (r3 == 0) r2_mlstm(F, k3 >> 8, k3 & 255); else { const int id = 2 * k3 + r3 - 1; r2_hgrn2(F, id >> 8, id & 255); } }
        if (BOTH(4)) GRID_BAR();
    }
    if (IN(5)) {
        { pg8::Gemm g{F.Y, F.WoT, M, DM, DM}; pg8::StaticOrder S; S.init(M, DM, F.G, F.bid);
          pg8::EpiRes E{F.x, F.out, F.HB, F.ssqh, DM};
          pg8::gemm_phase<pg8::EpiRes, pg8::StaticOrder, true, true>(F.lds, g, S, E); }
        { pg8::Gemm g{F.PB, F.WeT, M, DM, PE}; pg8::StaticOrder S; S.init(M, DM, F.G, F.bid);
          pg8::EpiBf16<0> E{F.EB, DM, nullptr, 0, 0, 1.f};
          pg8::gemm_phase<pg8::EpiBf16<0>, pg8::StaticOrder, true, true>(F.lds, g, S, E); }
        if (BOTH(5)) GRID_BAR();
    }
    if (IN(6)) {
        pg8::Gemm g{F.HB, F.WgT, M, DM, DM}; pg8::StaticOrder S; S.init(M, DM, F.G, F.bid);
        pg8::EpiGate E{F.out, F.EB, F.ssqh, F.ssq2, DM, 1.0f / DM, EPS};
        pg8::gemm_phase<pg8::EpiGate, pg8::StaticOrder, true, true>(F.lds, g, S, E);
        if (BOTH(6)) GRID_BAR();
    }
    if (IN(7)) final_norm(F);
#undef IN
#undef BOTH
}

#ifdef DBG_DUMP_AFTER
__global__ void dbg_dump(const unsigned char* wsb, float* out, int mode) {
    const unsigned short* a = (const unsigned short*)(wsb + (mode == 0 ? WS_PROJ : WS_U)); const unsigned short* b = (const unsigned short*)(wsb + WS_VT);
    size_t i = (size_t)blockIdx.x * blockDim.x + threadIdx.x;
    const size_t n = (size_t)M * DM;
    for (; i < n; i += (size_t)gridDim.x * blockDim.x) {
        float v;
        if (mode == 0) v = bf2f(a[3 * i]) + bf2f(a[3 * i + 1]) + bf2f(a[3 * i + 2]) + bf2f(b[i]);
        else v = bf2f(a[i]);
        out[i] = v;
    }
}
#endif
extern "C" void kernel_launch(void* const* d_in, const int* in_sizes, int n_in, void* d_out, int out_size, void* d_ws, size_t ws_size, hipStream_t stream) {
    static int grid = 0;
    if (grid == 0) {
        if (n_in != 16 || in_sizes[0] != M * DM || out_size != M * DM || ws_size < WS_END) { fprintf(stderr, "kernel_launch: unexpected shapes (n_in %d, in0 %d, out %d, ws %zu); nothing launched\n", n_in, n_in > 0 ? in_sizes[0] : -1, out_size, ws_size); grid = -1; return; }
        int dev = 0, cus = 0, per_cu = 0;
        if (hipGetDevice(&dev) != hipSuccess || hipDeviceGetAttribute(&cus, hipDeviceAttributeMultiprocessorCount, dev) != hipSuccess) { grid = -1; return; }
        if (hipFuncSetAttribute((const void*)hymba_fwd, hipFuncAttributeMaxDynamicSharedMemorySize, LDS_BYTES) != hipSuccess) { fprintf(stderr, "kernel_launch: hipFuncSetAttribute failed\n"); grid = -1; return; }
        if (hipOccupancyMaxActiveBlocksPerMultiprocessor(&per_cu, (const void*)hymba_fwd, NWAVES * 64, LDS_BYTES) != hipSuccess || per_cu < 1)
            fprintf(stderr, "kernel_launch: note: occupancy query reports %d workgroups per CU\n", per_cu);
        (void)hipGetLastError();
        grid = cus;
    }
    if (grid < 0) return;
    if (hipMemsetAsync((char*)d_ws + WS_CTL, 0, CTL_ZERO_BYTES, stream) != hipSuccess) { fprintf(stderr, "kernel_launch: hipMemsetAsync failed\n"); return; }
    Args a{};
    for (int i = 0; i < 16; ++i) a.in[i] = (const float*)d_in[i];
    a.out = (float*)d_out; a.ws = (unsigned char*)d_ws;
    for (int li = 0; li < N_LAUNCHES; ++li) {
#ifdef DBG_DUMP_AFTER
        if (li > DBG_DUMP_AFTER) { if (DBG_DUMP_AFTER != 2 && DBG_DUMP_AFTER != 3) hipLaunchKernelGGL(dbg_dump, dim3(2048), dim3(256), 0, stream, (const unsigned char*)d_ws, (float*)d_out, DBG_DUMP_AFTER == 1 ? 0 : 1);
            break; }
#endif
        a.ph_lo = (N_LAUNCHES == PER_PHASE) ? li : 0; a.ph_hi = (N_LAUNCHES == PER_PHASE) ? li + 1 : PER_PHASE; a.li = li;
        hipLaunchKernelGGL(hymba_fwd, dim3(grid), dim3(NWAVES * 64), LDS_BYTES, stream, a);
        const hipError_t le = hipPeekAtLastError();
        if (le != hipSuccess) { fprintf(stderr, "kernel_launch: launch %d failed: %s\n", li, hipGetErrorName(le)); break; }
    }
}
```

```cpp
#include <hip/hip_runtime.h>
#include <cstdio>
#include <cstdint>
namespace pg8 {
#define PG8_LAS __attribute__((address_space(3)))
typedef unsigned short bf16_t;
typedef short bf16x8 __attribute__((ext_vector_type(8)));
typedef float f32x4 __attribute__((ext_vector_type(4)));
typedef unsigned u32x4 __attribute__((ext_vector_type(4)));
constexpr int BM = 256, BK = 64, HALF = 128, HTB = HALF * BK * 2  , STAGE_BYTES = 8 * HTB, NXCD = 8, WGM = 8;

__host__ __device__ __forceinline__ int lds_byte(int r, int c) { const int st = (r >> 4) * 2 + (c >> 5), rr = r & 15, cc = c & 31, ob = rr * 64 + cc * 2; return st * 1024 + (ob ^ (((ob >> 9) & 1) << 5)); }
__host__ __device__ __forceinline__ void stage_rc(int b, int& R, int& C) { const int st = b / 1024, sb = b % 1024, swz = sb ^ (((sb >> 9) & 1) << 5); R = (st >> 1) * 16 + swz / 64; C = (st & 1) * 32 + (swz % 64) / 2; }
__host__ __device__ __forceinline__ int perm32(int rho) { const int n = rho >> 4, i = rho & 15; return 8 * (i >> 2) + 4 * n + (i & 3); }

struct Unit { int pm, pn; };
struct Gemm { const bf16_t* A; const bf16_t* Bt; int M, N, K; };

struct StaticOrder {
    int nM, nN, nwg, G, c;
    __host__ __device__ void init(int M, int N, int G_, int c_) { nM = M / BM; nN = N / BM; nwg = nM * nN; G = G_; c = c_; }
    __host__ __device__ bool next(int i, Unit& u) const {
        const long L = (long)i * G + c; if (L >= nwg) return false;
        int wgid = (int)L; { const int q = nwg / NXCD, r = nwg % NXCD, xcd = wgid % NXCD, off = wgid / NXCD; wgid = (xcd < r ? xcd * (q + 1) : r * (q + 1) + (xcd - r) * q) + off; }
        const int nig = WGM * nN, gid = wgid / nig, fm = gid * WGM, gsz = (nM - fm) < WGM ? (nM - fm) : WGM;
        u.pm = fm + ((wgid % nig) % gsz); u.pn = (wgid % nig) / gsz; return true;
    }
    __device__ __forceinline__ void a_ready(const Unit&) const {}
    __device__ __forceinline__ void done(const Unit&) const {}
};

__device__ __forceinline__ unsigned cvt_pk_bf16(float lo, float hi) { unsigned r; asm volatile("v_cvt_pk_bf16_f32 %0, %1, %2" : "=v"(r) : "v"(lo), "v"(hi)); return r; }
typedef float f32x2 __attribute__((ext_vector_type(2)));
__device__ __forceinline__ f32x2 gelu_pk(f32x2 v) {
    const f32x2 av = __builtin_elementwise_abs(v), d = av * 0.2316418882f + 1.0f;
    f32x2 t; t.x = __builtin_amdgcn_rcpf(d.x); t.y = __builtin_amdgcn_rcpf(d.y);
    f32x2 q = t * 0.5307027145f + (-0.7265760135f); q = q * t + 0.7107068705f; q = q * t + (-0.142248368f); q = q * t + 0.127414796f; q = q * t;
    const f32x2 s = (v * v) * (-0.72134752044f);
    f32x2 e; e.x = __builtin_amdgcn_exp2f(s.x); e.y = __builtin_amdgcn_exp2f(s.y);
    const f32x2 m = v * (q * e), r = v - m;
    f32x2 o; o.x = v.x < 0.f ? m.x : r.x; o.y = v.y < 0.f ? m.y : r.y; return o;
}

template <int ACT  > struct EpiBf16 {
    static constexpr bool PERM = true, AFTER_DRAIN = false; static_assert(ACT == 0 || ACT == 1, "EpiBf16: ACT is 0 (none) or 1 (gelu_pk)");
    bf16_t* O; int ldc; const float* bias; int split_cols; size_t split_stride; float scale0;
    __device__ __forceinline__ void operator()(const f32x4 (&acc)[2][2][4][2], const Unit& u, int wr, int wc, int fr, int fq) const {
        const int row0 = u.pm * BM + wr * 64 + fr; int colt = u.pn * BM; bf16_t* base = O;
        float sc = 1.f; if (split_cols) { const int t = colt / split_cols; base += (size_t)t * split_stride; colt -= t * split_cols; if (t == 0) sc = scale0; }
        const int col0 = colt + wc * 32 + 8 * fq, bcol0 = u.pn * BM + wc * 32 + 8 * fq;
        f32x4 bv[2][2];
#pragma unroll
        for (int bj = 0; bj < 2; ++bj)
#pragma unroll
            for (int n = 0; n < 2; ++n) bv[bj][n] = bias ? *(const f32x4*)(bias + bcol0 + bj * HALF + 4 * n) : (f32x4){0.f, 0.f, 0.f, 0.f};
#pragma unroll
        for (int ai = 0; ai < 2; ++ai)
#pragma unroll
            for (int m = 0; m < 4; ++m) { bf16_t* rowp = base + (size_t)(row0 + ai * HALF + m * 16) * ldc + col0;
#pragma unroll
                for (int bj = 0; bj < 2; ++bj) { f32x4 v0 = acc[ai][bj][m][0] + bv[bj][0], v1 = acc[ai][bj][m][1] + bv[bj][1];
                    if (ACT == 1) { f32x2 a = gelu_pk((f32x2){v0[0], v0[1]}), b = gelu_pk((f32x2){v0[2], v0[3]}), c = gelu_pk((f32x2){v1[0], v1[1]}), d = gelu_pk((f32x2){v1[2], v1[3]});
                        v0 = (f32x4){a.x, a.y, b.x, b.y}; v1 = (f32x4){c.x, c.y, d.x, d.y}; }
                    v0 = v0 * sc; v1 = v1 * sc; u32x4 w; w.x = cvt_pk_bf16(v0[0], v0[1]); w.y = cvt_pk_bf16(v0[2], v0[3]); w.z = cvt_pk_bf16(v1[0], v1[1]); w.w = cvt_pk_bf16(v1[2], v1[3]);
                    *(u32x4*)(rowp + bj * HALF) = w; } }
    }
};
__device__ __forceinline__ float bf_lo(unsigned w) { return __uint_as_float(w << 16); }
__device__ __forceinline__ float bf_hi(unsigned w) { return __uint_as_float(w & 0xffff0000u); }
__device__ __forceinline__ float fast_sigmoid(float x) { return __builtin_amdgcn_rcpf(1.0f + __expf(-x)); }
struct EpiRes {
    static constexpr bool PERM = true, AFTER_DRAIN = false;
    const float* x; float* out; bf16_t* hb; float* ssq; int ldc;
    __device__ __forceinline__ void operator()(const f32x4 (&acc)[2][2][4][2], const Unit& u, int wr, int wc, int fr, int fq) const {
        const int row0 = u.pm * BM + wr * 64 + fr, col0 = u.pn * BM + wc * 32 + 8 * fq;
#pragma unroll
        for (int ai = 0; ai < 2; ++ai)
#pragma unroll
            for (int m = 0; m < 4; ++m) { const int row = row0 + ai * HALF + m * 16; const size_t off = (size_t)row * ldc + col0; float ss = 0.f;
#pragma unroll
                for (int bj = 0; bj < 2; ++bj) {
                    const f32x4 x0 = *(const f32x4*)(x + off + bj * HALF), x1 = *(const f32x4*)(x + off + bj * HALF + 4);
                    const f32x4 h0 = x0 + acc[ai][bj][m][0], h1 = x1 + acc[ai][bj][m][1];
                    *(f32x4*)(out + off + bj * HALF) = h0; *(f32x4*)(out + off + bj * HALF + 4) = h1;
                    ss += (h0[0] * h0[0] + h0[1] * h0[1]) + (h0[2] * h0[2] + h0[3] * h0[3]) + (h1[0] * h1[0] + h1[1] * h1[1]) + (h1[2] * h1[2] + h1[3] * h1[3]);
                    u32x4 w; w.x = cvt_pk_bf16(h0[0], h0[1]); w.y = cvt_pk_bf16(h0[2], h0[3]); w.z = cvt_pk_bf16(h1[0], h1[1]); w.w = cvt_pk_bf16(h1[2], h1[3]);
                    *(u32x4*)(hb + off + bj * HALF) = w; }
                ss += __shfl_xor(ss, 16); ss += __shfl_xor(ss, 32);
                if (fq == 0) atomicAdd(ssq + row, ss); }
    }
};
struct EpiGate {
    static constexpr bool PERM = true, AFTER_DRAIN = false;
    float* out; const bf16_t* e; float* ssq_h; float* ssq2; int ldc; float inv_n, eps;
    __device__ __forceinline__ void operator()(const f32x4 (&acc)[2][2][4][2], const Unit& u, int wr, int wc, int fr, int fq) const {
        const int row0 = u.pm * BM + wr * 64 + fr, col0 = u.pn * BM + wc * 32 + 8 * fq;
#pragma unroll
        for (int ai = 0; ai < 2; ++ai)
#pragma unroll
            for (int m = 0; m < 4; ++m) { const int row = row0 + ai * HALF + m * 16; const size_t off = (size_t)row * ldc + col0; float ss = 0.f;
                const float sq = __hip_atomic_load(ssq_h + row, __ATOMIC_RELAXED, __HIP_MEMORY_SCOPE_AGENT);
                const float rstd = 1.0f / sqrtf(sq * inv_n + eps);
#pragma unroll
                for (int bj = 0; bj < 2; ++bj) {
                    const f32x4 h0 = *(const f32x4*)(out + off + bj * HALF), h1 = *(const f32x4*)(out + off + bj * HALF + 4);
                    const u32x4 ev = *(const u32x4*)(e + off + bj * HALF);
                    const f32x4 a0 = acc[ai][bj][m][0] * rstd, a1 = acc[ai][bj][m][1] * rstd;
                    f32x4 o0, o1;
                    o0[0] = h0[0] + fast_sigmoid(a0[0]) * bf_lo(ev.x); o0[1] = h0[1] + fast_sigmoid(a0[1]) * bf_hi(ev.x);
                    o0[2] = h0[2] + fast_sigmoid(a0[2]) * bf_lo(ev.y); o0[3] = h0[3] + fast_sigmoid(a0[3]) * bf_hi(ev.y);
                    o1[0] = h1[0] + fast_sigmoid(a1[0]) * bf_lo(ev.z); o1[1] = h1[1] + fast_sigmoid(a1[1]) * bf_hi(ev.z);
                    o1[2] = h1[2] + fast_sigmoid(a1[2]) * bf_lo(ev.w); o1[3] = h1[3] + fast_sigmoid(a1[3]) * bf_hi(ev.w);
                    *(f32x4*)(out + off + bj * HALF) = o0; *(f32x4*)(out + off + bj * HALF + 4) = o1;
                    ss += (o0[0] * o0[0] + o0[1] * o0[1]) + (o0[2] * o0[2] + o0[3] * o0[3]) + (o1[0] * o1[0] + o1[1] * o1[1]) + (o1[2] * o1[2] + o1[3] * o1[3]); }
                ss += __shfl_xor(ss, 16); ss += __shfl_xor(ss, 32);
                if (fq == 0) atomicAdd(ssq2 + row, ss); }
    }
};
template <class Epi, class Sched, bool ALIGN_EPI = false, bool SP2 = false>
__device__ __forceinline__ void gemm_phase(PG8_LAS unsigned char* lds, const Gemm g, const Sched& S, const Epi& E) {
    const int tid = threadIdx.x, wid = __builtin_amdgcn_readfirstlane(tid >> 6), lane = tid & 63, wr = wid >> 2, wc = wid & 3, fr = lane & 15, fq = lane >> 4;
    const int K = g.K, nt = K / BK;
    unsigned voffA[2], voffB[2];
#pragma unroll
    for (int i = 0; i < 2; ++i) { int R, C; stage_rc(tid * 16 + i * 8192, R, C); const int Rb = Epi::PERM ? ((R & ~31) + perm32(R & 31)) : R;
        voffA[i] = (unsigned)(R * K + C) * 2u; voffB[i] = (unsigned)(Rb * K + C) * 2u; }
    const size_t kstep = (size_t)(BK * 2);
    const size_t hstep = (size_t)HALF * K * 2;
    const size_t tstep = 2 * hstep;
    const unsigned ldsw = (unsigned)wid * 1024u;
    const int aoff = lds_byte(wr * 64 + fr, fq * 8), boff = lds_byte(wc * 32 + fr, fq * 8);
#define PG8_SA(b, h) (((b) * 2 + (h)) * HTB)
#define PG8_SB(b, h) ((4 + (b) * 2 + (h)) * HTB)
#define PG8_STAGE(bufoff, gbase, voff) do { _Pragma("unroll") for (int _i = 0; _i < 2; ++_i) \
        __builtin_amdgcn_global_load_lds((const unsigned*)((const char*)(gbase) + (voff)[_i]), (PG8_LAS unsigned*)(lds + (bufoff) + ldsw + _i * 8192), 16, 0, 0); } while (0)
#define PG8_LDA(dst, b, h) do { _Pragma("unroll") for (int m = 0; m < 4; ++m) _Pragma("unroll") for (int k = 0; k < 2; ++k) dst[m][k] = *(const PG8_LAS bf16x8*)(lds + PG8_SA(b, h) + aoff + m * 2048 + k * 1024); } while (0)
#define PG8_LDB(dst, b, h) do { _Pragma("unroll") for (int n = 0; n < 2; ++n) _Pragma("unroll") for (int k = 0; k < 2; ++k) dst[n][k] = *(const PG8_LAS bf16x8*)(lds + PG8_SB(b, h) + boff + n * 2048 + k * 1024); } while (0)
#define PG8_MMA(ai, bj, At, Bt) do { __builtin_amdgcn_s_setprio(1); _Pragma("unroll") for (int m = 0; m < 4; ++m) _Pragma("unroll") for (int n = 0; n < 2; ++n) _Pragma("unroll") for (int k = 0; k < 2; ++k) \
        acc[ai][bj][m][n] = __builtin_amdgcn_mfma_f32_16x16x32_bf16(Bt[n][k], At[m][k], acc[ai][bj][m][n], 0, 0, 0); __builtin_amdgcn_s_setprio(0); } while (0)
#define PG8_WAIT_V(n) asm volatile("s_waitcnt vmcnt(" #n ")" ::: "memory")
#define PG8_WAIT_L(n) asm volatile("s_waitcnt lgkmcnt(" #n ")" ::: "memory")
#define PG8_BAR __builtin_amdgcn_s_barrier()
#define PG8_SCHED __builtin_amdgcn_sched_barrier(0)
    Unit cur, nxt; int ui = 0;
    if (!S.next(0, cur)) return;
    f32x4 acc[2][2][4][2];
#pragma unroll
    for (int a = 0; a < 2; ++a)
#pragma unroll
        for (int b = 0; b < 2; ++b)
#pragma unroll
            for (int m = 0; m < 4; ++m)
#pragma unroll
                for (int n = 0; n < 2; ++n) acc[a][b][m][n] = (f32x4){0.f, 0.f, 0.f, 0.f};
    bf16x8 At[4][2], B0[2][2], B1[2][2];
    const char* cA = (const char*)g.A + (size_t)cur.pm * tstep; const char* cB = (const char*)g.Bt + (size_t)cur.pn * tstep;
    S.a_ready(cur);
    if constexpr (SP2) {
        PG8_STAGE(PG8_SB(0, 0), cB, voffB); PG8_STAGE(PG8_SB(0, 1), cB + hstep, voffB); PG8_STAGE(PG8_SA(0, 0), cA, voffA); PG8_STAGE(PG8_SA(0, 1), cA + hstep, voffA);
        if (wr == 1) PG8_BAR;
        PG8_WAIT_V(2); PG8_BAR;
        PG8_STAGE(PG8_SB(1, 0), cB + kstep, voffB); PG8_STAGE(PG8_SA(1, 0), cA + kstep, voffA); PG8_STAGE(PG8_SB(1, 1), cB + hstep + kstep, voffB);
        PG8_WAIT_V(6); PG8_BAR;
    } else {
        PG8_STAGE(PG8_SB(0, 0), cB, voffB); PG8_STAGE(PG8_SA(0, 0), cA, voffA); PG8_STAGE(PG8_SB(0, 1), cB + hstep, voffB); PG8_STAGE(PG8_SA(0, 1), cA + hstep, voffA);
        if (wr == 1) PG8_BAR;
        PG8_WAIT_V(4); PG8_BAR;
        PG8_STAGE(PG8_SB(1, 0), cB + kstep, voffB); PG8_STAGE(PG8_SA(1, 0), cA + kstep, voffA); PG8_STAGE(PG8_SB(1, 1), cB + hstep + kstep, voffB);
        PG8_WAIT_V(6); PG8_BAR;
    }
    for (;;) {
        const bool has_next = S.next(ui + 1, nxt);
        const char* nA = has_next ? (const char*)g.A + (size_t)nxt.pm * tstep : cA; const char* nB = has_next ? (const char*)g.Bt + (size_t)nxt.pn * tstep : cB;
        for (int t = 0; t < nt; t += 2) {
            const bool last = (t == nt - 2);
            const char* a1 = cA + (size_t)(t + 1) * kstep;
            const char* a2 = last ? nA : cA + (size_t)(t + 2) * kstep; const char* b2 = last ? nB : cB + (size_t)(t + 2) * kstep;
            const char* a3 = a2 + kstep; const char* b3 = b2 + kstep;
            if (last && has_next) S.a_ready(nxt);
            if constexpr (SP2) {
            PG8_LDB(B0, 0, 0); PG8_LDB(B1, 0, 1); PG8_SCHED; PG8_LDA(At, 0, 0); PG8_STAGE(PG8_SA(1, 1), a1 + hstep, voffA);
            PG8_WAIT_V(8); PG8_WAIT_L(0); PG8_BAR; PG8_MMA(0, 0, At, B0); PG8_MMA(0, 1, At, B1); PG8_BAR; PG8_SCHED;
            PG8_LDA(At, 0, 1); PG8_STAGE(PG8_SB(0, 0), b2, voffB); PG8_STAGE(PG8_SB(0, 1), b2 + hstep, voffB); PG8_STAGE(PG8_SA(0, 0), a2, voffA);
            PG8_WAIT_V(8); PG8_WAIT_L(0); PG8_BAR; PG8_MMA(1, 0, At, B0); PG8_MMA(1, 1, At, B1); PG8_BAR; PG8_SCHED;
            PG8_LDB(B0, 1, 0); PG8_LDB(B1, 1, 1); PG8_SCHED; PG8_LDA(At, 1, 0); PG8_STAGE(PG8_SA(0, 1), a2 + hstep, voffA);
            PG8_WAIT_V(8); PG8_WAIT_L(0); PG8_BAR; PG8_MMA(0, 0, At, B0); PG8_MMA(0, 1, At, B1); PG8_BAR; PG8_SCHED;
            PG8_LDA(At, 1, 1); PG8_STAGE(PG8_SB(1, 0), b3, voffB); PG8_STAGE(PG8_SB(1, 1), b3 + hstep, voffB); PG8_STAGE(PG8_SA(1, 0), a3, voffA);
            PG8_WAIT_V(8); PG8_WAIT_L(0); PG8_BAR; PG8_MMA(1, 0, At, B0); PG8_MMA(1, 1, At, B1); PG8_BAR; PG8_SCHED;
            } else {
            PG8_LDB(B0, 0, 0); PG8_SCHED; PG8_LDA(At, 0, 0); PG8_STAGE(PG8_SA(1, 1), a1 + hstep, voffA);
            PG8_WAIT_L(8); PG8_BAR; PG8_WAIT_L(0); PG8_MMA(0, 0, At, B0); PG8_BAR; PG8_SCHED;
            PG8_LDB(B1, 0, 1); PG8_STAGE(PG8_SB(0, 0), b2, voffB);
            PG8_BAR; PG8_WAIT_L(0); PG8_MMA(0, 1, At, B1); PG8_BAR;
            PG8_LDA(At, 0, 1); PG8_STAGE(PG8_SA(0, 0), a2, voffA);
            PG8_BAR; PG8_WAIT_L(0); PG8_MMA(1, 0, At, B0); PG8_BAR; PG8_SCHED;
            PG8_STAGE(PG8_SB(0, 1), b2 + hstep, voffB);
            PG8_WAIT_V(6); PG8_BAR; PG8_MMA(1, 1, At, B1); PG8_BAR;
            PG8_LDB(B0, 1, 0); PG8_SCHED; PG8_LDA(At, 1, 0); PG8_STAGE(PG8_SA(0, 1), a2 + hstep, voffA);
            PG8_WAIT_L(8); PG8_BAR; PG8_WAIT_L(0); PG8_MMA(0, 0, At, B0); PG8_BAR; PG8_SCHED;
            PG8_LDB(B1, 1, 1); PG8_STAGE(PG8_SB(1, 0), b3, voffB);
            PG8_BAR; PG8_WAIT_L(0); PG8_MMA(0, 1, At, B1); PG8_BAR;
            PG8_LDA(At, 1, 1); PG8_STAGE(PG8_SA(1, 0), a3, voffA);
            PG8_BAR; PG8_WAIT_L(0); PG8_MMA(1, 0, At, B0); PG8_BAR; PG8_SCHED;
            PG8_STAGE(PG8_SB(1, 1), b3 + hstep, voffB);
            PG8_WAIT_V(6); PG8_BAR; PG8_MMA(1, 1, At, B1); PG8_BAR;
            }
        }
        if constexpr (ALIGN_EPI) { if (wr == 0) PG8_BAR; }
        if constexpr (!Epi::AFTER_DRAIN) { E(acc, cur, wr, wc, fr, fq); S.done(cur); }
        if (!has_next) break;
#pragma unroll
        for (int a = 0; a < 2; ++a)
#pragma unroll
            for (int b = 0; b < 2; ++b)
#pragma unroll
                for (int m = 0; m < 4; ++m)
#pragma unroll
                    for (int n = 0; n < 2; ++n) acc[a][b][m][n] = (f32x4){0.f, 0.f, 0.f, 0.f};
        cur = nxt; cA = nA; cB = nB; ++ui;
        if constexpr (ALIGN_EPI) { if (wr == 1) PG8_BAR; }
    }
    PG8_WAIT_V(0);
    if constexpr (!ALIGN_EPI) { if (wr == 0) PG8_BAR; }
    PG8_BAR;
    if constexpr (Epi::AFTER_DRAIN) { E.fused(acc, cur, wr, wc, fr, fq, lds, wid, lane); S.done(cur); }
#undef PG8_SA
#undef PG8_SB
#undef PG8_STAGE
#undef PG8_LDA
#undef PG8_LDB
#undef PG8_MMA
#undef PG8_WAIT_V
#undef PG8_WAIT_L
#undef PG8_BAR
#undef PG8_SCHED
}
}
constexpr int NWAVES = 8, NTHR = 512;
#ifndef MK_N_LAUNCHES
#define MK_N_LAUNCHES 1
#endif
constexpr int N_LAUNCHES = MK_N_LAUNCHES;
constexpr int PER_PHASE = 8;
constexpr int BATCH = 2, SEQ = 16384, DM = 2048, M = BATCH * SEQ, NCH = SEQ / 64;
constexpr int IN_COLS = 8200, PE = 256, NNAT = 6144, NTR = 2048;
constexpr float EPS = 1e-6f;
constexpr int PC_Q = 0, PC_K = 512, PC_O = 1024, PC_Z = 2048, PC_HQ = 3072, PC_HF = 4096, PC_HG = 5120;
constexpr size_t MiB = 1u << 20;
constexpr size_t WS_CTL = 0, CTL_ZERO_BYTES = 1 * MiB;
constexpr size_t WS_SSQH = 256 * 1024, WS_SSQ2 = 512 * 1024;
constexpr size_t WS_WIN = 2 * MiB, WS_WO = 34 * MiB, WS_WG = 42 * MiB, WS_WE = 50 * MiB;
constexpr size_t WS_GATES = 52 * MiB;
constexpr size_t WS_BCUM = 53 * MiB;
constexpr size_t WS_MSC = 54 * MiB;
constexpr size_t WS_NST = 55 * MiB;
constexpr size_t WS_GDEC = 56 * MiB;
constexpr size_t WS_PB = 64 * MiB;
constexpr size_t WS_U = 80 * MiB;
constexpr size_t WS_PROJ = 208 * MiB;
constexpr size_t WS_VT = 592 * MiB;
constexpr size_t WS_END = 720 * MiB;
constexpr int CW_TMO = 0, CW_BAR = 4096;
constexpr int RING_BYTES = 131072, LDSCTL_OFF = RING_BYTES, MISC_OFF = LDSCTL_OFF + 320, LDS_BYTES = 147456;

#define GAS __attribute__((address_space(1)))
#define LAS __attribute__((address_space(3)))
typedef unsigned short bf16;
typedef unsigned v4u __attribute__((ext_vector_type(4)));
typedef unsigned v2u __attribute__((ext_vector_type(2)));
typedef float f32x4 __attribute__((ext_vector_type(4)));
typedef float f32x16 __attribute__((ext_vector_type(16)));
typedef short bf16x8 __attribute__((ext_vector_type(8)));
typedef GAS unsigned gu32;
#define RLX_AGENT __ATOMIC_RELAXED, __HIP_MEMORY_SCOPE_AGENT
#define LDS_WAIT() asm volatile("s_waitcnt lgkmcnt(0)" ::: "memory")
#define VM_WAIT() asm volatile("s_waitcnt vmcnt(0)" ::: "memory")
typedef __bf16 bf16x2_t __attribute__((ext_vector_type(2)));
__device__ __forceinline__ unsigned pk2(float lo, float hi) { bf16x2_t v; v[0] = (__bf16)lo; v[1] = (__bf16)hi; return __builtin_bit_cast(unsigned, v); }
__device__ __forceinline__ float bf2f(bf16 v) { return __uint_as_float((unsigned)v << 16); }
__device__ __forceinline__ float blo(unsigned w) { return __uint_as_float(w << 16); }
__device__ __forceinline__ float bhi(unsigned w) { return __uint_as_float(w & 0xffff0000u); }
__device__ __forceinline__ float sigm(float x) { return 1.0f / (1.0f + __expf(-x)); }

#define XB_TMO      128
#define XB_XCNT(j)  (256  + 64 * (j))
#define XB_XSUB(j)  (1280 + 64 * (j))
#define XB_XGEN(j)  (2304 + 64 * (j))
#define XB_TOP      3328
#define XB_TOPGEN   3392
#define XCD_BAR_WORDS 3456
#define XB_SPIN_CAP (1u << 18)
__device__ __forceinline__ unsigned xb_ld(unsigned* p)              { return __hip_atomic_load(p, __ATOMIC_RELAXED, __HIP_MEMORY_SCOPE_AGENT); }
__device__ __forceinline__ unsigned xb_add(unsigned* p, unsigned v) { return __hip_atomic_fetch_add(p, v, __ATOMIC_RELAXED, __HIP_MEMORY_SCOPE_AGENT); }
__device__ __forceinline__ unsigned xb_xcc_id() { return (unsigned)__builtin_amdgcn_s_getreg((3 << 11) | 20) & 0xFu; }
#define XB_SPIN(cond, bar) do { unsigned _sp = 0; while (cond) { __builtin_amdgcn_s_sleep(1); \
    if ((++_sp & 255u) == 0u) { if (xb_ld(&(bar)[XB_TMO])) break; if (_sp > XB_SPIN_CAP) { atomicAdd(&(bar)[XB_TMO], 1u); break; } } } } while (0)
struct XcdBarrier { unsigned* bar; unsigned x; volatile LAS unsigned* st; };
__device__ __forceinline__ XcdBarrier xcd_barrier_post(unsigned* bar, volatile LAS unsigned* st) {
    XcdBarrier b; b.bar = bar; b.x = xb_xcc_id(); b.st = st;
    if (threadIdx.x == 0) (void)xb_add(&bar[XB_XCNT(b.x)], 1u);
    return b;
}
__device__ __forceinline__ void xcd_barrier_complete(unsigned* bar, unsigned x, unsigned& nloc, unsigned& nx) {
    const unsigned G = gridDim.x * gridDim.y * gridDim.z;
    unsigned sum, cnt, mine, sp = 0u;
    for (;;) {
        sum = 0u; cnt = 0u; mine = 0u;
#pragma unroll
        for (unsigned j = 0; j < 16; ++j) { const unsigned c = xb_ld(&bar[XB_XCNT(j)]); sum += c; cnt += (c > 0u) ? 1u : 0u; mine = (j == x) ? c : mine; }
        if (sum == G) break;
        __builtin_amdgcn_s_sleep(1);
        if ((++sp & 255u) == 0u) { if (xb_ld(&bar[XB_TMO])) break; if (sp > XB_SPIN_CAP) { atomicAdd(&bar[XB_TMO], 1u); break; } }
    }
    nloc = mine > 0u ? mine : 1u; nx = cnt > 0u ? cnt : 1u;
}
__device__ __forceinline__ void xcd_barrier(const XcdBarrier& b) {
    asm volatile("s_waitcnt vmcnt(0)" ::: "memory");
    __syncthreads();
    if (threadIdx.x == 0) {
        unsigned* bar = b.bar;
        __builtin_amdgcn_s_waitcnt(0);
        unsigned nloc = b.st[0], nx = b.st[1];
        if (nloc == 0u) { xcd_barrier_complete(bar, b.x, nloc, nx); b.st[0] = nloc; b.st[1] = nx; }
        const unsigned old = xb_add(&bar[XB_XSUB(b.x)], 1u);
        const unsigned gen = old / nloc;
        if (old + 1u == (gen + 1u) * nloc) {
            __builtin_amdgcn_fence(__ATOMIC_RELEASE, "agent");
            asm volatile("s_waitcnt vmcnt(0)" ::: "memory");
            const unsigned og = xb_add(&bar[XB_TOP], 1u);
            const unsigned tg = og / nx;
            if (og + 1u == (tg + 1u) * nx) xb_add(&bar[XB_TOPGEN], 1u);
            else XB_SPIN(xb_ld(&bar[XB_TOPGEN]) == tg, bar);
            __builtin_amdgcn_fence(__ATOMIC_ACQUIRE, "agent");
            xb_add(&bar[XB_XGEN(b.x)], 1u);
            asm volatile("s_waitcnt vmcnt(0)" ::: "memory");
        } else {
            XB_SPIN(xb_ld(&bar[XB_XGEN(b.x)]) == gen, bar);
            __builtin_amdgcn_fence(__ATOMIC_ACQUIRE, "agent");
            asm volatile("s_waitcnt vmcnt(0)" ::: "memory");
        }
    }
    __syncthreads();
}

struct Frame {
    LAS unsigned char* lds;
    int tid, lane, wave, G, bid;
    const float *x, *p, *norm_w, *w_in, *conv_w, *conv_b, *b_i, *b_f, *ml_nw, *hg_lb, *hg_nw, *w_out, *pe_nw, *w_pg, *w_pe, *fin_nw;
    float* out;
    bf16 *Wt_in, *WoT, *WgT, *WeT, *PB, *U, *Y, *PROJ, *HB, *EB, *VT, *Cm, *Ch;
    float *gates, *bcum, *msc, *nst, *gdec, *ssqh, *ssq2;
};
__device__ __forceinline__ float wave_sum(float v) {
#pragma unroll
    for (int o = 1; o < 64; o <<= 1) v += __shfl_xor(v, o);
    return v;
}
__device__ __forceinline__ float wave_max(float v) {
#pragma unroll
    for (int o = 1; o < 64; o <<= 1) v = fmaxf(v, __shfl_xor(v, o));
    return v;
}
__device__ __forceinline__ float wave_scan_sum(float v, int lane) {
#pragma unroll
    for (int o = 1; o < 64; o <<= 1) { const float y = __shfl_up(v, o); if (lane >= o) v += y; }
    return v;
}
__device__ __forceinline__ float wave_scan_max(float v, int lane) {
#pragma unroll
    for (int o = 1; o < 64; o <<= 1) { const float y = __shfl_up(v, o); if (lane >= o) v = fmaxf(v, y); }
    return v;
}
__device__ __forceinline__ f32x16 mfma32(bf16x8 a, bf16x8 b, f32x16 c) { return __builtin_amdgcn_mfma_f32_32x32x16_bf16(a, b, c, 0, 0, 0); }
__device__ __forceinline__ f32x16 zero16() { f32x16 z;
#pragma unroll
    for (int i = 0; i < 16; ++i) z[i] = 0.f;
    return z; }

__device__ __forceinline__ void p0_transpose_item(const float* W, int ldw, int src_col, int K, bf16* WT, int dst_row, const float* kscale, LAS float* scr, int k0, int lane) {
#pragma unroll 8
    for (int i = 0; i < 32; ++i) { const int kk = 2 * i + (lane >> 5); float v = W[(size_t)(k0 + kk) * ldw + src_col + (lane & 31)]; if (kscale) v *= kscale[k0 + kk]; scr[kk * 33 + (lane & 31)] = v; }
    LDS_WAIT(); asm volatile("" ::: "memory");
    const int c = lane & 7;
#pragma unroll
    for (int j = 0; j < 4; ++j) { const int n = (lane >> 3) + 8 * j; const LAS float* s = scr + (8 * c) * 33 + n;
        v4u o; o.x = pk2(s[0 * 33], s[1 * 33]); o.y = pk2(s[2 * 33], s[3 * 33]); o.z = pk2(s[4 * 33], s[5 * 33]); o.w = pk2(s[6 * 33], s[7 * 33]);
        *(v4u*)(WT + (size_t)(dst_row + n) * K + k0 + 8 * c) = o; }
    LDS_WAIT(); asm volatile("" ::: "memory");
}
__device__ __forceinline__ int win_src_col(int r) { return r < 1024 ? r : r < 3072 ? r + 1024 : r < 5120 ? r + 1032 : r < 6144 ? r + 2056 : r < 7168 ? r - 5120 : r - 1016; }
__device__ __forceinline__ void p0_prologue(const Frame& F) {
    LAS float* scr = (LAS float*)(F.lds + F.wave * 16384);
    const int gw = F.bid * NWAVES + F.wave, NGW = F.G * NWAVES, lane = F.lane;
    for (int it = gw; it < 12544; it += NGW) {
        int r = it;
        if (r < 8192) { const int kb = r >> 8, nb = r & 255; p0_transpose_item(F.w_in, IN_COLS, win_src_col(nb * 32), DM, F.Wt_in, nb * 32, nullptr, scr, kb * 64, lane); continue; } r -= 8192;
        if (r < 2048) { const int kb = r >> 6, nb = r & 63; p0_transpose_item(F.w_out, DM, nb * 32, DM, F.WoT, nb * 32, nullptr, scr, kb * 64, lane); continue; } r -= 2048;
        if (r < 2048) { const int kb = r >> 6, nb = r & 63; p0_transpose_item(F.w_pg, DM, nb * 32, DM, F.WgT, nb * 32, F.pe_nw, scr, kb * 64, lane); continue; } r -= 2048;
        { const int kb = r >> 6, nb = r & 63; p0_transpose_item(F.w_pe, DM, nb * 32, PE, F.WeT, nb * 32, nullptr, scr, kb * 64, lane); }
    }
    for (int idx = F.bid * NTHR + F.tid; idx < M * PE / 4; idx += F.G * NTHR) { const f32x4 v = ((const f32x4*)F.p)[idx]; v2u o; o.x = pk2(v[0], v[1]); o.y = pk2(v[2], v[3]); ((v2u*)F.PB)[idx] = o; }
    __syncthreads();
    LAS float* Wg = (LAS float*)F.lds;
    for (int k = F.tid; k < DM; k += NTHR) { const f32x4 a = *(const f32x4*)(F.w_in + (size_t)k * IN_COLS + 4096), b = *(const f32x4*)(F.w_in + (size_t)k * IN_COLS + 4100);
        Wg[0 * DM + k] = a[0]; Wg[1 * DM + k] = a[1]; Wg[2 * DM + k] = a[2]; Wg[3 * DM + k] = a[3]; Wg[4 * DM + k] = b[0]; Wg[5 * DM + k] = b[1]; Wg[6 * DM + k] = b[2]; Wg[7 * DM + k] = b[3]; }
    __syncthreads();
    const f32x4* nwp = (const f32x4*)F.norm_w + lane;
    const float gbias = lane < 4 ? F.b_i[lane & 3] : F.b_f[lane & 3];
    for (int m = gw; m < M; m += NGW) {
        asm volatile("" ::: "memory");
        const f32x4* xr = (const f32x4*)(F.x + (size_t)m * DM) + lane;
        f32x4 t[8]; float ss = 0.f; float ga[8];
#pragma unroll
        for (int c = 0; c < 8; ++c) ga[c] = 0.f;
#pragma unroll
        for (int j = 0; j < 8; ++j) { const f32x4 v = xr[64 * j]; ss += (v[0] * v[0] + v[1] * v[1]) + (v[2] * v[2] + v[3] * v[3]); t[j] = v * nwp[64 * j]; }
#pragma unroll
        for (int j = 0; j < 8; ++j)
#pragma unroll
            for (int c = 0; c < 8; ++c) { const f32x4 w = *(const LAS f32x4*)(Wg + c * DM + 4 * lane + 256 * j); ga[c] += (t[j][0] * w[0] + t[j][1] * w[1]) + (t[j][2] * w[2] + t[j][3] * w[3]); }
        ss = wave_sum(ss); const float rstd = 1.0f / sqrtf(ss * (1.0f / DM) + EPS);
#pragma unroll
        for (int c = 0; c < 8; ++c) ga[c] = wave_sum(ga[c]) * rstd;
        v2u* uo = (v2u*)(F.U + (size_t)m * DM) + lane;
#pragma unroll
        for (int j = 0; j < 8; ++j) { const f32x4 q = t[j] * rstd; v2u o; o.x = pk2(q[0], q[1]); o.y = pk2(q[2], q[3]); uo[64 * j] = o; }
        float gv = ga[0];
        gv = lane == 1 ? ga[1] : gv; gv = lane == 2 ? ga[2] : gv; gv = lane == 3 ? ga[3] : gv; gv = lane == 4 ? ga[4] : gv; gv = lane == 5 ? ga[5] : gv; gv = lane == 6 ? ga[6] : gv; gv = lane == 7 ? ga[7] : gv;
        if (lane < 8) F.gates[(size_t)m * 8 + lane] = gv + gbias;
    }
}
__device__ __forceinline__ void conv_silu_16(const Frame& F, const bf16* src, int ch, bool has_halo, float scale, float (&out)[16]) {
    const float w0 = F.conv_w[ch], w1 = F.conv_w[1024 + ch], w2 = F.conv_w[2048 + ch], w3 = F.conv_w[3072 + ch], cb = F.conv_b[ch];
    float r0 = 0.f, r1 = 0.f, r2 = 0.f;
    if (has_halo) { r0 = bf2f(src[-3 * NNAT]); r1 = bf2f(src[-2 * NNAT]); r2 = bf2f(src[-1 * NNAT]); }
#pragma unroll
    for (int jj = 0; jj < 16; ++jj) { const float xv = bf2f(src[jj * NNAT]); const float cv = cb + w0 * r0 + w1 * r1 + w2 * r2 + w3 * xv; r0 = r1; r1 = r2; r2 = xv; out[jj] = cv * sigm(cv) * scale; }
}
__device__ __forceinline__ void pa_mlstm(const Frame& F, int bh, int c) {
    const int b = bh >> 2, h = bh & 3, m0 = b * SEQ + c * 64, unit = bh * NCH + c, tid = F.tid, lane = F.lane, wave = F.wave;
    LAS bf16* kT = (LAS bf16*)F.lds;
    LAS float* wl = (LAS float*)(F.lds + 18432);
    LAS float* nsum = wl + 64;
    if (wave == 0) {
        const float ig = F.gates[(size_t)(m0 + lane) * 8 + h], fp = F.gates[(size_t)(m0 + lane) * 8 + 4 + h];
        const float lf = fminf(fp, 0.f) - log1pf(expf(-fabsf(fp)));
        const float bc = wave_scan_sum(lf, lane);
        const float g = __shfl(bc, 63);
        const float a = g - bc + ig;
        const float ml = wave_max(a);
        wl[lane] = expf(a - ml);
        F.bcum[(size_t)bh * SEQ + c * 64 + lane] = bc;
        if (lane == 0) { F.msc[unit * 4 + 0] = g; F.msc[unit * 4 + 1] = ml; }
    }
    __syncthreads();
    {
        const int d = tid & 127, jq = tid >> 7;
        float kv[16];
        conv_silu_16(F, F.PROJ + (size_t)(m0 + 16 * jq) * NNAT + PC_K + h * 128 + d, 512 + h * 128 + d, (c | jq) != 0, 0.08838834764831845f, kv);
        float ns = 0.f; unsigned pk[8];
#pragma unroll
        for (int jj = 0; jj < 16; ++jj) { kv[jj] *= wl[16 * jq + jj]; ns += kv[jj]; }
#pragma unroll
        for (int i = 0; i < 8; ++i) pk[i] = pk2(kv[2 * i], kv[2 * i + 1]);
        LAS v4u* dst = (LAS v4u*)(kT + d * 72 + 16 * jq);
        dst[0] = (v4u){pk[0], pk[1], pk[2], pk[3]}; dst[1] = (v4u){pk[4], pk[5], pk[6], pk[7]};
        nsum[jq * 128 + d] = ns;
    }
    __syncthreads();
    if (tid < 128) F.nst[(size_t)unit * 128 + tid] = (nsum[tid] + nsum[128 + tid]) + (nsum[256 + tid] + nsum[384 + tid]);
    {
        const int r32 = lane & 31, hi = lane >> 5;
        f32x16 acc[4];
#pragma unroll
        for (int i = 0; i < 4; ++i) acc[i] = zero16();
        const bf16* vt = F.VT + (size_t)(h * 256 + 32 * wave + r32) * M + m0 + 8 * hi;
#pragma unroll
        for (int ks = 0; ks < 4; ++ks) { const bf16x8 bfr = *(const bf16x8*)(vt + 16 * ks);
#pragma unroll
            for (int dt = 0; dt < 4; ++dt) { const bf16x8 afr = *(const LAS bf16x8*)(kT + (32 * dt + r32) * 72 + 16 * ks + 8 * hi); acc[dt] = mfma32(afr, bfr, acc[dt]); } }
        bf16* dst = F.Cm + ((size_t)unit * 256 + 32 * wave + r32) * 128 + 4 * hi;
#pragma unroll
        for (int dt = 0; dt < 4; ++dt)
#pragma unroll
            for (int q = 0; q < 4; ++q) { v2u w; w.x = pk2(acc[dt][4 * q], acc[dt][4 * q + 1]); w.y = pk2(acc[dt][4 * q + 2], acc[dt][4 * q + 3]); *(v2u*)(dst + 32 * dt + 8 * q) = w; }
    }
    __syncthreads();
}
__device__ __forceinline__ float hg_forget_16(const bf16* srcf, float lb, float (&sg)[16], float (&cum)[16]) {
    float run = 0.f;
#pragma unroll
    for (int jj = 0; jj < 16; ++jj) { const float xv = bf2f(srcf[jj * NNAT]); const float s = sigm(xv); const float f = lb + (1.0f - lb) * s; run += logf(f); sg[jj] = s; cum[jj] = run; }
    return run;
}
__device__ __forceinline__ void pa_hgrn2(const Frame& F, int bh, int c) {
    const int b = bh >> 3, h = bh & 7, m0 = b * SEQ + c * 64, unit = bh * NCH + c, tid = F.tid, lane = F.lane, wave = F.wave;
    LAS bf16* kT = (LAS bf16*)F.lds;
    LAS float* seg = (LAS float*)(F.lds + 18432);
    const int e = tid & 127, jq = tid >> 7;
    const float lb = 1.0f / (1.0f + expf(F.hg_lb[1024 + h * 128 + e] - F.hg_lb[h * 128 + e]));
    float sg[16], cum[16];
    const float run = hg_forget_16(F.PROJ + (size_t)(m0 + 16 * jq) * NNAT + PC_HF + h * 128 + e, lb, sg, cum);
    seg[jq * 128 + e] = run;
    __syncthreads();
    {
        const float s0 = seg[e], s1 = seg[128 + e], s2 = seg[256 + e], s3 = seg[384 + e];
        const float off = jq == 0 ? 0.f : jq == 1 ? s0 : jq == 2 ? s0 + s1 : s0 + s1 + s2;
        const float g = (s0 + s1) + (s2 + s3);
        unsigned pk[8];
#pragma unroll
        for (int i = 0; i < 8; ++i) { const float k0 = (1.0f - lb) * (1.0f - sg[2 * i]) * expf(g - (off + cum[2 * i])), k1 = (1.0f - lb) * (1.0f - sg[2 * i + 1]) * expf(g - (off + cum[2 * i + 1])); pk[i] = pk2(k0, k1); }
        LAS v4u* dst = (LAS v4u*)(kT + e * 72 + 16 * jq);
        dst[0] = (v4u){pk[0], pk[1], pk[2], pk[3]}; dst[1] = (v4u){pk[4], pk[5], pk[6], pk[7]};
        if (jq == 0) F.gdec[(size_t)unit * 128 + e] = expf(g);
    }
    __syncthreads();
    {
        const int r32 = lane & 31, hi = lane >> 5, vt_i = wave & 3, et0 = 2 * (wave >> 2);
        f32x16 acc[2]; acc[0] = zero16(); acc[1] = zero16();
        const bf16* vt = F.VT + (size_t)(1024 + h * 128 + 32 * vt_i + r32) * M + m0 + 8 * hi;
#pragma unroll
        for (int ks = 0; ks < 4; ++ks) { const bf16x8 bfr = *(const bf16x8*)(vt + 16 * ks);
#pragma unroll
            for (int i = 0; i < 2; ++i) { const bf16x8 afr = *(const LAS bf16x8*)(kT + (32 * (et0 + i) + r32) * 72 + 16 * ks + 8 * hi); acc[i] = mfma32(afr, bfr, acc[i]); } }
        bf16* dst = F.Ch + ((size_t)unit * 128 + 32 * vt_i + r32) * 128 + 4 * hi;
#pragma unroll
        for (int i = 0; i < 2; ++i)
#pragma unroll
            for (int q = 0; q < 4; ++q) { v2u w; w.x = pk2(acc[i][4 * q], acc[i][4 * q + 1]); w.y = pk2(acc[i][4 * q + 2], acc[i][4 * q + 3]); *(v2u*)(dst + 32 * (et0 + i) + 8 * q) = w; }
    }
    __syncthreads();
}
__device__ __forceinline__ void unpack8(const v4u k, float (&o)[8]) { o[0] = blo(k.x); o[1] = bhi(k.x); o[2] = blo(k.y); o[3] = bhi(k.y); o[4] = blo(k.z); o[5] = bhi(k.z); o[6] = blo(k.w); o[7] = bhi(k.w); }
__device__ __forceinline__ v4u pack8(const float (&s)[8]) { v4u o; o.x = pk2(s[0], s[1]); o.y = pk2(s[2], s[3]); o.z = pk2(s[4], s[5]); o.w = pk2(s[6], s[7]); return o; }
__device__ __forceinline__ void scan_phase(const Frame& F) {
    const int gt = F.bid * NTHR + F.tid;
    if (gt < 32768) {
        const int bh = gt >> 12, v = (gt >> 4) & 255, dg = gt & 15;
        bf16* ptr = F.Cm + ((size_t)(bh * NCH) * 256 + v) * 128 + dg * 8;
        float* ms = F.msc + (size_t)bh * NCH * 4;
        float* np = F.nst + (size_t)bh * NCH * 128 + dg * 8;
        const bool nth = (v == 0);
        float C[8], n[8]; float m = 0.f;
#pragma unroll
        for (int i = 0; i < 8; ++i) { C[i] = 0.f; n[i] = 0.f; }
        for (int c0 = 0; c0 < NCH; c0 += 4) {
            v4u K[4];
#pragma unroll
            for (int i = 0; i < 4; ++i) K[i] = *(const v4u*)(ptr + (size_t)(c0 + i) * 32768);
#pragma unroll
            for (int i = 0; i < 4; ++i) { const int c = c0 + i;
                const float g = ms[c * 4], ml = ms[c * 4 + 1];
                const float mn = fmaxf(g + m, ml), ws = expf(g + m - mn), fl = expf(ml - mn);
                *(v4u*)(ptr + (size_t)c * 32768) = pack8(C);
                float kf[8]; unpack8(K[i], kf);
#pragma unroll
                for (int q = 0; q < 8; ++q) C[q] = ws * C[q] + fl * kf[q];
                if (nth) {
                    const f32x4 a = *(const f32x4*)(np + c * 128), bq = *(const f32x4*)(np + c * 128 + 4);
                    *(f32x4*)(np + c * 128) = (f32x4){n[0], n[1], n[2], n[3]}; *(f32x4*)(np + c * 128 + 4) = (f32x4){n[4], n[5], n[6], n[7]};
                    n[0] = ws * n[0] + fl * a[0]; n[1] = ws * n[1] + fl * a[1]; n[2] = ws * n[2] + fl * a[2]; n[3] = ws * n[3] + fl * a[3];
                    n[4] = ws * n[4] + fl * bq[0]; n[5] = ws * n[5] + fl * bq[1]; n[6] = ws * n[6] + fl * bq[2]; n[7] = ws * n[7] + fl * bq[3];
                    if (dg == 0) ms[c * 4 + 2] = m;
                }
                m = mn; }
        }
    } else if (gt < 65536) {
        const int g2 = gt - 32768, bh = g2 >> 11, v = (g2 >> 4) & 127, eg = g2 & 15;
        bf16* ptr = F.Ch + ((size_t)(bh * NCH) * 128 + v) * 128 + eg * 8;
        const float* gd = F.gdec + (size_t)bh * NCH * 128 + eg * 8;
        float S[8];
#pragma unroll
        for (int i = 0; i < 8; ++i) S[i] = 0.f;
        for (int c0 = 0; c0 < NCH; c0 += 4) {
            v4u K[4]; f32x4 D0[4], D1[4];
#pragma unroll
            for (int i = 0; i < 4; ++i) { K[i] = *(const v4u*)(ptr + (size_t)(c0 + i) * 16384); D0[i] = *(const f32x4*)(gd + (c0 + i) * 128); D1[i] = *(const f32x4*)(gd + (c0 + i) * 128 + 4); }
#pragma unroll
            for (int i = 0; i < 4; ++i) { const int c = c0 + i;
                *(v4u*)(ptr + (size_t)c * 16384) = pack8(S);
                float kf[8]; unpack8(K[i], kf);
                S[0] = D0[i][0] * S[0] + kf[0]; S[1] = D0[i][1] * S[1] + kf[1]; S[2] = D0[i][2] * S[2] + kf[2]; S[3] = D0[i][3] * S[3] + kf[3];
                S[4] = D1[i][0] * S[4] + kf[4]; S[5] = D1[i][1] * S[5] + kf[5]; S[6] = D1[i][2] * S[6] + kf[6]; S[7] = D1[i][3] * S[7] + kf[7]; }
        }
    }
}
constexpr int R_QS = 0, R_KS = 17408, R_QW = 34816, R_SC = 52224, R_F32 = 61440;
__device__ __forceinline__ void st_bf(LAS bf16* p, float v) { *p = (bf16)(pk2(v, v) & 0xffffu); }
template <int MODE>
__device__ __forceinline__ void score_tiles(const Frame& F, const LAS bf16* Kt, const LAS bf16* Qt, LAS bf16* Sc, const LAS float* bm, const LAS float* uu, LAS float* dnA, LAS float* dnB) {
    const int wave = F.wave, lane = F.lane, r32 = lane & 31, hi = lane >> 5;
    if (wave < 3) {
        const int jt = (wave == 2) ? 1 : 0, tt = (wave >= 1) ? 1 : 0;
        f32x16 acc = zero16();
#pragma unroll
        for (int ks = 0; ks < 8; ++ks) { const bf16x8 a = *(const LAS bf16x8*)(Kt + (32 * jt + r32) * 136 + 16 * ks + 8 * hi), bq = *(const LAS bf16x8*)(Qt + (32 * tt + r32) * 136 + 16 * ks + 8 * hi); acc = mfma32(a, bq, acc); }
        const int t = 32 * tt + r32; float rs = 0.f; float bmt = 0.f; if (MODE == 1) bmt = bm[t];
#pragma unroll
        for (int q = 0; q < 4; ++q) { const int j0 = 32 * jt + 8 * q + 4 * hi; float vv[4];
            f32x4 u4 = (f32x4){0.f, 0.f, 0.f, 0.f}; if (MODE == 1) u4 = *(const LAS f32x4*)(uu + j0);
#pragma unroll
            for (int i = 0; i < 4; ++i) { float val = acc[4 * q + i]; if (MODE == 1) val *= __expf(fminf(bmt + u4[i], 0.f)); val = (j0 + i <= t) ? val : 0.f; vv[i] = val; rs += val; }
            v2u w; w.x = pk2(vv[0], vv[1]); w.y = pk2(vv[2], vv[3]); *(LAS v2u*)(Sc + t * 72 + j0) = w; }
        if (MODE == 1) { rs += __shfl_xor(rs, 32); if (hi == 0) { if (jt == 0) dnA[t] = rs; else dnB[t] = rs; } }
    } else if (wave == 3) {
        for (int idx = lane; idx < 128; idx += 64) { const int t = idx >> 2, part = idx & 3; *(LAS v4u*)(Sc + t * 72 + 32 + 8 * part) = (v4u){0u, 0u, 0u, 0u}; }
        if (MODE == 1 && lane < 32) dnB[lane] = 0.f;
    }
}
__device__ __forceinline__ void r2_mlstm(const Frame& F, int bh, int c) {
    const int b = bh >> 2, h = bh & 3, m0 = b * SEQ + c * 64, unit = bh * NCH + c, tid = F.tid, lane = F.lane, wave = F.wave, r32 = lane & 31, hi = lane >> 5;
    LAS bf16* Qs = (LAS bf16*)(F.lds + R_QS); LAS bf16* Ks = (LAS bf16*)(F.lds + R_KS); LAS bf16* Qw = (LAS bf16*)(F.lds + R_QW); LAS bf16* Sc = (LAS bf16*)(F.lds + R_SC);
    LAS float* fb = (LAS float*)(F.lds + R_F32);
    LAS float *bm = fb, *uu = fb + 64, *wi = fb + 128, *emt = fb + 192, *qn = fb + 256, *dnA = fb + 320, *dnB = fb + 384, *nc = fb + 448, *hn = fb + 576;
    if (wave == 0) {
        const float bj = F.bcum[(size_t)bh * SEQ + c * 64 + lane], ig = F.gates[(size_t)(m0 + lane) * 8 + h], mc = F.msc[unit * 4 + 2];
        const float uj = ig - bj, pm = wave_scan_max(uj, lane), mt = bj + fmaxf(mc, pm);
        bm[lane] = bj - mt; uu[lane] = uj; wi[lane] = expf(bj + mc - mt); emt[lane] = expf(-mt);
    } else if (wave < 3) { const int i = tid - 64; nc[i] = F.nst[(size_t)unit * 128 + i]; }
    {
        const int d = tid & 127, jq = tid >> 7; float v[16];
        conv_silu_16(F, F.PROJ + (size_t)(m0 + 16 * jq) * NNAT + PC_Q + h * 128 + d, h * 128 + d, (c | jq) != 0, 1.0f, v);
#pragma unroll
        for (int jj = 0; jj < 16; ++jj) st_bf(Qs + (16 * jq + jj) * 136 + d, v[jj]);
        conv_silu_16(F, F.PROJ + (size_t)(m0 + 16 * jq) * NNAT + PC_K + h * 128 + d, 512 + h * 128 + d, (c | jq) != 0, 0.08838834764831845f, v);
#pragma unroll
        for (int jj = 0; jj < 16; ++jj) st_bf(Ks + (16 * jq + jj) * 136 + d, v[jj]);
    }
    __syncthreads();
    if (wave < 4) score_tiles<1>(F, Ks, Qs, Sc, bm, uu, dnA, dnB);
    else {
        const int lt = tid - 256, t = lt >> 2, part = lt & 3; const float wt = wi[t]; float dot = 0.f;
#pragma unroll
        for (int i = 0; i < 4; ++i) { const int d0 = 32 * part + 8 * i; const v4u qv = *(const LAS v4u*)(Qs + t * 136 + d0); float qf[8]; unpack8(qv, qf);
#pragma unroll
            for (int k = 0; k < 8; ++k) dot += qf[k] * nc[d0 + k];
            v4u o; o.x = pk2(qf[0] * wt, qf[1] * wt); o.y = pk2(qf[2] * wt, qf[3] * wt); o.z = pk2(qf[4] * wt, qf[5] * wt); o.w = pk2(qf[6] * wt, qf[7] * wt); *(LAS v4u*)(Qw + t * 136 + d0) = o; }
        dot += __shfl_xor(dot, 1); dot += __shfl_xor(dot, 2); if (part == 0) qn[t] = dot;
    }
    __syncthreads();
    f32x16 acc2[2]; acc2[0] = zero16(); acc2[1] = zero16();
    {
        const bf16* vt = F.VT + (size_t)(h * 256 + 32 * wave + r32) * M + m0 + 8 * hi;
#pragma unroll
        for (int ks = 0; ks < 4; ++ks) { const bf16x8 a = *(const bf16x8*)(vt + 16 * ks);
#pragma unroll
            for (int tt = 0; tt < 2; ++tt) { const bf16x8 bq = *(const LAS bf16x8*)(Sc + (32 * tt + r32) * 72 + 16 * ks + 8 * hi); acc2[tt] = mfma32(a, bq, acc2[tt]); } }
        const bf16* cs = F.Cm + ((size_t)unit * 256 + 32 * wave + r32) * 128 + 8 * hi;
#pragma unroll
        for (int ks = 0; ks < 8; ++ks) { const bf16x8 a = *(const bf16x8*)(cs + 16 * ks);
#pragma unroll
            for (int tt = 0; tt < 2; ++tt) { const bf16x8 bq = *(const LAS bf16x8*)(Qw + (32 * tt + r32) * 136 + 16 * ks + 8 * hi); acc2[tt] = mfma32(a, bq, acc2[tt]); } }
    }
#pragma unroll
    for (int tt = 0; tt < 2; ++tt) { const int t = 32 * tt + r32; const float den = dnA[t] + dnB[t] + wi[t] * qn[t]; const float inv = 1.0f / fmaxf(fabsf(den), emt[t]); float ssp = 0.f;
#pragma unroll
        for (int r = 0; r < 16; ++r) { acc2[tt][r] *= inv; ssp += acc2[tt][r] * acc2[tt][r]; }
        ssp += __shfl_xor(ssp, 32); if (hi == 0) hn[wave * 64 + t] = ssp; }
    __syncthreads();
#pragma unroll
    for (int tt = 0; tt < 2; ++tt) { const int t = 32 * tt + r32; float tot = 0.f;
#pragma unroll
        for (int w = 0; w < 8; ++w) tot += hn[w * 64 + t];
        const float rstd = 1.0f / sqrtf(tot * (1.0f / 256.0f) + EPS);
        const bf16* prow = F.PROJ + (size_t)(m0 + t) * NNAT + h * 256 + 32 * wave + 4 * hi;
        bf16* yrow = F.Y + (size_t)(m0 + t) * DM + h * 256 + 32 * wave + 4 * hi;
        const float* nwp = F.ml_nw + h * 256 + 32 * wave + 4 * hi;
#pragma unroll
        for (int q = 0; q < 4; ++q) { const v2u o4 = *(const v2u*)(prow + PC_O + 8 * q), z4 = *(const v2u*)(prow + PC_Z + 8 * q); const f32x4 nw = *(const f32x4*)(nwp + 8 * q);
            const float o0 = blo(o4.x), o1 = bhi(o4.x), o2 = blo(o4.y), o3 = bhi(o4.y), z0 = blo(z4.x), z1 = bhi(z4.x), z2 = blo(z4.y), z3 = bhi(z4.y);
            const float y0 = acc2[tt][4 * q] * rstd * nw[0] * sigm(o0) * z0 * sigm(z0), y1 = acc2[tt][4 * q + 1] * rstd * nw[1] * sigm(o1) * z1 * sigm(z1);
            const float y2 = acc2[tt][4 * q + 2] * rstd * nw[2] * sigm(o2) * z2 * sigm(z2), y3 = acc2[tt][4 * q + 3] * rstd * nw[3] * sigm(o3) * z3 * sigm(z3);
            v2u w; w.x = pk2(y0, y1); w.y = pk2(y2, y3); *(v2u*)(yrow + 8 * q) = w; } }
    __syncthreads();
}
__device__ __forceinline__ void r2_hgrn2(const Frame& F, int bh, int c) {
    const int b = bh >> 3, h = bh & 7, m0 = b * SEQ + c * 64, unit = bh * NCH + c, tid = F.tid, lane = F.lane, wave = F.wave, r32 = lane & 31, hi = lane >> 5;
    LAS bf16* Qt = (LAS bf16*)(F.lds + R_QS); LAS bf16* Kt = (LAS bf16*)(F.lds + R_KS); LAS bf16* Q2 = (LAS bf16*)(F.lds + R_QW); LAS bf16* Sc = (LAS bf16*)(F.lds + R_SC);
    LAS float* fb = (LAS float*)(F.lds + R_F32);
    LAS float *seg = fb, *hn = fb + 512;
    {
        const int e = tid & 127, jq = tid >> 7;
        const float lb = 1.0f / (1.0f + expf(F.hg_lb[1024 + h * 128 + e] - F.hg_lb[h * 128 + e]));
        float sg[16], cum[16];
        const float run = hg_forget_16(F.PROJ + (size_t)(m0 + 16 * jq) * NNAT + PC_HF + h * 128 + e, lb, sg, cum);
        seg[jq * 128 + e] = run;
        __syncthreads();
        const float s0 = seg[e], s1 = seg[128 + e], s2 = seg[256 + e];
        const float off = jq == 0 ? 0.f : jq == 1 ? s0 : jq == 2 ? s0 + s1 : s0 + s1 + s2;
        const float bref = s0 + s1;
        const bf16* srcq = F.PROJ + (size_t)(m0 + 16 * jq) * NNAT + PC_HQ + h * 128 + e;
#pragma unroll
        for (int jj = 0; jj < 16; ++jj) { const int j = 16 * jq + jj; const float bj = off + cum[jj]; const float qv = bf2f(srcq[jj * NNAT]);
            st_bf(Qt + j * 136 + e, qv * expf(bj - bref)); st_bf(Kt + j * 136 + e, (1.0f - lb) * (1.0f - sg[jj]) * expf(bref - bj)); st_bf(Q2 + j * 136 + e, qv * expf(bj)); }
    }
    __syncthreads();
    if (wave < 4) score_tiles<0>(F, Kt, Qt, Sc, nullptr, nullptr, nullptr, nullptr);
    __syncthreads();
    const int vt_i = wave & 3, tt = wave >> 2, t = 32 * tt + r32;
    f32x16 acc = zero16();
    {
        const bf16* vt = F.VT + (size_t)(1024 + h * 128 + 32 * vt_i + r32) * M + m0 + 8 * hi;
#pragma unroll
        for (int ks = 0; ks < 4; ++ks) { const bf16x8 a = *(const bf16x8*)(vt + 16 * ks); const bf16x8 bq = *(const LAS bf16x8*)(Sc + t * 72 + 16 * ks + 8 * hi); acc = mfma32(a, bq, acc); }
        const bf16* cs = F.Ch + ((size_t)unit * 128 + 32 * vt_i + r32) * 128 + 8 * hi;
#pragma unroll
        for (int ks = 0; ks < 8; ++ks) { const bf16x8 a = *(const bf16x8*)(cs + 16 * ks); const bf16x8 bq = *(const LAS bf16x8*)(Q2 + t * 136 + 16 * ks + 8 * hi); acc = mfma32(a, bq, acc); }
    }
    { float ssp = 0.f;
#pragma unroll
      for (int r = 0; r < 16; ++r) ssp += acc[r] * acc[r];
      ssp += __shfl_xor(ssp, 32); if (hi == 0) hn[vt_i * 64 + t] = ssp; }
    __syncthreads();
    {
        const float tot = (hn[t] + hn[64 + t]) + (hn[128 + t] + hn[192 + t]);
        const float rstd = 1.0f / sqrtf(tot * (1.0f / 128.0f) + EPS);
        const bf16* prow = F.PROJ + (size_t)(m0 + t) * NNAT + PC_HG + h * 128 + 32 * vt_i + 4 * hi;
        bf16* yrow = F.Y + (size_t)(m0 + t) * DM + 1024 + h * 128 + 32 * vt_i + 4 * hi;
        const float* nwp = F.hg_nw + h * 128 + 32 * vt_i + 4 * hi;
#pragma unroll
        for (int q = 0; q < 4; ++q) { const v2u g4 = *(const v2u*)(prow + 8 * q); const f32x4 nw = *(const f32x4*)(nwp + 8 * q);
            const float g0 = blo(g4.x), g1 = bhi(g4.x), g2 = blo(g4.y), g3 = bhi(g4.y);
            const float y0 = acc[4 * q] * rstd * nw[0] * g0 * sigm(g0), y1 = acc[4 * q + 1] * rstd * nw[1] * g1 * sigm(g1);
            const float y2 = acc[4 * q + 2] * rstd * nw[2] * g2 * sigm(g2), y3 = acc[4 * q + 3] * rstd * nw[3] * g3 * sigm(g3);
            v2u w; w.x = pk2(y0, y1); w.y = pk2(y2, y3); *(v2u*)(yrow + 8 * q) = w; }
    }
    __syncthreads();
}
__device__ __forceinline__ void final_norm(const Frame& F) {
    const int gw = F.bid * NWAVES + F.wave, NGW = F.G * NWAVES, lane = F.lane;
    const f32x4* nwp = (const f32x4*)F.fin_nw + lane;
    for (int m = gw; m < M; m += NGW) {
        const float sq = __hip_atomic_load(F.ssq2 + m, RLX_AGENT);
        const float rstd = 1.0f / sqrtf(sq * (1.0f / DM) + EPS);
        f32x4* xr = (f32x4*)(F.out + (size_t)m * DM) + lane;
#pragma unroll
        for (int j = 0; j < 8; ++j) xr[64 * j] = xr[64 * j] * rstd * nwp[64 * j];
    }
}
struct Args { const float* in[16]; float* out; unsigned char* ws; int ph_lo, ph_hi, li, pad; };
__global__ void __launch_bounds__(NWAVES * 64, 2) hymba_fwd(Args args) {
    extern __shared__ __attribute__((aligned(16))) unsigned char lds[];
    Frame F;
    F.lds = (LAS unsigned char*)lds;
    F.tid = threadIdx.x; F.lane = F.tid & 63; F.wave = __builtin_amdgcn_readfirstlane(F.tid >> 6); F.G = gridDim.x; F.bid = blockIdx.x;
    unsigned char* ws = args.ws;
    gu32* ctl = (gu32*)(ws + WS_CTL);
    F.x = args.in[0]; F.p = args.in[1]; F.norm_w = args.in[2]; F.w_in = args.in[3]; F.conv_w = args.in[4]; F.conv_b = args.in[5]; F.b_i = args.in[6]; F.b_f = args.in[7];
    F.ml_nw = args.in[8]; F.hg_lb = args.in[9]; F.hg_nw = args.in[10]; F.w_out = args.in[11]; F.pe_nw = args.in[12]; F.w_pg = args.in[13]; F.w_pe = args.in[14]; F.fin_nw = args.in[15];
    F.out = args.out;
    F.Wt_in = (bf16*)(ws + WS_WIN); F.WoT = (bf16*)(ws + WS_WO); F.WgT = (bf16*)(ws + WS_WG); F.WeT = (bf16*)(ws + WS_WE); F.PB = (bf16*)(ws + WS_PB);
    F.U = (bf16*)(ws + WS_U); F.Y = (bf16*)(ws + WS_U); F.PROJ = (bf16*)(ws + WS_PROJ); F.HB = (bf16*)(ws + WS_PROJ); F.EB = (bf16*)(ws + WS_PROJ + 128 * MiB); F.VT = (bf16*)(ws + WS_VT);
    F.Cm = (bf16*)args.out; F.Ch = (bf16*)args.out + (size_t)64 * MiB;
    F.gates = (float*)(ws + WS_GATES); F.bcum = (float*)(ws + WS_BCUM); F.msc = (float*)(ws + WS_MSC); F.nst = (float*)(ws + WS_NST); F.gdec = (float*)(ws + WS_GDEC);
    F.ssqh = (float*)(ws + WS_SSQH); F.ssq2 = (float*)(ws + WS_SSQ2);
    for (int u = F.tid; u < (LDS_BYTES - LDSCTL_OFF) / 4; u += NWAVES * 64) ((LAS unsigned*)(F.lds + LDSCTL_OFF))[u] = 0u;
    __syncthreads();
    XcdBarrier bar; bar.bar = (unsigned*)(ctl + CW_BAR); bar.x = 0; bar.st = nullptr;
    if (N_LAUNCHES != PER_PHASE) bar = xcd_barrier_post((unsigned*)(ctl + CW_BAR), (volatile LAS unsigned*)(F.lds + MISC_OFF) + 8);
#define GRID_BAR() do { if (N_LAUNCHES == PER_PHASE) { if (F.tid == 0) __hip_atomic_store(ctl + CW_TMO, 0xBADBA0u, RLX_AGENT); } else { xcd_barrier(bar); } } while (0)
    const int lo = args.ph_lo, hi = args.ph_hi;
#define IN(k) (lo <= (k) && (k) < hi)
#define BOTH(k) (IN(k) && IN((k) + 1))
    if (IN(0)) { p0_prologue(F); if (BOTH(0)) GRID_BAR(); }
    if (IN(1)) {
        { pg8::Gemm g{F.U, F.Wt_in, M, NNAT, DM}; pg8::StaticOrder S; S.init(M, NNAT, F.G, F.bid);
          pg8::EpiBf16<0> E{F.PROJ, NNAT, nullptr, 0, 0, 1.f};
          pg8::gemm_phase<pg8::EpiBf16<0>, pg8::StaticOrder, true, true>(F.lds, g, S, E); }
        { pg8::Gemm g{F.Wt_in + (size_t)NNAT * DM, F.U, NTR, M, DM}; pg8::StaticOrder S; S.init(NTR, M, F.G, F.bid);
          pg8::EpiBf16<0> E{F.VT, M, nullptr, 0, 0, 1.f};
          pg8::gemm_phase<pg8::EpiBf16<0>, pg8::StaticOrder, true, true>(F.lds, g, S, E); }
        if (BOTH(1)) GRID_BAR();
    }
    if (IN(2)) {
        for (int u = F.bid; u < 6144; u += F.G) { const int k3 = u / 3, r3 = u - 3 * k3; if (r3 == 0) pa_mlstm(F, k3 >> 8, k3 & 255); else { const int id = 2 * k3 + r3 - 1; pa_hgrn2(F, id >> 8, id & 255); } }
        if (BOTH(2)) GRID_BAR();
    }
    if (IN(3)) { scan_phase(F); if (BOTH(3)) GRID_BAR(); }
    if (IN(4)) {
        for (int u = F.bid; u < 6144; u += F.G) { const int k3 = u / 3, r3 = u - 3 * k3; if (r3 == 0) r2_mlstm(F, k3 >> 8, k3 & 255); else { const int id = 2 * k3 + r3 - 1; r2_hgrn2(F, id >> 8, id & 255); } }
        if (BOTH(4)) GRID_BAR();
    }
    if (IN(5)) {
        { pg8::Gemm g{F.Y, F.WoT, M, DM, DM}; pg8::StaticOrder S; S.init(M, DM, F.G, F.bid);
          pg8::EpiRes E{F.x, F.out, F.HB, F.ssqh, DM};
          pg8::gemm_phase<pg8::EpiRes, pg8::StaticOrder, true, true>(F.lds, g, S, E); }
        { pg8::Gemm g{F.PB, F.WeT, M, DM, PE}; pg8::StaticOrder S; S.init(M, DM, F.G, F.bid);
          pg8::EpiBf16<0> E{F.EB, DM, nullptr, 0, 0, 1.f};
          pg8::gemm_phase<pg8::EpiBf16<0>, pg8::StaticOrder, true, true>(F.lds, g, S, E); }
        if (BOTH(5)) GRID_BAR();
    }
    if (IN(6)) {
        pg8::Gemm g{F.HB, F.WgT, M, DM, DM}; pg8::StaticOrder S; S.init(M, DM, F.G, F.bid);
        pg8::EpiGate E{F.out, F.EB, F.ssqh, F.ssq2, DM, 1.0f / DM, EPS};
        pg8::gemm_phase<pg8::EpiGate, pg8::StaticOrder, true, true>(F.lds, g, S, E);
        if (BOTH(6)) GRID_BAR();
    }
    if (IN(7)) final_norm(F);
#undef IN
#undef BOTH
}

#ifdef DBG_DUMP_AFTER
__global__ void dbg_dump(const unsigned char* wsb, float* out, int mode) {
    const unsigned short* a = (const unsigned short*)(wsb + (mode == 0 ? WS_PROJ : WS_U)); const unsigned short* b = (const unsigned short*)(wsb + WS_VT);
    size_t i = (size_t)blockIdx.x * blockDim.x + threadIdx.x;
    const size_t n = (size_t)M * DM;
    for (; i < n; i += (size_t)gridDim.x * blockDim.x) {
        float v;
        if (mode == 0) v = bf2f(a[3 * i]) + bf2f(a[3 * i + 1]) + bf2f(a[3 * i + 2]) + bf2f(b[i]);
        else v = bf2f(a[i]);
        out[i] = v;
    }
}
#endif
extern "C" void kernel_launch(void* const* d_in, const int* in_sizes, int n_in, void* d_out, int out_size, void* d_ws, size_t ws_size, hipStream_t stream) {
    static int grid = 0;
    if (grid == 0) {
        if (n_in != 16 || in_sizes[0] != M * DM || out_size != M * DM || ws_size < WS_END) { fprintf(stderr, "kernel_launch: unexpected shapes (n_in %d, in0 %d, out %d, ws %zu); nothing launched\n", n_in, n_in > 0 ? in_sizes[0] : -1, out_size, ws_size); grid = -1; return; }
        int dev = 0, cus = 0, per_cu = 0;
        if (hipGetDevice(&dev) != hipSuccess || hipDeviceGetAttribute(&cus, hipDeviceAttributeMultiprocessorCount, dev) != hipSuccess) { grid = -1; return; }
        if (hipFuncSetAttribute((const void*)hymba_fwd, hipFuncAttributeMaxDynamicSharedMemorySize, LDS_BYTES) != hipSuccess) { fprintf(stderr, "kernel_launch: hipFuncSetAttribute failed\n"); grid = -1; return; }
        if (hipOccupancyMaxActiveBlocksPerMultiprocessor(&per_cu, (const void*)hymba_fwd, NWAVES * 64, LDS_BYTES) != hipSuccess || per_cu < 1)
            fprintf(stderr, "kernel_launch: note: occupancy query reports %d workgroups per CU\n", per_cu);
        (void)hipGetLastError();
        grid = cus;
    }
    if (grid < 0) return;
    if (hipMemsetAsync((char*)d_ws + WS_CTL, 0, CTL_ZERO_BYTES, stream) != hipSuccess) { fprintf(stderr, "kernel_launch: hipMemsetAsync failed\n"); return; }
    Args a{};
    for (int i = 0; i < 16; ++i) a.in[i] = (const float*)d_in[i];
    a.out = (float*)d_out; a.ws = (unsigned char*)d_ws;
    for (int li = 0; li < N_LAUNCHES; ++li) {
#ifdef DBG_DUMP_AFTER
        if (li > DBG_DUMP_AFTER) { if (DBG_DUMP_AFTER != 2 && DBG_DUMP_AFTER != 3) hipLaunchKernelGGL(dbg_dump, dim3(2048), dim3(256), 0, stream, (const unsigned char*)d_ws, (float*)d_out, DBG_DUMP_AFTER == 1 ? 0 : 1);
            break; }
#endif
        a.ph_lo = (N_LAUNCHES == PER_PHASE) ? li : 0; a.ph_hi = (N_LAUNCHES == PER_PHASE) ? li + 1 : PER_PHASE; a.li = li;
        hipLaunchKernelGGL(hymba_fwd, dim3(grid), dim3(NWAVES * 64), LDS_BYTES, stream, a);
        const hipError_t le = hipPeekAtLastError();
        if (le != hipSuccess) { fprintf(stderr, "kernel_launch: launch %d failed: %s\n", li, hipGetErrorName(le)); break; }
    }
}
```

```cpp
#include <hip/hip_runtime.h>
#include <cstdio>
#include <cstdint>
namespace pg8 {
#define PG8_LAS __attribute__((address_space(3)))
typedef unsigned short bf16_t;
typedef short bf16x8 __attribute__((ext_vector_type(8)));
typedef float f32x4 __attribute__((ext_vector_type(4)));
typedef unsigned u32x4 __attribute__((ext_vector_type(4)));
constexpr int BM = 256, BK = 64, HALF = 128, HTB = HALF * BK * 2  , STAGE_BYTES = 8 * HTB, NXCD = 8, WGM = 8;

__host__ __device__ __forceinline__ int lds_byte(int r, int c) { const int st = (r >> 4) * 2 + (c >> 5), rr = r & 15, cc = c & 31, ob = rr * 64 + cc * 2; return st * 1024 + (ob ^ (((ob >> 9) & 1) << 5)); }
__host__ __device__ __forceinline__ void stage_rc(int b, int& R, int& C) { const int st = b / 1024, sb = b % 1024, swz = sb ^ (((sb >> 9) & 1) << 5); R = (st >> 1) * 16 + swz / 64; C = (st & 1) * 32 + (swz % 64) / 2; }
__host__ __device__ __forceinline__ int perm32(int rho) { const int n = rho >> 4, i = rho & 15; return 8 * (i >> 2) + 4 * n + (i & 3); }

struct Unit { int pm, pn; };
struct Gemm { const bf16_t* A; const bf16_t* Bt; int M, N, K; };

struct StaticOrder {
    int nM, nN, nwg, G, c;
    __host__ __device__ void init(int M, int N, int G_, int c_) { nM = M / BM; nN = N / BM; nwg = nM * nN; G = G_; c = c_; }
    __host__ __device__ bool next(int i, Unit& u) const {
        const long L = (long)i * G + c; if (L >= nwg) return false;
        int wgid = (int)L; { const int q = nwg / NXCD, r = nwg % NXCD, xcd = wgid % NXCD, off = wgid / NXCD; wgid = (xcd < r ? xcd * (q + 1) : r * (q + 1) + (xcd - r) * q) + off; }
        const int nig = WGM * nN, gid = wgid / nig, fm = gid * WGM, gsz = (nM - fm) < WGM ? (nM - fm) : WGM;
        u.pm = fm + ((wgid % nig) % gsz); u.pn = (wgid % nig) / gsz; return true;
    }
    __device__ __forceinline__ void a_ready(const Unit&) const {}
    __device__ __forceinline__ void done(const Unit&) const {}
};

__device__ __forceinline__ unsigned cvt_pk_bf16(float lo, float hi) { unsigned r; asm volatile("v_cvt_pk_bf16_f32 %0, %1, %2" : "=v"(r) : "v"(lo), "v"(hi)); return r; }
typedef float f32x2 __attribute__((ext_vector_type(2)));
__device__ __forceinline__ f32x2 gelu_pk(f32x2 v) {
    const f32x2 av = __builtin_elementwise_abs(v), d = av * 0.2316418882f + 1.0f;
    f32x2 t; t.x = __builtin_amdgcn_rcpf(d.x); t.y = __builtin_amdgcn_rcpf(d.y);
    f32x2 q = t * 0.5307027145f + (-0.7265760135f); q = q * t + 0.7107068705f; q = q * t + (-0.142248368f); q = q * t + 0.127414796f; q = q * t;
    const f32x2 s = (v * v) * (-0.72134752044f);
    f32x2 e; e.x = __builtin_amdgcn_exp2f(s.x); e.y = __builtin_amdgcn_exp2f(s.y);
    const f32x2 m = v * (q * e), r = v - m;
    f32x2 o; o.x = v.x < 0.f ? m.x : r.x; o.y = v.y < 0.f ? m.y : r.y; return o;
}

template <int ACT  > struct EpiBf16 {
    static constexpr bool PERM = true, AFTER_DRAIN = false; static_assert(ACT == 0 || ACT == 1, "EpiBf16: ACT is 0 (none) or 1 (gelu_pk)");
    bf16_t* O; int ldc; const float* bias; int split_cols; size_t split_stride; float scale0;
    __device__ __forceinline__ void operator()(const f32x4 (&acc)[2][2][4][2], const Unit& u, int wr, int wc, int fr, int fq) const {
        const int row0 = u.pm * BM + wr * 64 + fr; int colt = u.pn * BM; bf16_t* base = O;
        float sc = 1.f; if (split_cols) { const int t = colt / split_cols; base += (size_t)t * split_stride; colt -= t * split_cols; if (t == 0) sc = scale0; }
        const int col0 = colt + wc * 32 + 8 * fq, bcol0 = u.pn * BM + wc * 32 + 8 * fq;
        f32x4 bv[2][2];
#pragma unroll
        for (int bj = 0; bj < 2; ++bj)
#pragma unroll
            for (int n = 0; n < 2; ++n) bv[bj][n] = bias ? *(const f32x4*)(bias + bcol0 + bj * HALF + 4 * n) : (f32x4){0.f, 0.f, 0.f, 0.f};
#pragma unroll
        for (int ai = 0; ai < 2; ++ai)
#pragma unroll
            for (int m = 0; m < 4; ++m) { bf16_t* rowp = base + (size_t)(row0 + ai * HALF + m * 16) * ldc + col0;
#pragma unroll
                for (int bj = 0; bj < 2; ++bj) { f32x4 v0 = acc[ai][bj][m][0] + bv[bj][0], v1 = acc[ai][bj][m][1] + bv[bj][1];
                    if (ACT == 1) { f32x2 a = gelu_pk((f32x2){v0[0], v0[1]}), b = gelu_pk((f32x2){v0[2], v0[3]}), c = gelu_pk((f32x2){v1[0], v1[1]}), d = gelu_pk((f32x2){v1[2], v1[3]});
                        v0 = (f32x4){a.x, a.y, b.x, b.y}; v1 = (f32x4){c.x, c.y, d.x, d.y}; }
                    v0 = v0 * sc; v1 = v1 * sc; u32x4 w; w.x = cvt_pk_bf16(v0[0], v0[1]); w.y = cvt_pk_bf16(v0[2], v0[3]); w.z = cvt_pk_bf16(v1[0], v1[1]); w.w = cvt_pk_bf16(v1[2], v1[3]);
                    __builtin_nontemporal_store(w, (u32x4*)(rowp + bj * HALF)); } }
    }
};
__device__ __forceinline__ float bf_lo(unsigned w) { return __uint_as_float(w << 16); }
__device__ __forceinline__ float bf_hi(unsigned w) { return __uint_as_float(w & 0xffff0000u); }
__device__ __forceinline__ float fast_sigmoid(float x) { return __builtin_amdgcn_rcpf(1.0f + __expf(-x)); }
struct EpiBf16T {
    static constexpr bool PERM = true, AFTER_DRAIN = false;
    bf16_t* O; int nN;
    __device__ __forceinline__ void operator()(const f32x4 (&acc)[2][2][4][2], const Unit& u, int wr, int wc, int fr, int fq) const {
        bf16_t* tile = O + (size_t)(u.pm * nN + u.pn) * 65536 + (wr * 64 + fr) * 256 + wc * 32 + 8 * fq;
#pragma unroll
        for (int ai = 0; ai < 2; ++ai)
#pragma unroll
            for (int m = 0; m < 4; ++m) { bf16_t* rowp = tile + (ai * HALF + m * 16) * 256;
#pragma unroll
                for (int bj = 0; bj < 2; ++bj) { const f32x4 v0 = acc[ai][bj][m][0], v1 = acc[ai][bj][m][1];
                    u32x4 w; w.x = cvt_pk_bf16(v0[0], v0[1]); w.y = cvt_pk_bf16(v0[2], v0[3]); w.z = cvt_pk_bf16(v1[0], v1[1]); w.w = cvt_pk_bf16(v1[2], v1[3]);
                    *(u32x4*)(rowp + bj * HALF) = w; } }
    }
};
struct EpiRes {
    static constexpr bool PERM = true, AFTER_DRAIN = false;
    const float* x; float* out; bf16_t* hb; float* ssq; int ldc;
    __device__ __forceinline__ void operator()(const f32x4 (&acc)[2][2][4][2], const Unit& u, int wr, int wc, int fr, int fq) const {
        const int row0 = u.pm * BM + wr * 64 + fr, col0 = u.pn * BM + wc * 32 + 8 * fq;
#pragma unroll
        for (int ai = 0; ai < 2; ++ai)
#pragma unroll
            for (int m = 0; m < 4; ++m) { const int row = row0 + ai * HALF + m * 16; const size_t off = (size_t)row * ldc + col0; float ss = 0.f;
#pragma unroll
                for (int bj = 0; bj < 2; ++bj) {
                    const f32x4 x0 = *(const f32x4*)(x + off + bj * HALF), x1 = *(const f32x4*)(x + off + bj * HALF + 4);
                    const f32x4 h0 = x0 + acc[ai][bj][m][0], h1 = x1 + acc[ai][bj][m][1];
                    *(f32x4*)(out + off + bj * HALF) = h0; *(f32x4*)(out + off + bj * HALF + 4) = h1;
                    ss += (h0[0] * h0[0] + h0[1] * h0[1]) + (h0[2] * h0[2] + h0[3] * h0[3]) + (h1[0] * h1[0] + h1[1] * h1[1]) + (h1[2] * h1[2] + h1[3] * h1[3]);
                    u32x4 w; w.x = cvt_pk_bf16(h0[0], h0[1]); w.y = cvt_pk_bf16(h0[2], h0[3]); w.z = cvt_pk_bf16(h1[0], h1[1]); w.w = cvt_pk_bf16(h1[2], h1[3]);
                    *(u32x4*)(hb + off + bj * HALF) = w; }
                ss += __shfl_xor(ss, 16); ss += __shfl_xor(ss, 32);
                if (fq == 0) atomicAdd(ssq + row, ss); }
    }
};
struct EpiGate {
    static constexpr bool PERM = true, AFTER_DRAIN = false;
    float* out; const bf16_t* e; float* ssq_h; float* ssq2; int ldc; float inv_n, eps;
    __device__ __forceinline__ void operator()(const f32x4 (&acc)[2][2][4][2], const Unit& u, int wr, int wc, int fr, int fq) const {
        const int row0 = u.pm * BM + wr * 64 + fr, col0 = u.pn * BM + wc * 32 + 8 * fq;
#pragma unroll
        for (int ai = 0; ai < 2; ++ai)
#pragma unroll
            for (int m = 0; m < 4; ++m) { const int row = row0 + ai * HALF + m * 16; const size_t off = (size_t)row * ldc + col0; float ss = 0.f;
                const float sq = __hip_atomic_load(ssq_h + row, __ATOMIC_RELAXED, __HIP_MEMORY_SCOPE_AGENT);
                const float rstd = 1.0f / sqrtf(sq * inv_n + eps);
#pragma unroll
                for (int bj = 0; bj < 2; ++bj) {
                    const f32x4 h0 = *(const f32x4*)(out + off + bj * HALF), h1 = *(const f32x4*)(out + off + bj * HALF + 4);
                    const u32x4 ev = *(const u32x4*)(e + off + bj * HALF);
                    const f32x4 a0 = acc[ai][bj][m][0] * rstd, a1 = acc[ai][bj][m][1] * rstd;
                    f32x4 o0, o1;
                    o0[0] = h0[0] + fast_sigmoid(a0[0]) * bf_lo(ev.x); o0[1] = h0[1] + fast_sigmoid(a0[1]) * bf_hi(ev.x);
                    o0[2] = h0[2] + fast_sigmoid(a0[2]) * bf_lo(ev.y); o0[3] = h0[3] + fast_sigmoid(a0[3]) * bf_hi(ev.y);
                    o1[0] = h1[0] + fast_sigmoid(a1[0]) * bf_lo(ev.z); o1[1] = h1[1] + fast_sigmoid(a1[1]) * bf_hi(ev.z);
                    o1[2] = h1[2] + fast_sigmoid(a1[2]) * bf_lo(ev.w); o1[3] = h1[3] + fast_sigmoid(a1[3]) * bf_hi(ev.w);
                    *(f32x4*)(out + off + bj * HALF) = o0; *(f32x4*)(out + off + bj * HALF + 4) = o1;
                    ss += (o0[0] * o0[0] + o0[1] * o0[1]) + (o0[2] * o0[2] + o0[3] * o0[3]) + (o1[0] * o1[0] + o1[1] * o1[1]) + (o1[2] * o1[2] + o1[3] * o1[3]); }
                ss += __shfl_xor(ss, 16); ss += __shfl_xor(ss, 32);
                if (fq == 0) atomicAdd(ssq2 + row, ss); }
    }
};
struct EpiNull {
    static constexpr bool PERM = true, AFTER_DRAIN = false;
    __device__ __forceinline__ void operator()(const f32x4 (&acc)[2][2][4][2], const Unit& u, int wr, int wc, int fr, int fq) const {
#pragma unroll
        for (int ai = 0; ai < 2; ++ai)
#pragma unroll
            for (int bj = 0; bj < 2; ++bj)
#pragma unroll
                for (int m = 0; m < 4; ++m)
#pragma unroll
                    for (int n = 0; n < 2; ++n) asm volatile("" :: "v"(acc[ai][bj][m][n]));
    }
};
struct SameTileOrder {
    int c, n;
    __device__ bool next(int i, Unit& u) const { if (i >= n) return false; u.pm = c & 7; u.pn = i % 24; return true; }
    __device__ __forceinline__ void a_ready(const Unit&) const {}
    __device__ __forceinline__ void done(const Unit&) const {}
};
struct EpiScratch {
    static constexpr bool PERM = true, AFTER_DRAIN = false;
    bf16_t* O0; int per_unit;
    __device__ __forceinline__ void operator()(const f32x4 (&acc)[2][2][4][2], const Unit& u, int wr, int wc, int fr, int fq) const {
        bf16_t* O = O0 + (per_unit ? (size_t)(u.pm * 24 + u.pn) * 65536 : (size_t)0);
        const int row0 = wr * 64 + fr, col0 = wc * 32 + 8 * fq;
#pragma unroll
        for (int ai = 0; ai < 2; ++ai)
#pragma unroll
            for (int m = 0; m < 4; ++m) { bf16_t* rowp = O + (size_t)(row0 + ai * HALF + m * 16) * 256 + col0;
#pragma unroll
                for (int bj = 0; bj < 2; ++bj) { const f32x4 v0 = acc[ai][bj][m][0], v1 = acc[ai][bj][m][1];
                    u32x4 w; w.x = cvt_pk_bf16(v0[0], v0[1]); w.y = cvt_pk_bf16(v0[2], v0[3]); w.z = cvt_pk_bf16(v1[0], v1[1]); w.w = cvt_pk_bf16(v1[2], v1[3]);
                    *(u32x4*)(rowp + bj * HALF) = w; } }
    }
};
template <class Epi, class Sched, bool ALIGN_EPI = false, bool SP2 = false, bool PROBE_K0 = false, int PF = 0, bool NOSTAGE = false, bool ABLK = false>
__device__ __forceinline__ void gemm_phase(PG8_LAS unsigned char* lds, const Gemm g, const Sched& S, const Epi& E) {
    const int tid = threadIdx.x, wid = __builtin_amdgcn_readfirstlane(tid >> 6), lane = tid & 63, wr = wid >> 2, wc = wid & 3, fr = lane & 15, fq = lane >> 4;
    const int K = g.K, nt = K / BK;
    unsigned voffA[2], voffB[2];
#pragma unroll
    for (int i = 0; i < 2; ++i) { int R, C; stage_rc(tid * 16 + i * 8192, R, C); const int Rb = Epi::PERM ? ((R & ~31) + perm32(R & 31)) : R;
        voffA[i] = (unsigned)(R * (ABLK ? 256 : K) + C) * 2u; voffB[i] = (unsigned)(Rb * K + C) * 2u; }
    const size_t kstep = PROBE_K0 ? (size_t)0 : (size_t)(BK * 2);
    const size_t hstepB = (size_t)HALF * K * 2, hstepA = ABLK ? (size_t)HALF * 256 * 2 : hstepB;
    const size_t tstep = 2 * hstepB;
    static_assert(!(ABLK && PF > 0), "L2 warming is not written for the blocked A layout");
    const unsigned pfoff = (unsigned)((wid & 3) * 64 + lane) * (unsigned)K * 2u;
    const unsigned pflds = (unsigned)STAGE_BYTES + 1024u + (unsigned)wid * 256u;
    const unsigned ldsw = (unsigned)wid * 1024u;
    const int aoff = lds_byte(wr * 64 + fr, fq * 8), boff = lds_byte(wc * 32 + fr, fq * 8);
#define PG8_SA(b, h) (((b) * 2 + (h)) * HTB)
#define PG8_SB(b, h) ((4 + (b) * 2 + (h)) * HTB)
#define PG8_STAGE(bufoff, gbase, voff) do { if constexpr (!NOSTAGE) _Pragma("unroll") for (int _i = 0; _i < 2; ++_i) \
        __builtin_amdgcn_global_load_lds((const unsigned*)((const char*)(gbase) + (voff)[_i]), (PG8_LAS unsigned*)(lds + (bufoff) + ldsw + _i * 8192), 16, 0, 0); } while (0)
#define PG8_LDA(dst, b, h) do { _Pragma("unroll") for (int m = 0; m < 4; ++m) _Pragma("unroll") for (int k = 0; k < 2; ++k) dst[m][k] = *(const PG8_LAS bf16x8*)(lds + PG8_SA(b, h) + aoff + m * 2048 + k * 1024); } while (0)
#define PG8_LDB(dst, b, h) do { _Pragma("unroll") for (int n = 0; n < 2; ++n) _Pragma("unroll") for (int k = 0; k < 2; ++k) dst[n][k] = *(const PG8_LAS bf16x8*)(lds + PG8_SB(b, h) + boff + n * 2048 + k * 1024); } while (0)
#define PG8_MMA(ai, bj, At, Bt) do { __builtin_amdgcn_s_setprio(1); _Pragma("unroll") for (int m = 0; m < 4; ++m) _Pragma("unroll") for (int n = 0; n < 2; ++n) _Pragma("unroll") for (int k = 0; k < 2; ++k) \
        acc[ai][bj][m][n] = __builtin_amdgcn_mfma_f32_16x16x32_bf16(Bt[n][k], At[m][k], acc[ai][bj][m][n], 0, 0, 0); __builtin_amdgcn_s_setprio(0); } while (0)
#define PG8_WAIT_V(n) asm volatile("s_waitcnt vmcnt(" #n ")" ::: "memory")
#define PG8_WARM(kt) do { if constexpr (PF > 0) { const int _kt = (kt); const char* _p = (wid < 4) ? ((_kt < nt) ? cA + (size_t)_kt * kstep : nA + (size_t)((_kt - nt) < nt ? (_kt - nt) : nt - 1) * kstep) : ((_kt < nt) ? cB + (size_t)_kt * kstep : nB + (size_t)((_kt - nt) < nt ? (_kt - nt) : nt - 1) * kstep); \
        __builtin_amdgcn_global_load_lds((const unsigned*)(_p + pfoff), (PG8_LAS unsigned*)(lds + pflds), 4, 0, 0); } } while (0)
#define PG8_WAIT_VK() do { if constexpr (PF > 0) PG8_WAIT_V(9); else PG8_WAIT_V(8); } while (0)
#define PG8_WAIT_L(n) asm volatile("s_waitcnt lgkmcnt(" #n ")" ::: "memory")
#define PG8_BAR __builtin_amdgcn_s_barrier()
#define PG8_SCHED __builtin_amdgcn_sched_barrier(0)
    Unit cur, nxt; int ui = 0;
    if (!S.next(0, cur)) return;
    f32x4 acc[2][2][4][2];
#pragma unroll
    for (int a = 0; a < 2; ++a)
#pragma unroll
        for (int b = 0; b < 2; ++b)
#pragma unroll
            for (int m = 0; m < 4; ++m)
#pragma unroll
                for (int n = 0; n < 2; ++n) acc[a][b][m][n] = (f32x4){0.f, 0.f, 0.f, 0.f};
    bf16x8 At[4][2], B0[2][2], B1[2][2];
    const char* cA = (const char*)g.A + (size_t)cur.pm * tstep; const char* cB = (const char*)g.Bt + (size_t)cur.pn * tstep;
    S.a_ready(cur);
    if constexpr (SP2) {
        PG8_STAGE(PG8_SB(0, 0), cB, voffB); PG8_STAGE(PG8_SB(0, 1), cB + hstepB, voffB); PG8_STAGE(PG8_SA(0, 0), cA, voffA); PG8_STAGE(PG8_SA(0, 1), cA + hstepA, voffA);
        if (wr == 1) PG8_BAR;
        PG8_WAIT_V(2); PG8_BAR;
        PG8_STAGE(PG8_SB(1, 0), cB + kstep, voffB); PG8_STAGE(PG8_SA(1, 0), cA + kstep, voffA); PG8_STAGE(PG8_SB(1, 1), cB + hstepB + kstep, voffB);
        PG8_WAIT_V(6); PG8_BAR;
    } else {
        PG8_STAGE(PG8_SB(0, 0), cB, voffB); PG8_STAGE(PG8_SA(0, 0), cA, voffA); PG8_STAGE(PG8_SB(0, 1), cB + hstepB, voffB); PG8_STAGE(PG8_SA(0, 1), cA + hstepA, voffA);
        if (wr == 1) PG8_BAR;
        PG8_WAIT_V(4); PG8_BAR;
        PG8_STAGE(PG8_SB(1, 0), cB + kstep, voffB); PG8_STAGE(PG8_SA(1, 0), cA + kstep, voffA); PG8_STAGE(PG8_SB(1, 1), cB + hstepB + kstep, voffB);
        PG8_WAIT_V(6); PG8_BAR;
    }
    for (;;) {
        const bool has_next = S.next(ui + 1, nxt);
        const char* nA = has_next ? (const char*)g.A + (size_t)nxt.pm * tstep : cA; const char* nB = has_next ? (const char*)g.Bt + (size_t)nxt.pn * tstep : cB;
        for (int t = 0; t < nt; t += 2) {
            const bool last = (t == nt - 2);
            const char* a1 = cA + (ABLK ? (size_t)((t + 1) >> 2) * 131072 + (size_t)((t + 1) & 3) * 128 : (size_t)(t + 1) * kstep);
            const char* a2 = last ? nA : cA + (ABLK ? (size_t)((t + 2) >> 2) * 131072 + (size_t)((t + 2) & 3) * 128 : (size_t)(t + 2) * kstep); const char* b2 = last ? nB : cB + (size_t)(t + 2) * kstep;
            const char* a3 = a2 + kstep; const char* b3 = b2 + kstep;
            if (last && has_next) S.a_ready(nxt);
            if constexpr (SP2) {
            PG8_LDB(B0, 0, 0); PG8_LDB(B1, 0, 1); PG8_SCHED; PG8_LDA(At, 0, 0); PG8_STAGE(PG8_SA(1, 1), a1 + hstepA, voffA); PG8_WARM(t + 2 + PF);
            PG8_WAIT_VK(); PG8_WAIT_L(0); PG8_BAR; PG8_MMA(0, 0, At, B0); PG8_MMA(0, 1, At, B1); PG8_BAR; PG8_SCHED;
            PG8_LDA(At, 0, 1); PG8_STAGE(PG8_SB(0, 0), b2, voffB); PG8_STAGE(PG8_SB(0, 1), b2 + hstepB, voffB); PG8_STAGE(PG8_SA(0, 0), a2, voffA);
            PG8_WAIT_VK(); PG8_WAIT_L(0); PG8_BAR; PG8_MMA(1, 0, At, B0); PG8_MMA(1, 1, At, B1); PG8_BAR; PG8_SCHED;
            PG8_LDB(B0, 1, 0); PG8_LDB(B1, 1, 1); PG8_SCHED; PG8_LDA(At, 1, 0); PG8_STAGE(PG8_SA(0, 1), a2 + hstepA, voffA); PG8_WARM(t + 3 + PF);
            PG8_WAIT_VK(); PG8_WAIT_L(0); PG8_BAR; PG8_MMA(0, 0, At, B0); PG8_MMA(0, 1, At, B1); PG8_BAR; PG8_SCHED;
            PG8_LDA(At, 1, 1); PG8_STAGE(PG8_SB(1, 0), b3, voffB); PG8_STAGE(PG8_SB(1, 1), b3 + hstepB, voffB); PG8_STAGE(PG8_SA(1, 0), a3, voffA);
            PG8_WAIT_VK(); PG8_WAIT_L(0); PG8_BAR; PG8_MMA(1, 0, At, B0); PG8_MMA(1, 1, At, B1); PG8_BAR; PG8_SCHED;
            } else {
            PG8_LDB(B0, 0, 0); PG8_SCHED; PG8_LDA(At, 0, 0); PG8_STAGE(PG8_SA(1, 1), a1 + hstepA, voffA);
            PG8_WAIT_L(8); PG8_BAR; PG8_WAIT_L(0); PG8_MMA(0, 0, At, B0); PG8_BAR; PG8_SCHED;
            PG8_LDB(B1, 0, 1); PG8_STAGE(PG8_SB(0, 0), b2, voffB);
            PG8_BAR; PG8_WAIT_L(0); PG8_MMA(0, 1, At, B1); PG8_BAR;
            PG8_LDA(At, 0, 1); PG8_STAGE(PG8_SA(0, 0), a2, voffA);
            PG8_BAR; PG8_WAIT_L(0); PG8_MMA(1, 0, At, B0); PG8_BAR; PG8_SCHED;
            PG8_STAGE(PG8_SB(0, 1), b2 + hstepB, voffB);
            PG8_WAIT_V(6); PG8_BAR; PG8_MMA(1, 1, At, B1); PG8_BAR;
            PG8_LDB(B0, 1, 0); PG8_SCHED; PG8_LDA(At, 1, 0); PG8_STAGE(PG8_SA(0, 1), a2 + hstepA, voffA);
            PG8_WAIT_L(8); PG8_BAR; PG8_WAIT_L(0); PG8_MMA(0, 0, At, B0); PG8_BAR; PG8_SCHED;
            PG8_LDB(B1, 1, 1); PG8_STAGE(PG8_SB(1, 0), b3, voffB);
            PG8_BAR; PG8_WAIT_L(0); PG8_MMA(0, 1, At, B1); PG8_BAR;
            PG8_LDA(At, 1, 1); PG8_STAGE(PG8_SA(1, 0), a3, voffA);
            PG8_BAR; PG8_WAIT_L(0); PG8_MMA(1, 0, At, B0); PG8_BAR; PG8_SCHED;
            PG8_STAGE(PG8_SB(1, 1), b3 + hstepB, voffB);
            PG8_WAIT_V(6); PG8_BAR; PG8_MMA(1, 1, At, B1); PG8_BAR;
            }
        }
        if constexpr (ALIGN_EPI) { if (wr == 0) PG8_BAR; }
        if constexpr (!Epi::AFTER_DRAIN) { E(acc, cur, wr, wc, fr, fq); S.done(cur); }
        if (!has_next) break;
#pragma unroll
        for (int a = 0; a < 2; ++a)
#pragma unroll
            for (int b = 0; b < 2; ++b)
#pragma unroll
                for (int m = 0; m < 4; ++m)
#pragma unroll
                    for (int n = 0; n < 2; ++n) acc[a][b][m][n] = (f32x4){0.f, 0.f, 0.f, 0.f};
        cur = nxt; cA = nA; cB = nB; ++ui;
        if constexpr (ALIGN_EPI) { if (wr == 1) PG8_BAR; }
    }
    PG8_WAIT_V(0);
    if constexpr (!ALIGN_EPI) { if (wr == 0) PG8_BAR; }
    PG8_BAR;
    if constexpr (Epi::AFTER_DRAIN) { E.fused(acc, cur, wr, wc, fr, fq, lds, wid, lane); S.done(cur); }
#undef PG8_SA
#undef PG8_SB
#undef PG8_STAGE
#undef PG8_LDA
#undef PG8_LDB
#undef PG8_MMA
#undef PG8_WAIT_V
#undef PG8_WARM
#undef PG8_WAIT_VK
#undef PG8_WAIT_L
#undef PG8_BAR
#undef PG8_SCHED
}
}
constexpr int NWAVES = 8, NTHR = 512;
#ifndef MK_N_LAUNCHES
#define MK_N_LAUNCHES 1
#define PROBE_DOUBLE 0
#endif
constexpr int N_LAUNCHES = MK_N_LAUNCHES;
constexpr int PER_PHASE = 8;
constexpr int BATCH = 2, SEQ = 16384, DM = 2048, M = BATCH * SEQ, NCH = SEQ / 64;
constexpr int IN_COLS = 8200, PE = 256, NNAT = 6144, NTR = 2048;
constexpr float EPS = 1e-6f;
constexpr int PC_Q = 0, PC_K = 512, PC_O = 1024, PC_Z = 2048, PC_HQ = 3072, PC_HF = 4096, PC_HG = 5120;
constexpr size_t MiB = 1u << 20;
constexpr size_t WS_CTL = 0, CTL_ZERO_BYTES = 1 * MiB;
constexpr size_t WS_SSQH = 256 * 1024, WS_SSQ2 = 512 * 1024;
constexpr size_t WS_WIN = 2 * MiB, WS_WO = 34 * MiB, WS_WG = 42 * MiB, WS_WE = 50 * MiB;
constexpr size_t WS_GATES = 52 * MiB;
constexpr size_t WS_BCUM = 53 * MiB;
constexpr size_t WS_MSC = 54 * MiB;
constexpr size_t WS_NST = 55 * MiB;
constexpr size_t WS_GDEC = 56 * MiB;
constexpr size_t WS_PB = 64 * MiB;
constexpr size_t WS_U = 80 * MiB;
constexpr size_t WS_PROJ = 208 * MiB;
constexpr size_t WS_VT = 592 * MiB;
constexpr size_t WS_H = 720 * MiB;
constexpr size_t WS_END = 976 * MiB;
constexpr int CW_TMO = 0, CW_BAR = 4096;
constexpr int RING_BYTES = 131072, LDSCTL_OFF = RING_BYTES, MISC_OFF = LDSCTL_OFF + 320, LDS_BYTES = 147456;

#define GAS __attribute__((address_space(1)))
#define LAS __attribute__((address_space(3)))
typedef unsigned short bf16;
typedef unsigned v4u __attribute__((ext_vector_type(4)));
typedef unsigned v2u __attribute__((ext_vector_type(2)));
typedef float f32x4 __attribute__((ext_vector_type(4)));
typedef float f32x16 __attribute__((ext_vector_type(16)));
typedef short bf16x8 __attribute__((ext_vector_type(8)));
typedef GAS unsigned gu32;
#define RLX_AGENT __ATOMIC_RELAXED, __HIP_MEMORY_SCOPE_AGENT
#define LDS_WAIT() asm volatile("s_waitcnt lgkmcnt(0)" ::: "memory")
#define VM_WAIT() asm volatile("s_waitcnt vmcnt(0)" ::: "memory")
typedef __bf16 bf16x2_t __attribute__((ext_vector_type(2)));
__device__ __forceinline__ unsigned pk2(float lo, float hi) { bf16x2_t v; v[0] = (__bf16)lo; v[1] = (__bf16)hi; return __builtin_bit_cast(unsigned, v); }
__device__ __forceinline__ float bf2f(bf16 v) { return __uint_as_float((unsigned)v << 16); }
__device__ __forceinline__ float blo(unsigned w) { return __uint_as_float(w << 16); }
__device__ __forceinline__ float bhi(unsigned w) { return __uint_as_float(w & 0xffff0000u); }
__device__ __forceinline__ float sigm(float x) { return 1.0f / (1.0f + __expf(-x)); }

#define XB_TMO      128
#define XB_XCNT(j)  (256  + 64 * (j))
#define XB_XSUB(j)  (1280 + 64 * (j))
#define XB_XGEN(j)  (2304 + 64 * (j))
#define XB_TOP      3328
#define XB_TOPGEN   3392
#define XCD_BAR_WORDS 3456
#define XB_SPIN_CAP (1u << 18)
__device__ __forceinline__ unsigned xb_ld(unsigned* p)              { return __hip_atomic_load(p, __ATOMIC_RELAXED, __HIP_MEMORY_SCOPE_AGENT); }
__device__ __forceinline__ unsigned xb_add(unsigned* p, unsigned v) { return __hip_atomic_fetch_add(p, v, __ATOMIC_RELAXED, __HIP_MEMORY_SCOPE_AGENT); }
__device__ __forceinline__ unsigned xb_xcc_id() { return (unsigned)__builtin_amdgcn_s_getreg((3 << 11) | 20) & 0xFu; }
#define XB_SPIN(cond, bar) do { unsigned _sp = 0; while (cond) { __builtin_amdgcn_s_sleep(1); \
    if ((++_sp & 255u) == 0u) { if (xb_ld(&(bar)[XB_TMO])) break; if (_sp > XB_SPIN_CAP) { atomicAdd(&(bar)[XB_TMO], 1u); break; } } } } while (0)
struct XcdBarrier { unsigned* bar; unsigned x; volatile LAS unsigned* st; };
__device__ __forceinline__ XcdBarrier xcd_barrier_post(unsigned* bar, volatile LAS unsigned* st) {
    XcdBarrier b; b.bar = bar; b.x = xb_xcc_id(); b.st = st;
    if (threadIdx.x == 0) st[3] = xb_add(&bar[XB_XCNT(b.x)], 1u);
    return b;
}
__device__ __forceinline__ void xcd_barrier_complete(unsigned* bar, unsigned x, unsigned& nloc, unsigned& nx, unsigned& even) {
    const unsigned G = gridDim.x * gridDim.y * gridDim.z;
    unsigned sum, cnt, mine, sp = 0u, ev;
    for (;;) {
        sum = 0u; cnt = 0u; mine = 0u; ev = 1u;
#pragma unroll
        for (unsigned j = 0; j < 16; ++j) { const unsigned c = xb_ld(&bar[XB_XCNT(j)]); sum += c; cnt += (c > 0u) ? 1u : 0u; mine = (j == x) ? c : mine; ev &= (j < 8u) ? (c * 8u == G ? 1u : 0u) : (c == 0u ? 1u : 0u); }
        if (sum == G) break;
        __builtin_amdgcn_s_sleep(1);
        if ((++sp & 255u) == 0u) { if (xb_ld(&bar[XB_TMO])) break; if (sp > XB_SPIN_CAP) { atomicAdd(&bar[XB_TMO], 1u); break; } }
    }
    nloc = mine > 0u ? mine : 1u; nx = cnt > 0u ? cnt : 1u; even = (sum == G) ? ev : 0u;
}
__device__ __forceinline__ void xcd_barrier(const XcdBarrier& b) {
    asm volatile("s_waitcnt vmcnt(0)" ::: "memory");
    __syncthreads();
    if (threadIdx.x == 0) {
        unsigned* bar = b.bar;
        __builtin_amdgcn_s_waitcnt(0);
        unsigned nloc = b.st[0], nx = b.st[1];
        if (nloc == 0u) { unsigned even; xcd_barrier_complete(bar, b.x, nloc, nx, even); b.st[0] = nloc; b.st[1] = nx; b.st[2] = even; }
        const unsigned old = xb_add(&bar[XB_XSUB(b.x)], 1u);
        const unsigned gen = old / nloc;
        if (old + 1u == (gen + 1u) * nloc) {
            __builtin_amdgcn_fence(__ATOMIC_RELEASE, "agent");
            asm volatile("s_waitcnt vmcnt(0)" ::: "memory");
            const unsigned og = xb_add(&bar[XB_TOP], 1u);
            const unsigned tg = og / nx;
            if (og + 1u == (tg + 1u) * nx) xb_add(&bar[XB_TOPGEN], 1u);
            else XB_SPIN(xb_ld(&bar[XB_TOPGEN]) == tg, bar);
            __builtin_amdgcn_fence(__ATOMIC_ACQUIRE, "agent");
            xb_add(&bar[XB_XGEN(b.x)], 1u);
            asm volatile("s_waitcnt vmcnt(0)" ::: "memory");
        } else {
            XB_SPIN(xb_ld(&bar[XB_XGEN(b.x)]) == gen, bar);
            __builtin_amdgcn_fence(__ATOMIC_ACQUIRE, "agent");
            asm volatile("s_waitcnt vmcnt(0)" ::: "memory");
        }
    }
    __syncthreads();
}

struct Frame {
    LAS unsigned char* lds;
    int tid, lane, wave, G, bid;
    const float *x, *p, *norm_w, *w_in, *conv_w, *conv_b, *b_i, *b_f, *ml_nw, *hg_lb, *hg_nw, *w_out, *pe_nw, *w_pg, *w_pe, *fin_nw;
    float* out;
    bf16 *Wt_in, *WoT, *WgT, *WeT, *PB, *U, *Y, *PROJ, *HB, *EB, *VT, *Cm, *Ch;
    float *gates, *bcum, *msc, *nst, *gdec, *ssqh, *ssq2, *H;
};
__device__ __forceinline__ size_t proj_off(int m, int n) { return ((size_t)((m >> 8) * 24 + (n >> 8)) << 16) + (size_t)((m & 255) * 256 + (n & 255)); }
__device__ __forceinline__ size_t vt_off(int v, int m) { return ((size_t)((v >> 8) * 128 + (m >> 8)) << 16) + (size_t)((v & 255) * 256 + (m & 255)); }
__device__ __forceinline__ float wave_sum(float v) {
#pragma unroll
    for (int o = 1; o < 64; o <<= 1) v += __shfl_xor(v, o);
    return v;
}
__device__ __forceinline__ float wave_max(float v) {
#pragma unroll
    for (int o = 1; o < 64; o <<= 1) v = fmaxf(v, __shfl_xor(v, o));
    return v;
}
__device__ __forceinline__ float wave_scan_sum(float v, int lane) {
#pragma unroll
    for (int o = 1; o < 64; o <<= 1) { const float y = __shfl_up(v, o); if (lane >= o) v += y; }
    return v;
}
__device__ __forceinline__ float wave_scan_max(float v, int lane) {
#pragma unroll
    for (int o = 1; o < 64; o <<= 1) { const float y = __shfl_up(v, o); if (lane >= o) v = fmaxf(v, y); }
    return v;
}
__device__ __forceinline__ f32x16 mfma32(bf16x8 a, bf16x8 b, f32x16 c) { return __builtin_amdgcn_mfma_f32_32x32x16_bf16(a, b, c, 0, 0, 0); }
__device__ __forceinline__ f32x16 zero16() { f32x16 z;
#pragma unroll
    for (int i = 0; i < 16; ++i) z[i] = 0.f;
    return z; }

__device__ __forceinline__ void p0_transpose_item(const float* W, int ldw, int src_col, int K, bf16* WT, int dst_row, const float* kscale, LAS float* scr, int k0, int lane) {
#pragma unroll 8
    for (int i = 0; i < 32; ++i) { const int kk = 2 * i + (lane >> 5); float v = W[(size_t)(k0 + kk) * ldw + src_col + (lane & 31)]; if (kscale) v *= kscale[k0 + kk]; scr[kk * 33 + (lane & 31)] = v; }
    LDS_WAIT(); asm volatile("" ::: "memory");
    const int c = lane & 7;
#pragma unroll
    for (int j = 0; j < 4; ++j) { const int n = (lane >> 3) + 8 * j; const LAS float* s = scr + (8 * c) * 33 + n;
        v4u o; o.x = pk2(s[0 * 33], s[1 * 33]); o.y = pk2(s[2 * 33], s[3 * 33]); o.z = pk2(s[4 * 33], s[5 * 33]); o.w = pk2(s[6 * 33], s[7 * 33]);
        *(v4u*)(WT + (size_t)(dst_row + n) * K + k0 + 8 * c) = o; }
    LDS_WAIT(); asm volatile("" ::: "memory");
}
__device__ __forceinline__ int win_src_col(int r) { return r < 1024 ? r : r < 3072 ? r + 1024 : r < 5120 ? r + 1032 : r < 6144 ? r + 2056 : r < 7168 ? r - 5120 : r - 1016; }
__device__ __forceinline__ void p0_prologue(const Frame& F) {
    LAS float* scr = (LAS float*)(F.lds + F.wave * 16384);
    const int gw = F.bid * NWAVES + F.wave, NGW = F.G * NWAVES, lane = F.lane;
    for (int it = gw; it < 12544; it += NGW) {
        int r = it;
        if (r < 8192) { const int kb = r >> 8, nb = r & 255; p0_transpose_item(F.w_in, IN_COLS, win_src_col(nb * 32), DM, F.Wt_in, nb * 32, nullptr, scr, kb * 64, lane); continue; } r -= 8192;
        if (r < 2048) { const int kb = r >> 6, nb = r & 63; p0_transpose_item(F.w_out, DM, nb * 32, DM, F.WoT, nb * 32, nullptr, scr, kb * 64, lane); continue; } r -= 2048;
        if (r < 2048) { const int kb = r >> 6, nb = r & 63; p0_transpose_item(F.w_pg, DM, nb * 32, DM, F.WgT, nb * 32, F.pe_nw, scr, kb * 64, lane); continue; } r -= 2048;
        { const int kb = r >> 6, nb = r & 63; p0_transpose_item(F.w_pe, DM, nb * 32, PE, F.WeT, nb * 32, nullptr, scr, kb * 64, lane); }
    }
    for (int idx = F.bid * NTHR + F.tid; idx < M * PE / 4; idx += F.G * NTHR) { const f32x4 v = ((const f32x4*)F.p)[idx]; v2u o; o.x = pk2(v[0], v[1]); o.y = pk2(v[2], v[3]); ((v2u*)F.PB)[idx] = o; }
    __syncthreads();
    LAS float* Wg = (LAS float*)F.lds;
    for (int k = F.tid; k < DM; k += NTHR) { const f32x4 a = *(const f32x4*)(F.w_in + (size_t)k * IN_COLS + 4096), b = *(const f32x4*)(F.w_in + (size_t)k * IN_COLS + 4100);
        Wg[0 * DM + k] = a[0]; Wg[1 * DM + k] = a[1]; Wg[2 * DM + k] = a[2]; Wg[3 * DM + k] = a[3]; Wg[4 * DM + k] = b[0]; Wg[5 * DM + k] = b[1]; Wg[6 * DM + k] = b[2]; Wg[7 * DM + k] = b[3]; }
    __syncthreads();
    const f32x4* nwp = (const f32x4*)F.norm_w + lane;
    const float gbias = lane < 4 ? F.b_i[lane & 3] : F.b_f[lane & 3];
    for (int m = gw; m < M; m += NGW) {
        asm volatile("" ::: "memory");
        const f32x4* xr = (const f32x4*)(F.x + (size_t)m * DM) + lane;
        f32x4 t[8]; float ss = 0.f; float ga[8];
#pragma unroll
        for (int c = 0; c < 8; ++c) ga[c] = 0.f;
#pragma unroll
        for (int j = 0; j < 8; ++j) { const f32x4 v = __builtin_nontemporal_load(xr + 64 * j); ss += (v[0] * v[0] + v[1] * v[1]) + (v[2] * v[2] + v[3] * v[3]); t[j] = v * nwp[64 * j]; }
#pragma unroll
        for (int j = 0; j < 8; ++j)
#pragma unroll
            for (int c = 0; c < 8; ++c) { const f32x4 w = *(const LAS f32x4*)(Wg + c * DM + 4 * lane + 256 * j); ga[c] += (t[j][0] * w[0] + t[j][1] * w[1]) + (t[j][2] * w[2] + t[j][3] * w[3]); }
        ss = wave_sum(ss); const float rstd = 1.0f / sqrtf(ss * (1.0f / DM) + EPS);
#pragma unroll
        for (int c = 0; c < 8; ++c) ga[c] = wave_sum(ga[c]) * rstd;
        v2u* uo = (v2u*)(F.U + (size_t)m * DM) + lane;
#pragma unroll
        for (int j = 0; j < 8; ++j) { const f32x4 q = t[j] * rstd; v2u o; o.x = pk2(q[0], q[1]); o.y = pk2(q[2], q[3]); uo[64 * j] = o; }
        float gv = ga[0];
        gv = lane == 1 ? ga[1] : gv; gv = lane == 2 ? ga[2] : gv; gv = lane == 3 ? ga[3] : gv; gv = lane == 4 ? ga[4] : gv; gv = lane == 5 ? ga[5] : gv; gv = lane == 6 ? ga[6] : gv; gv = lane == 7 ? ga[7] : gv;
        if (lane < 8) F.gates[(size_t)m * 8 + lane] = gv + gbias;
    }
}
__device__ __forceinline__ void conv_silu_16(const Frame& F, const bf16* src, const bf16* hsrc, int ch, bool has_halo, float scale, float (&out)[16]) {
    const float w0 = F.conv_w[ch], w1 = F.conv_w[1024 + ch], w2 = F.conv_w[2048 + ch], w3 = F.conv_w[3072 + ch], cb = F.conv_b[ch];
    float r0 = 0.f, r1 = 0.f, r2 = 0.f;
    if (has_halo) { r0 = bf2f(hsrc[0]); r1 = bf2f(hsrc[256]); r2 = bf2f(hsrc[512]); }
#pragma unroll
    for (int jj = 0; jj < 16; ++jj) { const float xv = bf2f(src[jj * 256]); const float cv = cb + w0 * r0 + w1 * r1 + w2 * r2 + w3 * xv; r0 = r1; r1 = r2; r2 = xv; out[jj] = cv * sigm(cv) * scale; }
}
__device__ __forceinline__ void proj_ptrs(const Frame& F, int mrow, int col, const bf16*& src, const bf16*& hsrc) {
    src = F.PROJ + proj_off(mrow, col);
    hsrc = (mrow & 255) ? src - 3 * 256 : src - (size_t)24 * 65536 + 253 * 256;
}
__device__ __forceinline__ void pa_mlstm(const Frame& F, int bh, int c) {
    const int b = bh >> 2, h = bh & 3, m0 = b * SEQ + c * 64, unit = bh * NCH + c, tid = F.tid, lane = F.lane, wave = F.wave;
    LAS bf16* kT = (LAS bf16*)F.lds;
    LAS float* wl = (LAS float*)(F.lds + 18432);
    LAS float* nsum = wl + 64;
    if (wave == 0) {
        const float ig = F.gates[(size_t)(m0 + lane) * 8 + h], fp = F.gates[(size_t)(m0 + lane) * 8 + 4 + h];
        const float lf = fminf(fp, 0.f) - log1pf(expf(-fabsf(fp)));
        const float bc = wave_scan_sum(lf, lane);
        const float g = __shfl(bc, 63);
        const float a = g - bc + ig;
        const float ml = wave_max(a);
        wl[lane] = expf(a - ml);
        F.bcum[(size_t)bh * SEQ + c * 64 + lane] = bc;
        if (lane == 0) { F.msc[unit * 4 + 0] = g; F.msc[unit * 4 + 1] = ml; }
    }
    __syncthreads();
    {
        const int d = tid & 127, jq = tid >> 7;
        float kv[16];
        const bf16 *src, *hsrc; proj_ptrs(F, m0 + 16 * jq, PC_K + h * 128 + d, src, hsrc);
        conv_silu_16(F, src, hsrc, 512 + h * 128 + d, (c | jq) != 0, 0.08838834764831845f, kv);
        float ns = 0.f; unsigned pk[8];
#pragma unroll
        for (int jj = 0; jj < 16; ++jj) { kv[jj] *= wl[16 * jq + jj]; ns += kv[jj]; }
#pragma unroll
        for (int i = 0; i < 8; ++i) pk[i] = pk2(kv[2 * i], kv[2 * i + 1]);
        LAS v4u* dst = (LAS v4u*)(kT + d * 72 + 16 * jq);
        dst[0] = (v4u){pk[0], pk[1], pk[2], pk[3]}; dst[1] = (v4u){pk[4], pk[5], pk[6], pk[7]};
        nsum[jq * 128 + d] = ns;
    }
    __syncthreads();
    if (tid < 128) F.nst[(size_t)unit * 128 + tid] = (nsum[tid] + nsum[128 + tid]) + (nsum[256 + tid] + nsum[384 + tid]);
    {
        const int r32 = lane & 31, hi = lane >> 5;
        f32x16 acc[4];
#pragma unroll
        for (int i = 0; i < 4; ++i) acc[i] = zero16();
        const bf16* vt = F.VT + vt_off(h * 256 + 32 * wave + r32, m0) + 8 * hi;
#pragma unroll
        for (int ks = 0; ks < 4; ++ks) { const bf16x8 bfr = *(const bf16x8*)(vt + 16 * ks);
#pragma unroll
            for (int dt = 0; dt < 4; ++dt) { const bf16x8 afr = *(const LAS bf16x8*)(kT + (32 * dt + r32) * 72 + 16 * ks + 8 * hi); acc[dt] = mfma32(afr, bfr, acc[dt]); } }
        bf16* dst = F.Cm + ((size_t)unit * 256 + 32 * wave + r32) * 128 + 4 * hi;
#pragma unroll
        for (int dt = 0; dt < 4; ++dt)
#pragma unroll
            for (int q = 0; q < 4; ++q) { v2u w; w.x = pk2(acc[dt][4 * q], acc[dt][4 * q + 1]); w.y = pk2(acc[dt][4 * q + 2], acc[dt][4 * q + 3]); *(v2u*)(dst + 32 * dt + 8 * q) = w; }
    }
    __syncthreads();
}
__device__ __forceinline__ float hg_forget_16(const bf16* srcf, float lb, float (&sg)[16], float (&cum)[16]) {
    float run = 0.f;
#pragma unroll
    for (int jj = 0; jj < 16; ++jj) { const float xv = bf2f(srcf[jj * 256]); const float s = sigm(xv); const float f = lb + (1.0f - lb) * s; run += logf(f); sg[jj] = s; cum[jj] = run; }
    return run;
}
__device__ __forceinline__ void pa_hgrn2(const Frame& F, int bh, int c) {
    const int b = bh >> 3, h = bh & 7, m0 = b * SEQ + c * 64, unit = bh * NCH + c, tid = F.tid, lane = F.lane, wave = F.wave;
    LAS bf16* kT = (LAS bf16*)F.lds;
    LAS float* seg = (LAS float*)(F.lds + 18432);
    const int e = tid & 127, jq = tid >> 7;
    const float lb = 1.0f / (1.0f + expf(F.hg_lb[1024 + h * 128 + e] - F.hg_lb[h * 128 + e]));
    float sg[16], cum[16];
    const float run = hg_forget_16(F.PROJ + proj_off(m0 + 16 * jq, PC_HF + h * 128 + e), lb, sg, cum);
    seg[jq * 128 + e] = run;
    __syncthreads();
    {
        const float s0 = seg[e], s1 = seg[128 + e], s2 = seg[256 + e], s3 = seg[384 + e];
        const float off = jq == 0 ? 0.f : jq == 1 ? s0 : jq == 2 ? s0 + s1 : s0 + s1 + s2;
        const float g = (s0 + s1) + (s2 + s3);
        unsigned pk[8];
#pragma unroll
        for (int i = 0; i < 8; ++i) { const float k0 = (1.0f - lb) * (1.0f - sg[2 * i]) * expf(g - (off + cum[2 * i])), k1 = (1.0f - lb) * (1.0f - sg[2 * i + 1]) * expf(g - (off + cum[2 * i + 1])); pk[i] = pk2(k0, k1); }
        LAS v4u* dst = (LAS v4u*)(kT + e * 72 + 16 * jq);
        dst[0] = (v4u){pk[0], pk[1], pk[2], pk[3]}; dst[1] = (v4u){pk[4], pk[5], pk[6], pk[7]};
        if (jq == 0) F.gdec[(size_t)unit * 128 + e] = expf(g);
    }
    __syncthreads();
    {
        const int r32 = lane & 31, hi = lane >> 5, vt_i = wave & 3, et0 = 2 * (wave >> 2);
        f32x16 acc[2]; acc[0] = zero16(); acc[1] = zero16();
        const bf16* vt = F.VT + vt_off(1024 + h * 128 + 32 * vt_i + r32, m0) + 8 * hi;
#pragma unroll
        for (int ks = 0; ks < 4; ++ks) { const bf16x8 bfr = *(const bf16x8*)(vt + 16 * ks);
#pragma unroll
            for (int i = 0; i < 2; ++i) { const bf16x8 afr = *(const LAS bf16x8*)(kT + (32 * (et0 + i) + r32) * 72 + 16 * ks + 8 * hi); acc[i] = mfma32(afr, bfr, acc[i]); } }
        bf16* dst = F.Ch + ((size_t)unit * 128 + 32 * vt_i + r32) * 128 + 4 * hi;
#pragma unroll
        for (int i = 0; i < 2; ++i)
#pragma unroll
            for (int q = 0; q < 4; ++q) { v2u w; w.x = pk2(acc[i][4 * q], acc[i][4 * q + 1]); w.y = pk2(acc[i][4 * q + 2], acc[i][4 * q + 3]); *(v2u*)(dst + 32 * (et0 + i) + 8 * q) = w; }
    }
    __syncthreads();
}
__device__ __forceinline__ void unpack8(const v4u k, float (&o)[8]) { o[0] = blo(k.x); o[1] = bhi(k.x); o[2] = blo(k.y); o[3] = bhi(k.y); o[4] = blo(k.z); o[5] = bhi(k.z); o[6] = blo(k.w); o[7] = bhi(k.w); }
__device__ __forceinline__ v4u pack8(const float (&s)[8]) { v4u o; o.x = pk2(s[0], s[1]); o.y = pk2(s[2], s[3]); o.z = pk2(s[4], s[5]); o.w = pk2(s[6], s[7]); return o; }
__device__ __forceinline__ void scan_phase(const Frame& F) {
    const int gt = F.bid * NTHR + F.tid;
    if (gt < 32768) {
        const int bh = gt >> 12, v = (gt >> 4) & 255, dg = gt & 15;
        bf16* ptr = F.Cm + ((size_t)(bh * NCH) * 256 + v) * 128 + dg * 8;
        float* ms = F.msc + (size_t)bh * NCH * 4;
        float* np = F.nst + (size_t)bh * NCH * 128 + dg * 8;
        const bool nth = (v == 0);
        float C[8], n[8]; float m = 0.f;
#pragma unroll
        for (int i = 0; i < 8; ++i) { C[i] = 0.f; n[i] = 0.f; }
        for (int c0 = 0; c0 < NCH; c0 += 4) {
            v4u K[4];
#pragma unroll
            for (int i = 0; i < 4; ++i) K[i] = *(const v4u*)(ptr + (size_t)(c0 + i) * 32768);
#pragma unroll
            for (int i = 0; i < 4; ++i) { const int c = c0 + i;
                const float g = ms[c * 4], ml = ms[c * 4 + 1];
                const float mn = fmaxf(g + m, ml), ws = expf(g + m - mn), fl = expf(ml - mn);
                *(v4u*)(ptr + (size_t)c * 32768) = pack8(C);
                float kf[8]; unpack8(K[i], kf);
#pragma unroll
                for (int q = 0; q < 8; ++q) C[q] = ws * C[q] + fl * kf[q];
                if (nth) {
                    const f32x4 a = *(const f32x4*)(np + c * 128), bq = *(const f32x4*)(np + c * 128 + 4);
                    *(f32x4*)(np + c * 128) = (f32x4){n[0], n[1], n[2], n[3]}; *(f32x4*)(np + c * 128 + 4) = (f32x4){n[4], n[5], n[6], n[7]};
                    n[0] = ws * n[0] + fl * a[0]; n[1] = ws * n[1] + fl * a[1]; n[2] = ws * n[2] + fl * a[2]; n[3] = ws * n[3] + fl * a[3];
                    n[4] = ws * n[4] + fl * bq[0]; n[5] = ws * n[5] + fl * bq[1]; n[6] = ws * n[6] + fl * bq[2]; n[7] = ws * n[7] + fl * bq[3];
                    if (dg == 0) ms[c * 4 + 2] = m;
                }
                m = mn; }
        }
    } else if (gt < 65536) {
        const int g2 = gt - 32768, bh = g2 >> 11, v = (g2 >> 4) & 127, eg = g2 & 15;
        bf16* ptr = F.Ch + ((size_t)(bh * NCH) * 128 + v) * 128 + eg * 8;
        const float* gd = F.gdec + (size_t)bh * NCH * 128 + eg * 8;
        float S[8];
#pragma unroll
        for (int i = 0; i < 8; ++i) S[i] = 0.f;
        for (int c0 = 0; c0 < NCH; c0 += 4) {
            v4u K[4]; f32x4 D0[4], D1[4];
#pragma unroll
            for (int i = 0; i < 4; ++i) { K[i] = *(const v4u*)(ptr + (size_t)(c0 + i) * 16384); D0[i] = *(const f32x4*)(gd + (c0 + i) * 128); D1[i] = *(const f32x4*)(gd + (c0 + i) * 128 + 4); }
#pragma unroll
            for (int i = 0; i < 4; ++i) { const int c = c0 + i;
                *(v4u*)(ptr + (size_t)c * 16384) = pack8(S);
                float kf[8]; unpack8(K[i], kf);
                S[0] = D0[i][0] * S[0] + kf[0]; S[1] = D0[i][1] * S[1] + kf[1]; S[2] = D0[i][2] * S[2] + kf[2]; S[3] = D0[i][3] * S[3] + kf[3];
                S[4] = D1[i][0] * S[4] + kf[4]; S[5] = D1[i][1] * S[5] + kf[5]; S[6] = D1[i][2] * S[6] + kf[6]; S[7] = D1[i][3] * S[7] + kf[7]; }
        }
    }
}
constexpr int R_QS = 0, R_KS = 17408, R_QW = 34816, R_SC = 52224, R_F32 = 61440;
__device__ __forceinline__ void st_bf(LAS bf16* p, float v) { *p = (bf16)(pk2(v, v) & 0xffffu); }
template <int MODE>
__device__ __forceinline__ void score_tiles(const Frame& F, const LAS bf16* Kt, const LAS bf16* Qt, LAS bf16* Sc, const LAS float* bm, const LAS float* uu, LAS float* dnA, LAS float* dnB) {
    const int wave = F.wave, lane = F.lane, r32 = lane & 31, hi = lane >> 5;
    if (wave < 3) {
        const int jt = (wave == 2) ? 1 : 0, tt = (wave >= 1) ? 1 : 0;
        f32x16 acc = zero16();
#pragma unroll
        for (int ks = 0; ks < 8; ++ks) { const bf16x8 a = *(const LAS bf16x8*)(Kt + (32 * jt + r32) * 136 + 16 * ks + 8 * hi), bq = *(const LAS bf16x8*)(Qt + (32 * tt + r32) * 136 + 16 * ks + 8 * hi); acc = mfma32(a, bq, acc); }
        const int t = 32 * tt + r32; float rs = 0.f; float bmt = 0.f; if (MODE == 1) bmt = bm[t];
#pragma unroll
        for (int q = 0; q < 4; ++q) { const int j0 = 32 * jt + 8 * q + 4 * hi; float vv[4];
            f32x4 u4 = (f32x4){0.f, 0.f, 0.f, 0.f}; if (MODE == 1) u4 = *(const LAS f32x4*)(uu + j0);
#pragma unroll
            for (int i = 0; i < 4; ++i) { float val = acc[4 * q + i]; if (MODE == 1) val *= __expf(fminf(bmt + u4[i], 0.f)); val = (j0 + i <= t) ? val : 0.f; vv[i] = val; rs += val; }
            v2u w; w.x = pk2(vv[0], vv[1]); w.y = pk2(vv[2], vv[3]); *(LAS v2u*)(Sc + t * 72 + j0) = w; }
        if (MODE == 1) { rs += __shfl_xor(rs, 32); if (hi == 0) { if (jt == 0) dnA[t] = rs; else dnB[t] = rs; } }
    } else if (wave == 3) {
        for (int idx = lane; idx < 128; idx += 64) { const int t = idx >> 2, part = idx & 3; *(LAS v4u*)(Sc + t * 72 + 32 + 8 * part) = (v4u){0u, 0u, 0u, 0u}; }
        if (MODE == 1 && lane < 32) dnB[lane] = 0.f;
    }
}
__device__ __forceinline__ void r2_mlstm(const Frame& F, int bh, int c) {
    const int b = bh >> 2, h = bh & 3, m0 = b * SEQ + c * 64, unit = bh * NCH + c, tid = F.tid, lane = F.lane, wave = F.wave, r32 = lane & 31, hi = lane >> 5;
    LAS bf16* Qs = (LAS bf16*)(F.lds + R_QS); LAS bf16* Ks = (LAS bf16*)(F.lds + R_KS); LAS bf16* Qw = (LAS bf16*)(F.lds + R_QW); LAS bf16* Sc = (LAS bf16*)(F.lds + R_SC);
    LAS float* fb = (LAS float*)(F.lds + R_F32);
    LAS float *bm = fb, *uu = fb + 64, *wi = fb + 128, *emt = fb + 192, *qn = fb + 256, *dnA = fb + 320, *dnB = fb + 384, *nc = fb + 448, *hn = fb + 576;
    if (wave == 0) {
        const float bj = F.bcum[(size_t)bh * SEQ + c * 64 + lane], ig = F.gates[(size_t)(m0 + lane) * 8 + h], mc = F.msc[unit * 4 + 2];
        const float uj = ig - bj, pm = wave_scan_max(uj, lane), mt = bj + fmaxf(mc, pm);
        bm[lane] = bj - mt; uu[lane] = uj; wi[lane] = expf(bj + mc - mt); emt[lane] = expf(-mt);
    } else if (wave < 3) { const int i = tid - 64; nc[i] = F.nst[(size_t)unit * 128 + i]; }
    {
        const int d = tid & 127, jq = tid >> 7; float v[16];
        const bf16 *src, *hsrc; proj_ptrs(F, m0 + 16 * jq, PC_Q + h * 128 + d, src, hsrc);
        conv_silu_16(F, src, hsrc, h * 128 + d, (c | jq) != 0, 1.0f, v);
#pragma unroll
        for (int jj = 0; jj < 16; ++jj) st_bf(Qs + (16 * jq + jj) * 136 + d, v[jj]);
        proj_ptrs(F, m0 + 16 * jq, PC_K + h * 128 + d, src, hsrc);
        conv_silu_16(F, src, hsrc, 512 + h * 128 + d, (c | jq) != 0, 0.08838834764831845f, v);
#pragma unroll
        for (int jj = 0; jj < 16; ++jj) st_bf(Ks + (16 * jq + jj) * 136 + d, v[jj]);
    }
    __syncthreads();
    if (wave < 4) score_tiles<1>(F, Ks, Qs, Sc, bm, uu, dnA, dnB);
    else {
        const int lt = tid - 256, t = lt >> 2, part = lt & 3; const float wt = wi[t]; float dot = 0.f;
#pragma unroll
        for (int i = 0; i < 4; ++i) { const int d0 = 32 * part + 8 * i; const v4u qv = *(const LAS v4u*)(Qs + t * 136 + d0); float qf[8]; unpack8(qv, qf);
#pragma unroll
            for (int k = 0; k < 8; ++k) dot += qf[k] * nc[d0 + k];
            v4u o; o.x = pk2(qf[0] * wt, qf[1] * wt); o.y = pk2(qf[2] * wt, qf[3] * wt); o.z = pk2(qf[4] * wt, qf[5] * wt); o.w = pk2(qf[6] * wt, qf[7] * wt); *(LAS v4u*)(Qw + t * 136 + d0) = o; }
        dot += __shfl_xor(dot, 1); dot += __shfl_xor(dot, 2); if (part == 0) qn[t] = dot;
    }
    __syncthreads();
    f32x16 acc2[2]; acc2[0] = zero16(); acc2[1] = zero16();
    {
        const bf16* vt = F.VT + vt_off(h * 256 + 32 * wave + r32, m0) + 8 * hi;
#pragma unroll
        for (int ks = 0; ks < 4; ++ks) { const bf16x8 a = *(const bf16x8*)(vt + 16 * ks);
#pragma unroll
            for (int tt = 0; tt < 2; ++tt) { const bf16x8 bq = *(const LAS bf16x8*)(Sc + (32 * tt + r32) * 72 + 16 * ks + 8 * hi); acc2[tt] = mfma32(a, bq, acc2[tt]); } }
        const bf16* cs = F.Cm + ((size_t)unit * 256 + 32 * wave + r32) * 128 + 8 * hi;
#pragma unroll
        for (int ks = 0; ks < 8; ++ks) { const bf16x8 a = *(const bf16x8*)(cs + 16 * ks);
#pragma unroll
            for (int tt = 0; tt < 2; ++tt) { const bf16x8 bq = *(const LAS bf16x8*)(Qw + (32 * tt + r32) * 136 + 16 * ks + 8 * hi); acc2[tt] = mfma32(a, bq, acc2[tt]); } }
    }
#pragma unroll
    for (int tt = 0; tt < 2; ++tt) { const int t = 32 * tt + r32; const float den = dnA[t] + dnB[t] + wi[t] * qn[t]; const float inv = 1.0f / fmaxf(fabsf(den), emt[t]); float ssp = 0.f;
#pragma unroll
        for (int r = 0; r < 16; ++r) { acc2[tt][r] *= inv; ssp += acc2[tt][r] * acc2[tt][r]; }
        ssp += __shfl_xor(ssp, 32); if (hi == 0) hn[wave * 64 + t] = ssp; }
    __syncthreads();
#pragma unroll
    for (int tt = 0; tt < 2; ++tt) { const int t = 32 * tt + r32; float tot = 0.f;
#pragma unroll
        for (int w = 0; w < 8; ++w) tot += hn[w * 64 + t];
        const float rstd = 1.0f / sqrtf(tot * (1.0f / 256.0f) + EPS);
        const bf16* prow_o = F.PROJ + proj_off(m0 + t, PC_O + h * 256 + 32 * wave + 4 * hi);
        const bf16* prow_z = F.PROJ + proj_off(m0 + t, PC_Z + h * 256 + 32 * wave + 4 * hi);
        bf16* yrow = F.Y + (size_t)(m0 + t) * DM + h * 256 + 32 * wave + 4 * hi;
        const float* nwp = F.ml_nw + h * 256 + 32 * wave + 4 * hi;
#pragma unroll
        for (int q = 0; q < 4; ++q) { const v2u o4 = *(const v2u*)(prow_o + 8 * q), z4 = *(const v2u*)(prow_z + 8 * q); const f32x4 nw = *(const f32x4*)(nwp + 8 * q);
            const float o0 = blo(o4.x), o1 = bhi(o4.x), o2 = blo(o4.y), o3 = bhi(o4.y), z0 = blo(z4.x), z1 = bhi(z4.x), z2 = blo(z4.y), z3 = bhi(z4.y);
            const float y0 = acc2[tt][4 * q] * rstd * nw[0] * sigm(o0) * z0 * sigm(z0), y1 = acc2[tt][4 * q + 1] * rstd * nw[1] * sigm(o1) * z1 * sigm(z1);
            const float y2 = acc2[tt][4 * q + 2] * rstd * nw[2] * sigm(o2) * z2 * sigm(z2), y3 = acc2[tt][4 * q + 3] * rstd * nw[3] * sigm(o3) * z3 * sigm(z3);
            v2u w; w.x = pk2(y0, y1); w.y = pk2(y2, y3); *(v2u*)(yrow + 8 * q) = w; } }
    __syncthreads();
}
__device__ __forceinline__ void r2_hgrn2(const Frame& F, int bh, int c) {
    const int b = bh >> 3, h = bh & 7, m0 = b * SEQ + c * 64, unit = bh * NCH + c, tid = F.tid, lane = F.lane, wave = F.wave, r32 = lane & 31, hi = lane >> 5;
    LAS bf16* Qt = (LAS bf16*)(F.lds + R_QS); LAS bf16* Kt = (LAS bf16*)(F.lds + R_KS); LAS bf16* Q2 = (LAS bf16*)(F.lds + R_QW); LAS bf16* Sc = (LAS bf16*)(F.lds + R_SC);
    LAS float* fb = (LAS float*)(F.lds + R_F32);
    LAS float *seg = fb, *hn = fb + 512;
    {
        const int e = tid & 127, jq = tid >> 7;
        const float lb = 1.0f / (1.0f + expf(F.hg_lb[1024 + h * 128 + e] - F.hg_lb[h * 128 + e]));
        float sg[16], cum[16];
        const float run = hg_forget_16(F.PROJ + proj_off(m0 + 16 * jq, PC_HF + h * 128 + e), lb, sg, cum);
        seg[jq * 128 + e] = run;
        __syncthreads();
        const float s0 = seg[e], s1 = seg[128 + e], s2 = seg[256 + e];
        const float off = jq == 0 ? 0.f : jq == 1 ? s0 : jq == 2 ? s0 + s1 : s0 + s1 + s2;
        const float bref = s0 + s1;
        const bf16* srcq = F.PROJ + proj_off(m0 + 16 * jq, PC_HQ + h * 128 + e);
#pragma unroll
        for (int jj = 0; jj < 16; ++jj) { const int j = 16 * jq + jj; const float bj = off + cum[jj]; const float qv = bf2f(srcq[jj * 256]);
            st_bf(Qt + j * 136 + e, qv * expf(bj - bref)); st_bf(Kt + j * 136 + e, (1.0f - lb) * (1.0f - sg[jj]) * expf(bref - bj)); st_bf(Q2 + j * 136 + e, qv * expf(bj)); }
    }
    __syncthreads();
    if (wave < 4) score_tiles<0>(F, Kt, Qt, Sc, nullptr, nullptr, nullptr, nullptr);
    __syncthreads();
    const int vt_i = wave & 3, tt = wave >> 2, t = 32 * tt + r32;
    f32x16 acc = zero16();
    {
        const bf16* vt = F.VT + vt_off(1024 + h * 128 + 32 * vt_i + r32, m0) + 8 * hi;
#pragma unroll
        for (int ks = 0; ks < 4; ++ks) { const bf16x8 a = *(const bf16x8*)(vt + 16 * ks); const bf16x8 bq = *(const LAS bf16x8*)(Sc + t * 72 + 16 * ks + 8 * hi); acc = mfma32(a, bq, acc); }
        const bf16* cs = F.Ch + ((size_t)unit * 128 + 32 * vt_i + r32) * 128 + 8 * hi;
#pragma unroll
        for (int ks = 0; ks < 8; ++ks) { const bf16x8 a = *(const bf16x8*)(cs + 16 * ks); const bf16x8 bq = *(const LAS bf16x8*)(Q2 + t * 136 + 16 * ks + 8 * hi); acc = mfma32(a, bq, acc); }
    }
    { float ssp = 0.f;
#pragma unroll
      for (int r = 0; r < 16; ++r) ssp += acc[r] * acc[r];
      ssp += __shfl_xor(ssp, 32); if (hi == 0) hn[vt_i * 64 + t] = ssp; }
    __syncthreads();
    {
        const float tot = (hn[t] + hn[64 + t]) + (hn[128 + t] + hn[192 + t]);
        const float rstd = 1.0f / sqrtf(tot * (1.0f / 128.0f) + EPS);
        const bf16* prow = F.PROJ + proj_off(m0 + t, PC_HG + h * 128 + 32 * vt_i + 4 * hi);
        bf16* yrow = F.Y + (size_t)(m0 + t) * DM + 1024 + h * 128 + 32 * vt_i + 4 * hi;
        const float* nwp = F.hg_nw + h * 128 + 32 * vt_i + 4 * hi;
#pragma unroll
        for (int q = 0; q < 4; ++q) { const v2u g4 = *(const v2u*)(prow + 8 * q); const f32x4 nw = *(const f32x4*)(nwp + 8 * q);
            const float g0 = blo(g4.x), g1 = bhi(g4.x), g2 = blo(g4.y), g3 = bhi(g4.y);
            const float y0 = acc[4 * q] * rstd * nw[0] * g0 * sigm(g0), y1 = acc[4 * q + 1] * rstd * nw[1] * g1 * sigm(g1);
            const float y2 = acc[4 * q + 2] * rstd * nw[2] * g2 * sigm(g2), y3 = acc[4 * q + 3] * rstd * nw[3] * g3 * sigm(g3);
            v2u w; w.x = pk2(y0, y1); w.y = pk2(y2, y3); *(v2u*)(yrow + 8 * q) = w; }
    }
    __syncthreads();
}
__device__ __forceinline__ void final_norm(const Frame& F) {
    int lane; asm volatile("v_mbcnt_lo_u32_b32 %0, -1, 0\n\tv_mbcnt_hi_u32_b32 %0, -1, %0" : "=v"(lane));
    const int gw = F.bid * NWAVES + F.wave, NGW = F.G * NWAVES;
    const f32x4* nwp = (const f32x4*)F.fin_nw + lane;
    for (int m = gw; m < M; m += NGW) {
        const float sq = __hip_atomic_load(F.ssq2 + m, RLX_AGENT);
        const float rstd = 1.0f / sqrtf(sq * (1.0f / DM) + EPS);
        f32x4* xr = (f32x4*)(F.out + (size_t)m * DM) + lane;
#pragma unroll
        for (int j = 0; j < 8; ++j) xr[64 * j] = xr[64 * j] * rstd * nwp[64 * j];
    }
}
struct Args { const float* in[16]; float* out; unsigned char* ws; int ph_lo, ph_hi, li, pad; };
__global__ void __launch_bounds__(NWAVES * 64, 2) hymba_fwd(Args args) {
    extern __shared__ __attribute__((aligned(16))) unsigned char lds[];
    Frame F;
    F.lds = (LAS unsigned char*)lds;
    F.tid = threadIdx.x; F.lane = F.tid & 63; F.wave = __builtin_amdgcn_readfirstlane(F.tid >> 6); F.G = gridDim.x; F.bid = blockIdx.x;
    unsigned char* ws = args.ws;
    gu32* ctl = (gu32*)(ws + WS_CTL);
    F.x = args.in[0]; F.p = args.in[1]; F.norm_w = args.in[2]; F.w_in = args.in[3]; F.conv_w = args.in[4]; F.conv_b = args.in[5]; F.b_i = args.in[6]; F.b_f = args.in[7];
    F.ml_nw = args.in[8]; F.hg_lb = args.in[9]; F.hg_nw = args.in[10]; F.w_out = args.in[11]; F.pe_nw = args.in[12]; F.w_pg = args.in[13]; F.w_pe = args.in[14]; F.fin_nw = args.in[15];
    F.out = args.out;
    F.Wt_in = (bf16*)(ws + WS_WIN); F.WoT = (bf16*)(ws + WS_WO); F.WgT = (bf16*)(ws + WS_WG); F.WeT = (bf16*)(ws + WS_WE); F.PB = (bf16*)(ws + WS_PB);
    F.U = (bf16*)(ws + WS_U); F.Y = (bf16*)(ws + WS_U); F.PROJ = (bf16*)(ws + WS_PROJ); F.HB = (bf16*)(ws + WS_PROJ); F.EB = (bf16*)(ws + WS_PROJ + 128 * MiB); F.VT = (bf16*)(ws + WS_VT);
    F.Cm = (bf16*)args.out; F.Ch = (bf16*)args.out + (size_t)64 * MiB;
    F.gates = (float*)(ws + WS_GATES); F.bcum = (float*)(ws + WS_BCUM); F.msc = (float*)(ws + WS_MSC); F.nst = (float*)(ws + WS_NST); F.gdec = (float*)(ws + WS_GDEC);
    F.ssqh = (float*)(ws + WS_SSQH); F.ssq2 = (float*)(ws + WS_SSQ2); F.H = (float*)(ws + WS_H);
    for (int u = F.tid; u < (LDS_BYTES - LDSCTL_OFF) / 4; u += NWAVES * 64) ((LAS unsigned*)(F.lds + LDSCTL_OFF))[u] = 0u;
    __syncthreads();
    XcdBarrier bar; bar.bar = (unsigned*)(ctl + CW_BAR); bar.x = 0; bar.st = nullptr;
    if (N_LAUNCHES != PER_PHASE) bar = xcd_barrier_post((unsigned*)(ctl + CW_BAR), (volatile LAS unsigned*)(F.lds + MISC_OFF) + 8);
#define GRID_BAR() do { if (N_LAUNCHES == PER_PHASE) { if (F.tid == 0) __hip_atomic_store(ctl + CW_TMO, 0xBADBA0u, RLX_AGENT); } else { xcd_barrier(bar); } } while (0)
    const int lo = args.ph_lo, hi = args.ph_hi;
#define IN(k) (lo <= (k) && (k) < hi)
#define BOTH(k) (IN(k) && IN((k) + 1))
#ifndef GEMM_SP2
#define GEMM_SP2 true
#endif
#ifndef PROBE_DOUBLE
#define PROBE_DOUBLE 0
#endif
    if (IN(0)) { p0_prologue(F);
#if PROBE_DOUBLE & 1
        __syncthreads(); p0_prologue(F);
#endif
        if (BOTH(0)) GRID_BAR(); }
    int vcu = F.bid;
    if (N_LAUNCHES != PER_PHASE && lo == 0) { volatile LAS unsigned* st = (volatile LAS unsigned*)(F.lds + MISC_OFF) + 8; if (st[2] != 0u && F.G == 256) vcu = (int)(st[3] * 8u + bar.x); }
    if (IN(1)) {
#if PROBE_DOUBLE & 2
        { pg8::Gemm g{F.U, F.Wt_in, M, NNAT, DM}; pg8::StaticOrder S; S.init(M, NNAT, F.G, vcu);
          pg8::EpiBf16T E{F.PROJ, NNAT / 256};
          pg8::gemm_phase<pg8::EpiBf16T, pg8::StaticOrder, true, GEMM_SP2>(F.lds, g, S, E); }
        { pg8::Gemm g{F.Wt_in + (size_t)NNAT * DM, F.U, NTR, M, DM}; pg8::StaticOrder S; S.init(NTR, M, F.G, vcu);
          pg8::EpiBf16T E{F.VT, M / 256};
          pg8::gemm_phase<pg8::EpiBf16T, pg8::StaticOrder, true, GEMM_SP2>(F.lds, g, S, E); }
#endif
        { pg8::Gemm g{F.U, F.Wt_in, M, NNAT, DM}; pg8::StaticOrder S; S.init(M, NNAT, F.G, vcu);
          pg8::EpiBf16T E{F.PROJ, NNAT / 256};
          pg8::gemm_phase<pg8::EpiBf16T, pg8::StaticOrder, true, GEMM_SP2>(F.lds, g, S, E); }
        { pg8::Gemm g{F.Wt_in + (size_t)NNAT * DM, F.U, NTR, M, DM}; pg8::StaticOrder S; S.init(NTR, M, F.G, vcu);
          pg8::EpiBf16T E{F.VT, M / 256};
          pg8::gemm_phase<pg8::EpiBf16T, pg8::StaticOrder, true, GEMM_SP2>(F.lds, g, S, E); }
        if (BOTH(1)) GRID_BAR();
    }
    if (IN(2)) {
#if PROBE_DOUBLE & 4
        for (int u = F.bid; u < 6144; u += F.G) { const int k3 = u / 3, r3 = u - 3 * k3; if (r3 == 0) pa_mlstm(F, k3 >> 8, k3 & 255); else { const int id = 2 * k3 + r3 - 1; pa_hgrn2(F, id >> 8, id & 255); } }
#endif
        for (int u = F.bid; u < 6144; u += F.G) { const int k3 = u / 3, r3 = u - 3 * k3; if (r3 == 0) pa_mlstm(F, k3 >> 8, k3 & 255); else { const int id = 2 * k3 + r3 - 1; pa_hgrn2(F, id >> 8, id & 255); } }
        if (BOTH(2)) GRID_BAR();
    }
    if (IN(3)) { scan_phase(F); if (BOTH(3)) GRID_BAR(); }
    if (IN(4)) {
#if PROBE_DOUBLE & 16
        for (int u = F.bid; u < 6144; u += F.G) { const int k3 = u / 3, r3 = u - 3 * k3; if (r3 == 0) r2_mlstm(F, k3 >> 8, k3 & 255); else { const int id = 2 * k3 + r3 - 1; r2_hgrn2(F, id >> 8, id & 255); } }
#endif
        for (int u = F.bid; u < 6144; u += F.G) { const int k3 = u / 3, r3 = u - 3 * k3; if (r3 == 0) r2_mlstm(F, k3 >> 8, k3 & 255); else { const int id = 2 * k3 + r3 - 1; r2_hgrn2(F, id >> 8, id & 255); } }
        if (BOTH(4)) GRID_BAR();
    }
    if (IN(5)) {
        { pg8::Gemm g{F.Y, F.WoT, M, DM, DM}; pg8::StaticOrder S; S.init(M, DM, F.G, vcu);
          pg8::EpiRes E{F.x, F.out, F.HB, F.ssqh, DM};
          pg8::gemm_phase<pg8::EpiRes, pg8::StaticOrder, true, GEMM_SP2>(F.lds, g, S, E); }
        { pg8::Gemm g{F.PB, F.WeT, M, DM, PE}; pg8::StaticOrder S; S.init(M, DM, F.G, vcu);
          pg8::EpiBf16<0> E{F.EB, DM, nullptr, 0, 0, 1.f};
          pg8::gemm_phase<pg8::EpiBf16<0>, pg8::StaticOrder, true, GEMM_SP2>(F.lds, g, S, E); }
        if (BOTH(5)) GRID_BAR();
    }
    if (IN(6)) {
        pg8::Gemm g{F.HB, F.WgT, M, DM, DM}; pg8::StaticOrder S; S.init(M, DM, F.G, vcu);
        pg8::EpiGate E{F.out, F.EB, F.ssqh, F.ssq2, DM, 1.0f / DM, EPS};
        pg8::gemm_phase<pg8::EpiGate, pg8::StaticOrder, true, GEMM_SP2>(F.lds, g, S, E);
        if (BOTH(6)) GRID_BAR();
    }
    if (IN(7)) final_norm(F);
#undef IN
#undef BOTH
}

#ifdef DBG_DUMP_AFTER
__global__ void dbg_dump(const unsigned char* wsb, float* out, int mode) {
    const unsigned short* a = (const unsigned short*)(wsb + (mode == 0 ? WS_PROJ : WS_U)); const unsigned short* b = (const unsigned short*)(wsb + WS_VT);
    size_t i = (size_t)blockIdx.x * blockDim.x + threadIdx.x;
    const size_t n = (size_t)M * DM;
    for (; i < n; i += (size_t)gridDim.x * blockDim.x) {
        float v;
        if (mode == 0) v = bf2f(a[3 * i]) + bf2f(a[3 * i + 1]) + bf2f(a[3 * i + 2]) + bf2f(b[i]);
        else v = bf2f(a[i]);
        out[i] = v;
    }
}
#endif
extern "C" void kernel_launch(void* const* d_in, const int* in_sizes, int n_in, void* d_out, int out_size, void* d_ws, size_t ws_size, hipStream_t stream) {
    static int grid = 0;
    if (grid == 0) {
        if (n_in != 16 || in_sizes[0] != M * DM || out_size != M * DM || ws_size < WS_END) { fprintf(stderr, "kernel_launch: unexpected shapes (n_in %d, in0 %d, out %d, ws %zu); nothing launched\n", n_in, n_in > 0 ? in_sizes[0] : -1, out_size, ws_size); grid = -1; return; }
        int dev = 0, cus = 0, per_cu = 0;
        if (hipGetDevice(&dev) != hipSuccess || hipDeviceGetAttribute(&cus, hipDeviceAttributeMultiprocessorCount, dev) != hipSuccess) { grid = -1; return; }
        if (hipFuncSetAttribute((const void*)hymba_fwd, hipFuncAttributeMaxDynamicSharedMemorySize, LDS_BYTES) != hipSuccess) { fprintf(stderr, "kernel_launch: hipFuncSetAttribute failed\n"); grid = -1; return; }
        if (hipOccupancyMaxActiveBlocksPerMultiprocessor(&per_cu, (const void*)hymba_fwd, NWAVES * 64, LDS_BYTES) != hipSuccess || per_cu < 1)
            fprintf(stderr, "kernel_launch: note: occupancy query reports %d workgroups per CU\n", per_cu);
        (void)hipGetLastError();
        grid = cus;
    }
    if (grid < 0) return;
    if (hipMemsetAsync((char*)d_ws + WS_CTL, 0, CTL_ZERO_BYTES, stream) != hipSuccess) { fprintf(stderr, "kernel_launch: hipMemsetAsync failed\n"); return; }
    Args a{};
    for (int i = 0; i < 16; ++i) a.in[i] = (const float*)d_in[i];
    a.out = (float*)d_out; a.ws = (unsigned char*)d_ws;
    for (int li = 0; li < N_LAUNCHES; ++li) {
#ifdef DBG_DUMP_AFTER
        if (li > DBG_DUMP_AFTER) { if (DBG_DUMP_AFTER != 2 && DBG_DUMP_AFTER != 3) hipLaunchKernelGGL(dbg_dump, dim3(2048), dim3(256), 0, stream, (const unsigned char*)d_ws, (float*)d_out, DBG_DUMP_AFTER == 1 ? 0 : 1);
            break; }
#endif
        a.ph_lo = (N_LAUNCHES == PER_PHASE) ? li : 0; a.ph_hi = (N_LAUNCHES == PER_PHASE) ? li + 1 : PER_PHASE; a.li = li;
        hipLaunchKernelGGL(hymba_fwd, dim3(grid), dim3(NWAVES * 64), LDS_BYTES, stream, a);
        const hipError_t le = hipPeekAtLastError();
        if (le != hipSuccess) { fprintf(stderr, "kernel_launch: launch %d failed: %s\n", li, hipGetErrorName(le)); break; }
    }
}
```

```cpp
#include <hip/hip_runtime.h>
#include <cstdio>
#include <cstdint>
namespace pg8 {
#define PG8_LAS __attribute__((address_space(3)))
typedef unsigned short bf16_t;
typedef short bf16x8 __attribute__((ext_vector_type(8)));
typedef float f32x4 __attribute__((ext_vector_type(4)));
typedef unsigned u32x4 __attribute__((ext_vector_type(4)));
constexpr int BM = 256, BK = 64, HALF = 128, HTB = HALF * BK * 2  , STAGE_BYTES = 8 * HTB, NXCD = 8, WGM = 8;

__host__ __device__ __forceinline__ int lds_byte(int r, int c) { const int st = (r >> 4) * 2 + (c >> 5), rr = r & 15, cc = c & 31, ob = rr * 64 + cc * 2; return st * 1024 + (ob ^ (((ob >> 9) & 1) << 5)); }
__host__ __device__ __forceinline__ void stage_rc(int b, int& R, int& C) { const int st = b / 1024, sb = b % 1024, swz = sb ^ (((sb >> 9) & 1) << 5); R = (st >> 1) * 16 + swz / 64; C = (st & 1) * 32 + (swz % 64) / 2; }
__host__ __device__ __forceinline__ int perm32(int rho) { const int n = rho >> 4, i = rho & 15; return 8 * (i >> 2) + 4 * n + (i & 3); }

struct Unit { int pm, pn; };
struct Gemm { const bf16_t* A; const bf16_t* Bt; int M, N, K; };

struct StaticOrder {
    int nM, nN, nwg, G, c;
    __host__ __device__ void init(int M, int N, int G_, int c_) { nM = M / BM; nN = N / BM; nwg = nM * nN; G = G_; c = c_; }
    __host__ __device__ bool next(int i, Unit& u) const {
        const long L = (long)i * G + c; if (L >= nwg) return false;
        int wgid = (int)L; { const int q = nwg / NXCD, r = nwg % NXCD, xcd = wgid % NXCD, off = wgid / NXCD; wgid = (xcd < r ? xcd * (q + 1) : r * (q + 1) + (xcd - r) * q) + off; }
        const int nig = WGM * nN, gid = wgid / nig, fm = gid * WGM, gsz = (nM - fm) < WGM ? (nM - fm) : WGM;
        u.pm = fm + ((wgid % nig) % gsz); u.pn = (wgid % nig) / gsz; return true;
    }
    __device__ __forceinline__ void a_ready(const Unit&) const {}
    __device__ __forceinline__ void done(const Unit&) const {}
};

typedef unsigned u32x2 __attribute__((ext_vector_type(2)));
typedef int i32x4_ __attribute__((ext_vector_type(4)));
typedef int i32x8_ __attribute__((ext_vector_type(8)));
typedef long i64x2_ __attribute__((ext_vector_type(2)));
__device__ __forceinline__ i32x8_ cat8(bf16x8 a, bf16x8 b) { const i32x4_ x = __builtin_bit_cast(i32x4_, a), y = __builtin_bit_cast(i32x4_, b); return __builtin_shufflevector(x, y, 0, 1, 2, 3, 4, 5, 6, 7); }
__device__ __forceinline__ void mfma_fp8_inplace(f32x4& acc, i32x8_ a, i32x8_ b, int scale) {
    asm volatile("v_mfma_scale_f32_16x16x128_f8f6f4 %0, %1, %2, %0, %3, %3 op_sel_hi:[0,0,0]" : "+v"(acc) : "v"(a), "v"(b), "v"(scale));
}
__device__ __forceinline__ unsigned cvt_pk4_fp8(float a, float b, float c, float d) { int w = __builtin_amdgcn_cvt_pk_fp8_f32(a, b, 0, false); w = __builtin_amdgcn_cvt_pk_fp8_f32(c, d, w, true); return (unsigned)w; }
__device__ __forceinline__ unsigned cvt_pk_bf16(float lo, float hi) { unsigned r; asm volatile("v_cvt_pk_bf16_f32 %0, %1, %2" : "=v"(r) : "v"(lo), "v"(hi)); return r; }
typedef float f32x2 __attribute__((ext_vector_type(2)));
__device__ __forceinline__ f32x2 gelu_pk(f32x2 v) {
    const f32x2 av = __builtin_elementwise_abs(v), d = av * 0.2316418882f + 1.0f;
    f32x2 t; t.x = __builtin_amdgcn_rcpf(d.x); t.y = __builtin_amdgcn_rcpf(d.y);
    f32x2 q = t * 0.5307027145f + (-0.7265760135f); q = q * t + 0.7107068705f; q = q * t + (-0.142248368f); q = q * t + 0.127414796f; q = q * t;
    const f32x2 s = (v * v) * (-0.72134752044f);
    f32x2 e; e.x = __builtin_amdgcn_exp2f(s.x); e.y = __builtin_amdgcn_exp2f(s.y);
    const f32x2 m = v * (q * e), r = v - m;
    f32x2 o; o.x = v.x < 0.f ? m.x : r.x; o.y = v.y < 0.f ? m.y : r.y; return o;
}

template <int ACT  > struct EpiBf16 {
    static constexpr bool PERM = true, AFTER_DRAIN = false; static_assert(ACT == 0 || ACT == 1, "EpiBf16: ACT is 0 (none) or 1 (gelu_pk)");
    bf16_t* O; int ldc; const float* bias; int split_cols; size_t split_stride; float scale0;
    __device__ __forceinline__ void operator()(const f32x4 (&acc)[2][2][4][2], const Unit& u, int wr, int wc, int fr, int fq) const {
        const int row0 = u.pm * BM + wr * 64 + fr; int colt = u.pn * BM; bf16_t* base = O;
        float sc = 1.f; if (split_cols) { const int t = colt / split_cols; base += (size_t)t * split_stride; colt -= t * split_cols; if (t == 0) sc = scale0; }
        const int col0 = colt + wc * 32 + 8 * fq, bcol0 = u.pn * BM + wc * 32 + 8 * fq;
        f32x4 bv[2][2];
#pragma unroll
        for (int bj = 0; bj < 2; ++bj)
#pragma unroll
            for (int n = 0; n < 2; ++n) bv[bj][n] = bias ? *(const f32x4*)(bias + bcol0 + bj * HALF + 4 * n) : (f32x4){0.f, 0.f, 0.f, 0.f};
#pragma unroll
        for (int ai = 0; ai < 2; ++ai)
#pragma unroll
            for (int m = 0; m < 4; ++m) { bf16_t* rowp = base + (size_t)(row0 + ai * HALF + m * 16) * ldc + col0;
#pragma unroll
                for (int bj = 0; bj < 2; ++bj) { f32x4 v0 = acc[ai][bj][m][0] + bv[bj][0], v1 = acc[ai][bj][m][1] + bv[bj][1];
                    if (ACT == 1) { f32x2 a = gelu_pk((f32x2){v0[0], v0[1]}), b = gelu_pk((f32x2){v0[2], v0[3]}), c = gelu_pk((f32x2){v1[0], v1[1]}), d = gelu_pk((f32x2){v1[2], v1[3]});
                        v0 = (f32x4){a.x, a.y, b.x, b.y}; v1 = (f32x4){c.x, c.y, d.x, d.y}; }
                    v0 = v0 * sc; v1 = v1 * sc; u32x4 w; w.x = cvt_pk_bf16(v0[0], v0[1]); w.y = cvt_pk_bf16(v0[2], v0[3]); w.z = cvt_pk_bf16(v1[0], v1[1]); w.w = cvt_pk_bf16(v1[2], v1[3]);
                    __builtin_nontemporal_store(w, (u32x4*)(rowp + bj * HALF)); } }
    }
};
__device__ __forceinline__ float bf_lo(unsigned w) { return __uint_as_float(w << 16); }
__device__ __forceinline__ float bf_hi(unsigned w) { return __uint_as_float(w & 0xffff0000u); }
__device__ __forceinline__ float fast_sigmoid(float x) { return __builtin_amdgcn_rcpf(1.0f + __expf(-x)); }
struct EpiBf16T {
    static constexpr bool PERM = true, AFTER_DRAIN = false;
    bf16_t* O; int nN;
    __device__ __forceinline__ void operator()(const f32x4 (&acc)[2][2][4][2], const Unit& u, int wr, int wc, int fr, int fq) const {
        bf16_t* tile = O + (size_t)(u.pm * nN + u.pn) * 65536 + (wr * 64 + fr) * 256 + wc * 32 + 8 * fq;
#pragma unroll
        for (int ai = 0; ai < 2; ++ai)
#pragma unroll
            for (int m = 0; m < 4; ++m) { bf16_t* rowp = tile + (ai * HALF + m * 16) * 256;
#pragma unroll
                for (int bj = 0; bj < 2; ++bj) { const f32x4 v0 = acc[ai][bj][m][0], v1 = acc[ai][bj][m][1];
                    u32x4 w; w.x = cvt_pk_bf16(v0[0], v0[1]); w.y = cvt_pk_bf16(v0[2], v0[3]); w.z = cvt_pk_bf16(v1[0], v1[1]); w.w = cvt_pk_bf16(v1[2], v1[3]);
                    *(u32x4*)(rowp + bj * HALF) = w; } }
    }
};
struct EpiProj {
    static constexpr bool PERM = true, AFTER_DRAIN = false;
    bf16_t* O; int nN, oz_lo, oz_hi, silu_lo;
    __device__ __forceinline__ void operator()(const f32x4 (&acc)[2][2][4][2], const Unit& u, int wr, int wc, int fr, int fq) const {
        bf16_t* tile = O + (size_t)(u.pm * nN + u.pn) * 65536 + (wr * 64 + fr) * 256 + wc * 32 + 8 * fq;
        if (u.pn >= oz_lo && u.pn < oz_hi) {
#pragma unroll
            for (int ai = 0; ai < 2; ++ai)
#pragma unroll
                for (int m = 0; m < 4; ++m) { float g[8];
#pragma unroll
                    for (int n = 0; n < 2; ++n)
#pragma unroll
                        for (int k = 0; k < 4; ++k) { const float o = acc[ai][0][m][n][k], z = acc[ai][1][m][n][k]; g[4 * n + k] = z * __builtin_amdgcn_rcpf((1.0f + __expf(-o)) * (1.0f + __expf(-z))); }
                    u32x4 w; w.x = cvt_pk_bf16(g[0], g[1]); w.y = cvt_pk_bf16(g[2], g[3]); w.z = cvt_pk_bf16(g[4], g[5]); w.w = cvt_pk_bf16(g[6], g[7]);
                    *(u32x4*)(tile + (ai * HALF + m * 16) * 256) = w; }
        } else if (u.pn >= silu_lo) {
#pragma unroll
            for (int ai = 0; ai < 2; ++ai)
#pragma unroll
                for (int m = 0; m < 4; ++m) { bf16_t* rowp = tile + (ai * HALF + m * 16) * 256;
#pragma unroll
                    for (int bj = 0; bj < 2; ++bj) { f32x4 v0 = acc[ai][bj][m][0], v1 = acc[ai][bj][m][1];
#pragma unroll
                        for (int k = 0; k < 4; ++k) { v0[k] = v0[k] * fast_sigmoid(v0[k]); v1[k] = v1[k] * fast_sigmoid(v1[k]); }
                        u32x4 w; w.x = cvt_pk_bf16(v0[0], v0[1]); w.y = cvt_pk_bf16(v0[2], v0[3]); w.z = cvt_pk_bf16(v1[0], v1[1]); w.w = cvt_pk_bf16(v1[2], v1[3]);
                        *(u32x4*)(rowp + bj * HALF) = w; } }
        } else {
#pragma unroll
            for (int ai = 0; ai < 2; ++ai)
#pragma unroll
                for (int m = 0; m < 4; ++m) { bf16_t* rowp = tile + (ai * HALF + m * 16) * 256;
#pragma unroll
                    for (int bj = 0; bj < 2; ++bj) { const f32x4 v0 = acc[ai][bj][m][0], v1 = acc[ai][bj][m][1];
                        u32x4 w; w.x = cvt_pk_bf16(v0[0], v0[1]); w.y = cvt_pk_bf16(v0[2], v0[3]); w.z = cvt_pk_bf16(v1[0], v1[1]); w.w = cvt_pk_bf16(v1[2], v1[3]);
                        *(u32x4*)(rowp + bj * HALF) = w; } }
        }
    }
};
struct EpiRes {
    static constexpr bool PERM = true, AFTER_DRAIN = false;
    const bf16_t* ub; const float* rms; const float* nw; bf16_t* hb; unsigned char* hb8; float* ssq; int ldc, nN;
    __device__ __forceinline__ void operator()(const f32x4 (&acc)[2][2][4][2], const Unit& u, int wr, int wc, int fr, int fq) const {
        const int row0 = u.pm * BM + wr * 64 + fr, col0 = u.pn * BM + wc * 32 + 8 * fq;
        const size_t toff = (size_t)(u.pm * nN + u.pn) * 65536 + (wr * 64 + fr) * 256 + wc * 32 + 8 * fq;
        f32x4 inw[2][2];
#pragma unroll
        for (int bj = 0; bj < 2; ++bj)
#pragma unroll
            for (int n = 0; n < 2; ++n) { const f32x4 w = *(const f32x4*)(nw + col0 + bj * HALF + 4 * n); inw[bj][n] = (f32x4){__builtin_amdgcn_rcpf(w[0]), __builtin_amdgcn_rcpf(w[1]), __builtin_amdgcn_rcpf(w[2]), __builtin_amdgcn_rcpf(w[3])}; }
#pragma unroll
        for (int ai = 0; ai < 2; ++ai) {
            u32x4 xv[4][2]; float rm[4];
#pragma unroll
            for (int m = 0; m < 4; ++m) { const size_t off = (size_t)(row0 + ai * HALF + m * 16) * ldc + col0; rm[m] = rms[row0 + ai * HALF + m * 16];
#pragma unroll
                for (int bj = 0; bj < 2; ++bj) xv[m][bj] = *(const u32x4*)(ub + off + bj * HALF); }
#pragma unroll
            for (int m = 0; m < 4; ++m) { const int row = row0 + ai * HALF + m * 16; const size_t to = toff + (ai * HALF + m * 16) * 256; float ss = 0.f;
#pragma unroll
                for (int bj = 0; bj < 2; ++bj) {
                    const u32x4 xw = xv[m][bj];
                    const f32x4 h0 = (f32x4){bf_lo(xw.x), bf_hi(xw.x), bf_lo(xw.y), bf_hi(xw.y)} * inw[bj][0] * rm[m] + acc[ai][bj][m][0], h1 = (f32x4){bf_lo(xw.z), bf_hi(xw.z), bf_lo(xw.w), bf_hi(xw.w)} * inw[bj][1] * rm[m] + acc[ai][bj][m][1];
                    ss += (h0[0] * h0[0] + h0[1] * h0[1]) + (h0[2] * h0[2] + h0[3] * h0[3]) + (h1[0] * h1[0] + h1[1] * h1[1]) + (h1[2] * h1[2] + h1[3] * h1[3]);
                    u32x4 w; w.x = cvt_pk_bf16(h0[0], h0[1]); w.y = cvt_pk_bf16(h0[2], h0[3]); w.z = cvt_pk_bf16(h1[0], h1[1]); w.w = cvt_pk_bf16(h1[2], h1[3]);
                    *(u32x4*)(hb + to + bj * HALF) = w;
                    u32x2 w8; w8.x = cvt_pk4_fp8(h0[0] * 16.0f, h0[1] * 16.0f, h0[2] * 16.0f, h0[3] * 16.0f); w8.y = cvt_pk4_fp8(h1[0] * 16.0f, h1[1] * 16.0f, h1[2] * 16.0f, h1[3] * 16.0f);
                    *(u32x2*)(hb8 + to + bj * HALF) = w8; }
                ss += __shfl_xor(ss, 16); ss += __shfl_xor(ss, 32);
                if (fq == 0) atomicAdd(ssq + row, ss); }
        }
    }
};
struct EpiGate {
    static constexpr bool PERM = true, AFTER_DRAIN = false;
    bf16_t* e; const bf16_t* hb; float* ssq_h; int nN; float inv_n, eps, ascale;
    __device__ __forceinline__ void operator()(const f32x4 (&acc)[2][2][4][2], const Unit& u, int wr, int wc, int fr, int fq) const {
        const int row0 = u.pm * BM + wr * 64 + fr;
        const size_t toff = (size_t)(u.pm * nN + u.pn) * 65536 + (wr * 64 + fr) * 256 + wc * 32 + 8 * fq;
#pragma unroll
        for (int ai = 0; ai < 2; ++ai) {
            u32x4 ev[4][2], hv[4][2]; float sq[4];
#pragma unroll
            for (int m = 0; m < 4; ++m) { const size_t to = toff + (ai * HALF + m * 16) * 256;
                sq[m] = __hip_atomic_load(ssq_h + row0 + ai * HALF + m * 16, __ATOMIC_RELAXED, __HIP_MEMORY_SCOPE_AGENT);
#pragma unroll
                for (int bj = 0; bj < 2; ++bj) { ev[m][bj] = *(const u32x4*)(e + to + bj * HALF); hv[m][bj] = *(const u32x4*)(hb + to + bj * HALF); } }
#pragma unroll
            for (int m = 0; m < 4; ++m) { const size_t to = toff + (ai * HALF + m * 16) * 256;
                const float rstd = __builtin_amdgcn_rsqf(sq[m] * inv_n + eps) * ascale;
#pragma unroll
                for (int bj = 0; bj < 2; ++bj) { const u32x4 v = ev[m][bj], h = hv[m][bj];
                    const f32x4 a0 = acc[ai][bj][m][0] * rstd, a1 = acc[ai][bj][m][1] * rstd;
                    u32x4 w;
                    w.x = cvt_pk_bf16(bf_lo(h.x) + fast_sigmoid(a0[0]) * bf_lo(v.x), bf_hi(h.x) + fast_sigmoid(a0[1]) * bf_hi(v.x)); w.y = cvt_pk_bf16(bf_lo(h.y) + fast_sigmoid(a0[2]) * bf_lo(v.y), bf_hi(h.y) + fast_sigmoid(a0[3]) * bf_hi(v.y));
                    w.z = cvt_pk_bf16(bf_lo(h.z) + fast_sigmoid(a1[0]) * bf_lo(v.z), bf_hi(h.z) + fast_sigmoid(a1[1]) * bf_hi(v.z)); w.w = cvt_pk_bf16(bf_lo(h.w) + fast_sigmoid(a1[2]) * bf_lo(v.w), bf_hi(h.w) + fast_sigmoid(a1[3]) * bf_hi(v.w));
                    *(u32x4*)(e + to + bj * HALF) = w; } }
        }
    }
};
struct EpiNull {
    static constexpr bool PERM = true, AFTER_DRAIN = false;
    __device__ __forceinline__ void operator()(const f32x4 (&acc)[2][2][4][2], const Unit& u, int wr, int wc, int fr, int fq) const {
#pragma unroll
        for (int ai = 0; ai < 2; ++ai)
#pragma unroll
            for (int bj = 0; bj < 2; ++bj)
#pragma unroll
                for (int m = 0; m < 4; ++m)
#pragma unroll
                    for (int n = 0; n < 2; ++n) asm volatile("" :: "v"(acc[ai][bj][m][n]));
    }
};
struct SameTileOrder {
    int c, n;
    __device__ bool next(int i, Unit& u) const { if (i >= n) return false; u.pm = c & 7; u.pn = i % 24; return true; }
    __device__ __forceinline__ void a_ready(const Unit&) const {}
    __device__ __forceinline__ void done(const Unit&) const {}
};
struct EpiScratch {
    static constexpr bool PERM = true, AFTER_DRAIN = false;
    bf16_t* O0; int per_unit;
    __device__ __forceinline__ void operator()(const f32x4 (&acc)[2][2][4][2], const Unit& u, int wr, int wc, int fr, int fq) const {
        bf16_t* O = O0 + (per_unit ? (size_t)(u.pm * 24 + u.pn) * 65536 : (size_t)0);
        const int row0 = wr * 64 + fr, col0 = wc * 32 + 8 * fq;
#pragma unroll
        for (int ai = 0; ai < 2; ++ai)
#pragma unroll
            for (int m = 0; m < 4; ++m) { bf16_t* rowp = O + (size_t)(row0 + ai * HALF + m * 16) * 256 + col0;
#pragma unroll
                for (int bj = 0; bj < 2; ++bj) { const f32x4 v0 = acc[ai][bj][m][0], v1 = acc[ai][bj][m][1];
                    u32x4 w; w.x = cvt_pk_bf16(v0[0], v0[1]); w.y = cvt_pk_bf16(v0[2], v0[3]); w.z = cvt_pk_bf16(v1[0], v1[1]); w.w = cvt_pk_bf16(v1[2], v1[3]);
                    *(u32x4*)(rowp + bj * HALF) = w; } }
    }
};
template <class Epi, class Sched, bool ALIGN_EPI = false, bool SP2 = false, bool PROBE_K0 = false, int PF = 0, bool NOSTAGE = false, int ABLK = 0, bool NOWAIT = false, bool NOREAD = false, bool FP8 = false>
__device__ __forceinline__ void gemm_phase(PG8_LAS unsigned char* lds, const Gemm g, const Sched& S, const Epi& E) {
    int tid_ = threadIdx.x; asm volatile("" : "+v"(tid_));
    const int tid = tid_, wid = __builtin_amdgcn_readfirstlane(tid >> 6), lane = tid & 63, wr = wid >> 2, wc = wid & 3, fr = lane & 15, fq = lane >> 4;
    const int K = g.K, nt = K / BK;
    unsigned voffA[2], voffB[2];
#pragma unroll
    for (int i = 0; i < 2; ++i) { int R, C; stage_rc(tid * 16 + i * 8192, R, C); const int Rb = Epi::PERM ? ((R & ~31) + perm32(R & 31)) : R;
        voffA[i] = (unsigned)(R * (ABLK == 2 ? 128 : ABLK == 1 ? 256 : K) + C) * 2u; voffB[i] = (unsigned)(Rb * K + C) * 2u; }
    const size_t kstep = PROBE_K0 ? (size_t)0 : (size_t)(BK * 2);
    const size_t hstepB = (size_t)HALF * K * 2, hstepA = ABLK == 2 ? (size_t)HALF * 256 : ABLK == 1 ? (size_t)HALF * 256 * 2 : hstepB;
    const size_t tstep = 2 * hstepB;
    static_assert(!(ABLK && PF > 0), "L2 warming is not written for the blocked A layout");
    const unsigned pfoff = (unsigned)((wid & 3) * 64 + lane) * (unsigned)K * 2u;
    const unsigned pflds = (unsigned)STAGE_BYTES + 1024u + (unsigned)wid * 256u;
    const unsigned ldsw = (unsigned)wid * 1024u;
    const int aoff = lds_byte(wr * 64 + fr, fq * 8), boff = lds_byte(wc * 32 + fr, fq * 8);
#define PG8_SA(b, h) (((b) * 2 + (h)) * HTB)
#define PG8_SB(b, h) ((4 + (b) * 2 + (h)) * HTB)
#define PG8_STAGE(bufoff, gbase, voff) do { if constexpr (!NOSTAGE) _Pragma("unroll") for (int _i = 0; _i < 2; ++_i) \
        __builtin_amdgcn_global_load_lds((const unsigned*)((const char*)(gbase) + (voff)[_i]), (PG8_LAS unsigned*)(lds + (bufoff) + ldsw + _i * 8192), 16, 0, 0); } while (0)
#define PG8_LDA(dst, b, h) do { if constexpr (!NOREAD) _Pragma("unroll") for (int m = 0; m < 4; ++m) _Pragma("unroll") for (int k = 0; k < 2; ++k) dst[m][k] = *(const PG8_LAS bf16x8*)(lds + PG8_SA(b, h) + aoff + m * 2048 + k * 1024); } while (0)
#define PG8_LDB(dst, b, h) do { if constexpr (!NOREAD) _Pragma("unroll") for (int n = 0; n < 2; ++n) _Pragma("unroll") for (int k = 0; k < 2; ++k) dst[n][k] = *(const PG8_LAS bf16x8*)(lds + PG8_SB(b, h) + boff + n * 2048 + k * 1024); } while (0)
#define PG8_MMA(ai, bj, At, Bt) do { __builtin_amdgcn_s_setprio(1); _Pragma("unroll") for (int m = 0; m < 4; ++m) _Pragma("unroll") for (int n = 0; n < 2; ++n) { \
        if constexpr (FP8 && FP8_MX) mfma_fp8_inplace(acc[ai][bj][m][n], cat8(Bt[n][0], Bt[n][1]), cat8(At[m][0], At[m][1]), one_scale); \
        else if constexpr (FP8) { _Pragma("unroll") for (int k = 0; k < 2; ++k) { const i64x2_ bb = __builtin_bit_cast(i64x2_, Bt[n][k]), aa = __builtin_bit_cast(i64x2_, At[m][k]); \
            acc[ai][bj][m][n] = __builtin_amdgcn_mfma_f32_16x16x32_fp8_fp8(bb[0], aa[0], acc[ai][bj][m][n], 0, 0, 0); acc[ai][bj][m][n] = __builtin_amdgcn_mfma_f32_16x16x32_fp8_fp8(bb[1], aa[1], acc[ai][bj][m][n], 0, 0, 0); } } \
        else { _Pragma("unroll") for (int k = 0; k < 2; ++k) acc[ai][bj][m][n] = __builtin_amdgcn_mfma_f32_16x16x32_bf16(Bt[n][k], At[m][k], acc[ai][bj][m][n], 0, 0, 0); } } __builtin_amdgcn_s_setprio(0); } while (0)
#define PG8_WAIT_V(n) asm volatile("s_waitcnt vmcnt(" #n ")" ::: "memory")
#define PG8_WARM(kt) do { if constexpr (PF > 0) { const int _kt = (kt); const char* _p = (wid < 4) ? ((_kt < nt) ? cA + (size_t)_kt * kstep : nA + (size_t)((_kt - nt) < nt ? (_kt - nt) : nt - 1) * kstep) : ((_kt < nt) ? cB + (size_t)_kt * kstep : nB + (size_t)((_kt - nt) < nt ? (_kt - nt) : nt - 1) * kstep); \
        __builtin_amdgcn_global_load_lds((const unsigned*)(_p + pfoff), (PG8_LAS unsigned*)(lds + pflds), 4, 0, 0); } } while (0)
#define PG8_WAIT_VK() do { if constexpr (NOWAIT) {} else if constexpr (PF > 0) PG8_WAIT_V(9); else PG8_WAIT_V(8); } while (0)
#define PG8_WAIT_L(n) asm volatile("s_waitcnt lgkmcnt(" #n ")" ::: "memory")
#define PG8_BAR __builtin_amdgcn_s_barrier()
#define PG8_SCHED __builtin_amdgcn_sched_barrier(0)
    constexpr bool FP8_MX = true;
    const int one_scale = 0x7f7f7f7f;
    Unit cur, nxt; int ui = 0;
    if (!S.next(0, cur)) return;
    f32x4 acc[2][2][4][2];
#pragma unroll
    for (int a = 0; a < 2; ++a)
#pragma unroll
        for (int b = 0; b < 2; ++b)
#pragma unroll
            for (int m = 0; m < 4; ++m)
#pragma unroll
                for (int n = 0; n < 2; ++n) acc[a][b][m][n] = (f32x4){0.f, 0.f, 0.f, 0.f};
    bf16x8 At[4][2], B0[2][2], B1[2][2];
    if constexpr (NOREAD) {
#pragma unroll
        for (int i = 0; i < 8; ++i) { const bf16x8 v = {(short)(0x3f80 + lane + i), (short)(0x3f00 + i), (short)(0xbf80 + lane), (short)0x3e80, (short)(0x3f80 + i), (short)0xbf00, (short)(0x3f81 + lane), (short)0x3f00}; At[i & 3][i >> 2] = v; if (i < 4) { B0[i & 1][i >> 1] = v; B1[i & 1][i >> 1] = v; } }
    }
    const char* cA = (const char*)g.A + (size_t)cur.pm * tstep; const char* cB = (const char*)g.Bt + (size_t)cur.pn * tstep;
    S.a_ready(cur);
    if constexpr (SP2) {
        PG8_STAGE(PG8_SB(0, 0), cB, voffB); PG8_STAGE(PG8_SB(0, 1), cB + hstepB, voffB); PG8_STAGE(PG8_SA(0, 0), cA, voffA); PG8_STAGE(PG8_SA(0, 1), cA + hstepA, voffA);
        if (wr == 1) PG8_BAR;
        PG8_WAIT_V(2); PG8_BAR;
        PG8_STAGE(PG8_SB(1, 0), cB + kstep, voffB); PG8_STAGE(PG8_SA(1, 0), cA + kstep, voffA); PG8_STAGE(PG8_SB(1, 1), cB + hstepB + kstep, voffB);
        PG8_WAIT_V(6); PG8_BAR;
    } else {
        PG8_STAGE(PG8_SB(0, 0), cB, voffB); PG8_STAGE(PG8_SA(0, 0), cA, voffA); PG8_STAGE(PG8_SB(0, 1), cB + hstepB, voffB); PG8_STAGE(PG8_SA(0, 1), cA + hstepA, voffA);
        if (wr == 1) PG8_BAR;
        PG8_WAIT_V(4); PG8_BAR;
        PG8_STAGE(PG8_SB(1, 0), cB + kstep, voffB); PG8_STAGE(PG8_SA(1, 0), cA + kstep, voffA); PG8_STAGE(PG8_SB(1, 1), cB + hstepB + kstep, voffB);
        PG8_WAIT_V(6); PG8_BAR;
    }
    for (;;) {
        const bool has_next = S.next(ui + 1, nxt);
        const char* nA = has_next ? (const char*)g.A + (size_t)nxt.pm * tstep : cA; const char* nB = has_next ? (const char*)g.Bt + (size_t)nxt.pn * tstep : cB;
        for (int t = 0; t < nt; t += 2) {
            const bool last = (t == nt - 2);
            const char* a1 = cA + (ABLK == 2 ? (size_t)((t + 1) >> 1) * 65536 + (size_t)((t + 1) & 1) * 128 : ABLK == 1 ? (size_t)((t + 1) >> 2) * 131072 + (size_t)((t + 1) & 3) * 128 : (size_t)(t + 1) * kstep);
            const char* a2 = last ? nA : cA + (ABLK == 2 ? (size_t)((t + 2) >> 1) * 65536 + (size_t)((t + 2) & 1) * 128 : ABLK == 1 ? (size_t)((t + 2) >> 2) * 131072 + (size_t)((t + 2) & 3) * 128 : (size_t)(t + 2) * kstep); const char* b2 = last ? nB : cB + (size_t)(t + 2) * kstep;
            const char* a3 = a2 + kstep; const char* b3 = b2 + kstep;
            if (last && has_next) S.a_ready(nxt);
            if constexpr (SP2) {
            PG8_LDB(B0, 0, 0); PG8_LDB(B1, 0, 1); PG8_SCHED; PG8_LDA(At, 0, 0); PG8_STAGE(PG8_SA(1, 1), a1 + hstepA, voffA); PG8_WARM(t + 2 + PF);
            PG8_WAIT_VK(); PG8_WAIT_L(0); PG8_BAR; PG8_MMA(0, 0, At, B0); PG8_MMA(0, 1, At, B1); PG8_BAR; PG8_SCHED;
            PG8_LDA(At, 0, 1); PG8_STAGE(PG8_SB(0, 0), b2, voffB); PG8_STAGE(PG8_SB(0, 1), b2 + hstepB, voffB); PG8_STAGE(PG8_SA(0, 0), a2, voffA);
            PG8_WAIT_VK(); PG8_WAIT_L(0); PG8_BAR; PG8_MMA(1, 0, At, B0); PG8_MMA(1, 1, At, B1); PG8_BAR; PG8_SCHED;
            PG8_LDB(B0, 1, 0); PG8_LDB(B1, 1, 1); PG8_SCHED; PG8_LDA(At, 1, 0); PG8_STAGE(PG8_SA(0, 1), a2 + hstepA, voffA); PG8_WARM(t + 3 + PF);
            PG8_WAIT_VK(); PG8_WAIT_L(0); PG8_BAR; PG8_MMA(0, 0, At, B0); PG8_MMA(0, 1, At, B1); PG8_BAR; PG8_SCHED;
            PG8_LDA(At, 1, 1); PG8_STAGE(PG8_SB(1, 0), b3, voffB); PG8_STAGE(PG8_SB(1, 1), b3 + hstepB, voffB); PG8_STAGE(PG8_SA(1, 0), a3, voffA);
            PG8_WAIT_VK(); PG8_WAIT_L(0); PG8_BAR; PG8_MMA(1, 0, At, B0); PG8_MMA(1, 1, At, B1); PG8_BAR; PG8_SCHED;
            } else {
            PG8_LDB(B0, 0, 0); PG8_SCHED; PG8_LDA(At, 0, 0); PG8_STAGE(PG8_SA(1, 1), a1 + hstepA, voffA);
            PG8_WAIT_L(8); PG8_BAR; PG8_WAIT_L(0); PG8_MMA(0, 0, At, B0); PG8_BAR; PG8_SCHED;
            PG8_LDB(B1, 0, 1); PG8_STAGE(PG8_SB(0, 0), b2, voffB);
            PG8_BAR; PG8_WAIT_L(0); PG8_MMA(0, 1, At, B1); PG8_BAR;
            PG8_LDA(At, 0, 1); PG8_STAGE(PG8_SA(0, 0), a2, voffA);
            PG8_BAR; PG8_WAIT_L(0); PG8_MMA(1, 0, At, B0); PG8_BAR; PG8_SCHED;
            PG8_STAGE(PG8_SB(0, 1), b2 + hstepB, voffB);
            PG8_WAIT_V(6); PG8_BAR; PG8_MMA(1, 1, At, B1); PG8_BAR;
            PG8_LDB(B0, 1, 0); PG8_SCHED; PG8_LDA(At, 1, 0); PG8_STAGE(PG8_SA(0, 1), a2 + hstepA, voffA);
            PG8_WAIT_L(8); PG8_BAR; PG8_WAIT_L(0); PG8_MMA(0, 0, At, B0); PG8_BAR; PG8_SCHED;
            PG8_LDB(B1, 1, 1); PG8_STAGE(PG8_SB(1, 0), b3, voffB);
            PG8_BAR; PG8_WAIT_L(0); PG8_MMA(0, 1, At, B1); PG8_BAR;
            PG8_LDA(At, 1, 1); PG8_STAGE(PG8_SA(1, 0), a3, voffA);
            PG8_BAR; PG8_WAIT_L(0); PG8_MMA(1, 0, At, B0); PG8_BAR; PG8_SCHED;
            PG8_STAGE(PG8_SB(1, 1), b3 + hstepB, voffB);
            PG8_WAIT_V(6); PG8_BAR; PG8_MMA(1, 1, At, B1); PG8_BAR;
            }
        }
        if constexpr (FP8 && FP8_MX) asm volatile("s_nop 15\n\ts_nop 15" ::: "memory");
        if constexpr (ALIGN_EPI) { if (wr == 0) PG8_BAR; }
        if constexpr (!Epi::AFTER_DRAIN) { E(acc, cur, wr, wc, fr, fq); S.done(cur); }
        if (!has_next) break;
#pragma unroll
        for (int a = 0; a < 2; ++a)
#pragma unroll
            for (int b = 0; b < 2; ++b)
#pragma unroll
                for (int m = 0; m < 4; ++m)
#pragma unroll
                    for (int n = 0; n < 2; ++n) acc[a][b][m][n] = (f32x4){0.f, 0.f, 0.f, 0.f};
        cur = nxt; cA = nA; cB = nB; ++ui;
        if constexpr (ALIGN_EPI) { if (wr == 1) PG8_BAR; }
    }
    PG8_WAIT_V(0);
    if constexpr (!ALIGN_EPI) { if (wr == 0) PG8_BAR; }
    PG8_BAR;
    if constexpr (Epi::AFTER_DRAIN) { E.fused(acc, cur, wr, wc, fr, fq, lds, wid, lane); S.done(cur); }
#undef PG8_SA
#undef PG8_SB
#undef PG8_STAGE
#undef PG8_LDA
#undef PG8_LDB
#undef PG8_MMA
#undef PG8_WAIT_V
#undef PG8_WARM
#undef PG8_WAIT_VK
#undef PG8_WAIT_L
#undef PG8_BAR
#undef PG8_SCHED
}
}
constexpr int NWAVES = 8, NTHR = 512;
#ifndef MK_N_LAUNCHES
#define MK_N_LAUNCHES 1
#define PROBE_DOUBLE 0
#define PROBE_KIND 0
#define PROBE_TS (-1)
#define PROBE_TB (PROBE_TS + 1)
#define PROBE_F0 0.0f
#endif
constexpr int N_LAUNCHES = MK_N_LAUNCHES;
constexpr int PER_PHASE = 8;
constexpr int BATCH = 2, SEQ = 16384, DM = 2048, M = BATCH * SEQ, NCH = SEQ / 64;
constexpr int IN_COLS = 8200, PE = 256, NNAT = 6144, NTR = 2048;
constexpr float EPS = 1e-6f;
constexpr int PC_Q = 0, PC_K = 512, PC_OZ = 1024  , PC_HQ = 3072, PC_HF = 4096, PC_HG = 5120;
constexpr size_t MiB = 1u << 20;
constexpr size_t WS_CTL = 0, CTL_ZERO_BYTES = 1 * MiB;
constexpr size_t WS_SSQH = 256 * 1024, WS_SSQ2 = 512 * 1024;
constexpr size_t WS_WIN = 2 * MiB, WS_WO = 34 * MiB, WS_WG = 42 * MiB, WS_WE = 50 * MiB;
constexpr size_t WS_GATES = 52 * MiB;
constexpr size_t WS_BCUM = 53 * MiB;
constexpr size_t WS_MSC = 54 * MiB;
constexpr size_t WS_NST = 55 * MiB;
constexpr size_t WS_GDEC = 56 * MiB;
constexpr size_t WS_EBR = 58 * MiB;
constexpr size_t WS_CARRY = 976 * MiB;
constexpr size_t WS_RMS = 59 * MiB;
constexpr size_t WS_Y = 784 * MiB;
constexpr size_t WS_PB = 64 * MiB;
constexpr size_t WS_U = 80 * MiB;
constexpr size_t WS_PROJ = 208 * MiB;
constexpr size_t WS_VT = 592 * MiB;
constexpr size_t WS_QC = 720 * MiB, WS_KC = 752 * MiB;
constexpr size_t WS_HQT = 784 * MiB, WS_HKT = 848 * MiB, WS_HQ2 = 912 * MiB;
constexpr size_t WS_END = 984 * MiB;
constexpr int CW_TMO = 0, CW_BAR = 4096;
constexpr int RING_BYTES = 131072, LDSCTL_OFF = RING_BYTES, MISC_OFF = LDSCTL_OFF + 320, LDS_BYTES = 147456;

#define GAS __attribute__((address_space(1)))
#define LAS __attribute__((address_space(3)))
typedef unsigned short bf16;
typedef unsigned v4u __attribute__((ext_vector_type(4)));
typedef unsigned v2u __attribute__((ext_vector_type(2)));
typedef float f32x4 __attribute__((ext_vector_type(4)));
typedef float f32x16 __attribute__((ext_vector_type(16)));
typedef short bf16x8 __attribute__((ext_vector_type(8)));
typedef GAS unsigned gu32;
#define RLX_AGENT __ATOMIC_RELAXED, __HIP_MEMORY_SCOPE_AGENT
#define LDS_WAIT() asm volatile("s_waitcnt lgkmcnt(0)" ::: "memory")
#define VM_WAIT() asm volatile("s_waitcnt vmcnt(0)" ::: "memory")
typedef __bf16 bf16x2_t __attribute__((ext_vector_type(2)));
__device__ __forceinline__ unsigned pk2(float lo, float hi) { bf16x2_t v; v[0] = (__bf16)lo; v[1] = (__bf16)hi; return __builtin_bit_cast(unsigned, v); }
__device__ __forceinline__ float bf2f(bf16 v) { return __uint_as_float((unsigned)v << 16); }
__device__ __forceinline__ float blo(unsigned w) { return __uint_as_float(w << 16); }
__device__ __forceinline__ float bhi(unsigned w) { return __uint_as_float(w & 0xffff0000u); }
__device__ __forceinline__ float frcp(float x) { return __builtin_amdgcn_rcpf(x); }
__device__ __forceinline__ float frsq(float x) { return __builtin_amdgcn_rsqf(x); }
__device__ __forceinline__ float fexp(float x) { return __expf(x); }
__device__ __forceinline__ float flog(float x) { return __logf(x); }
__device__ __forceinline__ float sigm(float x) { return frcp(1.0f + __expf(-x)); }

#define XB_TMO      128
#define XB_XCNT(j)  (256  + 64 * (j))
#define XB_XSUB(j)  (1280 + 64 * (j))
#define XB_XGEN(j)  (2304 + 64 * (j))
#define XB_TOP      3328
#define XB_TOPGEN   3392
#define XCD_BAR_WORDS 3456
#define XB_SPIN_CAP (1u << 18)
__device__ __forceinline__ unsigned xb_ld(unsigned* p)              { return __hip_atomic_load(p, __ATOMIC_RELAXED, __HIP_MEMORY_SCOPE_AGENT); }
__device__ __forceinline__ unsigned xb_add(unsigned* p, unsigned v) { return __hip_atomic_fetch_add(p, v, __ATOMIC_RELAXED, __HIP_MEMORY_SCOPE_AGENT); }
__device__ __forceinline__ unsigned xb_xcc_id() { return (unsigned)__builtin_amdgcn_s_getreg((3 << 11) | 20) & 0xFu; }
#define XB_SPIN(cond, bar) do { unsigned _sp = 0; while (cond) { __builtin_amdgcn_s_sleep(1); \
    if ((++_sp & 255u) == 0u) { if (xb_ld(&(bar)[XB_TMO])) break; if (_sp > XB_SPIN_CAP) { atomicAdd(&(bar)[XB_TMO], 1u); break; } } } } while (0)
struct XcdBarrier { unsigned* bar; unsigned x; volatile LAS unsigned* st; };
__device__ __forceinline__ XcdBarrier xcd_barrier_post(unsigned* bar, volatile LAS unsigned* st) {
    XcdBarrier b; b.bar = bar; b.x = xb_xcc_id(); b.st = st;
    if (threadIdx.x == 0) st[3] = xb_add(&bar[XB_XCNT(b.x)], 1u);
    return b;
}
__device__ __forceinline__ void xcd_barrier_complete(unsigned* bar, unsigned x, unsigned& nloc, unsigned& nx, unsigned& even) {
    const unsigned G = gridDim.x * gridDim.y * gridDim.z;
    unsigned sum, cnt, mine, sp = 0u, ev;
    for (;;) {
        sum = 0u; cnt = 0u; mine = 0u; ev = 1u;
#pragma unroll
        for (unsigned j = 0; j < 16; ++j) { const unsigned c = xb_ld(&bar[XB_XCNT(j)]); sum += c; cnt += (c > 0u) ? 1u : 0u; mine = (j == x) ? c : mine; ev &= (j < 8u) ? (c * 8u == G ? 1u : 0u) : (c == 0u ? 1u : 0u); }
        if (sum == G) break;
        __builtin_amdgcn_s_sleep(1);
        if ((++sp & 255u) == 0u) { if (xb_ld(&bar[XB_TMO])) break; if (sp > XB_SPIN_CAP) { atomicAdd(&bar[XB_TMO], 1u); break; } }
    }
    nloc = mine > 0u ? mine : 1u; nx = cnt > 0u ? cnt : 1u; even = (sum == G) ? ev : 0u;
}
__device__ __forceinline__ void xcd_barrier(const XcdBarrier& b) {
    asm volatile("s_waitcnt vmcnt(0)" ::: "memory");
    __syncthreads();
    if (threadIdx.x == 0) {
        unsigned* bar = b.bar;
        __builtin_amdgcn_s_waitcnt(0);
        unsigned nloc = b.st[0], nx = b.st[1];
        if (nloc == 0u) { unsigned even; xcd_barrier_complete(bar, b.x, nloc, nx, even); b.st[0] = nloc; b.st[1] = nx; b.st[2] = even; }
        const unsigned old = xb_add(&bar[XB_XSUB(b.x)], 1u);
        const unsigned gen = old / nloc;
        if (old + 1u == (gen + 1u) * nloc) {
            __builtin_amdgcn_fence(__ATOMIC_RELEASE, "agent");
            asm volatile("s_waitcnt vmcnt(0)" ::: "memory");
            const unsigned og = xb_add(&bar[XB_TOP], 1u);
            const unsigned tg = og / nx;
            if (og + 1u == (tg + 1u) * nx) xb_add(&bar[XB_TOPGEN], 1u);
            else XB_SPIN(xb_ld(&bar[XB_TOPGEN]) == tg, bar);
            __builtin_amdgcn_fence(__ATOMIC_ACQUIRE, "agent");
            xb_add(&bar[XB_XGEN(b.x)], 1u);
            asm volatile("s_waitcnt vmcnt(0)" ::: "memory");
        } else {
            XB_SPIN(xb_ld(&bar[XB_XGEN(b.x)]) == gen, bar);
            __builtin_amdgcn_fence(__ATOMIC_ACQUIRE, "agent");
            asm volatile("s_waitcnt vmcnt(0)" ::: "memory");
        }
    }
    __syncthreads();
}

struct Frame {
    LAS unsigned char* lds;
    int tid, lane, wave, G, bid;
    const float *x, *p, *norm_w, *w_in, *conv_w, *conv_b, *b_i, *b_f, *ml_nw, *hg_lb, *hg_nw, *w_out, *pe_nw, *w_pg, *w_pe, *fin_nw;
    float* out;
    bf16 *Wt_in, *WoT, *WgT, *WeT, *PB, *U, *Y, *PROJ, *HB, *EB, *VT, *Cm, *Ch, *QC, *KC, *HQT, *HKT, *HQ2;
    float *gates, *bcum, *msc, *nst, *gdec, *ebr, *carry, *ssqh, *ssq2;
};
__device__ __forceinline__ size_t proj_off(int m, int n) { return ((size_t)((m >> 8) * 24 + (n >> 8)) << 16) + (size_t)((m & 255) * 256 + (n & 255)); }
__device__ __forceinline__ size_t vt_off(int v, int m) { return ((size_t)((v >> 8) * 128 + (m >> 8)) << 16) + (size_t)((v & 255) * 256 + (m & 255)); }
__device__ __forceinline__ float wave_sum(float v) {
#pragma unroll
    for (int o = 1; o < 64; o <<= 1) v += __shfl_xor(v, o);
    return v;
}
__device__ __forceinline__ float wave_max(float v) {
#pragma unroll
    for (int o = 1; o < 64; o <<= 1) v = fmaxf(v, __shfl_xor(v, o));
    return v;
}
__device__ __forceinline__ float wave_scan_sum(float v, int lane) {
#pragma unroll
    for (int o = 1; o < 64; o <<= 1) { const float y = __shfl_up(v, o); if (lane >= o) v += y; }
    return v;
}
__device__ __forceinline__ float wave_scan_max(float v, int lane) {
#pragma unroll
    for (int o = 1; o < 64; o <<= 1) { const float y = __shfl_up(v, o); if (lane >= o) v = fmaxf(v, y); }
    return v;
}
__device__ __forceinline__ int opaque_i(int v) { asm volatile("" : "+v"(v)); return v; }
__device__ __forceinline__ f32x16 mfma32(bf16x8 a, bf16x8 b, f32x16 c) { return __builtin_amdgcn_mfma_f32_32x32x16_bf16(a, b, c, 0, 0, 0); }
__device__ __forceinline__ f32x16 zero16() { f32x16 z;
#pragma unroll
    for (int i = 0; i < 16; ++i) z[i] = 0.f;
    return z; }

constexpr float WG_SCALE = 256.0f, HB8_SCALE = 16.0f;
constexpr size_t HB8_OFF = 256 * MiB;
__device__ __forceinline__ void p0_transpose_item(const float* W, int ldw, int src_col, int K, bf16* WT, int dst_row, const float* kscale, LAS float* scr, int k0, int lane) {
#pragma unroll 8
    for (int i = 0; i < 32; ++i) { const int kk = 2 * i + (lane >> 5); float v = W[(size_t)(k0 + kk) * ldw + src_col + (lane & 31)]; if (kscale) v *= kscale[k0 + kk]; scr[kk * 33 + (lane & 31)] = v; }
    LDS_WAIT(); asm volatile("" ::: "memory");
    const int c = lane & 7;
#pragma unroll
    for (int j = 0; j < 4; ++j) { const int n = (lane >> 3) + 8 * j; const LAS float* s = scr + (8 * c) * 33 + n;
        v4u o; o.x = pk2(s[0 * 33], s[1 * 33]); o.y = pk2(s[2 * 33], s[3 * 33]); o.z = pk2(s[4 * 33], s[5 * 33]); o.w = pk2(s[6 * 33], s[7 * 33]);
        *(v4u*)(WT + (size_t)(dst_row + n) * K + k0 + 8 * c) = o; }
    LDS_WAIT(); asm volatile("" ::: "memory");
}
__device__ __forceinline__ void p0_transpose_item_fp8(const float* W, int ldw, int src_col, int K, unsigned char* WT, int dst_row, const float* kscale, float scale, LAS float* scr, int k0, int lane) {
#pragma unroll 8
    for (int i = 0; i < 32; ++i) { const int kk = 2 * i + (lane >> 5); const float v = W[(size_t)(k0 + kk) * ldw + src_col + (lane & 31)] * (kscale[k0 + kk] * scale); scr[kk * 33 + (lane & 31)] = v; }
    LDS_WAIT(); asm volatile("" ::: "memory");
    const int c = lane & 7;
#pragma unroll
    for (int j = 0; j < 4; ++j) { const int n = (lane >> 3) + 8 * j; const LAS float* s = scr + (8 * c) * 33 + n;
        v2u o; o.x = pg8::cvt_pk4_fp8(s[0 * 33], s[1 * 33], s[2 * 33], s[3 * 33]); o.y = pg8::cvt_pk4_fp8(s[4 * 33], s[5 * 33], s[6 * 33], s[7 * 33]);
        *(v2u*)(WT + (size_t)(dst_row + n) * K + k0 + 8 * c) = o; }
    LDS_WAIT(); asm volatile("" ::: "memory");
}
__device__ __forceinline__ int win_src_col(int r) { if (r >= 1024 && r < 3072) { const int q = r - 1024, i = q >> 8, rr = q & 255; return rr < 128 ? 2048 + 128 * i + rr : 3072 + 128 * i + (rr - 128); }
    return r < 1024 ? r : r < 5120 ? r + 1032 : r < 6144 ? r + 2056 : r < 7168 ? r - 5120 : r - 1016; }
__device__ __forceinline__ void p0_prologue(const Frame& F) {
    LAS float* scr = (LAS float*)(F.lds + F.wave * 16384);
    const int gw = F.bid * NWAVES + F.wave, NGW = F.G * NWAVES, lane = F.lane;
    for (int it = gw; it < 12544; it += NGW) {
        int r = it;
        if (r < 8192) { const int kb = r >> 8, nb = r & 255; p0_transpose_item(F.w_in, IN_COLS, win_src_col(nb * 32), DM, F.Wt_in, nb * 32, nullptr, scr, kb * 64, lane); continue; } r -= 8192;
        if (r < 2048) { const int kb = r >> 6, nb = r & 63; p0_transpose_item(F.w_out, DM, nb * 32, DM, F.WoT, nb * 32, nullptr, scr, kb * 64, lane); continue; } r -= 2048;
        if (r < 2048) { const int kb = r >> 6, nb = r & 63; p0_transpose_item_fp8(F.w_pg, DM, nb * 32, DM, (unsigned char*)F.WgT, nb * 32, F.pe_nw, WG_SCALE, scr, kb * 64, lane); continue; } r -= 2048;
        { const int kb = r >> 6, nb = r & 63; p0_transpose_item(F.w_pe, DM, nb * 32, PE, F.WeT, nb * 32, nullptr, scr, kb * 64, lane); }
    }
    for (int idx = F.bid * NTHR + F.tid; idx < M * PE / 4; idx += F.G * NTHR) { const f32x4 v = ((const f32x4*)F.p)[idx]; v2u o; o.x = pk2(v[0], v[1]); o.y = pk2(v[2], v[3]); ((v2u*)F.PB)[idx] = o; }
    __syncthreads();
    LAS float* Wg = (LAS float*)F.lds;
    for (int k = F.tid; k < DM; k += NTHR) { const f32x4 a = *(const f32x4*)(F.w_in + (size_t)k * IN_COLS + 4096), b = *(const f32x4*)(F.w_in + (size_t)k * IN_COLS + 4100);
        Wg[0 * DM + k] = a[0]; Wg[1 * DM + k] = a[1]; Wg[2 * DM + k] = a[2]; Wg[3 * DM + k] = a[3]; Wg[4 * DM + k] = b[0]; Wg[5 * DM + k] = b[1]; Wg[6 * DM + k] = b[2]; Wg[7 * DM + k] = b[3]; }
    __syncthreads();
    const f32x4* nwp = (const f32x4*)F.norm_w + lane;
    const float gbias = lane < 4 ? F.b_i[lane & 3] : F.b_f[lane & 3];
    for (int m = gw; m < M; m += NGW) {
        asm volatile("" ::: "memory");
        const f32x4* xr = (const f32x4*)(F.x + (size_t)m * DM) + lane;
        f32x4 t[8]; float ss = 0.f; float ga[8];
#pragma unroll
        for (int c = 0; c < 8; ++c) ga[c] = 0.f;
#pragma unroll
        for (int j = 0; j < 8; ++j) { const f32x4 v = __builtin_nontemporal_load(xr + 64 * j); ss += (v[0] * v[0] + v[1] * v[1]) + (v[2] * v[2] + v[3] * v[3]); t[j] = v * nwp[64 * j]; }
#pragma unroll
        for (int j = 0; j < 8; ++j)
#pragma unroll
            for (int c = 0; c < 8; ++c) { const f32x4 w = *(const LAS f32x4*)(Wg + c * DM + 4 * lane + 256 * j); ga[c] += (t[j][0] * w[0] + t[j][1] * w[1]) + (t[j][2] * w[2] + t[j][3] * w[3]); }
        ss = wave_sum(ss); const float rstd = 1.0f / sqrtf(ss * (1.0f / DM) + EPS);
#pragma unroll
        for (int c = 0; c < 8; ++c) ga[c] = wave_sum(ga[c]) * rstd;
        v2u* uo = (v2u*)(F.U + (size_t)m * DM) + lane;
#pragma unroll
        for (int j = 0; j < 8; ++j) { const f32x4 q = t[j] * rstd; v2u o; o.x = pk2(q[0], q[1]); o.y = pk2(q[2], q[3]); uo[64 * j] = o; }
        float gv = ga[0];
        gv = lane == 1 ? ga[1] : gv; gv = lane == 2 ? ga[2] : gv; gv = lane == 3 ? ga[3] : gv; gv = lane == 4 ? ga[4] : gv; gv = lane == 5 ? ga[5] : gv; gv = lane == 6 ? ga[6] : gv; gv = lane == 7 ? ga[7] : gv;
        if (lane < 8) F.gates[(size_t)m * 8 + lane] = gv + gbias;
        if (lane == 8) F.gates[(WS_RMS - WS_GATES) / 4 + m] = 1.0f / rstd;
    }
}
__device__ __forceinline__ v4u ld16(const bf16* p) { return __builtin_nontemporal_load((const v4u*)p); }
__device__ __forceinline__ void st_bf(LAS bf16* p, float v) { *p = (bf16)(pk2(v, v) & 0xffffu); }
__device__ __forceinline__ void conv_lds_16(const float (&cw)[5], const LAS bf16* col, float scale, float (&out)[16]) {
    float r0 = bf2f(col[0]), r1 = bf2f(col[136]), r2 = bf2f(col[272]);
#pragma unroll
    for (int jj = 0; jj < 16; ++jj) { const float xv = bf2f(col[(jj + 3) * 136]); const float cv = cw[4] + cw[0] * r0 + cw[1] * r1 + cw[2] * r2 + cw[3] * xv; r0 = r1; r1 = r2; r2 = xv; out[jj] = cv * sigm(cv) * scale; }
}
__device__ __forceinline__ void conv_inplace_32(const float (&cw)[5], LAS bf16* col, float t0, float t1, float t2, float scale) {
    float r0 = bf2f(col[0]), r1 = bf2f(col[136]), r2 = bf2f(col[272]);
#pragma unroll
    for (int jj = 0; jj < 32; ++jj) { const float xv = jj < 29 ? bf2f(col[(jj + 3) * 136]) : (jj == 29 ? t0 : jj == 30 ? t1 : t2); const float cv = cw[4] + cw[0] * r0 + cw[1] * r1 + cw[2] * r2 + cw[3] * xv; r0 = r1; r1 = r2; r2 = xv; st_bf(col + jj * 136, cv * sigm(cv) * scale); }
}
constexpr int NCH2 = SEQ / 128;
constexpr int PA_KR = 0, PA_KT = 36864, PA_F32 = 71680;
struct PaM { v4u rk[4], hk; float ig[2], fp[2]; bf16x8 bfr[8]; float cwk[5]; };
__device__ __forceinline__ void pa_mlstm_load(const Frame& F, int bh, int C, PaM& L) {
    const int b = bh >> 2, h = bh & 3, m0 = b * SEQ + C * 128, tid = opaque_i(F.tid), lane = tid & 63, wave = F.wave, r32 = lane & 31, hi = lane >> 5;
    L.hk = (v4u){0u, 0u, 0u, 0u}; L.ig[0] = 0.f; L.ig[1] = 0.f; L.fp[0] = 0.f; L.fp[1] = 0.f;
#pragma unroll
    for (int i = 0; i < 4; ++i) { const int idx = tid + 512 * i, row = idx >> 4, ch = idx & 15; L.rk[i] = ld16(F.PROJ + proj_off(m0 + row, PC_K + h * 128) + ch * 8); }
    if (tid < 48 && C != 0) { const int row = tid >> 4, ch = tid & 15; L.hk = ld16(F.PROJ + proj_off(m0 - 3 + row, PC_K + h * 128) + ch * 8); }
    if (wave == 0) {
#pragma unroll
        for (int hf = 0; hf < 2; ++hf) { L.ig[hf] = F.gates[(size_t)(m0 + 64 * hf + lane) * 8 + h]; L.fp[hf] = F.gates[(size_t)(m0 + 64 * hf + lane) * 8 + 4 + h]; } }
    const bf16* vt = F.VT + vt_off(h * 256 + 32 * wave + r32, m0) + 8 * hi;
#pragma unroll
    for (int ks = 0; ks < 8; ++ks) L.bfr[ks] = *(const bf16x8*)(vt + 16 * ks);
    const int chk = 512 + h * 128 + (tid & 127);
#pragma unroll
    for (int i = 0; i < 4; ++i) L.cwk[i] = F.conv_w[i * 1024 + chk];
    L.cwk[4] = F.conv_b[chk];
}
__device__ __forceinline__ void pa_mlstm_fill(const Frame& F, const PaM& L) {
    const int tid = opaque_i(F.tid);
    LAS bf16* KR = (LAS bf16*)(F.lds + PA_KR);
#pragma unroll
    for (int i = 0; i < 4; ++i) { const int idx = tid + 512 * i, row = idx >> 4, ch = idx & 15; *(LAS v4u*)(KR + (row + 3) * 136 + ch * 8) = L.rk[i]; }
    if (tid < 48) { const int row = tid >> 4, ch = tid & 15; *(LAS v4u*)(KR + row * 136 + ch * 8) = L.hk; }
}
__device__ __forceinline__ void pa_mlstm_gates(const Frame& F, int bh, int C, const PaM& L) {
    const int unit = bh * NCH2 + C, lane = opaque_i(F.lane);
    LAS float* wl = (LAS float*)(F.lds + PA_F32);
    if (F.wave == 0) {
        const float lf0 = fminf(L.fp[0], 0.f) - flog(1.0f + fexp(-fabsf(L.fp[0]))), lf1 = fminf(L.fp[1], 0.f) - flog(1.0f + fexp(-fabsf(L.fp[1])));
        const float b0 = wave_scan_sum(lf0, lane), t0 = __shfl(b0, 63), b1 = t0 + wave_scan_sum(lf1, lane);
        const float g = __shfl(b1, 63);
        const float a0 = g - b0 + L.ig[0], a1 = g - b1 + L.ig[1];
        const float ml = wave_max(fmaxf(a0, a1));
        wl[lane] = fexp(a0 - ml); wl[64 + lane] = fexp(a1 - ml);
        F.bcum[(size_t)bh * SEQ + C * 128 + lane] = b0; F.bcum[(size_t)bh * SEQ + C * 128 + 64 + lane] = b1;
        if (lane == 0) { F.msc[unit * 4 + 0] = g; F.msc[unit * 4 + 1] = ml; }
    }
}
__device__ __forceinline__ void pa_mlstm_compute(const Frame& F, int bh, int C, const PaM& L) {
    const int unit = bh * NCH2 + C, tid = opaque_i(F.tid), lane = tid & 63, wave = F.wave, r32 = lane & 31, hi = lane >> 5;
    LAS bf16 *KR = (LAS bf16*)(F.lds + PA_KR), *kT = (LAS bf16*)(F.lds + PA_KT);
    LAS float* wl = (LAS float*)(F.lds + PA_F32); LAS float* nsum = wl + 128;
    const int d = tid & 127, jq = tid >> 7;
    float ns = 0.f;
    __syncthreads();
#pragma unroll
    for (int s = 0; s < 2; ++s) {
        float kv[16];
        conv_lds_16(L.cwk, KR + (32 * jq + 16 * s) * 136 + d, 0.08838834764831845f, kv);
        unsigned pk[8];
#pragma unroll
        for (int jj = 0; jj < 16; ++jj) { kv[jj] *= wl[32 * jq + 16 * s + jj]; ns += kv[jj]; }
#pragma unroll
        for (int i = 0; i < 8; ++i) pk[i] = pk2(kv[2 * i], kv[2 * i + 1]);
        LAS v4u* dst = (LAS v4u*)(kT + d * 136 + 32 * jq + 16 * s);
        dst[0] = (v4u){pk[0], pk[1], pk[2], pk[3]}; dst[1] = (v4u){pk[4], pk[5], pk[6], pk[7]};
    }
    nsum[jq * 128 + d] = ns;
    __syncthreads();
    if (tid < 128) F.nst[(size_t)unit * 128 + tid] = (nsum[tid] + nsum[128 + tid]) + (nsum[256 + tid] + nsum[384 + tid]);
    {
        f32x16 acc[4];
#pragma unroll
        for (int i = 0; i < 4; ++i) acc[i] = zero16();
#pragma unroll
        for (int ks = 0; ks < 8; ++ks)
#pragma unroll
            for (int dt = 0; dt < 4; ++dt) { const bf16x8 afr = *(const LAS bf16x8*)(kT + (32 * dt + r32) * 136 + 16 * ks + 8 * hi); acc[dt] = mfma32(afr, L.bfr[ks], acc[dt]); }
        LAS bf16* pt = (LAS bf16*)(F.lds + PA_KR) + wave * (32 * 72);
        bf16* dst = F.Cm + ((size_t)unit * 256 + 32 * wave) * 128;
#pragma unroll
        for (int rd = 0; rd < 2; ++rd) {
#pragma unroll
            for (int i = 0; i < 2; ++i)
#pragma unroll
                for (int q = 0; q < 4; ++q) { const int dt = 2 * rd + i; v2u w; w.x = pk2(acc[dt][4 * q], acc[dt][4 * q + 1]); w.y = pk2(acc[dt][4 * q + 2], acc[dt][4 * q + 3]); *(LAS v2u*)(pt + r32 * 72 + 32 * i + 8 * q + 4 * hi) = w; }
            LDS_WAIT();
#pragma unroll
            for (int k = 0; k < 4; ++k) { const int row = 8 * k + (lane >> 3), ch = lane & 7; *(v4u*)(dst + (size_t)row * 128 + 64 * rd + ch * 8) = *(const LAS v4u*)(pt + row * 72 + ch * 8); }
            LDS_WAIT();
        }
    }
    __syncthreads();
}
constexpr int PH_FR = 0, PH_KT = 34816, PH_F32 = 69632, PH_PATCH = 73728;
struct PaH { v4u rf[4]; bf16x8 bfr[8]; float lb; };
__device__ __forceinline__ void pa_hgrn2_load(const Frame& F, int bh, int C, PaH& L) {
    const int b = bh >> 3, h = bh & 7, m0 = b * SEQ + C * 128, tid = opaque_i(F.tid), lane = tid & 63, wave = F.wave, r32 = lane & 31, hi = lane >> 5, vt_i = wave & 3;
#pragma unroll
    for (int i = 0; i < 4; ++i) { const int idx = tid + 512 * i, row = idx >> 4, ch = idx & 15; L.rf[i] = ld16(F.PROJ + proj_off(m0 + row, PC_HF + h * 128) + ch * 8); }
    const bf16* vt = F.VT + vt_off(1024 + h * 128 + 32 * vt_i + r32, m0) + 8 * hi;
#pragma unroll
    for (int ks = 0; ks < 8; ++ks) L.bfr[ks] = *(const bf16x8*)(vt + 16 * ks);
    const int e = tid & 127;
    L.lb = F.hg_lb[1024 + h * 128 + e] - F.hg_lb[h * 128 + e];
}
__device__ __forceinline__ void pa_hgrn2_fill(const Frame& F, const PaH& L) {
    const int tid = opaque_i(F.tid);
    LAS bf16* FR = (LAS bf16*)(F.lds + PH_FR);
#pragma unroll
    for (int i = 0; i < 4; ++i) { const int idx = tid + 512 * i, row = idx >> 4, ch = idx & 15; *(LAS v4u*)(FR + row * 136 + ch * 8) = L.rf[i]; }
}
__device__ __forceinline__ void pa_hgrn2_compute(const Frame& F, int bh, int C, const PaH& L) {
    const int unit = bh * NCH2 + C, tid = opaque_i(F.tid), lane = tid & 63, wave = F.wave, r32 = lane & 31, hi = lane >> 5;
    LAS bf16 *FR = (LAS bf16*)(F.lds + PH_FR), *kT = (LAS bf16*)(F.lds + PH_KT);
    LAS float* seg = (LAS float*)(F.lds + PH_F32);
    const int vt_i = wave & 3, et0 = 2 * (wave >> 2);
    const int e = tid & 127, jq = tid >> 7;
    const float lb = frcp(1.0f + fexp(L.lb));
    __syncthreads();
    float kv[32]; float suf = 1.0f;
#pragma unroll
    for (int jj = 0; jj < 32; ++jj) { const float xv = bf2f(FR[(32 * jq + jj) * 136 + e]); kv[jj] = lb + (1.0f - lb) * sigm(xv); }
#pragma unroll
    for (int jj = 31; jj >= 0; --jj) { const float fj = kv[jj]; kv[jj] = (1.0f - fj) * suf; suf *= fj; }
    seg[jq * 128 + e] = suf;
    __syncthreads();
    {
        const float s0 = seg[e], s1 = seg[128 + e], s2 = seg[256 + e], s3 = seg[384 + e];
        const float later = jq == 0 ? s1 * s2 * s3 : jq == 1 ? s2 * s3 : jq == 2 ? s3 : 1.0f;
        LAS v4u* dst = (LAS v4u*)(kT + e * 136 + 32 * jq);
#pragma unroll
        for (int i4 = 0; i4 < 4; ++i4) { unsigned pk[4];
#pragma unroll
            for (int i = 0; i < 4; ++i) { const int j0 = 8 * i4 + 2 * i; pk[i] = pk2(kv[j0] * later, kv[j0 + 1] * later); }
            dst[i4] = (v4u){pk[0], pk[1], pk[2], pk[3]}; }
        if (jq == 0) { F.gdec[(size_t)unit * 128 + e] = (s0 * s1) * (s2 * s3); F.ebr[(size_t)unit * 128 + e] = s0 * s1; }
    }
    __syncthreads();
    {
        f32x16 acc[2]; acc[0] = zero16(); acc[1] = zero16();
#pragma unroll
        for (int ks = 0; ks < 8; ++ks)
#pragma unroll
            for (int i = 0; i < 2; ++i) { const bf16x8 afr = *(const LAS bf16x8*)(kT + (32 * (et0 + i) + r32) * 136 + 16 * ks + 8 * hi); acc[i] = mfma32(afr, L.bfr[ks], acc[i]); }
        LAS bf16* pt = (LAS bf16*)(F.lds + PH_PATCH) + wave * (32 * 72);
#pragma unroll
        for (int i = 0; i < 2; ++i)
#pragma unroll
            for (int q = 0; q < 4; ++q) { v2u w; w.x = pk2(acc[i][4 * q], acc[i][4 * q + 1]); w.y = pk2(acc[i][4 * q + 2], acc[i][4 * q + 3]); *(LAS v2u*)(pt + r32 * 72 + 32 * i + 8 * q + 4 * hi) = w; }
        LDS_WAIT();
        bf16* dst = F.Ch + ((size_t)unit * 128 + 32 * vt_i) * 128 + 32 * et0;
#pragma unroll
        for (int k = 0; k < 4; ++k) { const int row = 8 * k + (lane >> 3), ch = lane & 7; *(v4u*)(dst + (size_t)row * 128 + ch * 8) = *(const LAS v4u*)(pt + row * 72 + ch * 8); }
    }
    __syncthreads();
}
constexpr int NSLAB = 1, CPS = NCH / NSLAB, CPS_SH = 8;
static_assert(CPS == (1 << CPS_SH) && NSLAB == 1, "slab size; the 128-token HGRN2 units are written for one slab");
__device__ __forceinline__ void pa_phase(const Frame& F, int c_lo, volatile LAS unsigned long long* tsl) {
    { PaM cur; int id = F.bid; pa_mlstm_load(F, id >> 7, id & 127, cur);
      for (; id < 8 * NCH2; id += F.G) { const int nid = (id + F.G < 8 * NCH2) ? id + F.G : id;
          pa_mlstm_fill(F, cur); pa_mlstm_gates(F, id >> 7, id & 127, cur);
          PaM nxt; pa_mlstm_load(F, nid >> 7, nid & 127, nxt);
          pa_mlstm_compute(F, id >> 7, id & 127, cur); cur = nxt; } }
    if (PROBE_TS >= 0 && F.tid == 0) tsl[9] = __builtin_amdgcn_s_memrealtime();
    { PaH cur; int id = F.bid; pa_hgrn2_load(F, id >> 7, id & 127, cur);
      for (; id < 16 * NCH2; id += F.G) { const int nid = (id + F.G < 16 * NCH2) ? id + F.G : id;
          pa_hgrn2_fill(F, cur);
          PaH nxt; pa_hgrn2_load(F, nid >> 7, nid & 127, nxt);
          pa_hgrn2_compute(F, id >> 7, id & 127, cur); cur = nxt; } }
}
__device__ __forceinline__ void unpack8(const v4u k, float (&o)[8]) { o[0] = blo(k.x); o[1] = bhi(k.x); o[2] = blo(k.y); o[3] = bhi(k.y); o[4] = blo(k.z); o[5] = bhi(k.z); o[6] = blo(k.w); o[7] = bhi(k.w); }
__device__ __forceinline__ v4u pack8(const float (&s)[8]) { v4u o; o.x = pk2(s[0], s[1]); o.y = pk2(s[2], s[3]); o.z = pk2(s[4], s[5]); o.w = pk2(s[6], s[7]); return o; }
__device__ __forceinline__ void scan_phase(const Frame& F, int c_lo, int c_hi) {
    typedef float f32x2 __attribute__((ext_vector_type(2)));
    constexpr int SB = 16;
    const int lane_ = opaque_i(F.lane);
    const int item = ((F.bid * 4 + (F.wave >> 1)) << 6) + lane_;
    const int gt = (F.wave & 1) ? 65536 + item : item;
    if ((F.wave & 1) == 0) {
        const int bh = gt >> 13, v = (gt >> 5) & 255, dg = gt & 31;
        bf16* ptr = F.Cm + ((size_t)(bh * NCH2) * 256 + v) * 128 + dg * 4;
        float* ms = F.msc + (size_t)bh * NCH2 * 4;
        const int wq = (item >> 6) & 127;
        float* np = F.nst + (size_t)bh * NCH2 * 128 + wq;
        const bool nth = (lane_ == 0);
        bf16* ptr_s = ptr; asm volatile("" : "+v"(ptr_s));
        float C0 = 0.f, C1 = 0.f, C2 = 0.f, C3 = 0.f, n0 = 0.f, m = 0.f;
        float* cr = F.carry + (size_t)gt * 12;
        if (c_lo != 0) { const f32x4 a = *(const f32x4*)cr; C0 = a[0]; C1 = a[1]; C2 = a[2]; C3 = a[3]; n0 = cr[4]; m = cr[8]; }
        for (int c0 = c_lo >> 1; c0 < (c_hi >> 1); c0 += SB) {
            v2u K[SB]; f32x2 gm[SB]; float nl[SB];
#pragma unroll
            for (int i = 0; i < SB; ++i) { K[i] = *(const v2u*)(ptr + (size_t)(c0 + i) * 32768); gm[i] = *(const f32x2*)(ms + (c0 + i) * 4); }
            if (nth) {
#pragma unroll
                for (int i = 0; i < SB; ++i) nl[i] = np[(c0 + i) * 128];
            }
#pragma unroll
            for (int i = 0; i < SB; ++i) { const int c = c0 + i;
                const float g = gm[i][0], ml = gm[i][1];
                const float mn = fmaxf(g + m, ml), ws = fexp(g + m - mn), fl = fexp(ml - mn);
                v2u o; o.x = pk2(C0, C1); o.y = pk2(C2, C3); *(v2u*)(ptr_s + (size_t)c * 32768) = o;
                C0 = ws * C0 + fl * blo(K[i].x); C1 = ws * C1 + fl * bhi(K[i].x); C2 = ws * C2 + fl * blo(K[i].y); C3 = ws * C3 + fl * bhi(K[i].y);
                if (nth) {
                    np[c * 128] = n0;
                    n0 = ws * n0 + fl * nl[i];
                    if (wq == 0) ms[c * 4 + 2] = m;
                }
                m = mn; }
        }
        if (c_hi != NCH) { *(f32x4*)cr = (f32x4){C0, C1, C2, C3}; cr[4] = n0; cr[8] = m; }
    } else {
        const int g2 = gt - 65536, bh = g2 >> 12, v = (g2 >> 5) & 127, eg = g2 & 31;
        bf16* ptr = F.Ch + ((size_t)(bh * NCH2) * 128 + v) * 128 + eg * 4;
        const float* gd = F.gdec + (size_t)bh * NCH2 * 128 + eg * 4;
        const float* eb = F.ebr + (size_t)bh * NCH2 * 128 + eg * 4;
        bf16* ptr_s = ptr; asm volatile("" : "+v"(ptr_s));
        float S0 = 0.f, S1 = 0.f, S2 = 0.f, S3 = 0.f;
        float* cr = F.carry + (size_t)gt * 12;
        if (c_lo != 0) { const f32x4 a = *(const f32x4*)cr; S0 = a[0]; S1 = a[1]; S2 = a[2]; S3 = a[3]; }
        for (int c0 = c_lo >> 1; c0 < (c_hi >> 1); c0 += SB) {
            v2u K[SB]; f32x4 D[SB], E[SB];
#pragma unroll
            for (int i = 0; i < SB; ++i) { K[i] = *(const v2u*)(ptr + (size_t)(c0 + i) * 16384); D[i] = *(const f32x4*)(gd + (c0 + i) * 128); E[i] = *(const f32x4*)(eb + (c0 + i) * 128); }
#pragma unroll
            for (int i = 0; i < SB; ++i) { const int c = c0 + i;
                v2u o; o.x = pk2(S0 * E[i][0], S1 * E[i][1]); o.y = pk2(S2 * E[i][2], S3 * E[i][3]); *(v2u*)(ptr_s + (size_t)c * 16384) = o;
                S0 = D[i][0] * S0 + blo(K[i].x); S1 = D[i][1] * S1 + bhi(K[i].x); S2 = D[i][2] * S2 + blo(K[i].y); S3 = D[i][3] * S3 + bhi(K[i].y); }
        }
        if (c_hi != NCH) *(f32x4*)cr = (f32x4){S0, S1, S2, S3};
    }
}
template <int MODE>
__device__ __forceinline__ void score_tiles(const Frame& F, const LAS bf16* Kt, const LAS bf16* Qt, LAS bf16* Sc, const LAS float* bm, const LAS float* uu, LAS float* dnA, LAS float* dnB) {
    const int wave = F.wave, lane = opaque_i(F.lane), r32 = lane & 31, hi = lane >> 5;
    if (wave < 3) {
        const int jt = (wave == 2) ? 1 : 0, tt = (wave >= 1) ? 1 : 0;
        f32x16 acc = zero16();
#pragma unroll
        for (int ks = 0; ks < 8; ++ks) { const bf16x8 a = *(const LAS bf16x8*)(Kt + (32 * jt + r32) * 136 + 16 * ks + 8 * hi), bq = *(const LAS bf16x8*)(Qt + (32 * tt + r32) * 136 + 16 * ks + 8 * hi); acc = mfma32(a, bq, acc); }
        const int t = 32 * tt + r32; float rs = 0.f; float bmt = 0.f; if (MODE == 1) bmt = bm[t];
#pragma unroll
        for (int q = 0; q < 4; ++q) { const int j0 = 32 * jt + 8 * q + 4 * hi; float vv[4];
            f32x4 u4 = (f32x4){0.f, 0.f, 0.f, 0.f}; if (MODE == 1) u4 = *(const LAS f32x4*)(uu + j0);
#pragma unroll
            for (int i = 0; i < 4; ++i) { float val = acc[4 * q + i]; if (MODE == 1) val *= __expf(fminf(bmt + u4[i], 0.f)); val = (j0 + i <= t) ? val : 0.f; vv[i] = val; rs += val; }
            v2u w; w.x = pk2(vv[0], vv[1]); w.y = pk2(vv[2], vv[3]); *(LAS v2u*)(Sc + t * 72 + j0) = w; }
        if (MODE == 1) { rs += __shfl_xor(rs, 32); if (hi == 0) { if (jt == 0) dnA[t] = rs; else dnB[t] = rs; } }
    } else if (wave == 3) {
        for (int idx = lane; idx < 128; idx += 64) { const int t = idx >> 2, part = idx & 3; *(LAS v4u*)(Sc + t * 72 + 32 + 8 * part) = (v4u){0u, 0u, 0u, 0u}; }
        if (MODE == 1 && lane < 32) dnB[lane] = 0.f;
    }
}
constexpr int RM_KS = 0, RM_QS = 35840, RM_SC = 71680, RM_OT = 89088, RM_F32 = 122880;
struct RmH { v4u hq, hk; };
struct RmA { v4u rq[4], rk[4]; float bj0, bj1, ig0, ig1, mc, ncv; };
struct RmB { bf16x8 avt[8], acs[8]; v4u ro[2][4]; };
__device__ __forceinline__ void r2m_loadA(const Frame& F, int bh, int C, RmA& L) {
    const int b = bh >> 2, h = bh & 3, m0 = b * SEQ + C * 128, unit = bh * NCH2 + C, tid = opaque_i(F.tid), lane = tid & 63, wave = F.wave;
#pragma unroll
    for (int i = 0; i < 4; ++i) { const int idx = tid + 512 * i, row = idx >> 4, ch = idx & 15;
        L.rq[i] = ld16(F.PROJ + proj_off(m0 + row, PC_Q + h * 128) + ch * 8); L.rk[i] = ld16(F.PROJ + proj_off(m0 + row, PC_K + h * 128) + ch * 8); }
    L.bj0 = 0.f; L.bj1 = 0.f; L.ig0 = 0.f; L.ig1 = 0.f; L.mc = 0.f; L.ncv = 0.f;
    if (wave == 0) { L.bj0 = F.bcum[(size_t)bh * SEQ + C * 128 + lane]; L.bj1 = F.bcum[(size_t)bh * SEQ + C * 128 + 64 + lane]; L.ig0 = F.gates[(size_t)(m0 + lane) * 8 + h]; L.ig1 = F.gates[(size_t)(m0 + 64 + lane) * 8 + h]; L.mc = F.msc[unit * 4 + 2]; }
    else if (wave < 3) L.ncv = F.nst[(size_t)unit * 128 + tid - 64];
}
__device__ __forceinline__ void r2m_loadH(const Frame& F, int bh, int C, RmH& L) {
    const int b = bh >> 2, h = bh & 3, m0 = b * SEQ + C * 128, tid = opaque_i(F.tid);
    L.hq = (v4u){0u, 0u, 0u, 0u}; L.hk = (v4u){0u, 0u, 0u, 0u};
    if (tid < 48 && C != 0) { const int row = tid >> 4, ch = tid & 15; L.hq = ld16(F.PROJ + proj_off(m0 - 3 + row, PC_Q + h * 128) + ch * 8); L.hk = ld16(F.PROJ + proj_off(m0 - 3 + row, PC_K + h * 128) + ch * 8); }
}
__device__ __forceinline__ void r2m_loadB(const Frame& F, int bh, int C, RmB& L) {
    const int b = bh >> 2, h = bh & 3, m0 = b * SEQ + C * 128, unit = bh * NCH2 + C, tid = opaque_i(F.tid), lane = tid & 63, wave = F.wave, r32 = lane & 31, hi = lane >> 5;
#pragma unroll
    for (int th = 0; th < 2; ++th)
#pragma unroll
        for (int i = 0; i < 4; ++i) { const int idx = tid + 512 * i, row = idx >> 5, ch = idx & 31;
            L.ro[th][i] = ld16(F.PROJ + proj_off(m0 + 64 * th + row, PC_OZ + 512 * h + 256 * (ch >> 4)) + (ch & 15) * 8); }
    const bf16* vt = F.VT + vt_off(h * 256 + 32 * wave + r32, m0) + 8 * hi;
#pragma unroll
    for (int ks = 0; ks < 8; ++ks) L.avt[ks] = *(const bf16x8*)(vt + 16 * ks);
    const bf16* cs = F.Cm + ((size_t)unit * 256 + 32 * wave + r32) * 128 + 8 * hi;
#pragma unroll
    for (int ks = 0; ks < 8; ++ks) L.acs[ks] = *(const bf16x8*)(cs + 16 * ks);
}
__device__ __forceinline__ void r2m_unit(const Frame& F, int bh, int C, const RmA& A, const RmB& B, const RmH& H, int nbh, int nC, RmA& NA, RmB& NB, RmH& NH) {
    const int b = bh >> 2, h = bh & 3, m0 = b * SEQ + C * 128, tid = opaque_i(F.tid), lane = tid & 63, wave = F.wave, r32 = lane & 31, hi = lane >> 5;
    LAS bf16 *Ks = (LAS bf16*)(F.lds + RM_KS), *Qs = (LAS bf16*)(F.lds + RM_QS), *Sc = (LAS bf16*)(F.lds + RM_SC), *OT = (LAS bf16*)(F.lds + RM_OT);
    LAS float* fb = (LAS float*)(F.lds + RM_F32);
    LAS float *bm = fb, *uu = fb + 128, *wi = fb + 256, *emt = fb + 384, *qn = fb + 512, *dn = fb + 640, *nc = fb + 896, *hn = fb + 1024;
    bf16x8 avt[8], acs[8]; v4u ro1[4];
#pragma unroll
    for (int ks = 0; ks < 8; ++ks) { avt[ks] = B.avt[ks]; acs[ks] = B.acs[ks]; }
#pragma unroll
    for (int q = 0; q < 4; ++q) ro1[q] = B.ro[1][q];
    const float bj0 = A.bj0, bj1 = A.bj1, ig0 = A.ig0, ig1 = A.ig1, mc = A.mc, ncv = A.ncv;
#pragma unroll
    for (int i = 0; i < 4; ++i) { const int idx = tid + 512 * i, row = idx >> 4, ch = idx & 15; *(LAS v4u*)(Qs + (row + 3) * 136 + ch * 8) = A.rq[i]; *(LAS v4u*)(Ks + (row + 3) * 136 + ch * 8) = A.rk[i]; }
    if (tid < 48) { const int row = tid >> 4, ch = tid & 15; *(LAS v4u*)(Qs + row * 136 + ch * 8) = H.hq; *(LAS v4u*)(Ks + row * 136 + ch * 8) = H.hk; }
#pragma unroll
    for (int i = 0; i < 4; ++i) { const int idx = tid + 512 * i, row = idx >> 5, ch = idx & 31; *(LAS v4u*)(OT + row * 264 + ch * 8) = B.ro[0][i]; }
    if (wave == 0) {
        const float u0 = ig0 - bj0, u1 = ig1 - bj1;
        const float p0 = wave_scan_max(u0, lane), p1 = fmaxf(__shfl(p0, 63), wave_scan_max(u1, lane));
        const float mt0 = bj0 + fmaxf(mc, p0), mt1 = bj1 + fmaxf(mc, p1);
        bm[lane] = bj0 - mt0; uu[lane] = u0; wi[lane] = fexp(bj0 + mc - mt0); emt[lane] = fexp(-mt0);
        bm[64 + lane] = bj1 - mt1; uu[64 + lane] = u1; wi[64 + lane] = fexp(bj1 + mc - mt1); emt[64 + lane] = fexp(-mt1);
    } else if (wave < 3) nc[tid - 64] = ncv;
    r2m_loadA(F, nbh, nC, NA);
    __syncthreads();
    {
        const int d = tid & 127, jq = tid >> 7;
        float cwq[5], cwk[5];
        { const int chq = h * 128 + d, chk = 512 + chq;
#pragma unroll
          for (int i = 0; i < 4; ++i) { cwq[i] = F.conv_w[i * 1024 + chq]; cwk[i] = F.conv_w[i * 1024 + chk]; }
          cwq[4] = F.conv_b[chq]; cwk[4] = F.conv_b[chk]; }
        LAS bf16 *qc = Qs + (32 * jq) * 136 + d, *kc = Ks + (32 * jq) * 136 + d;
        const float tq0 = bf2f(qc[32 * 136]), tq1 = bf2f(qc[33 * 136]), tq2 = bf2f(qc[34 * 136]), tk0 = bf2f(kc[32 * 136]), tk1 = bf2f(kc[33 * 136]), tk2 = bf2f(kc[34 * 136]);
        __syncthreads();
        conv_inplace_32(cwq, qc, tq0, tq1, tq2, 1.0f);
        conv_inplace_32(cwk, kc, tk0, tk1, tk2, 0.08838834764831845f);
    }
    __syncthreads();
    {
        const int t = tid >> 2, part = tid & 3; float dot = 0.f;
#pragma unroll
        for (int i = 0; i < 4; ++i) { const int d0 = 32 * part + 8 * i; const v4u qv = *(const LAS v4u*)(Qs + t * 136 + d0); float qf[8]; unpack8(qv, qf);
#pragma unroll
            for (int k = 0; k < 8; ++k) dot += qf[k] * nc[d0 + k]; }
        dot += __shfl_xor(dot, 1); dot += __shfl_xor(dot, 2); if (part == 0) qn[t] = dot;
    }
#pragma unroll
    for (int th = 0; th < 2; ++th) {
        {
            int jt, st; bool zero = false, act = true;
            if (th == 0) { jt = (wave == 2) ? 1 : 0; st = (wave >= 1) ? 1 : 0; zero = (wave == 3); act = (wave < 4); if (zero) { jt = 1; st = 0; } }
            else { jt = (wave < 4) ? (wave >> 1) : (wave < 6 ? 2 : 3); st = (wave < 4) ? (wave & 1) : (wave == 4 ? 0 : 1); zero = (wave == 7); if (zero) { jt = 3; st = 0; } }
            if (act && !zero) {
                f32x16 acc = zero16();
#pragma unroll
                for (int ks = 0; ks < 8; ++ks) { const bf16x8 a = *(const LAS bf16x8*)(Ks + (32 * jt + r32) * 136 + 16 * ks + 8 * hi), bq = *(const LAS bf16x8*)(Qs + (64 * th + 32 * st + r32) * 136 + 16 * ks + 8 * hi); acc = mfma32(a, bq, acc); }
                const int tl = 32 * st + r32, tg = 64 * th + tl; const float bmt = bm[tg]; float rs = 0.f;
#pragma unroll
                for (int q = 0; q < 4; ++q) { const int j0 = 32 * jt + 8 * q + 4 * hi; float vv[4]; const f32x4 u4 = *(const LAS f32x4*)(uu + j0);
#pragma unroll
                    for (int i = 0; i < 4; ++i) { const float val = (j0 + i <= tg) ? acc[4 * q + i] * __expf(fminf(bmt + u4[i], 0.f)) : 0.f; vv[i] = val; rs += val; }
                    v2u w; w.x = pk2(vv[0], vv[1]); w.y = pk2(vv[2], vv[3]); *(LAS v2u*)(Sc + tl * 136 + j0) = w; }
                rs += __shfl_xor(rs, 32); if (hi == 0) dn[jt * 64 + tl] = rs;
            } else if (act) {
                for (int idx = lane; idx < 128; idx += 64) { const int tl = 32 * st + (idx >> 2), part = idx & 3; *(LAS v4u*)(Sc + tl * 136 + 32 * jt + 8 * part) = (v4u){0u, 0u, 0u, 0u}; }
                if (lane < 32) dn[jt * 64 + 32 * st + lane] = 0.f;
            }
            if (th == 0 && wave >= 4 && wave < 6) dn[(wave - 2) * 64 + lane] = 0.f;
        }
        __syncthreads();
        f32x4 nw[4];
        { const float* nwp = F.ml_nw + h * 256 + 32 * wave + 4 * hi;
          asm volatile("" ::: "memory");
#pragma unroll
          for (int q = 0; q < 4; ++q) nw[q] = *(const f32x4*)(nwp + 8 * q); }
        f32x16 accA[2], accB[2]; accA[0] = zero16(); accA[1] = zero16(); accB[0] = zero16(); accB[1] = zero16();
#pragma unroll
        for (int ks = 0; ks < 8; ++ks) if (ks < 4 * (th + 1))
#pragma unroll
            for (int tt = 0; tt < 2; ++tt) { const bf16x8 bq = *(const LAS bf16x8*)(Sc + (32 * tt + r32) * 136 + 16 * ks + 8 * hi); accA[tt] = mfma32(avt[ks], bq, accA[tt]); }
#pragma unroll
        for (int ks = 0; ks < 8; ++ks)
#pragma unroll
            for (int tt = 0; tt < 2; ++tt) { const bf16x8 bq = *(const LAS bf16x8*)(Qs + (64 * th + 32 * tt + r32) * 136 + 16 * ks + 8 * hi); accB[tt] = mfma32(acs[ks], bq, accB[tt]); }
        if (th == 1) r2m_loadB(F, nbh, nC, NB);
#pragma unroll
        for (int tt = 0; tt < 2; ++tt) { const int tl = 32 * tt + r32, tg = 64 * th + tl; const float wit = wi[tg];
            const float den = (dn[tl] + dn[64 + tl]) + (dn[128 + tl] + dn[192 + tl]) + wit * qn[tg]; const float inv = frcp(fmaxf(fabsf(den), emt[tg])); float ssp = 0.f;
#pragma unroll
            for (int r = 0; r < 16; ++r) { const float hv = (accA[tt][r] + wit * accB[tt][r]) * inv; accA[tt][r] = hv; ssp += hv * hv; }
            ssp += __shfl_xor(ssp, 32); if (hi == 0) hn[wave * 64 + tl] = ssp; }
        __syncthreads();
        if (th == 1) r2m_loadH(F, nbh, nC, NH);
#pragma unroll
        for (int tt = 0; tt < 2; ++tt) { const int tl = 32 * tt + r32; float tot = 0.f;
#pragma unroll
            for (int w = 0; w < 8; ++w) tot += hn[w * 64 + tl];
            const float rstd = frsq(tot * (1.0f / 256.0f) + EPS);
            const int v0 = 32 * wave + 4 * hi;
#pragma unroll
            for (int q = 0; q < 4; ++q) { LAS v2u* op = (LAS v2u*)(OT + tl * 264 + v0 + 8 * q); const v2u o4 = *op;
                const float y0 = accA[tt][4 * q] * rstd * nw[q][0] * blo(o4.x), y1 = accA[tt][4 * q + 1] * rstd * nw[q][1] * bhi(o4.x);
                const float y2 = accA[tt][4 * q + 2] * rstd * nw[q][2] * blo(o4.y), y3 = accA[tt][4 * q + 3] * rstd * nw[q][3] * bhi(o4.y);
                v2u w; w.x = pk2(y0, y1); w.y = pk2(y2, y3); *op = w; } }
        __syncthreads();
#pragma unroll
        for (int i = 0; i < 4; ++i) { const int idx = tid + 512 * i, row = idx >> 5, ch = idx & 31; *(v4u*)(F.Y + (size_t)(m0 + 64 * th + row) * DM + h * 256 + ch * 8) = *(const LAS v4u*)(OT + row * 264 + ch * 8); }
        __syncthreads();
        if (th == 0) {
#pragma unroll
            for (int i = 0; i < 4; ++i) { const int idx = tid + 512 * i, row = idx >> 5, ch = idx & 31; *(LAS v4u*)(OT + row * 264 + ch * 8) = ro1[i]; }
        }
    }
}
constexpr int RH_QT = 0, RH_KT = 34816, RH_GT = 69632, RH_SC = 104448, RH_F32 = 121856;
struct RhL { v4u rq[4], rf[4], rg[4]; float lbd; };
__device__ __forceinline__ void r2h_load(const Frame& F, int bh, int C, RhL& L) {
    const int b = bh >> 3, h = bh & 7, m0 = b * SEQ + C * 128, tid = opaque_i(F.tid);
#pragma unroll
    for (int i = 0; i < 4; ++i) { const int idx = tid + 512 * i, row = idx >> 4, ch = idx & 15;
        L.rq[i] = ld16(F.PROJ + proj_off(m0 + row, PC_HQ + h * 128) + ch * 8); L.rf[i] = ld16(F.PROJ + proj_off(m0 + row, PC_HF + h * 128) + ch * 8); L.rg[i] = ld16(F.PROJ + proj_off(m0 + row, PC_HG + h * 128) + ch * 8); }
    L.lbd = F.hg_lb[1024 + h * 128 + (tid & 127)] - F.hg_lb[h * 128 + (tid & 127)];
}
__device__ __forceinline__ void r2h_fill(const Frame& F, const RhL& L) {
    const int tid = opaque_i(F.tid);
    LAS bf16 *Qt = (LAS bf16*)(F.lds + RH_QT), *Kt = (LAS bf16*)(F.lds + RH_KT), *GT = (LAS bf16*)(F.lds + RH_GT);
#pragma unroll
    for (int i = 0; i < 4; ++i) { const int idx = tid + 512 * i, row = idx >> 4, ch = idx & 15; const int lo = row * 136 + ch * 8;
        *(LAS v4u*)(Qt + lo) = L.rq[i]; *(LAS v4u*)(Kt + lo) = L.rf[i]; *(LAS v4u*)(GT + lo) = L.rg[i]; }
}
__device__ __forceinline__ void r2h_compute(const Frame& F, int bh, int C, float lbd) {
    const int b = bh >> 3, h = bh & 7, m0 = b * SEQ + C * 128, unit = bh * NCH2 + C, tid = opaque_i(F.tid), lane = tid & 63, wave = F.wave, r32 = lane & 31, hi = lane >> 5;
    LAS bf16 *Qt = (LAS bf16*)(F.lds + RH_QT), *Kt = (LAS bf16*)(F.lds + RH_KT), *GT = (LAS bf16*)(F.lds + RH_GT), *Sc = (LAS bf16*)(F.lds + RH_SC);
    LAS float* hn = (LAS float*)(F.lds + RH_F32);
    LAS float* seg = hn + 256;
    const int vt_i = wave & 3, tt = wave >> 2, t = 32 * tt + r32;
    bf16x8 avt[8], ast[8]; f32x4 nw[4];
    { const bf16* vt = F.VT + vt_off(1024 + h * 128 + 32 * vt_i + r32, m0) + 8 * hi;
#pragma unroll
      for (int ks = 0; ks < 8; ++ks) avt[ks] = *(const bf16x8*)(vt + 16 * ks);
      const bf16* cs = F.Ch + ((size_t)unit * 128 + 32 * vt_i + r32) * 128 + 8 * hi;
#pragma unroll
      for (int ks = 0; ks < 8; ++ks) ast[ks] = *(const bf16x8*)(cs + 16 * ks);
      const float* nwp = F.hg_nw + h * 128 + 32 * vt_i + 4 * hi;
#pragma unroll
      for (int q = 0; q < 4; ++q) nw[q] = *(const f32x4*)(nwp + 8 * q); }
    __syncthreads();
    {
        const int e = tid & 127, jq = tid >> 7;
        const float lb = frcp(1.0f + fexp(lbd));
        float yv[32], fv[32];
#pragma unroll
        for (int jj = 0; jj < 32; ++jj) { const float xv = bf2f(Kt[(32 * jq + jj) * 136 + e]); fv[jj] = lb + (1.0f - lb) * sigm(xv); }
        float run = 1.0f;
        if (jq < 2) {
#pragma unroll
            for (int jj = 31; jj >= 0; --jj) { yv[jj] = run; run *= fv[jj]; }
        } else {
#pragma unroll
            for (int jj = 0; jj < 32; ++jj) { run *= fv[jj]; yv[jj] = run; }
        }
        seg[jq * 128 + e] = run;
        __syncthreads();
        const float other = jq == 0 ? seg[128 + e] : jq == 3 ? seg[256 + e] : 1.0f;
#pragma unroll
        for (int jj = 0; jj < 32; ++jj) { const int j = 32 * jq + jj; const float y = yv[jj] * other, ry = frcp(y); const float qv = bf2f(Qt[j * 136 + e]);
            st_bf(Qt + j * 136 + e, qv * (jq < 2 ? ry : y)); st_bf(Kt + j * 136 + e, (1.0f - fv[jj]) * (jq < 2 ? y : ry)); }
    }
    __syncthreads();
#pragma unroll
    for (int th = 0; th < 2; ++th) {
        {
            int jt, st; bool zero = false, act = true;
            if (th == 0) { jt = (wave == 2) ? 1 : 0; st = (wave >= 1) ? 1 : 0; zero = (wave == 3); act = (wave < 4); if (zero) { jt = 1; st = 0; } }
            else { jt = (wave < 4) ? (wave >> 1) : (wave < 6 ? 2 : 3); st = (wave < 4) ? (wave & 1) : (wave == 4 ? 0 : 1); zero = (wave == 7); if (zero) { jt = 3; st = 0; } }
            if (act && !zero) {
                f32x16 acc = zero16();
#pragma unroll
                for (int ks = 0; ks < 8; ++ks) { const bf16x8 a = *(const LAS bf16x8*)(Kt + (32 * jt + r32) * 136 + 16 * ks + 8 * hi), bq = *(const LAS bf16x8*)(Qt + (64 * th + 32 * st + r32) * 136 + 16 * ks + 8 * hi); acc = mfma32(a, bq, acc); }
                const int tl = 32 * st + r32, tg = 64 * th + tl;
#pragma unroll
                for (int q = 0; q < 4; ++q) { const int j0 = 32 * jt + 8 * q + 4 * hi; float vv[4];
#pragma unroll
                    for (int i = 0; i < 4; ++i) vv[i] = (j0 + i <= tg) ? acc[4 * q + i] : 0.f;
                    v2u w; w.x = pk2(vv[0], vv[1]); w.y = pk2(vv[2], vv[3]); *(LAS v2u*)(Sc + tl * 136 + j0) = w; }
            } else if (act) {
                for (int idx = lane; idx < 128; idx += 64) { const int tl = 32 * st + (idx >> 2), part = idx & 3; *(LAS v4u*)(Sc + tl * 136 + 32 * jt + 8 * part) = (v4u){0u, 0u, 0u, 0u}; }
            }
        }
        __syncthreads();
        f32x16 acc = zero16();
#pragma unroll
        for (int ks = 0; ks < 8; ++ks) if (ks < 4 * (th + 1)) { const bf16x8 bq = *(const LAS bf16x8*)(Sc + t * 136 + 16 * ks + 8 * hi); acc = mfma32(avt[ks], bq, acc); }
#pragma unroll
        for (int ks = 0; ks < 8; ++ks) { const bf16x8 bq = *(const LAS bf16x8*)(Qt + (64 * th + t) * 136 + 16 * ks + 8 * hi); acc = mfma32(ast[ks], bq, acc); }
        { float ssp = 0.f;
#pragma unroll
          for (int r = 0; r < 16; ++r) ssp += acc[r] * acc[r];
          ssp += __shfl_xor(ssp, 32); if (hi == 0) hn[vt_i * 64 + t] = ssp; }
        __syncthreads();
        LAS bf16* YT = Qt + 64 * th * 136;
        {
            const float tot = (hn[t] + hn[64 + t]) + (hn[128 + t] + hn[192 + t]);
            const float rstd = frsq(tot * (1.0f / 128.0f) + EPS);
            const int v0 = 32 * vt_i + 4 * hi;
#pragma unroll
            for (int q = 0; q < 4; ++q) { const v2u g4 = *(const LAS v2u*)(GT + (64 * th + t) * 136 + v0 + 8 * q);
                const float g0 = blo(g4.x), g1 = bhi(g4.x), g2 = blo(g4.y), g3 = bhi(g4.y);
                const float y0 = acc[4 * q] * rstd * nw[q][0] * g0, y1 = acc[4 * q + 1] * rstd * nw[q][1] * g1;
                const float y2 = acc[4 * q + 2] * rstd * nw[q][2] * g2, y3 = acc[4 * q + 3] * rstd * nw[q][3] * g3;
                v2u w; w.x = pk2(y0, y1); w.y = pk2(y2, y3); *(LAS v2u*)(YT + t * 136 + v0 + 8 * q) = w; }
        }
        __syncthreads();
#pragma unroll
        for (int i = 0; i < 2; ++i) { const int idx = tid + 512 * i, row = idx >> 4, ch = idx & 15; *(v4u*)(F.Y + (size_t)(m0 + 64 * th + row) * DM + 1024 + h * 128 + ch * 8) = *(const LAS v4u*)(YT + row * 136 + ch * 8); }
        __syncthreads();
    }
}
__device__ __forceinline__ void r2_phase(const Frame& F, int c_lo, volatile LAS unsigned long long* tsl) {
#define R2_BH(id) ((id) >> CPS_SH)
#define R2_C(id) (c_lo + ((id) & (CPS - 1)))
    { RmA curA; RmB curB; RmH curH; int id = F.bid; r2m_loadA(F, id >> 7, id & 127, curA); r2m_loadH(F, id >> 7, id & 127, curH); r2m_loadB(F, id >> 7, id & 127, curB);
      for (; id < 8 * NCH2; id += F.G) { const int nid = (id + F.G < 8 * NCH2) ? id + F.G : id;
          RmA nxtA; RmB nxtB; RmH nxtH; r2m_unit(F, id >> 7, id & 127, curA, curB, curH, nid >> 7, nid & 127, nxtA, nxtB, nxtH); curA = nxtA; curB = nxtB; curH = nxtH; } }
    if (PROBE_TS >= 0 && F.tid == 0) tsl[8] = __builtin_amdgcn_s_memrealtime();
    { RhL cur; int id = F.bid; r2h_load(F, id >> 7, id & 127, cur);
      for (; id < 16 * NCH2; id += F.G) { const int nid = (id + F.G < 16 * NCH2) ? id + F.G : id;
          r2h_fill(F, cur); const float lbd = cur.lbd;
          RhL nxt; r2h_load(F, nid >> 7, nid & 127, nxt);
          r2h_compute(F, id >> 7, id & 127, lbd); cur = nxt; } }
#undef R2_BH
#undef R2_C
}
__device__ __forceinline__ void final_norm(const Frame& F, float oscale) {
    int lane; asm volatile("v_mbcnt_lo_u32_b32 %0, -1, 0\n\tv_mbcnt_hi_u32_b32 %0, -1, %0" : "=v"(lane));
    const int gw = F.bid * NWAVES + F.wave, NGW = F.G * NWAVES;
    const int sub = lane >> 5, l8 = (lane & 31) * 8;
    for (int m = gw; m < M; m += NGW) {
        const size_t base = (((size_t)(m >> 8) * 8) << 16) + (size_t)(m & 255) * 256 + l8;
        float hv[4][8]; float ss = 0.f;
#pragma unroll
        for (int i = 0; i < 4; ++i) { const size_t off = base + ((size_t)(2 * i + sub) << 16); const v4u g = __builtin_nontemporal_load((const v4u*)(F.EB + off));
            hv[i][0] = blo(g.x); hv[i][1] = bhi(g.x); hv[i][2] = blo(g.y); hv[i][3] = bhi(g.y);
            hv[i][4] = blo(g.z); hv[i][5] = bhi(g.z); hv[i][6] = blo(g.w); hv[i][7] = bhi(g.w);
#pragma unroll
            for (int k = 0; k < 8; ++k) ss += hv[i][k] * hv[i][k]; }
        ss = wave_sum(ss);
        const float rstd = oscale / sqrtf(ss * (1.0f / DM) + EPS);
#pragma unroll
        for (int i = 0; i < 4; ++i) { const int col = (2 * i + sub) * 256 + l8; const f32x4 w0 = *(const f32x4*)(F.fin_nw + col), w1 = *(const f32x4*)(F.fin_nw + col + 4);
            float* o = F.out + (size_t)m * DM + col;
            __builtin_nontemporal_store((f32x4){hv[i][0] * rstd * w0[0], hv[i][1] * rstd * w0[1], hv[i][2] * rstd * w0[2], hv[i][3] * rstd * w0[3]}, (f32x4*)o);
            __builtin_nontemporal_store((f32x4){hv[i][4] * rstd * w1[0], hv[i][5] * rstd * w1[1], hv[i][6] * rstd * w1[2], hv[i][7] * rstd * w1[3]}, (f32x4*)(o + 4)); }
    }
}
struct Args { const float* in[16]; float* out; unsigned char* ws; int ph_lo, ph_hi, li, pad; };
__global__ void __launch_bounds__(NWAVES * 64, 2) hymba_fwd(Args args) {
    extern __shared__ __attribute__((aligned(16))) unsigned char lds[];
    Frame F;
    F.lds = (LAS unsigned char*)lds;
    F.tid = threadIdx.x; F.lane = F.tid & 63; F.wave = __builtin_amdgcn_readfirstlane(F.tid >> 6); F.G = gridDim.x; F.bid = blockIdx.x;
    unsigned char* ws = args.ws;
    gu32* ctl = (gu32*)(ws + WS_CTL);
    F.x = args.in[0]; F.p = args.in[1]; F.norm_w = args.in[2]; F.w_in = args.in[3]; F.conv_w = args.in[4]; F.conv_b = args.in[5]; F.b_i = args.in[6]; F.b_f = args.in[7];
    F.ml_nw = args.in[8]; F.hg_lb = args.in[9]; F.hg_nw = args.in[10]; F.w_out = args.in[11]; F.pe_nw = args.in[12]; F.w_pg = args.in[13]; F.w_pe = args.in[14]; F.fin_nw = args.in[15];
    F.out = args.out;
    F.Wt_in = (bf16*)(ws + WS_WIN); F.WoT = (bf16*)(ws + WS_WO); F.WgT = (bf16*)(ws + WS_WG); F.WeT = (bf16*)(ws + WS_WE); F.PB = (bf16*)(ws + WS_PB);
    F.U = (bf16*)(ws + WS_U); F.Y = (bf16*)(ws + WS_Y); F.PROJ = (bf16*)(ws + WS_PROJ); F.HB = (bf16*)(ws + WS_PROJ); F.EB = (bf16*)(ws + WS_PROJ + 128 * MiB); F.VT = (bf16*)(ws + WS_VT);
    F.Cm = (bf16*)args.out; F.Ch = (bf16*)args.out + (size_t)64 * MiB;
    F.gates = (float*)(ws + WS_GATES); F.bcum = (float*)(ws + WS_BCUM); F.msc = (float*)(ws + WS_MSC); F.nst = (float*)(ws + WS_NST); F.gdec = (float*)(ws + WS_GDEC); F.ebr = (float*)(ws + WS_EBR); F.carry = (float*)(ws + WS_CARRY);
    F.ssqh = (float*)(ws + WS_SSQH); F.ssq2 = (float*)(ws + WS_SSQ2); F.QC = (bf16*)(ws + WS_QC); F.KC = (bf16*)(ws + WS_KC); F.HQT = (bf16*)(ws + WS_HQT); F.HKT = (bf16*)(ws + WS_HKT); F.HQ2 = (bf16*)(ws + WS_HQ2);
    for (int u = F.tid; u < (LDS_BYTES - LDSCTL_OFF) / 4; u += NWAVES * 64) ((LAS unsigned*)(F.lds + LDSCTL_OFF))[u] = 0u;
    __syncthreads();
    XcdBarrier bar; bar.bar = (unsigned*)(ctl + CW_BAR); bar.x = 0; bar.st = nullptr;
    if (N_LAUNCHES != PER_PHASE) bar = xcd_barrier_post((unsigned*)(ctl + CW_BAR), (volatile LAS unsigned*)(F.lds + MISC_OFF) + 8);
#define GRID_BAR() do { if (N_LAUNCHES == PER_PHASE) { if (F.tid == 0) __hip_atomic_store(ctl + CW_TMO, 0xBADBA0u, RLX_AGENT); } else { xcd_barrier(bar); } } while (0)
    const int lo = args.ph_lo, hi = args.ph_hi;
#ifndef PROBE_TS
#define PROBE_TS (-1)
#endif
#ifndef PROBE_TB
#define PROBE_TB (PROBE_TS + 1)
#endif
    volatile LAS unsigned long long* tsl = (volatile LAS unsigned long long*)(F.lds + LDSCTL_OFF + 512);
#define STAMP(k) do { if (PROBE_TS >= 0 && F.tid == 0) tsl[k] = __builtin_amdgcn_s_memrealtime(); } while (0)
    STAMP(0);
#define IN(k) (lo <= (k) && (k) < hi)
#define BOTH(k) (IN(k) && IN((k) + 1))
#ifndef GEMM_ALIGN
#define GEMM_ALIGN true
#endif
#ifndef GEMM_SP2
#define GEMM_SP2 true
#endif
#ifndef PROBE_KIND
#define PROBE_KIND 0
#endif
#ifndef PROBE_DOUBLE
#define PROBE_DOUBLE 0
#endif
    if (IN(0)) { p0_prologue(F);
#if PROBE_DOUBLE & 1
        __syncthreads(); p0_prologue(F);
#endif
        if (BOTH(0)) { GRID_BAR(); STAMP(1); } }
    int vcu = F.bid;
    if (N_LAUNCHES != PER_PHASE && lo == 0) { volatile LAS unsigned* st = (volatile LAS unsigned*)(F.lds + MISC_OFF) + 8; if (st[2] != 0u && F.G == 256) vcu = (int)(st[3] * 8u + bar.x); }
    if (IN(1)) {
#if PROBE_KIND == 10
        { pg8::Gemm g{F.U, F.Wt_in, M, NNAT, DM}; pg8::StaticOrder S; S.init(M, NNAT, F.G, vcu); pg8::EpiNull E;
          pg8::gemm_phase<pg8::EpiNull, pg8::StaticOrder, true, true, false, 0, false, false, true>(F.lds, g, S, E); }
#elif PROBE_KIND == 12
        { pg8::Gemm g{F.U, F.Wt_in, M, NNAT, DM}; pg8::StaticOrder S; S.init(M, NNAT, F.G, vcu); pg8::EpiNull E;
          pg8::gemm_phase<pg8::EpiNull, pg8::StaticOrder, true, true, false, 0, true, false, false, true>(F.lds, g, S, E); }
#elif PROBE_KIND == 13
        { f32x16 acc[8]; bf16x8 a, b;
#pragma unroll
          for (int i = 0; i < 8; ++i) acc[i] = zero16();
#pragma unroll
          for (int i = 0; i < 8; ++i) { a[i] = (short)(F.tid + i); b[i] = (short)(F.lane * 3 + i); }
          for (int it = 0; it < 12 * 32 * 8; ++it) {
#pragma unroll
              for (int i = 0; i < 8; ++i) acc[i] = mfma32(a, b, acc[i]);
          }
#pragma unroll
          for (int i = 0; i < 8; ++i) asm volatile("" :: "v"(acc[i])); }
#elif PROBE_KIND == 11
        { pg8::Gemm g{F.U, F.Wt_in, M, NNAT, DM}; pg8::StaticOrder S; S.init(M, NNAT, F.G, vcu); pg8::EpiNull E;
          pg8::gemm_phase<pg8::EpiNull, pg8::StaticOrder, true, true>(F.lds, g, S, E); }
#endif
#if PROBE_DOUBLE & 2
        { pg8::Gemm g{F.U, F.Wt_in, M, NNAT, DM}; pg8::StaticOrder S; S.init(M, NNAT, F.G, vcu);
          pg8::EpiProj E{F.PROJ, NNAT / 256, PC_OZ / 256, PC_OZ / 256 + 8, PC_HG / 256};
          pg8::gemm_phase<pg8::EpiProj, pg8::StaticOrder, GEMM_ALIGN, GEMM_SP2>(F.lds, g, S, E); }
        { pg8::Gemm g{F.Wt_in + (size_t)NNAT * DM, F.U, NTR, M, DM}; pg8::StaticOrder S; S.init(NTR, M, F.G, vcu);
          pg8::EpiBf16T E{F.VT, M / 256};
          pg8::gemm_phase<pg8::EpiBf16T, pg8::StaticOrder, GEMM_ALIGN, GEMM_SP2>(F.lds, g, S, E); }
#endif
        { pg8::Gemm g{F.U, F.Wt_in, M, NNAT, DM}; pg8::StaticOrder S; S.init(M, NNAT, F.G, vcu);
          pg8::EpiProj E{F.PROJ, NNAT / 256, PC_OZ / 256, PC_OZ / 256 + 8, PC_HG / 256};
          pg8::gemm_phase<pg8::EpiProj, pg8::StaticOrder, GEMM_ALIGN, GEMM_SP2>(F.lds, g, S, E); }
        { pg8::Gemm g{F.Wt_in + (size_t)NNAT * DM, F.U, NTR, M, DM}; pg8::StaticOrder S; S.init(NTR, M, F.G, vcu);
          pg8::EpiBf16T E{F.VT, M / 256};
          pg8::gemm_phase<pg8::EpiBf16T, pg8::StaticOrder, GEMM_ALIGN, GEMM_SP2>(F.lds, g, S, E); }
        if (BOTH(1)) { GRID_BAR(); STAMP(2); }
    }
    if (N_LAUNCHES == PER_PHASE) {
        if (IN(2)) for (int sl = 0; sl < NSLAB; ++sl) pa_phase(F, sl * CPS, tsl);
        if (IN(3)) scan_phase(F, 0, NCH);
        if (IN(4)) for (int sl = 0; sl < NSLAB; ++sl) r2_phase(F, sl * CPS, tsl);
    } else if (IN(2)) {
        for (int sl = 0; sl < NSLAB; ++sl) {
            pa_phase(F, sl * CPS, tsl); STAMP(10); GRID_BAR(); STAMP(11);
            scan_phase(F, sl * CPS, (sl + 1) * CPS); STAMP(12); GRID_BAR(); STAMP(13);
            r2_phase(F, sl * CPS, tsl); if (sl + 1 < NSLAB) GRID_BAR();
        }
        STAMP(3); STAMP(4);
        GRID_BAR(); STAMP(5);
    }
    if (IN(5)) {
        { pg8::Gemm g{F.Y, F.WoT, M, DM, DM}; pg8::StaticOrder S; S.init(M, DM, F.G, vcu);
          pg8::EpiRes E{F.U, F.gates + (WS_RMS - WS_GATES) / 4, F.norm_w, F.HB, (unsigned char*)F.HB + HB8_OFF, F.ssqh, DM, DM / 256};
          pg8::gemm_phase<pg8::EpiRes, pg8::StaticOrder, GEMM_ALIGN, GEMM_SP2>(F.lds, g, S, E); }
        { pg8::Gemm g{F.PB, F.WeT, M, DM, PE}; pg8::StaticOrder S; S.init(M, DM, F.G, vcu);
          pg8::EpiBf16T E{F.EB, DM / 256};
          pg8::gemm_phase<pg8::EpiBf16T, pg8::StaticOrder, GEMM_ALIGN, GEMM_SP2>(F.lds, g, S, E); }
        if (BOTH(5)) { GRID_BAR(); STAMP(6); }
    }
    if (IN(6)) {
        pg8::Gemm g{(const bf16*)((const unsigned char*)F.HB + HB8_OFF), F.WgT, M, DM, DM / 2}; pg8::StaticOrder S; S.init(M, DM, F.G, vcu);
        pg8::EpiGate E{F.EB, F.HB, F.ssqh, DM / 256, 1.0f / DM, EPS, 1.0f / (WG_SCALE * HB8_SCALE)};
        pg8::gemm_phase<pg8::EpiGate, pg8::StaticOrder, GEMM_ALIGN, GEMM_SP2, false, 0, false, 2, false, false, true>(F.lds, g, S, E);
        if (BOTH(6)) { GRID_BAR(); STAMP(7); }
    }
    float oscale = 1.0f;
    if (PROBE_TS >= 0) { __syncthreads(); const float f = (float)(tsl[PROBE_TB] - tsl[PROBE_TS]) / (float)(tsl[7] - tsl[0]); oscale = 1.0f + sqrtf(fmaxf(f - PROBE_F0, 0.f) * 1e-3f); }
    if (IN(7)) final_norm(F, oscale);
#undef IN
#undef BOTH
}

#ifdef DBG_DUMP_AFTER
__global__ void dbg_dump(const unsigned char* wsb, float* out, int mode) {
    const unsigned short* a = (const unsigned short*)(wsb + (mode == 0 ? WS_PROJ : WS_U)); const unsigned short* b = (const unsigned short*)(wsb + WS_VT);
    size_t i = (size_t)blockIdx.x * blockDim.x + threadIdx.x;
    const size_t n = (size_t)M * DM;
    for (; i < n; i += (size_t)gridDim.x * blockDim.x) {
        float v;
        if (mode == 0) v = bf2f(a[3 * i]) + bf2f(a[3 * i + 1]) + bf2f(a[3 * i + 2]) + bf2f(b[i]);
        else v = bf2f(a[i]);
        out[i] = v;
    }
}
#endif
extern "C" void kernel_launch(void* const* d_in, const int* in_sizes, int n_in, void* d_out, int out_size, void* d_ws, size_t ws_size, hipStream_t stream) {
    static int grid = 0;
    if (grid == 0) {
        if (n_in != 16 || in_sizes[0] != M * DM || out_size != M * DM || ws_size < WS_END) { fprintf(stderr, "kernel_launch: unexpected shapes (n_in %d, in0 %d, out %d, ws %zu); nothing launched\n", n_in, n_in > 0 ? in_sizes[0] : -1, out_size, ws_size); grid = -1; return; }
        int dev = 0, cus = 0, per_cu = 0;
        if (hipGetDevice(&dev) != hipSuccess || hipDeviceGetAttribute(&cus, hipDeviceAttributeMultiprocessorCount, dev) != hipSuccess) { grid = -1; return; }
        if (hipFuncSetAttribute((const void*)hymba_fwd, hipFuncAttributeMaxDynamicSharedMemorySize, LDS_BYTES) != hipSuccess) { fprintf(stderr, "kernel_launch: hipFuncSetAttribute failed\n"); grid = -1; return; }
        if (hipOccupancyMaxActiveBlocksPerMultiprocessor(&per_cu, (const void*)hymba_fwd, NWAVES * 64, LDS_BYTES) != hipSuccess || per_cu < 1)
            fprintf(stderr, "kernel_launch: note: occupancy query reports %d workgroups per CU\n", per_cu);
        (void)hipGetLastError();
        grid = cus < 256 ? cus : 256;
        if (grid != 256) fprintf(stderr, "kernel_launch: %d CUs: this kernel is written for a 256-CU device; results will be wrong\n", cus);
    }
    if (grid < 0) return;
    if (hipMemsetAsync((char*)d_ws + WS_CTL, 0, CTL_ZERO_BYTES, stream) != hipSuccess) { fprintf(stderr, "kernel_launch: hipMemsetAsync failed\n"); return; }
    Args a{};
    for (int i = 0; i < 16; ++i) a.in[i] = (const float*)d_in[i];
    a.out = (float*)d_out; a.ws = (unsigned char*)d_ws;
    for (int li = 0; li < N_LAUNCHES; ++li) {
#ifdef DBG_DUMP_AFTER
        if (li > DBG_DUMP_AFTER) { if (DBG_DUMP_AFTER != 2 && DBG_DUMP_AFTER != 3) hipLaunchKernelGGL(dbg_dump, dim3(2048), dim3(256), 0, stream, (const unsigned char*)d_ws, (float*)d_out, DBG_DUMP_AFTER == 1 ? 0 : 1);
            break; }
#endif
        a.ph_lo = (N_LAUNCHES == PER_PHASE) ? li : 0; a.ph_hi = (N_LAUNCHES == PER_PHASE) ? li + 1 : PER_PHASE; a.li = li;
        hipLaunchKernelGGL(hymba_fwd, dim3(grid), dim3(NWAVES * 64), LDS_BYTES, stream, a);
        const hipError_t le = hipPeekAtLastError();
        if (le != hipSuccess) { fprintf(stderr, "kernel_launch: launch %d failed: %s\n", li, hipGetErrorName(le)); break; }
    }
}
```

```cpp
#include <hip/hip_runtime.h>
#include <cstdio>
#include <cstdint>
namespace pg8 {
#define PG8_LAS __attribute__((address_space(3)))
typedef unsigned short bf16_t;
typedef short bf16x8 __attribute__((ext_vector_type(8)));
typedef float f32x4 __attribute__((ext_vector_type(4)));
typedef unsigned u32x4 __attribute__((ext_vector_type(4)));
constexpr int BM = 256, BK = 64, HALF = 128, HTB = HALF * BK * 2  , STAGE_BYTES = 8 * HTB, NXCD = 8, WGM = 8;

__host__ __device__ __forceinline__ int lds_byte(int r, int c) { const int st = (r >> 4) * 2 + (c >> 5), rr = r & 15, cc = c & 31, ob = rr * 64 + cc * 2; return st * 1024 + (ob ^ (((ob >> 9) & 1) << 5)); }
__host__ __device__ __forceinline__ void stage_rc(int b, int& R, int& C) { const int st = b / 1024, sb = b % 1024, swz = sb ^ (((sb >> 9) & 1) << 5); R = (st >> 1) * 16 + swz / 64; C = (st & 1) * 32 + (swz % 64) / 2; }
__host__ __device__ __forceinline__ int perm32(int rho) { const int n = rho >> 4, i = rho & 15; return 8 * (i >> 2) + 4 * n + (i & 3); }

struct Unit { int pm, pn; };
struct Gemm { const bf16_t* A; const bf16_t* Bt; int M, N, K; };

struct StaticOrder {
    int nM, nN, nwg, G, c;
    __host__ __device__ void init(int M, int N, int G_, int c_) { nM = M / BM; nN = N / BM; nwg = nM * nN; G = G_; c = c_; }
    __host__ __device__ bool next(int i, Unit& u) const {
        const long L = (long)i * G + c; if (L >= nwg) return false;
        int wgid = (int)L; { const int q = nwg / NXCD, r = nwg % NXCD, xcd = wgid % NXCD, off = wgid / NXCD; wgid = (xcd < r ? xcd * (q + 1) : r * (q + 1) + (xcd - r) * q) + off; }
        const int nig = WGM * nN, gid = wgid / nig, fm = gid * WGM, gsz = (nM - fm) < WGM ? (nM - fm) : WGM;
        u.pm = fm + ((wgid % nig) % gsz); u.pn = (wgid % nig) / gsz; return true;
    }
    __device__ __forceinline__ void a_ready(const Unit&) const {}
    __device__ __forceinline__ void done(const Unit&) const {}
};

typedef unsigned u32x2 __attribute__((ext_vector_type(2)));
typedef int i32x4_ __attribute__((ext_vector_type(4)));
typedef int i32x8_ __attribute__((ext_vector_type(8)));
typedef long i64x2_ __attribute__((ext_vector_type(2)));
__device__ __forceinline__ i32x8_ cat8(bf16x8 a, bf16x8 b) { const i32x4_ x = __builtin_bit_cast(i32x4_, a), y = __builtin_bit_cast(i32x4_, b); return __builtin_shufflevector(x, y, 0, 1, 2, 3, 4, 5, 6, 7); }
__device__ __forceinline__ void mfma_fp8_inplace(f32x4& acc, i32x8_ a, i32x8_ b, int scale) {
    asm volatile("v_mfma_scale_f32_16x16x128_f8f6f4 %0, %1, %2, %0, %3, %3 op_sel_hi:[0,0,0]" : "+v"(acc) : "v"(a), "v"(b), "v"(scale));
}
__device__ __forceinline__ unsigned cvt_pk4_fp8(float a, float b, float c, float d) { int w = __builtin_amdgcn_cvt_pk_fp8_f32(a, b, 0, false); w = __builtin_amdgcn_cvt_pk_fp8_f32(c, d, w, true); return (unsigned)w; }
__device__ __forceinline__ unsigned cvt_pk_bf16(float lo, float hi) { unsigned r; asm volatile("v_cvt_pk_bf16_f32 %0, %1, %2" : "=v"(r) : "v"(lo), "v"(hi)); return r; }
typedef float f32x2 __attribute__((ext_vector_type(2)));
__device__ __forceinline__ f32x2 gelu_pk(f32x2 v) {
    const f32x2 av = __builtin_elementwise_abs(v), d = av * 0.2316418882f + 1.0f;
    f32x2 t; t.x = __builtin_amdgcn_rcpf(d.x); t.y = __builtin_amdgcn_rcpf(d.y);
    f32x2 q = t * 0.5307027145f + (-0.7265760135f); q = q * t + 0.7107068705f; q = q * t + (-0.142248368f); q = q * t + 0.127414796f; q = q * t;
    const f32x2 s = (v * v) * (-0.72134752044f);
    f32x2 e; e.x = __builtin_amdgcn_exp2f(s.x); e.y = __builtin_amdgcn_exp2f(s.y);
    const f32x2 m = v * (q * e), r = v - m;
    f32x2 o; o.x = v.x < 0.f ? m.x : r.x; o.y = v.y < 0.f ? m.y : r.y; return o;
}

template <int ACT  > struct EpiBf16 {
    static constexpr bool PERM = true, AFTER_DRAIN = false; static_assert(ACT == 0 || ACT == 1, "EpiBf16: ACT is 0 (none) or 1 (gelu_pk)");
    bf16_t* O; int ldc; const float* bias; int split_cols; size_t split_stride; float scale0;
    __device__ __forceinline__ void operator()(const f32x4 (&acc)[2][2][4][2], const Unit& u, int wr, int wc, int fr, int fq) const {
        const int row0 = u.pm * BM + wr * 64 + fr; int colt = u.pn * BM; bf16_t* base = O;
        float sc = 1.f; if (split_cols) { const int t = colt / split_cols; base += (size_t)t * split_stride; colt -= t * split_cols; if (t == 0) sc = scale0; }
        const int col0 = colt + wc * 32 + 8 * fq, bcol0 = u.pn * BM + wc * 32 + 8 * fq;
        f32x4 bv[2][2];
#pragma unroll
        for (int bj = 0; bj < 2; ++bj)
#pragma unroll
            for (int n = 0; n < 2; ++n) bv[bj][n] = bias ? *(const f32x4*)(bias + bcol0 + bj * HALF + 4 * n) : (f32x4){0.f, 0.f, 0.f, 0.f};
#pragma unroll
        for (int ai = 0; ai < 2; ++ai)
#pragma unroll
            for (int m = 0; m < 4; ++m) { bf16_t* rowp = base + (size_t)(row0 + ai * HALF + m * 16) * ldc + col0;
#pragma unroll
                for (int bj = 0; bj < 2; ++bj) { f32x4 v0 = acc[ai][bj][m][0] + bv[bj][0], v1 = acc[ai][bj][m][1] + bv[bj][1];
                    if (ACT == 1) { f32x2 a = gelu_pk((f32x2){v0[0], v0[1]}), b = gelu_pk((f32x2){v0[2], v0[3]}), c = gelu_pk((f32x2){v1[0], v1[1]}), d = gelu_pk((f32x2){v1[2], v1[3]});
                        v0 = (f32x4){a.x, a.y, b.x, b.y}; v1 = (f32x4){c.x, c.y, d.x, d.y}; }
                    v0 = v0 * sc; v1 = v1 * sc; u32x4 w; w.x = cvt_pk_bf16(v0[0], v0[1]); w.y = cvt_pk_bf16(v0[2], v0[3]); w.z = cvt_pk_bf16(v1[0], v1[1]); w.w = cvt_pk_bf16(v1[2], v1[3]);
                    __builtin_nontemporal_store(w, (u32x4*)(rowp + bj * HALF)); } }
    }
};
__device__ __forceinline__ float bf_lo(unsigned w) { return __uint_as_float(w << 16); }
__device__ __forceinline__ float bf_hi(unsigned w) { return __uint_as_float(w & 0xffff0000u); }
__device__ __forceinline__ float fast_sigmoid(float x) { return __builtin_amdgcn_rcpf(1.0f + __expf(-x)); }
struct EpiBf16T {
    static constexpr bool PERM = true, AFTER_DRAIN = false;
    bf16_t* O; int nN;
    __device__ __forceinline__ void operator()(const f32x4 (&acc)[2][2][4][2], const Unit& u, int wr, int wc, int fr, int fq) const {
        bf16_t* tile = O + (size_t)(u.pm * nN + u.pn) * 65536 + (wr * 64 + fr) * 256 + wc * 32 + 8 * fq;
#pragma unroll
        for (int ai = 0; ai < 2; ++ai)
#pragma unroll
            for (int m = 0; m < 4; ++m) { bf16_t* rowp = tile + (ai * HALF + m * 16) * 256;
#pragma unroll
                for (int bj = 0; bj < 2; ++bj) { const f32x4 v0 = acc[ai][bj][m][0], v1 = acc[ai][bj][m][1];
                    u32x4 w; w.x = cvt_pk_bf16(v0[0], v0[1]); w.y = cvt_pk_bf16(v0[2], v0[3]); w.z = cvt_pk_bf16(v1[0], v1[1]); w.w = cvt_pk_bf16(v1[2], v1[3]);
                    *(u32x4*)(rowp + bj * HALF) = w; } }
    }
};
struct EpiProj {
    static constexpr bool PERM = true, AFTER_DRAIN = false;
    bf16_t* O; int nN, oz_lo, oz_hi, silu_lo;
    __device__ __forceinline__ void operator()(const f32x4 (&acc)[2][2][4][2], const Unit& u, int wr, int wc, int fr, int fq) const {
        bf16_t* tile = O + (size_t)(u.pm * nN + u.pn) * 65536 + (wr * 64 + fr) * 256 + wc * 32 + 8 * fq;
        if (u.pn >= oz_lo && u.pn < oz_hi) {
#pragma unroll
            for (int ai = 0; ai < 2; ++ai)
#pragma unroll
                for (int m = 0; m < 4; ++m) { float g[8];
#pragma unroll
                    for (int n = 0; n < 2; ++n)
#pragma unroll
                        for (int k = 0; k < 4; ++k) { const float o = acc[ai][0][m][n][k], z = acc[ai][1][m][n][k]; g[4 * n + k] = z * __builtin_amdgcn_rcpf((1.0f + __expf(-o)) * (1.0f + __expf(-z))); }
                    u32x4 w; w.x = cvt_pk_bf16(g[0], g[1]); w.y = cvt_pk_bf16(g[2], g[3]); w.z = cvt_pk_bf16(g[4], g[5]); w.w = cvt_pk_bf16(g[6], g[7]);
                    *(u32x4*)(tile + (ai * HALF + m * 16) * 256) = w; }
        } else if (u.pn >= silu_lo) {
#pragma unroll
            for (int ai = 0; ai < 2; ++ai)
#pragma unroll
                for (int m = 0; m < 4; ++m) { bf16_t* rowp = tile + (ai * HALF + m * 16) * 256;
#pragma unroll
                    for (int bj = 0; bj < 2; ++bj) { f32x4 v0 = acc[ai][bj][m][0], v1 = acc[ai][bj][m][1];
#pragma unroll
                        for (int k = 0; k < 4; ++k) { v0[k] = v0[k] * fast_sigmoid(v0[k]); v1[k] = v1[k] * fast_sigmoid(v1[k]); }
                        u32x4 w; w.x = cvt_pk_bf16(v0[0], v0[1]); w.y = cvt_pk_bf16(v0[2], v0[3]); w.z = cvt_pk_bf16(v1[0], v1[1]); w.w = cvt_pk_bf16(v1[2], v1[3]);
                        *(u32x4*)(rowp + bj * HALF) = w; } }
        } else {
#pragma unroll
            for (int ai = 0; ai < 2; ++ai)
#pragma unroll
                for (int m = 0; m < 4; ++m) { bf16_t* rowp = tile + (ai * HALF + m * 16) * 256;
#pragma unroll
                    for (int bj = 0; bj < 2; ++bj) { const f32x4 v0 = acc[ai][bj][m][0], v1 = acc[ai][bj][m][1];
                        u32x4 w; w.x = cvt_pk_bf16(v0[0], v0[1]); w.y = cvt_pk_bf16(v0[2], v0[3]); w.z = cvt_pk_bf16(v1[0], v1[1]); w.w = cvt_pk_bf16(v1[2], v1[3]);
                        *(u32x4*)(rowp + bj * HALF) = w; } }
        }
    }
};
struct EpiRes {
    static constexpr bool PERM = true, AFTER_DRAIN = false;
    const bf16_t* ub; const float* rms; const float* nw; bf16_t* hb; unsigned char* hb8; float* ssq; int ldc, nN;
    __device__ __forceinline__ void operator()(const f32x4 (&acc)[2][2][4][2], const Unit& u, int wr, int wc, int fr, int fq) const {
        const int row0 = u.pm * BM + wr * 64 + fr, col0 = u.pn * BM + wc * 32 + 8 * fq;
        const size_t toff = (size_t)(u.pm * nN + u.pn) * 65536 + (wr * 64 + fr) * 256 + wc * 32 + 8 * fq;
        f32x4 inw[2][2];
#pragma unroll
        for (int bj = 0; bj < 2; ++bj)
#pragma unroll
            for (int n = 0; n < 2; ++n) { const f32x4 w = *(const f32x4*)(nw + col0 + bj * HALF + 4 * n); inw[bj][n] = (f32x4){__builtin_amdgcn_rcpf(w[0]), __builtin_amdgcn_rcpf(w[1]), __builtin_amdgcn_rcpf(w[2]), __builtin_amdgcn_rcpf(w[3])}; }
#pragma unroll
        for (int ai = 0; ai < 2; ++ai) {
            u32x4 xv[4][2]; float rm[4];
#pragma unroll
            for (int m = 0; m < 4; ++m) { const size_t off = (size_t)(row0 + ai * HALF + m * 16) * ldc + col0; rm[m] = rms[row0 + ai * HALF + m * 16];
#pragma unroll
                for (int bj = 0; bj < 2; ++bj) xv[m][bj] = *(const u32x4*)(ub + off + bj * HALF); }
#pragma unroll
            for (int m = 0; m < 4; ++m) { const int row = row0 + ai * HALF + m * 16; const size_t to = toff + (ai * HALF + m * 16) * 256; float ss = 0.f;
#pragma unroll
                for (int bj = 0; bj < 2; ++bj) {
                    const u32x4 xw = xv[m][bj];
                    const f32x4 h0 = (f32x4){bf_lo(xw.x), bf_hi(xw.x), bf_lo(xw.y), bf_hi(xw.y)} * inw[bj][0] * rm[m] + acc[ai][bj][m][0], h1 = (f32x4){bf_lo(xw.z), bf_hi(xw.z), bf_lo(xw.w), bf_hi(xw.w)} * inw[bj][1] * rm[m] + acc[ai][bj][m][1];
                    ss += (h0[0] * h0[0] + h0[1] * h0[1]) + (h0[2] * h0[2] + h0[3] * h0[3]) + (h1[0] * h1[0] + h1[1] * h1[1]) + (h1[2] * h1[2] + h1[3] * h1[3]);
                    u32x4 w; w.x = cvt_pk_bf16(h0[0], h0[1]); w.y = cvt_pk_bf16(h0[2], h0[3]); w.z = cvt_pk_bf16(h1[0], h1[1]); w.w = cvt_pk_bf16(h1[2], h1[3]);
                    *(u32x4*)(hb + to + bj * HALF) = w;
                    u32x2 w8; w8.x = cvt_pk4_fp8(h0[0] * 16.0f, h0[1] * 16.0f, h0[2] * 16.0f, h0[3] * 16.0f); w8.y = cvt_pk4_fp8(h1[0] * 16.0f, h1[1] * 16.0f, h1[2] * 16.0f, h1[3] * 16.0f);
                    *(u32x2*)(hb8 + to + bj * HALF) = w8; }
                ss += __shfl_xor(ss, 16); ss += __shfl_xor(ss, 32);
                if (fq == 0) atomicAdd(ssq + row, ss); }
        }
    }
};
struct EpiGate {
    static constexpr bool PERM = true, AFTER_DRAIN = false;
    bf16_t* e; const bf16_t* hb; float* ssq_h; int nN; float inv_n, eps, ascale;
    __device__ __forceinline__ void operator()(const f32x4 (&acc)[2][2][4][2], const Unit& u, int wr, int wc, int fr, int fq) const {
        const int row0 = u.pm * BM + wr * 64 + fr;
        const size_t toff = (size_t)(u.pm * nN + u.pn) * 65536 + (wr * 64 + fr) * 256 + wc * 32 + 8 * fq;
#pragma unroll
        for (int ai = 0; ai < 2; ++ai) {
            u32x4 ev[4][2], hv[4][2]; float sq[4];
#pragma unroll
            for (int m = 0; m < 4; ++m) { const size_t to = toff + (ai * HALF + m * 16) * 256;
                sq[m] = __hip_atomic_load(ssq_h + row0 + ai * HALF + m * 16, __ATOMIC_RELAXED, __HIP_MEMORY_SCOPE_AGENT);
#pragma unroll
                for (int bj = 0; bj < 2; ++bj) { ev[m][bj] = *(const u32x4*)(e + to + bj * HALF); hv[m][bj] = *(const u32x4*)(hb + to + bj * HALF); } }
#pragma unroll
            for (int m = 0; m < 4; ++m) { const size_t to = toff + (ai * HALF + m * 16) * 256;
                const float rstd = __builtin_amdgcn_rsqf(sq[m] * inv_n + eps) * ascale;
#pragma unroll
                for (int bj = 0; bj < 2; ++bj) { const u32x4 v = ev[m][bj], h = hv[m][bj];
                    const f32x4 a0 = acc[ai][bj][m][0] * rstd, a1 = acc[ai][bj][m][1] * rstd;
                    u32x4 w;
                    w.x = cvt_pk_bf16(bf_lo(h.x) + fast_sigmoid(a0[0]) * bf_lo(v.x), bf_hi(h.x) + fast_sigmoid(a0[1]) * bf_hi(v.x)); w.y = cvt_pk_bf16(bf_lo(h.y) + fast_sigmoid(a0[2]) * bf_lo(v.y), bf_hi(h.y) + fast_sigmoid(a0[3]) * bf_hi(v.y));
                    w.z = cvt_pk_bf16(bf_lo(h.z) + fast_sigmoid(a1[0]) * bf_lo(v.z), bf_hi(h.z) + fast_sigmoid(a1[1]) * bf_hi(v.z)); w.w = cvt_pk_bf16(bf_lo(h.w) + fast_sigmoid(a1[2]) * bf_lo(v.w), bf_hi(h.w) + fast_sigmoid(a1[3]) * bf_hi(v.w));
                    *(u32x4*)(e + to + bj * HALF) = w; } }
        }
    }
};
struct EpiNull {
    static constexpr bool PERM = true, AFTER_DRAIN = false;
    __device__ __forceinline__ void operator()(const f32x4 (&acc)[2][2][4][2], const Unit& u, int wr, int wc, int fr, int fq) const {
#pragma unroll
        for (int ai = 0; ai < 2; ++ai)
#pragma unroll
            for (int bj = 0; bj < 2; ++bj)
#pragma unroll
                for (int m = 0; m < 4; ++m)
#pragma unroll
                    for (int n = 0; n < 2; ++n) asm volatile("" :: "v"(acc[ai][bj][m][n]));
    }
};
struct SameTileOrder {
    int c, n;
    __device__ bool next(int i, Unit& u) const { if (i >= n) return false; u.pm = c & 7; u.pn = i % 24; return true; }
    __device__ __forceinline__ void a_ready(const Unit&) const {}
    __device__ __forceinline__ void done(const Unit&) const {}
};
struct EpiScratch {
    static constexpr bool PERM = true, AFTER_DRAIN = false;
    bf16_t* O0; int per_unit;
    __device__ __forceinline__ void operator()(const f32x4 (&acc)[2][2][4][2], const Unit& u, int wr, int wc, int fr, int fq) const {
        bf16_t* O = O0 + (per_unit ? (size_t)(u.pm * 24 + u.pn) * 65536 : (size_t)0);
        const int row0 = wr * 64 + fr, col0 = wc * 32 + 8 * fq;
#pragma unroll
        for (int ai = 0; ai < 2; ++ai)
#pragma unroll
            for (int m = 0; m < 4; ++m) { bf16_t* rowp = O + (size_t)(row0 + ai * HALF + m * 16) * 256 + col0;
#pragma unroll
                for (int bj = 0; bj < 2; ++bj) { const f32x4 v0 = acc[ai][bj][m][0], v1 = acc[ai][bj][m][1];
                    u32x4 w; w.x = cvt_pk_bf16(v0[0], v0[1]); w.y = cvt_pk_bf16(v0[2], v0[3]); w.z = cvt_pk_bf16(v1[0], v1[1]); w.w = cvt_pk_bf16(v1[2], v1[3]);
                    *(u32x4*)(rowp + bj * HALF) = w; } }
    }
};
template <class Epi, class Sched, bool ALIGN_EPI = false, bool SP2 = false, bool PROBE_K0 = false, int PF = 0, bool NOSTAGE = false, int ABLK = 0, bool NOWAIT = false, bool NOREAD = false, bool FP8 = false>
__device__ __forceinline__ void gemm_phase(PG8_LAS unsigned char* lds, const Gemm g, const Sched& S, const Epi& E) {
    int tid_ = threadIdx.x; asm volatile("" : "+v"(tid_));
    const int tid = tid_, wid = __builtin_amdgcn_readfirstlane(tid >> 6), lane = tid & 63, wr = wid >> 2, wc = wid & 3, fr = lane & 15, fq = lane >> 4;
    const int K = g.K, nt = K / BK;
    unsigned voffA[2], voffB[2];
#pragma unroll
    for (int i = 0; i < 2; ++i) { int R, C; stage_rc(tid * 16 + i * 8192, R, C); const int Rb = Epi::PERM ? ((R & ~31) + perm32(R & 31)) : R;
        voffA[i] = (unsigned)(R * (ABLK == 2 ? 128 : ABLK == 1 ? 256 : K) + C) * 2u; voffB[i] = (unsigned)(Rb * K + C) * 2u; }
    const size_t kstep = PROBE_K0 ? (size_t)0 : (size_t)(BK * 2);
    const size_t hstepB = (size_t)HALF * K * 2, hstepA = ABLK == 2 ? (size_t)HALF * 256 : ABLK == 1 ? (size_t)HALF * 256 * 2 : hstepB;
    const size_t tstep = 2 * hstepB;
    static_assert(!(ABLK && PF > 0), "L2 warming is not written for the blocked A layout");
    const unsigned pfoff = (unsigned)((wid & 3) * 64 + lane) * (unsigned)K * 2u;
    const unsigned pflds = (unsigned)STAGE_BYTES + 1024u + (unsigned)wid * 256u;
    const unsigned ldsw = (unsigned)wid * 1024u;
    const int aoff = lds_byte(wr * 64 + fr, fq * 8), boff = lds_byte(wc * 32 + fr, fq * 8);
#define PG8_SA(b, h) (((b) * 2 + (h)) * HTB)
#define PG8_SB(b, h) ((4 + (b) * 2 + (h)) * HTB)
#define PG8_STAGE(bufoff, gbase, voff) do { if constexpr (!NOSTAGE) _Pragma("unroll") for (int _i = 0; _i < 2; ++_i) \
        __builtin_amdgcn_global_load_lds((const unsigned*)((const char*)(gbase) + (voff)[_i]), (PG8_LAS unsigned*)(lds + (bufoff) + ldsw + _i * 8192), 16, 0, 0); } while (0)
#define PG8_LDA(dst, b, h) do { if constexpr (!NOREAD) _Pragma("unroll") for (int m = 0; m < 4; ++m) _Pragma("unroll") for (int k = 0; k < 2; ++k) dst[m][k] = *(const PG8_LAS bf16x8*)(lds + PG8_SA(b, h) + aoff + m * 2048 + k * 1024); } while (0)
#define PG8_LDB(dst, b, h) do { if constexpr (!NOREAD) _Pragma("unroll") for (int n = 0; n < 2; ++n) _Pragma("unroll") for (int k = 0; k < 2; ++k) dst[n][k] = *(const PG8_LAS bf16x8*)(lds + PG8_SB(b, h) + boff + n * 2048 + k * 1024); } while (0)
#define PG8_MMA(ai, bj, At, Bt) do { __builtin_amdgcn_s_setprio(1); _Pragma("unroll") for (int m = 0; m < 4; ++m) _Pragma("unroll") for (int n = 0; n < 2; ++n) { \
        if constexpr (FP8 && FP8_MX) mfma_fp8_inplace(acc[ai][bj][m][n], cat8(Bt[n][0], Bt[n][1]), cat8(At[m][0], At[m][1]), one_scale); \
        else if constexpr (FP8) { _Pragma("unroll") for (int k = 0; k < 2; ++k) { const i64x2_ bb = __builtin_bit_cast(i64x2_, Bt[n][k]), aa = __builtin_bit_cast(i64x2_, At[m][k]); \
            acc[ai][bj][m][n] = __builtin_amdgcn_mfma_f32_16x16x32_fp8_fp8(bb[0], aa[0], acc[ai][bj][m][n], 0, 0, 0); acc[ai][bj][m][n] = __builtin_amdgcn_mfma_f32_16x16x32_fp8_fp8(bb[1], aa[1], acc[ai][bj][m][n], 0, 0, 0); } } \
        else { _Pragma("unroll") for (int k = 0; k < 2; ++k) acc[ai][bj][m][n] = __builtin_amdgcn_mfma_f32_16x16x32_bf16(Bt[n][k], At[m][k], acc[ai][bj][m][n], 0, 0, 0); } } __builtin_amdgcn_s_setprio(0); } while (0)
#define PG8_WAIT_V(n) asm volatile("s_waitcnt vmcnt(" #n ")" ::: "memory")
#define PG8_WARM(kt) do { if constexpr (PF > 0) { const int _kt = (kt); const char* _p = (wid < 4) ? ((_kt < nt) ? cA + (size_t)_kt * kstep : nA + (size_t)((_kt - nt) < nt ? (_kt - nt) : nt - 1) * kstep) : ((_kt < nt) ? cB + (size_t)_kt * kstep : nB + (size_t)((_kt - nt) < nt ? (_kt - nt) : nt - 1) * kstep); \
        __builtin_amdgcn_global_load_lds((const unsigned*)(_p + pfoff), (PG8_LAS unsigned*)(lds + pflds), 4, 0, 0); } } while (0)
#define PG8_WAIT_VK() do { if constexpr (NOWAIT) {} else if constexpr (PF > 0) PG8_WAIT_V(9); else PG8_WAIT_V(8); } while (0)
#define PG8_WAIT_L(n) asm volatile("s_waitcnt lgkmcnt(" #n ")" ::: "memory")
#define PG8_BAR __builtin_amdgcn_s_barrier()
#define PG8_SCHED __builtin_amdgcn_sched_barrier(0)
    constexpr bool FP8_MX = true;
    const int one_scale = 0x7f7f7f7f;
    Unit cur, nxt; int ui = 0;
    if (!S.next(0, cur)) return;
    f32x4 acc[2][2][4][2];
#pragma unroll
    for (int a = 0; a < 2; ++a)
#pragma unroll
        for (int b = 0; b < 2; ++b)
#pragma unroll
            for (int m = 0; m < 4; ++m)
#pragma unroll
                for (int n = 0; n < 2; ++n) acc[a][b][m][n] = (f32x4){0.f, 0.f, 0.f, 0.f};
    bf16x8 At[4][2], B0[2][2], B1[2][2];
    if constexpr (NOREAD) {
#pragma unroll
        for (int i = 0; i < 8; ++i) { const bf16x8 v = {(short)(0x3f80 + lane + i), (short)(0x3f00 + i), (short)(0xbf80 + lane), (short)0x3e80, (short)(0x3f80 + i), (short)0xbf00, (short)(0x3f81 + lane), (short)0x3f00}; At[i & 3][i >> 2] = v; if (i < 4) { B0[i & 1][i >> 1] = v; B1[i & 1][i >> 1] = v; } }
    }
    const char* cA = (const char*)g.A + (size_t)cur.pm * tstep; const char* cB = (const char*)g.Bt + (size_t)cur.pn * tstep;
    S.a_ready(cur);
    if constexpr (SP2) {
        PG8_STAGE(PG8_SB(0, 0), cB, voffB); PG8_STAGE(PG8_SB(0, 1), cB + hstepB, voffB); PG8_STAGE(PG8_SA(0, 0), cA, voffA); PG8_STAGE(PG8_SA(0, 1), cA + hstepA, voffA);
        if (wr == 1) PG8_BAR;
        PG8_WAIT_V(2); PG8_BAR;
        PG8_STAGE(PG8_SB(1, 0), cB + kstep, voffB); PG8_STAGE(PG8_SA(1, 0), cA + kstep, voffA); PG8_STAGE(PG8_SB(1, 1), cB + hstepB + kstep, voffB);
        PG8_WAIT_V(6); PG8_BAR;
    } else {
        PG8_STAGE(PG8_SB(0, 0), cB, voffB); PG8_STAGE(PG8_SA(0, 0), cA, voffA); PG8_STAGE(PG8_SB(0, 1), cB + hstepB, voffB); PG8_STAGE(PG8_SA(0, 1), cA + hstepA, voffA);
        if (wr == 1) PG8_BAR;
        PG8_WAIT_V(4); PG8_BAR;
        PG8_STAGE(PG8_SB(1, 0), cB + kstep, voffB); PG8_STAGE(PG8_SA(1, 0), cA + kstep, voffA); PG8_STAGE(PG8_SB(1, 1), cB + hstepB + kstep, voffB);
        PG8_WAIT_V(6); PG8_BAR;
    }
    for (;;) {
        const bool has_next = S.next(ui + 1, nxt);
        const char* nA = has_next ? (const char*)g.A + (size_t)nxt.pm * tstep : cA; const char* nB = has_next ? (const char*)g.Bt + (size_t)nxt.pn * tstep : cB;
        for (int t = 0; t < nt; t += 2) {
            const bool last = (t == nt - 2);
            const char* a1 = cA + (ABLK == 2 ? (size_t)((t + 1) >> 1) * 65536 + (size_t)((t + 1) & 1) * 128 : ABLK == 1 ? (size_t)((t + 1) >> 2) * 131072 + (size_t)((t + 1) & 3) * 128 : (size_t)(t + 1) * kstep);
            const char* a2 = last ? nA : cA + (ABLK == 2 ? (size_t)((t + 2) >> 1) * 65536 + (size_t)((t + 2) & 1) * 128 : ABLK == 1 ? (size_t)((t + 2) >> 2) * 131072 + (size_t)((t + 2) & 3) * 128 : (size_t)(t + 2) * kstep); const char* b2 = last ? nB : cB + (size_t)(t + 2) * kstep;
            const char* a3 = a2 + kstep; const char* b3 = b2 + kstep;
            if (last && has_next) S.a_ready(nxt);
            if constexpr (SP2) {
            PG8_LDB(B0, 0, 0); PG8_LDB(B1, 0, 1); PG8_SCHED; PG8_LDA(At, 0, 0); PG8_STAGE(PG8_SA(1, 1), a1 + hstepA, voffA); PG8_WARM(t + 2 + PF);
            PG8_WAIT_VK(); PG8_WAIT_L(0); PG8_BAR; PG8_MMA(0, 0, At, B0); PG8_MMA(0, 1, At, B1); PG8_BAR; PG8_SCHED;
            PG8_LDA(At, 0, 1); PG8_STAGE(PG8_SB(0, 0), b2, voffB); PG8_STAGE(PG8_SB(0, 1), b2 + hstepB, voffB); PG8_STAGE(PG8_SA(0, 0), a2, voffA);
            PG8_WAIT_VK(); PG8_WAIT_L(0); PG8_BAR; PG8_MMA(1, 0, At, B0); PG8_MMA(1, 1, At, B1); PG8_BAR; PG8_SCHED;
            PG8_LDB(B0, 1, 0); PG8_LDB(B1, 1, 1); PG8_SCHED; PG8_LDA(At, 1, 0); PG8_STAGE(PG8_SA(0, 1), a2 + hstepA, voffA); PG8_WARM(t + 3 + PF);
            PG8_WAIT_VK(); PG8_WAIT_L(0); PG8_BAR; PG8_MMA(0, 0, At, B0); PG8_MMA(0, 1, At, B1); PG8_BAR; PG8_SCHED;
            PG8_LDA(At, 1, 1); PG8_STAGE(PG8_SB(1, 0), b3, voffB); PG8_STAGE(PG8_SB(1, 1), b3 + hstepB, voffB); PG8_STAGE(PG8_SA(1, 0), a3, voffA);
            PG8_WAIT_VK(); PG8_WAIT_L(0); PG8_BAR; PG8_MMA(1, 0, At, B0); PG8_MMA(1, 1, At, B1); PG8_BAR; PG8_SCHED;
            } else {
            PG8_LDB(B0, 0, 0); PG8_SCHED; PG8_LDA(At, 0, 0); PG8_STAGE(PG8_SA(1, 1), a1 + hstepA, voffA);
            PG8_WAIT_L(8); PG8_BAR; PG8_WAIT_L(0); PG8_MMA(0, 0, At, B0); PG8_BAR; PG8_SCHED;
            PG8_LDB(B1, 0, 1); PG8_STAGE(PG8_SB(0, 0), b2, voffB);
            PG8_BAR; PG8_WAIT_L(0); PG8_MMA(0, 1, At, B1); PG8_BAR;
            PG8_LDA(At, 0, 1); PG8_STAGE(PG8_SA(0, 0), a2, voffA);
            PG8_BAR; PG8_WAIT_L(0); PG8_MMA(1, 0, At, B0); PG8_BAR; PG8_SCHED;
            PG8_STAGE(PG8_SB(0, 1), b2 + hstepB, voffB);
            PG8_WAIT_V(6); PG8_BAR; PG8_MMA(1, 1, At, B1); PG8_BAR;
            PG8_LDB(B0, 1, 0); PG8_SCHED; PG8_LDA(At, 1, 0); PG8_STAGE(PG8_SA(0, 1), a2 + hstepA, voffA);
            PG8_WAIT_L(8); PG8_BAR; PG8_WAIT_L(0); PG8_MMA(0, 0, At, B0); PG8_BAR; PG8_SCHED;
            PG8_LDB(B1, 1, 1); PG8_STAGE(PG8_SB(1, 0), b3, voffB);
            PG8_BAR; PG8_WAIT_L(0); PG8_MMA(0, 1, At, B1); PG8_BAR;
            PG8_LDA(At, 1, 1); PG8_STAGE(PG8_SA(1, 0), a3, voffA);
            PG8_BAR; PG8_WAIT_L(0); PG8_MMA(1, 0, At, B0); PG8_BAR; PG8_SCHED;
            PG8_STAGE(PG8_SB(1, 1), b3 + hstepB, voffB);
            PG8_WAIT_V(6); PG8_BAR; PG8_MMA(1, 1, At, B1); PG8_BAR;
            }
        }
        if constexpr (FP8 && FP8_MX) asm volatile("s_nop 15\n\ts_nop 15" ::: "memory");
        if constexpr (ALIGN_EPI) { if (wr == 0) PG8_BAR; }
        if constexpr (!Epi::AFTER_DRAIN) { E(acc, cur, wr, wc, fr, fq); S.done(cur); }
        if (!has_next) break;
#pragma unroll
        for (int a = 0; a < 2; ++a)
#pragma unroll
            for (int b = 0; b < 2; ++b)
#pragma unroll
                for (int m = 0; m < 4; ++m)
#pragma unroll
                    for (int n = 0; n < 2; ++n) acc[a][b][m][n] = (f32x4){0.f, 0.f, 0.f, 0.f};
        cur = nxt; cA = nA; cB = nB; ++ui;
        if constexpr (ALIGN_EPI) { if (wr == 1) PG8_BAR; }
    }
    PG8_WAIT_V(0);
    if constexpr (!ALIGN_EPI) { if (wr == 0) PG8_BAR; }
    PG8_BAR;
    if constexpr (Epi::AFTER_DRAIN) { E.fused(acc, cur, wr, wc, fr, fq, lds, wid, lane); S.done(cur); }
#undef PG8_SA
#undef PG8_SB
#undef PG8_STAGE
#undef PG8_LDA
#undef PG8_LDB
#undef PG8_MMA
#undef PG8_WAIT_V
#undef PG8_WARM
#undef PG8_WAIT_VK
#undef PG8_WAIT_L
#undef PG8_BAR
#undef PG8_SCHED
}
}
constexpr int NWAVES = 8, NTHR = 512;
#ifndef MK_N_LAUNCHES
#define MK_N_LAUNCHES 1
#define PROBE_DOUBLE 0
#define PROBE_KIND 0
#define PROBE_TS (-1)
#define PROBE_TB (PROBE_TS + 1)
#define PROBE_F0 0.0f
#endif
constexpr int N_LAUNCHES = MK_N_LAUNCHES;
constexpr int PER_PHASE = 8;
constexpr int BATCH = 2, SEQ = 16384, DM = 2048, M = BATCH * SEQ, NCH = SEQ / 64;
constexpr int IN_COLS = 8200, PE = 256, NNAT = 6144, NTR = 2048;
constexpr float EPS = 1e-6f;
constexpr int PC_Q = 0, PC_K = 512, PC_OZ = 1024  , PC_HQ = 3072, PC_HF = 4096, PC_HG = 5120;
constexpr size_t MiB = 1u << 20;
constexpr size_t WS_CTL = 0, CTL_ZERO_BYTES = 1 * MiB;
constexpr size_t WS_SSQH = 256 * 1024, WS_SSQ2 = 512 * 1024;
constexpr size_t WS_WIN = 2 * MiB, WS_WO = 34 * MiB, WS_WG = 42 * MiB, WS_WE = 50 * MiB;
constexpr size_t WS_GATES = 52 * MiB;
constexpr size_t WS_BCUM = 53 * MiB;
constexpr size_t WS_MSC = 54 * MiB;
constexpr size_t WS_NST = 55 * MiB;
constexpr size_t WS_GDEC = 56 * MiB;
constexpr size_t WS_EBR = 58 * MiB;
constexpr size_t WS_CARRY = 976 * MiB;
constexpr size_t WS_RMS = 59 * MiB;
constexpr size_t WS_Y = 784 * MiB;
constexpr size_t WS_PB = 64 * MiB;
constexpr size_t WS_U = 80 * MiB;
constexpr size_t WS_PROJ = 208 * MiB;
constexpr size_t WS_VT = 592 * MiB;
constexpr size_t WS_QC = 720 * MiB, WS_KC = 752 * MiB;
constexpr size_t WS_HQT = 784 * MiB, WS_HKT = 848 * MiB, WS_HQ2 = 912 * MiB;
constexpr size_t WS_END = 984 * MiB;
constexpr int CW_TMO = 0, CW_BAR = 4096;
constexpr int RING_BYTES = 131072, LDSCTL_OFF = RING_BYTES, MISC_OFF = LDSCTL_OFF + 320, LDS_BYTES = 147456;

#define GAS __attribute__((address_space(1)))
#define LAS __attribute__((address_space(3)))
typedef unsigned short bf16;
typedef unsigned v4u __attribute__((ext_vector_type(4)));
typedef unsigned v2u __attribute__((ext_vector_type(2)));
typedef float f32x4 __attribute__((ext_vector_type(4)));
typedef float f32x16 __attribute__((ext_vector_type(16)));
typedef short bf16x8 __attribute__((ext_vector_type(8)));
typedef GAS unsigned gu32;
#define RLX_AGENT __ATOMIC_RELAXED, __HIP_MEMORY_SCOPE_AGENT
#define LDS_WAIT() asm volatile("s_waitcnt lgkmcnt(0)" ::: "memory")
#define VM_WAIT() asm volatile("s_waitcnt vmcnt(0)" ::: "memory")
typedef __bf16 bf16x2_t __attribute__((ext_vector_type(2)));
__device__ __forceinline__ unsigned pk2(float lo, float hi) { bf16x2_t v; v[0] = (__bf16)lo; v[1] = (__bf16)hi; return __builtin_bit_cast(unsigned, v); }
__device__ __forceinline__ float bf2f(bf16 v) { return __uint_as_float((unsigned)v << 16); }
__device__ __forceinline__ float blo(unsigned w) { return __uint_as_float(w << 16); }
__device__ __forceinline__ float bhi(unsigned w) { return __uint_as_float(w & 0xffff0000u); }
__device__ __forceinline__ float frcp(float x) { return __builtin_amdgcn_rcpf(x); }
__device__ __forceinline__ float frsq(float x) { return __builtin_amdgcn_rsqf(x); }
__device__ __forceinline__ float fexp(float x) { return __expf(x); }
__device__ __forceinline__ float flog(float x) { return __logf(x); }
__device__ __forceinline__ float sigm(float x) { return frcp(1.0f + __expf(-x)); }

#define XB_TMO      128
#define XB_XCNT(j)  (256  + 64 * (j))
#define XB_XSUB(j)  (1280 + 64 * (j))
#define XB_XGEN(j)  (2304 + 64 * (j))
#define XB_TOP      3328
#define XB_TOPGEN   3392
#define XCD_BAR_WORDS 3456
#define XB_SPIN_CAP (1u << 18)
__device__ __forceinline__ unsigned xb_ld(unsigned* p)              { return __hip_atomic_load(p, __ATOMIC_RELAXED, __HIP_MEMORY_SCOPE_AGENT); }
__device__ __forceinline__ unsigned xb_add(unsigned* p, unsigned v) { return __hip_atomic_fetch_add(p, v, __ATOMIC_RELAXED, __HIP_MEMORY_SCOPE_AGENT); }
__device__ __forceinline__ unsigned xb_xcc_id() { return (unsigned)__builtin_amdgcn_s_getreg((3 << 11) | 20) & 0xFu; }
#define XB_SPIN(cond, bar) do { unsigned _sp = 0; while (cond) { __builtin_amdgcn_s_sleep(1); \
    if ((++_sp & 255u) == 0u) { if (xb_ld(&(bar)[XB_TMO])) break; if (_sp > XB_SPIN_CAP) { atomicAdd(&(bar)[XB_TMO], 1u); break; } } } } while (0)
struct XcdBarrier { unsigned* bar; unsigned x; volatile LAS unsigned* st; };
__device__ __forceinline__ XcdBarrier xcd_barrier_post(unsigned* bar, volatile LAS unsigned* st) {
    XcdBarrier b; b.bar = bar; b.x = xb_xcc_id(); b.st = st;
    if (threadIdx.x == 0) st[3] = xb_add(&bar[XB_XCNT(b.x)], 1u);
    return b;
}
__device__ __forceinline__ void xcd_barrier_complete(unsigned* bar, unsigned x, unsigned& nloc, unsigned& nx, unsigned& even) {
    const unsigned G = gridDim.x * gridDim.y * gridDim.z;
    unsigned sum, cnt, mine, sp = 0u, ev;
    for (;;) {
        sum = 0u; cnt = 0u; mine = 0u; ev = 1u;
#pragma unroll
        for (unsigned j = 0; j < 16; ++j) { const unsigned c = xb_ld(&bar[XB_XCNT(j)]); sum += c; cnt += (c > 0u) ? 1u : 0u; mine = (j == x) ? c : mine; ev &= (j < 8u) ? (c * 8u == G ? 1u : 0u) : (c == 0u ? 1u : 0u); }
        if (sum == G) break;
        __builtin_amdgcn_s_sleep(1);
        if ((++sp & 255u) == 0u) { if (xb_ld(&bar[XB_TMO])) break; if (sp > XB_SPIN_CAP) { atomicAdd(&bar[XB_TMO], 1u); break; } }
    }
    nloc = mine > 0u ? mine : 1u; nx = cnt > 0u ? cnt : 1u; even = (sum == G) ? ev : 0u;
}
__device__ __forceinline__ void xcd_barrier(const XcdBarrier& b) {
    asm volatile("s_waitcnt vmcnt(0)" ::: "memory");
    __syncthreads();
    if (threadIdx.x == 0) {
        unsigned* bar = b.bar;
        __builtin_amdgcn_s_waitcnt(0);
        unsigned nloc = b.st[0], nx = b.st[1];
        if (nloc == 0u) { unsigned even; xcd_barrier_complete(bar, b.x, nloc, nx, even); b.st[0] = nloc; b.st[1] = nx; b.st[2] = even; }
        const unsigned old = xb_add(&bar[XB_XSUB(b.x)], 1u);
        const unsigned gen = old / nloc;
        if (old + 1u == (gen + 1u) * nloc) {
            __builtin_amdgcn_fence(__ATOMIC_RELEASE, "agent");
            asm volatile("s_waitcnt vmcnt(0)" ::: "memory");
            const unsigned og = xb_add(&bar[XB_TOP], 1u);
            const unsigned tg = og / nx;
            if (og + 1u == (tg + 1u) * nx) xb_add(&bar[XB_TOPGEN], 1u);
            else XB_SPIN(xb_ld(&bar[XB_TOPGEN]) == tg, bar);
            __builtin_amdgcn_fence(__ATOMIC_ACQUIRE, "agent");
            xb_add(&bar[XB_XGEN(b.x)], 1u);
            asm volatile("s_waitcnt vmcnt(0)" ::: "memory");
        } else {
            XB_SPIN(xb_ld(&bar[XB_XGEN(b.x)]) == gen, bar);
            __builtin_amdgcn_fence(__ATOMIC_ACQUIRE, "agent");
            asm volatile("s_waitcnt vmcnt(0)" ::: "memory");
        }
    }
    __syncthreads();
}

struct Frame {
    LAS unsigned char* lds;
    int tid, lane, wave, G, bid;
    const float *x, *p, *norm_w, *w_in, *conv_w, *conv_b, *b_i, *b_f, *ml_nw, *hg_lb, *hg_nw, *w_out, *pe_nw, *w_pg, *w_pe, *fin_nw;
    float* out;
    bf16 *Wt_in, *WoT, *WgT, *WeT, *PB, *U, *Y, *PROJ, *HB, *EB, *VT, *Cm, *Ch, *QC, *KC, *HQT, *HKT, *HQ2;
    float *gates, *bcum, *msc, *nst, *gdec, *ebr, *carry, *ssqh, *ssq2;
};
__device__ __forceinline__ size_t proj_off(int m, int n) { return ((size_t)((m >> 8) * 24 + (n >> 8)) << 16) + (size_t)((m & 255) * 256 + (n & 255)); }
__device__ __forceinline__ size_t vt_off(int v, int m) { return ((size_t)((v >> 8) * 128 + (m >> 8)) << 16) + (size_t)((v & 255) * 256 + (m & 255)); }
__device__ __forceinline__ float wave_sum(float v) {
#pragma unroll
    for (int o = 1; o < 64; o <<= 1) v += __shfl_xor(v, o);
    return v;
}
__device__ __forceinline__ float wave_max(float v) {
#pragma unroll
    for (int o = 1; o < 64; o <<= 1) v = fmaxf(v, __shfl_xor(v, o));
    return v;
}
__device__ __forceinline__ float wave_scan_sum(float v, int lane) {
#pragma unroll
    for (int o = 1; o < 64; o <<= 1) { const float y = __shfl_up(v, o); if (lane >= o) v += y; }
    return v;
}
__device__ __forceinline__ float wave_scan_max(float v, int lane) {
#pragma unroll
    for (int o = 1; o < 64; o <<= 1) { const float y = __shfl_up(v, o); if (lane >= o) v = fmaxf(v, y); }
    return v;
}
__device__ __forceinline__ int opaque_i(int v) { asm volatile("" : "+v"(v)); return v; }
__device__ __forceinline__ f32x16 mfma32(bf16x8 a, bf16x8 b, f32x16 c) { return __builtin_amdgcn_mfma_f32_32x32x16_bf16(a, b, c, 0, 0, 0); }
__device__ __forceinline__ f32x16 zero16() { f32x16 z;
#pragma unroll
    for (int i = 0; i < 16; ++i) z[i] = 0.f;
    return z; }

constexpr float WG_SCALE = 256.0f, HB8_SCALE = 16.0f;
constexpr size_t HB8_OFF = 256 * MiB;
__device__ __forceinline__ void p0_transpose_item(const float* W, int ldw, int src_col, int K, bf16* WT, int dst_row, const float* kscale, LAS float* scr, int k0, int lane) {
#pragma unroll 8
    for (int i = 0; i < 32; ++i) { const int kk = 2 * i + (lane >> 5); float v = W[(size_t)(k0 + kk) * ldw + src_col + (lane & 31)]; if (kscale) v *= kscale[k0 + kk]; scr[kk * 33 + (lane & 31)] = v; }
    LDS_WAIT(); asm volatile("" ::: "memory");
    const int c = lane & 7;
#pragma unroll
    for (int j = 0; j < 4; ++j) { const int n = (lane >> 3) + 8 * j; const LAS float* s = scr + (8 * c) * 33 + n;
        v4u o; o.x = pk2(s[0 * 33], s[1 * 33]); o.y = pk2(s[2 * 33], s[3 * 33]); o.z = pk2(s[4 * 33], s[5 * 33]); o.w = pk2(s[6 * 33], s[7 * 33]);
        *(v4u*)(WT + (size_t)(dst_row + n) * K + k0 + 8 * c) = o; }
    LDS_WAIT(); asm volatile("" ::: "memory");
}
__device__ __forceinline__ void p0_transpose_item_fp8(const float* W, int ldw, int src_col, int K, unsigned char* WT, int dst_row, const float* kscale, float scale, LAS float* scr, int k0, int lane) {
#pragma unroll 8
    for (int i = 0; i < 32; ++i) { const int kk = 2 * i + (lane >> 5); const float v = W[(size_t)(k0 + kk) * ldw + src_col + (lane & 31)] * (kscale[k0 + kk] * scale); scr[kk * 33 + (lane & 31)] = v; }
    LDS_WAIT(); asm volatile("" ::: "memory");
    const int c = lane & 7;
#pragma unroll
    for (int j = 0; j < 4; ++j) { const int n = (lane >> 3) + 8 * j; const LAS float* s = scr + (8 * c) * 33 + n;
        v2u o; o.x = pg8::cvt_pk4_fp8(s[0 * 33], s[1 * 33], s[2 * 33], s[3 * 33]); o.y = pg8::cvt_pk4_fp8(s[4 * 33], s[5 * 33], s[6 * 33], s[7 * 33]);
        *(v2u*)(WT + (size_t)(dst_row + n) * K + k0 + 8 * c) = o; }
    LDS_WAIT(); asm volatile("" ::: "memory");
}
__device__ __forceinline__ int win_src_col(int r) { if (r >= 1024 && r < 3072) { const int q = r - 1024, i = q >> 8, rr = q & 255; return rr < 128 ? 2048 + 128 * i + rr : 3072 + 128 * i + (rr - 128); }
    return r < 1024 ? r : r < 5120 ? r + 1032 : r < 6144 ? r + 2056 : r < 7168 ? r - 5120 : r - 1016; }
__device__ __forceinline__ void p0_prologue(const Frame& F) {
    LAS float* scr = (LAS float*)(F.lds + F.wave * 16384);
    const int gw = F.bid * NWAVES + F.wave, NGW = F.G * NWAVES, lane = F.lane;
    for (int it = gw; it < 12544; it += NGW) {
        int r = it;
        if (r < 8192) { const int kb = r >> 8, nb = r & 255; p0_transpose_item(F.w_in, IN_COLS, win_src_col(nb * 32), DM, F.Wt_in, nb * 32, nullptr, scr, kb * 64, lane); continue; } r -= 8192;
        if (r < 2048) { const int kb = r >> 6, nb = r & 63; p0_transpose_item(F.w_out, DM, nb * 32, DM, F.WoT, nb * 32, nullptr, scr, kb * 64, lane); continue; } r -= 2048;
        if (r < 2048) { const int kb = r >> 6, nb = r & 63; p0_transpose_item_fp8(F.w_pg, DM, nb * 32, DM, (unsigned char*)F.WgT, nb * 32, F.pe_nw, WG_SCALE, scr, kb * 64, lane); continue; } r -= 2048;
        { const int kb = r >> 6, nb = r & 63; p0_transpose_item(F.w_pe, DM, nb * 32, PE, F.WeT, nb * 32, nullptr, scr, kb * 64, lane); }
    }
    for (int idx = F.bid * NTHR + F.tid; idx < M * PE / 4; idx += F.G * NTHR) { const f32x4 v = ((const f32x4*)F.p)[idx]; v2u o; o.x = pk2(v[0], v[1]); o.y = pk2(v[2], v[3]); ((v2u*)F.PB)[idx] = o; }
    __syncthreads();
    LAS float* Wg = (LAS float*)F.lds;
    for (int k = F.tid; k < DM; k += NTHR) { const f32x4 a = *(const f32x4*)(F.w_in + (size_t)k * IN_COLS + 4096), b = *(const f32x4*)(F.w_in + (size_t)k * IN_COLS + 4100);
        Wg[0 * DM + k] = a[0]; Wg[1 * DM + k] = a[1]; Wg[2 * DM + k] = a[2]; Wg[3 * DM + k] = a[3]; Wg[4 * DM + k] = b[0]; Wg[5 * DM + k] = b[1]; Wg[6 * DM + k] = b[2]; Wg[7 * DM + k] = b[3]; }
    __syncthreads();
    const f32x4* nwp = (const f32x4*)F.norm_w + lane;
    const float gbias = lane < 4 ? F.b_i[lane & 3] : F.b_f[lane & 3];
    for (int m = gw; m < M; m += NGW) {
        asm volatile("" ::: "memory");
        const f32x4* xr = (const f32x4*)(F.x + (size_t)m * DM) + lane;
        f32x4 t[8]; float ss = 0.f; float ga[8];
#pragma unroll
        for (int c = 0; c < 8; ++c) ga[c] = 0.f;
#pragma unroll
        for (int j = 0; j < 8; ++j) { const f32x4 v = __builtin_nontemporal_load(xr + 64 * j); ss += (v[0] * v[0] + v[1] * v[1]) + (v[2] * v[2] + v[3] * v[3]); t[j] = v * nwp[64 * j]; }
#pragma unroll
        for (int j = 0; j < 8; ++j)
#pragma unroll
            for (int c = 0; c < 8; ++c) { const f32x4 w = *(const LAS f32x4*)(Wg + c * DM + 4 * lane + 256 * j); ga[c] += (t[j][0] * w[0] + t[j][1] * w[1]) + (t[j][2] * w[2] + t[j][3] * w[3]); }
        ss = wave_sum(ss); const float rstd = 1.0f / sqrtf(ss * (1.0f / DM) + EPS);
#pragma unroll
        for (int c = 0; c < 8; ++c) ga[c] = wave_sum(ga[c]) * rstd;
        v2u* uo = (v2u*)(F.U + (size_t)m * DM) + lane;
#pragma unroll
        for (int j = 0; j < 8; ++j) { const f32x4 q = t[j] * rstd; v2u o; o.x = pk2(q[0], q[1]); o.y = pk2(q[2], q[3]); uo[64 * j] = o; }
        float gv = ga[0];
        gv = lane == 1 ? ga[1] : gv; gv = lane == 2 ? ga[2] : gv; gv = lane == 3 ? ga[3] : gv; gv = lane == 4 ? ga[4] : gv; gv = lane == 5 ? ga[5] : gv; gv = lane == 6 ? ga[6] : gv; gv = lane == 7 ? ga[7] : gv;
        if (lane < 8) F.gates[(size_t)m * 8 + lane] = gv + gbias;
        if (lane == 8) F.gates[(WS_RMS - WS_GATES) / 4 + m] = 1.0f / rstd;
    }
}
__device__ __forceinline__ v4u ld16(const bf16* p) { return __builtin_nontemporal_load((const v4u*)p); }
__device__ __forceinline__ void st_bf(LAS bf16* p, float v) { *p = (bf16)(pk2(v, v) & 0xffffu); }
__device__ __forceinline__ void conv_lds_16(const float (&cw)[5], const LAS bf16* col, float scale, float (&out)[16]) {
    float r0 = bf2f(col[0]), r1 = bf2f(col[136]), r2 = bf2f(col[272]);
#pragma unroll
    for (int jj = 0; jj < 16; ++jj) { const float xv = bf2f(col[(jj + 3) * 136]); const float cv = cw[4] + cw[0] * r0 + cw[1] * r1 + cw[2] * r2 + cw[3] * xv; r0 = r1; r1 = r2; r2 = xv; out[jj] = cv * sigm(cv) * scale; }
}
__device__ __forceinline__ void conv_inplace_32(const float (&cw)[5], LAS bf16* col, float t0, float t1, float t2, float scale) {
    float r0 = bf2f(col[0]), r1 = bf2f(col[136]), r2 = bf2f(col[272]);
#pragma unroll
    for (int jj = 0; jj < 32; ++jj) { const float xv = jj < 29 ? bf2f(col[(jj + 3) * 136]) : (jj == 29 ? t0 : jj == 30 ? t1 : t2); const float cv = cw[4] + cw[0] * r0 + cw[1] * r1 + cw[2] * r2 + cw[3] * xv; r0 = r1; r1 = r2; r2 = xv; st_bf(col + jj * 136, cv * sigm(cv) * scale); }
}
constexpr int NCH2 = SEQ / 128;
constexpr size_t ST_PAD = 2048 + 128, CM_US = 256 * 128 + ST_PAD, CH_US = 128 * 128 + ST_PAD;
constexpr int PA_KR = 0, PA_KT = 36864, PA_F32 = 71680;
struct PaM { v4u rk[4], hk; float ig[2], fp[2]; bf16x8 bfr[8]; float cwk[5]; };
__device__ __forceinline__ void pa_mlstm_load(const Frame& F, int bh, int C, PaM& L) {
    const int b = bh >> 2, h = bh & 3, m0 = b * SEQ + C * 128, tid = opaque_i(F.tid), lane = tid & 63, wave = F.wave, r32 = lane & 31, hi = lane >> 5;
    L.hk = (v4u){0u, 0u, 0u, 0u}; L.ig[0] = 0.f; L.ig[1] = 0.f; L.fp[0] = 0.f; L.fp[1] = 0.f;
#pragma unroll
    for (int i = 0; i < 4; ++i) { const int idx = tid + 512 * i, row = idx >> 4, ch = idx & 15; L.rk[i] = ld16(F.PROJ + proj_off(m0 + row, PC_K + h * 128) + ch * 8); }
    if (tid < 48 && C != 0) { const int row = tid >> 4, ch = tid & 15; L.hk = ld16(F.PROJ + proj_off(m0 - 3 + row, PC_K + h * 128) + ch * 8); }
    if (wave == 0) {
#pragma unroll
        for (int hf = 0; hf < 2; ++hf) { L.ig[hf] = F.gates[(size_t)(m0 + 64 * hf + lane) * 8 + h]; L.fp[hf] = F.gates[(size_t)(m0 + 64 * hf + lane) * 8 + 4 + h]; } }
    const bf16* vt = F.VT + vt_off(h * 256 + 32 * wave + r32, m0) + 8 * hi;
#pragma unroll
    for (int ks = 0; ks < 8; ++ks) L.bfr[ks] = *(const bf16x8*)(vt + 16 * ks);
    const int chk = 512 + h * 128 + (tid & 127);
#pragma unroll
    for (int i = 0; i < 4; ++i) L.cwk[i] = F.conv_w[i * 1024 + chk];
    L.cwk[4] = F.conv_b[chk];
}
__device__ __forceinline__ void pa_mlstm_fill(const Frame& F, const PaM& L) {
    const int tid = opaque_i(F.tid);
    LAS bf16* KR = (LAS bf16*)(F.lds + PA_KR);
#pragma unroll
    for (int i = 0; i < 4; ++i) { const int idx = tid + 512 * i, row = idx >> 4, ch = idx & 15; *(LAS v4u*)(KR + (row + 3) * 136 + ch * 8) = L.rk[i]; }
    if (tid < 48) { const int row = tid >> 4, ch = tid & 15; *(LAS v4u*)(KR + row * 136 + ch * 8) = L.hk; }
}
__device__ __forceinline__ void pa_mlstm_gates(const Frame& F, int bh, int C, const PaM& L) {
    const int unit = bh * NCH2 + C, lane = opaque_i(F.lane);
    LAS float* wl = (LAS float*)(F.lds + PA_F32);
    if (F.wave == 0) {
        const float lf0 = fminf(L.fp[0], 0.f) - flog(1.0f + fexp(-fabsf(L.fp[0]))), lf1 = fminf(L.fp[1], 0.f) - flog(1.0f + fexp(-fabsf(L.fp[1])));
        const float b0 = wave_scan_sum(lf0, lane), t0 = __shfl(b0, 63), b1 = t0 + wave_scan_sum(lf1, lane);
        const float g = __shfl(b1, 63);
        const float a0 = g - b0 + L.ig[0], a1 = g - b1 + L.ig[1];
        const float ml = wave_max(fmaxf(a0, a1));
        wl[lane] = fexp(a0 - ml); wl[64 + lane] = fexp(a1 - ml);
        F.bcum[(size_t)bh * SEQ + C * 128 + lane] = b0; F.bcum[(size_t)bh * SEQ + C * 128 + 64 + lane] = b1;
        if (lane == 0) { F.msc[unit * 4 + 0] = g; F.msc[unit * 4 + 1] = ml; }
    }
}
__device__ __forceinline__ void pa_mlstm_compute(const Frame& F, int bh, int C, const PaM& L) {
    const int unit = bh * NCH2 + C, tid = opaque_i(F.tid), lane = tid & 63, wave = F.wave, r32 = lane & 31, hi = lane >> 5;
    LAS bf16 *KR = (LAS bf16*)(F.lds + PA_KR), *kT = (LAS bf16*)(F.lds + PA_KT);
    LAS float* wl = (LAS float*)(F.lds + PA_F32); LAS float* nsum = wl + 128;
    const int d = tid & 127, jq = tid >> 7;
    float ns = 0.f;
    __syncthreads();
#pragma unroll
    for (int s = 0; s < 2; ++s) {
        float kv[16];
        conv_lds_16(L.cwk, KR + (32 * jq + 16 * s) * 136 + d, 0.08838834764831845f, kv);
        unsigned pk[8];
#pragma unroll
        for (int jj = 0; jj < 16; ++jj) { kv[jj] *= wl[32 * jq + 16 * s + jj]; ns += kv[jj]; }
#pragma unroll
        for (int i = 0; i < 8; ++i) pk[i] = pk2(kv[2 * i], kv[2 * i + 1]);
        LAS v4u* dst = (LAS v4u*)(kT + d * 136 + 32 * jq + 16 * s);
        dst[0] = (v4u){pk[0], pk[1], pk[2], pk[3]}; dst[1] = (v4u){pk[4], pk[5], pk[6], pk[7]};
    }
    nsum[jq * 128 + d] = ns;
    __syncthreads();
    if (tid < 128) F.nst[(size_t)unit * 128 + tid] = (nsum[tid] + nsum[128 + tid]) + (nsum[256 + tid] + nsum[384 + tid]);
    {
        f32x16 acc[4];
#pragma unroll
        for (int i = 0; i < 4; ++i) acc[i] = zero16();
#pragma unroll
        for (int ks = 0; ks < 8; ++ks)
#pragma unroll
            for (int dt = 0; dt < 4; ++dt) { const bf16x8 afr = *(const LAS bf16x8*)(kT + (32 * dt + r32) * 136 + 16 * ks + 8 * hi); acc[dt] = mfma32(afr, L.bfr[ks], acc[dt]); }
        LAS bf16* pt = (LAS bf16*)(F.lds + PA_KR) + wave * (32 * 72);
        bf16* dst = F.Cm + (size_t)unit * CM_US + (32 * wave) * 128;
#pragma unroll
        for (int rd = 0; rd < 2; ++rd) {
#pragma unroll
            for (int i = 0; i < 2; ++i)
#pragma unroll
                for (int q = 0; q < 4; ++q) { const int dt = 2 * rd + i; v2u w; w.x = pk2(acc[dt][4 * q], acc[dt][4 * q + 1]); w.y = pk2(acc[dt][4 * q + 2], acc[dt][4 * q + 3]); *(LAS v2u*)(pt + r32 * 72 + 32 * i + 8 * q + 4 * hi) = w; }
            LDS_WAIT();
#pragma unroll
            for (int k = 0; k < 4; ++k) { const int row = 8 * k + (lane >> 3), ch = lane & 7; *(v4u*)(dst + (size_t)row * 128 + 64 * rd + ch * 8) = *(const LAS v4u*)(pt + row * 72 + ch * 8); }
            LDS_WAIT();
        }
    }
    __syncthreads();
}
constexpr int PH_FR = 0, PH_KT = 34816, PH_F32 = 69632, PH_PATCH = 73728;
struct PaH { v4u rf[4]; bf16x8 bfr[8]; float lb; };
__device__ __forceinline__ void pa_hgrn2_load(const Frame& F, int bh, int C, PaH& L) {
    const int b = bh >> 3, h = bh & 7, m0 = b * SEQ + C * 128, tid = opaque_i(F.tid), lane = tid & 63, wave = F.wave, r32 = lane & 31, hi = lane >> 5, vt_i = wave & 3;
#pragma unroll
    for (int i = 0; i < 4; ++i) { const int idx = tid + 512 * i, row = idx >> 4, ch = idx & 15; L.rf[i] = ld16(F.PROJ + proj_off(m0 + row, PC_HF + h * 128) + ch * 8); }
    const bf16* vt = F.VT + vt_off(1024 + h * 128 + 32 * vt_i + r32, m0) + 8 * hi;
#pragma unroll
    for (int ks = 0; ks < 8; ++ks) L.bfr[ks] = *(const bf16x8*)(vt + 16 * ks);
    const int e = tid & 127;
    L.lb = F.hg_lb[1024 + h * 128 + e] - F.hg_lb[h * 128 + e];
}
__device__ __forceinline__ void pa_hgrn2_fill(const Frame& F, const PaH& L) {
    const int tid = opaque_i(F.tid);
    LAS bf16* FR = (LAS bf16*)(F.lds + PH_FR);
#pragma unroll
    for (int i = 0; i < 4; ++i) { const int idx = tid + 512 * i, row = idx >> 4, ch = idx & 15; *(LAS v4u*)(FR + row * 136 + ch * 8) = L.rf[i]; }
}
__device__ __forceinline__ void pa_hgrn2_compute(const Frame& F, int bh, int C, const PaH& L) {
    const int unit = bh * NCH2 + C, tid = opaque_i(F.tid), lane = tid & 63, wave = F.wave, r32 = lane & 31, hi = lane >> 5;
    LAS bf16 *FR = (LAS bf16*)(F.lds + PH_FR), *kT = (LAS bf16*)(F.lds + PH_KT);
    LAS float* seg = (LAS float*)(F.lds + PH_F32);
    const int vt_i = wave & 3, et0 = 2 * (wave >> 2);
    const int e = tid & 127, jq = tid >> 7;
    const float lb = frcp(1.0f + fexp(L.lb));
    __syncthreads();
    float kv[32]; float suf = 1.0f;
#pragma unroll
    for (int jj = 0; jj < 32; ++jj) { const float xv = bf2f(FR[(32 * jq + jj) * 136 + e]); kv[jj] = lb + (1.0f - lb) * sigm(xv); }
#pragma unroll
    for (int jj = 31; jj >= 0; --jj) { const float fj = kv[jj]; kv[jj] = (1.0f - fj) * suf; suf *= fj; }
    seg[jq * 128 + e] = suf;
    __syncthreads();
    {
        const float s0 = seg[e], s1 = seg[128 + e], s2 = seg[256 + e], s3 = seg[384 + e];
        const float later = jq == 0 ? s1 * s2 * s3 : jq == 1 ? s2 * s3 : jq == 2 ? s3 : 1.0f;
        LAS v4u* dst = (LAS v4u*)(kT + e * 136 + 32 * jq);
#pragma unroll
        for (int i4 = 0; i4 < 4; ++i4) { unsigned pk[4];
#pragma unroll
            for (int i = 0; i < 4; ++i) { const int j0 = 8 * i4 + 2 * i; pk[i] = pk2(kv[j0] * later, kv[j0 + 1] * later); }
            dst[i4] = (v4u){pk[0], pk[1], pk[2], pk[3]}; }
        if (jq == 0) { F.gdec[(size_t)unit * 128 + e] = (s0 * s1) * (s2 * s3); F.ebr[(size_t)unit * 128 + e] = s0 * s1; }
    }
    __syncthreads();
    {
        f32x16 acc[2]; acc[0] = zero16(); acc[1] = zero16();
#pragma unroll
        for (int ks = 0; ks < 8; ++ks)
#pragma unroll
            for (int i = 0; i < 2; ++i) { const bf16x8 afr = *(const LAS bf16x8*)(kT + (32 * (et0 + i) + r32) * 136 + 16 * ks + 8 * hi); acc[i] = mfma32(afr, L.bfr[ks], acc[i]); }
        LAS bf16* pt = (LAS bf16*)(F.lds + PH_PATCH) + wave * (32 * 72);
#pragma unroll
        for (int i = 0; i < 2; ++i)
#pragma unroll
            for (int q = 0; q < 4; ++q) { v2u w; w.x = pk2(acc[i][4 * q], acc[i][4 * q + 1]); w.y = pk2(acc[i][4 * q + 2], acc[i][4 * q + 3]); *(LAS v2u*)(pt + r32 * 72 + 32 * i + 8 * q + 4 * hi) = w; }
        LDS_WAIT();
        bf16* dst = F.Ch + (size_t)unit * CH_US + (32 * vt_i) * 128 + 32 * et0;
#pragma unroll
        for (int k = 0; k < 4; ++k) { const int row = 8 * k + (lane >> 3), ch = lane & 7; *(v4u*)(dst + (size_t)row * 128 + ch * 8) = *(const LAS v4u*)(pt + row * 72 + ch * 8); }
    }
    __syncthreads();
}
constexpr int NSLAB = 1, CPS = NCH / NSLAB, CPS_SH = 8;
static_assert(CPS == (1 << CPS_SH) && NSLAB == 1, "slab size; the 128-token HGRN2 units are written for one slab");
__device__ __forceinline__ void pa_phase(const Frame& F, int c_lo, volatile LAS unsigned long long* tsl) {
    { PaM cur; int id = F.bid; pa_mlstm_load(F, id >> 7, id & 127, cur);
      for (; id < 8 * NCH2; id += F.G) { const int nid = (id + F.G < 8 * NCH2) ? id + F.G : id;
          pa_mlstm_fill(F, cur); pa_mlstm_gates(F, id >> 7, id & 127, cur);
          PaM nxt; pa_mlstm_load(F, nid >> 7, nid & 127, nxt);
          pa_mlstm_compute(F, id >> 7, id & 127, cur); cur = nxt; } }
    if (PROBE_TS >= 0 && F.tid == 0) tsl[9] = __builtin_amdgcn_s_memrealtime();
    { PaH cur; int id = F.bid; pa_hgrn2_load(F, id >> 7, id & 127, cur);
      for (; id < 16 * NCH2; id += F.G) { const int nid = (id + F.G < 16 * NCH2) ? id + F.G : id;
          pa_hgrn2_fill(F, cur);
          PaH nxt; pa_hgrn2_load(F, nid >> 7, nid & 127, nxt);
          pa_hgrn2_compute(F, id >> 7, id & 127, cur); cur = nxt; } }
}
__device__ __forceinline__ void unpack8(const v4u k, float (&o)[8]) { o[0] = blo(k.x); o[1] = bhi(k.x); o[2] = blo(k.y); o[3] = bhi(k.y); o[4] = blo(k.z); o[5] = bhi(k.z); o[6] = blo(k.w); o[7] = bhi(k.w); }
__device__ __forceinline__ v4u pack8(const float (&s)[8]) { v4u o; o.x = pk2(s[0], s[1]); o.y = pk2(s[2], s[3]); o.z = pk2(s[4], s[5]); o.w = pk2(s[6], s[7]); return o; }
__device__ __forceinline__ void scan_phase(const Frame& F, int c_lo, int c_hi) {
    typedef float f32x2 __attribute__((ext_vector_type(2)));
    constexpr int SB = 16;
    const int lane_ = opaque_i(F.lane);
    const int item = ((F.bid * 4 + (F.wave >> 1)) << 6) + lane_;
    const int gt = (F.wave & 1) ? 65536 + item : item;
    if ((F.wave & 1) == 0) {
        const int bh = gt >> 13, v = (gt >> 5) & 255, dg = gt & 31;
        bf16* ptr = F.Cm + (size_t)(bh * NCH2) * CM_US + v * 128 + dg * 4;
        float* ms = F.msc + (size_t)bh * NCH2 * 4;
        const int wq = (item >> 6) & 127;
        float* np = F.nst + (size_t)bh * NCH2 * 128 + wq;
        const bool nth = (lane_ == 0);
        bf16* ptr_s = ptr; asm volatile("" : "+v"(ptr_s));
        float C0 = 0.f, C1 = 0.f, C2 = 0.f, C3 = 0.f, n0 = 0.f, m = 0.f;
        float* cr = F.carry + (size_t)gt * 12;
        if (c_lo != 0) { const f32x4 a = *(const f32x4*)cr; C0 = a[0]; C1 = a[1]; C2 = a[2]; C3 = a[3]; n0 = cr[4]; m = cr[8]; }
        for (int c0 = c_lo >> 1; c0 < (c_hi >> 1); c0 += SB) {
            v2u K[SB]; f32x2 gm[SB]; float nl[SB];
#pragma unroll
            for (int i = 0; i < SB; ++i) { K[i] = *(const v2u*)(ptr + (size_t)(c0 + i) * CM_US); gm[i] = *(const f32x2*)(ms + (c0 + i) * 4); }
            if (nth) {
#pragma unroll
                for (int i = 0; i < SB; ++i) nl[i] = np[(c0 + i) * 128];
            }
#pragma unroll
            for (int i = 0; i < SB; ++i) { const int c = c0 + i;
                const float g = gm[i][0], ml = gm[i][1];
                const float mn = fmaxf(g + m, ml), ws = fexp(g + m - mn), fl = fexp(ml - mn);
                v2u o; o.x = pk2(C0, C1); o.y = pk2(C2, C3); *(v2u*)(ptr_s + (size_t)c * CM_US) = o;
                C0 = ws * C0 + fl * blo(K[i].x); C1 = ws * C1 + fl * bhi(K[i].x); C2 = ws * C2 + fl * blo(K[i].y); C3 = ws * C3 + fl * bhi(K[i].y);
                if (nth) {
                    np[c * 128] = n0;
                    n0 = ws * n0 + fl * nl[i];
                    if (wq == 0) ms[c * 4 + 2] = m;
                }
                m = mn; }
        }
        if (c_hi != NCH) { *(f32x4*)cr = (f32x4){C0, C1, C2, C3}; cr[4] = n0; cr[8] = m; }
    } else {
        const int g2 = gt - 65536, bh = g2 >> 12, v = (g2 >> 5) & 127, eg = g2 & 31;
        bf16* ptr = F.Ch + (size_t)(bh * NCH2) * CH_US + v * 128 + eg * 4;
        const float* gd = F.gdec + (size_t)bh * NCH2 * 128 + eg * 4;
        const float* eb = F.ebr + (size_t)bh * NCH2 * 128 + eg * 4;
        bf16* ptr_s = ptr; asm volatile("" : "+v"(ptr_s));
        float S0 = 0.f, S1 = 0.f, S2 = 0.f, S3 = 0.f;
        float* cr = F.carry + (size_t)gt * 12;
        if (c_lo != 0) { const f32x4 a = *(const f32x4*)cr; S0 = a[0]; S1 = a[1]; S2 = a[2]; S3 = a[3]; }
        for (int c0 = c_lo >> 1; c0 < (c_hi >> 1); c0 += SB) {
            v2u K[SB]; f32x4 D[SB], E[SB];
#pragma unroll
            for (int i = 0; i < SB; ++i) { K[i] = *(const v2u*)(ptr + (size_t)(c0 + i) * CH_US); D[i] = *(const f32x4*)(gd + (c0 + i) * 128); E[i] = *(const f32x4*)(eb + (c0 + i) * 128); }
#pragma unroll
            for (int i = 0; i < SB; ++i) { const int c = c0 + i;
                v2u o; o.x = pk2(S0 * E[i][0], S1 * E[i][1]); o.y = pk2(S2 * E[i][2], S3 * E[i][3]); *(v2u*)(ptr_s + (size_t)c * CH_US) = o;
                S0 = D[i][0] * S0 + blo(K[i].x); S1 = D[i][1] * S1 + bhi(K[i].x); S2 = D[i][2] * S2 + blo(K[i].y); S3 = D[i][3] * S3 + bhi(K[i].y); }
        }
        if (c_hi != NCH) *(f32x4*)cr = (f32x4){S0, S1, S2, S3};
    }
}
template <int MODE>
__device__ __forceinline__ void score_tiles(const Frame& F, const LAS bf16* Kt, const LAS bf16* Qt, LAS bf16* Sc, const LAS float* bm, const LAS float* uu, LAS float* dnA, LAS float* dnB) {
    const int wave = F.wave, lane = opaque_i(F.lane), r32 = lane & 31, hi = lane >> 5;
    if (wave < 3) {
        const int jt = (wave == 2) ? 1 : 0, tt = (wave >= 1) ? 1 : 0;
        f32x16 acc = zero16();
#pragma unroll
        for (int ks = 0; ks < 8; ++ks) { const bf16x8 a = *(const LAS bf16x8*)(Kt + (32 * jt + r32) * 136 + 16 * ks + 8 * hi), bq = *(const LAS bf16x8*)(Qt + (32 * tt + r32) * 136 + 16 * ks + 8 * hi); acc = mfma32(a, bq, acc); }
        const int t = 32 * tt + r32; float rs = 0.f; float bmt = 0.f; if (MODE == 1) bmt = bm[t];
#pragma unroll
        for (int q = 0; q < 4; ++q) { const int j0 = 32 * jt + 8 * q + 4 * hi; float vv[4];
            f32x4 u4 = (f32x4){0.f, 0.f, 0.f, 0.f}; if (MODE == 1) u4 = *(const LAS f32x4*)(uu + j0);
#pragma unroll
            for (int i = 0; i < 4; ++i) { float val = acc[4 * q + i]; if (MODE == 1) val *= __expf(fminf(bmt + u4[i], 0.f)); val = (j0 + i <= t) ? val : 0.f; vv[i] = val; rs += val; }
            v2u w; w.x = pk2(vv[0], vv[1]); w.y = pk2(vv[2], vv[3]); *(LAS v2u*)(Sc + t * 72 + j0) = w; }
        if (MODE == 1) { rs += __shfl_xor(rs, 32); if (hi == 0) { if (jt == 0) dnA[t] = rs; else dnB[t] = rs; } }
    } else if (wave == 3) {
        for (int idx = lane; idx < 128; idx += 64) { const int t = idx >> 2, part = idx & 3; *(LAS v4u*)(Sc + t * 72 + 32 + 8 * part) = (v4u){0u, 0u, 0u, 0u}; }
        if (MODE == 1 && lane < 32) dnB[lane] = 0.f;
    }
}
constexpr int RM_KS = 0, RM_QS = 35840, RM_SC = 71680, RM_OT = 89088, RM_F32 = 122880;
struct RmH { v4u hq, hk; };
struct RmA { v4u rq[4], rk[4]; float bj0, bj1, ig0, ig1, mc, ncv; };
struct RmB { bf16x8 avt[8], acs[8]; v4u ro[2][4]; };
__device__ __forceinline__ void r2m_loadA(const Frame& F, int bh, int C, RmA& L) {
    const int b = bh >> 2, h = bh & 3, m0 = b * SEQ + C * 128, unit = bh * NCH2 + C, tid = opaque_i(F.tid), lane = tid & 63, wave = F.wave;
#pragma unroll
    for (int i = 0; i < 4; ++i) { const int idx = tid + 512 * i, row = idx >> 4, ch = idx & 15;
        L.rq[i] = ld16(F.PROJ + proj_off(m0 + row, PC_Q + h * 128) + ch * 8); L.rk[i] = ld16(F.PROJ + proj_off(m0 + row, PC_K + h * 128) + ch * 8); }
    L.bj0 = 0.f; L.bj1 = 0.f; L.ig0 = 0.f; L.ig1 = 0.f; L.mc = 0.f; L.ncv = 0.f;
    if (wave == 0) { L.bj0 = F.bcum[(size_t)bh * SEQ + C * 128 + lane]; L.bj1 = F.bcum[(size_t)bh * SEQ + C * 128 + 64 + lane]; L.ig0 = F.gates[(size_t)(m0 + lane) * 8 + h]; L.ig1 = F.gates[(size_t)(m0 + 64 + lane) * 8 + h]; L.mc = F.msc[unit * 4 + 2]; }
    else if (wave < 3) L.ncv = F.nst[(size_t)unit * 128 + tid - 64];
}
__device__ __forceinline__ void r2m_loadH(const Frame& F, int bh, int C, RmH& L) {
    const int b = bh >> 2, h = bh & 3, m0 = b * SEQ + C * 128, tid = opaque_i(F.tid);
    L.hq = (v4u){0u, 0u, 0u, 0u}; L.hk = (v4u){0u, 0u, 0u, 0u};
    if (tid < 48 && C != 0) { const int row = tid >> 4, ch = tid & 15; L.hq = ld16(F.PROJ + proj_off(m0 - 3 + row, PC_Q + h * 128) + ch * 8); L.hk = ld16(F.PROJ + proj_off(m0 - 3 + row, PC_K + h * 128) + ch * 8); }
}
__device__ __forceinline__ void r2m_loadB(const Frame& F, int bh, int C, RmB& L) {
    const int b = bh >> 2, h = bh & 3, m0 = b * SEQ + C * 128, unit = bh * NCH2 + C, tid = opaque_i(F.tid), lane = tid & 63, wave = F.wave, r32 = lane & 31, hi = lane >> 5;
#pragma unroll
    for (int th = 0; th < 2; ++th)
#pragma unroll
        for (int i = 0; i < 4; ++i) { const int idx = tid + 512 * i, row = idx >> 5, ch = idx & 31;
            L.ro[th][i] = ld16(F.PROJ + proj_off(m0 + 64 * th + row, PC_OZ + 512 * h + 256 * (ch >> 4)) + (ch & 15) * 8); }
    const bf16* vt = F.VT + vt_off(h * 256 + 32 * wave + r32, m0) + 8 * hi;
#pragma unroll
    for (int ks = 0; ks < 8; ++ks) L.avt[ks] = *(const bf16x8*)(vt + 16 * ks);
    const bf16* cs = F.Cm + (size_t)unit * CM_US + (32 * wave + r32) * 128 + 8 * hi;
#pragma unroll
    for (int ks = 0; ks < 8; ++ks) L.acs[ks] = *(const bf16x8*)(cs + 16 * ks);
}
__device__ __forceinline__ void r2m_unit(const Frame& F, int bh, int C, const RmA& A, const RmB& B, const RmH& H, int nbh, int nC, RmA& NA, RmB& NB, RmH& NH) {
    const int b = bh >> 2, h = bh & 3, m0 = b * SEQ + C * 128, tid = opaque_i(F.tid), lane = tid & 63, wave = F.wave, r32 = lane & 31, hi = lane >> 5;
    LAS bf16 *Ks = (LAS bf16*)(F.lds + RM_KS), *Qs = (LAS bf16*)(F.lds + RM_QS), *Sc = (LAS bf16*)(F.lds + RM_SC), *OT = (LAS bf16*)(F.lds + RM_OT);
    LAS float* fb = (LAS float*)(F.lds + RM_F32);
    LAS float *bm = fb, *uu = fb + 128, *wi = fb + 256, *emt = fb + 384, *qn = fb + 512, *dn = fb + 640, *nc = fb + 896, *hn = fb + 1024;
    bf16x8 avt[8], acs[8]; v4u ro1[4];
#pragma unroll
    for (int ks = 0; ks < 8; ++ks) { avt[ks] = B.avt[ks]; acs[ks] = B.acs[ks]; }
#pragma unroll
    for (int q = 0; q < 4; ++q) ro1[q] = B.ro[1][q];
    const float bj0 = A.bj0, bj1 = A.bj1, ig0 = A.ig0, ig1 = A.ig1, mc = A.mc, ncv = A.ncv;
#pragma unroll
    for (int i = 0; i < 4; ++i) { const int idx = tid + 512 * i, row = idx >> 4, ch = idx & 15; *(LAS v4u*)(Qs + (row + 3) * 136 + ch * 8) = A.rq[i]; *(LAS v4u*)(Ks + (row + 3) * 136 + ch * 8) = A.rk[i]; }
    if (tid < 48) { const int row = tid >> 4, ch = tid & 15; *(LAS v4u*)(Qs + row * 136 + ch * 8) = H.hq; *(LAS v4u*)(Ks + row * 136 + ch * 8) = H.hk; }
#pragma unroll
    for (int i = 0; i < 4; ++i) { const int idx = tid + 512 * i, row = idx >> 5, ch = idx & 31; *(LAS v4u*)(OT + row * 264 + ch * 8) = B.ro[0][i]; }
    if (wave == 0) {
        const float u0 = ig0 - bj0, u1 = ig1 - bj1;
        const float p0 = wave_scan_max(u0, lane), p1 = fmaxf(__shfl(p0, 63), wave_scan_max(u1, lane));
        const float mt0 = bj0 + fmaxf(mc, p0), mt1 = bj1 + fmaxf(mc, p1);
        bm[lane] = bj0 - mt0; uu[lane] = u0; wi[lane] = fexp(bj0 + mc - mt0); emt[lane] = fexp(-mt0);
        bm[64 + lane] = bj1 - mt1; uu[64 + lane] = u1; wi[64 + lane] = fexp(bj1 + mc - mt1); emt[64 + lane] = fexp(-mt1);
    } else if (wave < 3) nc[tid - 64] = ncv;
    r2m_loadA(F, nbh, nC, NA);
    __syncthreads();
    {
        const int d = tid & 127, jq = tid >> 7;
        float cwq[5], cwk[5];
        { const int chq = h * 128 + d, chk = 512 + chq;
#pragma unroll
          for (int i = 0; i < 4; ++i) { cwq[i] = F.conv_w[i * 1024 + chq]; cwk[i] = F.conv_w[i * 1024 + chk]; }
          cwq[4] = F.conv_b[chq]; cwk[4] = F.conv_b[chk]; }
        LAS bf16 *qc = Qs + (32 * jq) * 136 + d, *kc = Ks + (32 * jq) * 136 + d;
        const float tq0 = bf2f(qc[32 * 136]), tq1 = bf2f(qc[33 * 136]), tq2 = bf2f(qc[34 * 136]), tk0 = bf2f(kc[32 * 136]), tk1 = bf2f(kc[33 * 136]), tk2 = bf2f(kc[34 * 136]);
        __syncthreads();
        conv_inplace_32(cwq, qc, tq0, tq1, tq2, 1.0f);
        conv_inplace_32(cwk, kc, tk0, tk1, tk2, 0.08838834764831845f);
    }
    __syncthreads();
    {
        const int t = tid >> 2, part = tid & 3; float dot = 0.f;
#pragma unroll
        for (int i = 0; i < 4; ++i) { const int d0 = 32 * part + 8 * i; const v4u qv = *(const LAS v4u*)(Qs + t * 136 + d0); float qf[8]; unpack8(qv, qf);
#pragma unroll
            for (int k = 0; k < 8; ++k) dot += qf[k] * nc[d0 + k]; }
        dot += __shfl_xor(dot, 1); dot += __shfl_xor(dot, 2); if (part == 0) qn[t] = dot;
    }
#pragma unroll
    for (int th = 0; th < 2; ++th) {
        {
            int jt, st; bool zero = false, act = true;
            if (th == 0) { jt = (wave == 2) ? 1 : 0; st = (wave >= 1) ? 1 : 0; zero = (wave == 3); act = (wave < 4); if (zero) { jt = 1; st = 0; } }
            else { jt = (wave < 4) ? (wave >> 1) : (wave < 6 ? 2 : 3); st = (wave < 4) ? (wave & 1) : (wave == 4 ? 0 : 1); zero = (wave == 7); if (zero) { jt = 3; st = 0; } }
            if (act && !zero) {
                f32x16 acc = zero16();
#pragma unroll
                for (int ks = 0; ks < 8; ++ks) { const bf16x8 a = *(const LAS bf16x8*)(Ks + (32 * jt + r32) * 136 + 16 * ks + 8 * hi), bq = *(const LAS bf16x8*)(Qs + (64 * th + 32 * st + r32) * 136 + 16 * ks + 8 * hi); acc = mfma32(a, bq, acc); }
                const int tl = 32 * st + r32, tg = 64 * th + tl; const float bmt = bm[tg]; float rs = 0.f;
#pragma unroll
                for (int q = 0; q < 4; ++q) { const int j0 = 32 * jt + 8 * q + 4 * hi; float vv[4]; const f32x4 u4 = *(const LAS f32x4*)(uu + j0);
#pragma unroll
                    for (int i = 0; i < 4; ++i) { const float val = (j0 + i <= tg) ? acc[4 * q + i] * __expf(fminf(bmt + u4[i], 0.f)) : 0.f; vv[i] = val; rs += val; }
                    v2u w; w.x = pk2(vv[0], vv[1]); w.y = pk2(vv[2], vv[3]); *(LAS v2u*)(Sc + tl * 136 + j0) = w; }
                rs += __shfl_xor(rs, 32); if (hi == 0) dn[jt * 64 + tl] = rs;
            } else if (act) {
                for (int idx = lane; idx < 128; idx += 64) { const int tl = 32 * st + (idx >> 2), part = idx & 3; *(LAS v4u*)(Sc + tl * 136 + 32 * jt + 8 * part) = (v4u){0u, 0u, 0u, 0u}; }
                if (lane < 32) dn[jt * 64 + 32 * st + lane] = 0.f;
            }
            if (th == 0 && wave >= 4 && wave < 6) dn[(wave - 2) * 64 + lane] = 0.f;
        }
        __syncthreads();
        f32x4 nw[4];
        { const float* nwp = F.ml_nw + h * 256 + 32 * wave + 4 * hi;
          asm volatile("" ::: "memory");
#pragma unroll
          for (int q = 0; q < 4; ++q) nw[q] = *(const f32x4*)(nwp + 8 * q); }
        f32x16 accA[2], accB[2]; accA[0] = zero16(); accA[1] = zero16(); accB[0] = zero16(); accB[1] = zero16();
#pragma unroll
        for (int ks = 0; ks < 8; ++ks) if (ks < 4 * (th + 1))
#pragma unroll
            for (int tt = 0; tt < 2; ++tt) { const bf16x8 bq = *(const LAS bf16x8*)(Sc + (32 * tt + r32) * 136 + 16 * ks + 8 * hi); accA[tt] = mfma32(avt[ks], bq, accA[tt]); }
#pragma unroll
        for (int ks = 0; ks < 8; ++ks)
#pragma unroll
            for (int tt = 0; tt < 2; ++tt) { const bf16x8 bq = *(const LAS bf16x8*)(Qs + (64 * th + 32 * tt + r32) * 136 + 16 * ks + 8 * hi); accB[tt] = mfma32(acs[ks], bq, accB[tt]); }
        if (th == 1) r2m_loadB(F, nbh, nC, NB);
#pragma unroll
        for (int tt = 0; tt < 2; ++tt) { const int tl = 32 * tt + r32, tg = 64 * th + tl; const float wit = wi[tg];
            const float den = (dn[tl] + dn[64 + tl]) + (dn[128 + tl] + dn[192 + tl]) + wit * qn[tg]; const float inv = frcp(fmaxf(fabsf(den), emt[tg])); float ssp = 0.f;
#pragma unroll
            for (int r = 0; r < 16; ++r) { const float hv = (accA[tt][r] + wit * accB[tt][r]) * inv; accA[tt][r] = hv; ssp += hv * hv; }
            ssp += __shfl_xor(ssp, 32); if (hi == 0) hn[wave * 64 + tl] = ssp; }
        __syncthreads();
        if (th == 1) r2m_loadH(F, nbh, nC, NH);
#pragma unroll
        for (int tt = 0; tt < 2; ++tt) { const int tl = 32 * tt + r32; float tot = 0.f;
#pragma unroll
            for (int w = 0; w < 8; ++w) tot += hn[w * 64 + tl];
            const float rstd = frsq(tot * (1.0f / 256.0f) + EPS);
            const int v0 = 32 * wave + 4 * hi;
#pragma unroll
            for (int q = 0; q < 4; ++q) { LAS v2u* op = (LAS v2u*)(OT + tl * 264 + v0 + 8 * q); const v2u o4 = *op;
                const float y0 = accA[tt][4 * q] * rstd * nw[q][0] * blo(o4.x), y1 = accA[tt][4 * q + 1] * rstd * nw[q][1] * bhi(o4.x);
                const float y2 = accA[tt][4 * q + 2] * rstd * nw[q][2] * blo(o4.y), y3 = accA[tt][4 * q + 3] * rstd * nw[q][3] * bhi(o4.y);
                v2u w; w.x = pk2(y0, y1); w.y = pk2(y2, y3); *op = w; } }
        __syncthreads();
#pragma unroll
        for (int i = 0; i < 4; ++i) { const int idx = tid + 512 * i, row = idx >> 5, ch = idx & 31; *(v4u*)(F.Y + (size_t)(m0 + 64 * th + row) * DM + h * 256 + ch * 8) = *(const LAS v4u*)(OT + row * 264 + ch * 8); }
        __syncthreads();
        if (th == 0) {
#pragma unroll
            for (int i = 0; i < 4; ++i) { const int idx = tid + 512 * i, row = idx >> 5, ch = idx & 31; *(LAS v4u*)(OT + row * 264 + ch * 8) = ro1[i]; }
        }
    }
}
constexpr int RH_QT = 0, RH_KT = 34816, RH_GT = 69632, RH_SC = 104448, RH_F32 = 121856;
struct RhL { v4u rq[4], rf[4], rg[4]; float lbd; };
__device__ __forceinline__ void r2h_load(const Frame& F, int bh, int C, RhL& L) {
    const int b = bh >> 3, h = bh & 7, m0 = b * SEQ + C * 128, tid = opaque_i(F.tid);
#pragma unroll
    for (int i = 0; i < 4; ++i) { const int idx = tid + 512 * i, row = idx >> 4, ch = idx & 15;
        L.rq[i] = ld16(F.PROJ + proj_off(m0 + row, PC_HQ + h * 128) + ch * 8); L.rf[i] = ld16(F.PROJ + proj_off(m0 + row, PC_HF + h * 128) + ch * 8); L.rg[i] = ld16(F.PROJ + proj_off(m0 + row, PC_HG + h * 128) + ch * 8); }
    L.lbd = F.hg_lb[1024 + h * 128 + (tid & 127)] - F.hg_lb[h * 128 + (tid & 127)];
}
__device__ __forceinline__ void r2h_fill(const Frame& F, const RhL& L) {
    const int tid = opaque_i(F.tid);
    LAS bf16 *Qt = (LAS bf16*)(F.lds + RH_QT), *Kt = (LAS bf16*)(F.lds + RH_KT), *GT = (LAS bf16*)(F.lds + RH_GT);
#pragma unroll
    for (int i = 0; i < 4; ++i) { const int idx = tid + 512 * i, row = idx >> 4, ch = idx & 15; const int lo = row * 136 + ch * 8;
        *(LAS v4u*)(Qt + lo) = L.rq[i]; *(LAS v4u*)(Kt + lo) = L.rf[i]; *(LAS v4u*)(GT + lo) = L.rg[i]; }
}
__device__ __forceinline__ void r2h_compute(const Frame& F, int bh, int C, float lbd) {
    const int b = bh >> 3, h = bh & 7, m0 = b * SEQ + C * 128, unit = bh * NCH2 + C, tid = opaque_i(F.tid), lane = tid & 63, wave = F.wave, r32 = lane & 31, hi = lane >> 5;
    LAS bf16 *Qt = (LAS bf16*)(F.lds + RH_QT), *Kt = (LAS bf16*)(F.lds + RH_KT), *GT = (LAS bf16*)(F.lds + RH_GT), *Sc = (LAS bf16*)(F.lds + RH_SC);
    LAS float* hn = (LAS float*)(F.lds + RH_F32);
    LAS float* seg = hn + 256;
    const int vt_i = wave & 3, tt = wave >> 2, t = 32 * tt + r32;
    bf16x8 avt[8], ast[8]; f32x4 nw[4];
    { const bf16* vt = F.VT + vt_off(1024 + h * 128 + 32 * vt_i + r32, m0) + 8 * hi;
#pragma unroll
      for (int ks = 0; ks < 8; ++ks) avt[ks] = *(const bf16x8*)(vt + 16 * ks);
      const bf16* cs = F.Ch + (size_t)unit * CH_US + (32 * vt_i + r32) * 128 + 8 * hi;
#pragma unroll
      for (int ks = 0; ks < 8; ++ks) ast[ks] = *(const bf16x8*)(cs + 16 * ks);
      const float* nwp = F.hg_nw + h * 128 + 32 * vt_i + 4 * hi;
#pragma unroll
      for (int q = 0; q < 4; ++q) nw[q] = *(const f32x4*)(nwp + 8 * q); }
    __syncthreads();
    {
        const int e = tid & 127, jq = tid >> 7;
        const float lb = frcp(1.0f + fexp(lbd));
        float yv[32], fv[32];
#pragma unroll
        for (int jj = 0; jj < 32; ++jj) { const float xv = bf2f(Kt[(32 * jq + jj) * 136 + e]); fv[jj] = lb + (1.0f - lb) * sigm(xv); }
        float run = 1.0f;
        if (jq < 2) {
#pragma unroll
            for (int jj = 31; jj >= 0; --jj) { yv[jj] = run; run *= fv[jj]; }
        } else {
#pragma unroll
            for (int jj = 0; jj < 32; ++jj) { run *= fv[jj]; yv[jj] = run; }
        }
        seg[jq * 128 + e] = run;
        __syncthreads();
        const float other = jq == 0 ? seg[128 + e] : jq == 3 ? seg[256 + e] : 1.0f;
#pragma unroll
        for (int jj = 0; jj < 32; ++jj) { const int j = 32 * jq + jj; const float y = yv[jj] * other, ry = frcp(y); const float qv = bf2f(Qt[j * 136 + e]);
            st_bf(Qt + j * 136 + e, qv * (jq < 2 ? ry : y)); st_bf(Kt + j * 136 + e, (1.0f - fv[jj]) * (jq < 2 ? y : ry)); }
    }
    __syncthreads();
#pragma unroll
    for (int th = 0; th < 2; ++th) {
        {
            int jt, st; bool zero = false, act = true;
            if (th == 0) { jt = (wave == 2) ? 1 : 0; st = (wave >= 1) ? 1 : 0; zero = (wave == 3); act = (wave < 4); if (zero) { jt = 1; st = 0; } }
            else { jt = (wave < 4) ? (wave >> 1) : (wave < 6 ? 2 : 3); st = (wave < 4) ? (wave & 1) : (wave == 4 ? 0 : 1); zero = (wave == 7); if (zero) { jt = 3; st = 0; } }
            if (act && !zero) {
                f32x16 acc = zero16();
#pragma unroll
                for (int ks = 0; ks < 8; ++ks) { const bf16x8 a = *(const LAS bf16x8*)(Kt + (32 * jt + r32) * 136 + 16 * ks + 8 * hi), bq = *(const LAS bf16x8*)(Qt + (64 * th + 32 * st + r32) * 136 + 16 * ks + 8 * hi); acc = mfma32(a, bq, acc); }
                const int tl = 32 * st + r32, tg = 64 * th + tl;
#pragma unroll
                for (int q = 0; q < 4; ++q) { const int j0 = 32 * jt + 8 * q + 4 * hi; float vv[4];
#pragma unroll
                    for (int i = 0; i < 4; ++i) vv[i] = (j0 + i <= tg) ? acc[4 * q + i] : 0.f;
                    v2u w; w.x = pk2(vv[0], vv[1]); w.y = pk2(vv[2], vv[3]); *(LAS v2u*)(Sc + tl * 136 + j0) = w; }
            } else if (act) {
                for (int idx = lane; idx < 128; idx += 64) { const int tl = 32 * st + (idx >> 2), part = idx & 3; *(LAS v4u*)(Sc + tl * 136 + 32 * jt + 8 * part) = (v4u){0u, 0u, 0u, 0u}; }
            }
        }
        __syncthreads();
        f32x16 acc = zero16();
#pragma unroll
        for (int ks = 0; ks < 8; ++ks) if (ks < 4 * (th + 1)) { const bf16x8 bq = *(const LAS bf16x8*)(Sc + t * 136 + 16 * ks + 8 * hi); acc = mfma32(avt[ks], bq, acc); }
#pragma unroll
        for (int ks = 0; ks < 8; ++ks) { const bf16x8 bq = *(const LAS bf16x8*)(Qt + (64 * th + t) * 136 + 16 * ks + 8 * hi); acc = mfma32(ast[ks], bq, acc); }
        { float ssp = 0.f;
#pragma unroll
          for (int r = 0; r < 16; ++r) ssp += acc[r] * acc[r];
          ssp += __shfl_xor(ssp, 32); if (hi == 0) hn[vt_i * 64 + t] = ssp; }
        __syncthreads();
        LAS bf16* YT = Qt + 64 * th * 136;
        {
            const float tot = (hn[t] + hn[64 + t]) + (hn[128 + t] + hn[192 + t]);
            const float rstd = frsq(tot * (1.0f / 128.0f) + EPS);
            const int v0 = 32 * vt_i + 4 * hi;
#pragma unroll
            for (int q = 0; q < 4; ++q) { const v2u g4 = *(const LAS v2u*)(GT + (64 * th + t) * 136 + v0 + 8 * q);
                const float g0 = blo(g4.x), g1 = bhi(g4.x), g2 = blo(g4.y), g3 = bhi(g4.y);
                const float y0 = acc[4 * q] * rstd * nw[q][0] * g0, y1 = acc[4 * q + 1] * rstd * nw[q][1] * g1;
                const float y2 = acc[4 * q + 2] * rstd * nw[q][2] * g2, y3 = acc[4 * q + 3] * rstd * nw[q][3] * g3;
                v2u w; w.x = pk2(y0, y1); w.y = pk2(y2, y3); *(LAS v2u*)(YT + t * 136 + v0 + 8 * q) = w; }
        }
        __syncthreads();
#pragma unroll
        for (int i = 0; i < 2; ++i) { const int idx = tid + 512 * i, row = idx >> 4, ch = idx & 15; *(v4u*)(F.Y + (size_t)(m0 + 64 * th + row) * DM + 1024 + h * 128 + ch * 8) = *(const LAS v4u*)(YT + row * 136 + ch * 8); }
        __syncthreads();
    }
}
__device__ __forceinline__ void r2_phase(const Frame& F, int c_lo, volatile LAS unsigned long long* tsl) {
#define R2_BH(id) ((id) >> CPS_SH)
#define R2_C(id) (c_lo + ((id) & (CPS - 1)))
    { RmA curA; RmB curB; RmH curH; int id = F.bid; r2m_loadA(F, id >> 7, id & 127, curA); r2m_loadH(F, id >> 7, id & 127, curH); r2m_loadB(F, id >> 7, id & 127, curB);
      for (; id < 8 * NCH2; id += F.G) { const int nid = (id + F.G < 8 * NCH2) ? id + F.G : id;
          RmA nxtA; RmB nxtB; RmH nxtH; r2m_unit(F, id >> 7, id & 127, curA, curB, curH, nid >> 7, nid & 127, nxtA, nxtB, nxtH); curA = nxtA; curB = nxtB; curH = nxtH; } }
    if (PROBE_TS >= 0 && F.tid == 0) tsl[8] = __builtin_amdgcn_s_memrealtime();
    { RhL cur; int id = F.bid; r2h_load(F, id >> 7, id & 127, cur);
      for (; id < 16 * NCH2; id += F.G) { const int nid = (id + F.G < 16 * NCH2) ? id + F.G : id;
          r2h_fill(F, cur); const float lbd = cur.lbd;
          RhL nxt; r2h_load(F, nid >> 7, nid & 127, nxt);
          r2h_compute(F, id >> 7, id & 127, lbd); cur = nxt; } }
#undef R2_BH
#undef R2_C
}
__device__ __forceinline__ void final_norm(const Frame& F, float oscale) {
    int lane; asm volatile("v_mbcnt_lo_u32_b32 %0, -1, 0\n\tv_mbcnt_hi_u32_b32 %0, -1, %0" : "=v"(lane));
    const int gw = F.bid * NWAVES + F.wave, NGW = F.G * NWAVES;
    const int sub = lane >> 5, l8 = (lane & 31) * 8;
    for (int m = gw; m < M; m += NGW) {
        const size_t base = (((size_t)(m >> 8) * 8) << 16) + (size_t)(m & 255) * 256 + l8;
        float hv[4][8]; float ss = 0.f;
#pragma unroll
        for (int i = 0; i < 4; ++i) { const size_t off = base + ((size_t)(2 * i + sub) << 16); const v4u g = __builtin_nontemporal_load((const v4u*)(F.EB + off));
            hv[i][0] = blo(g.x); hv[i][1] = bhi(g.x); hv[i][2] = blo(g.y); hv[i][3] = bhi(g.y);
            hv[i][4] = blo(g.z); hv[i][5] = bhi(g.z); hv[i][6] = blo(g.w); hv[i][7] = bhi(g.w);
#pragma unroll
            for (int k = 0; k < 8; ++k) ss += hv[i][k] * hv[i][k]; }
        ss = wave_sum(ss);
        const float rstd = oscale / sqrtf(ss * (1.0f / DM) + EPS);
#pragma unroll
        for (int i = 0; i < 4; ++i) { const int col = (2 * i + sub) * 256 + l8; const f32x4 w0 = *(const f32x4*)(F.fin_nw + col), w1 = *(const f32x4*)(F.fin_nw + col + 4);
            float* o = F.out + (size_t)m * DM + col;
            __builtin_nontemporal_store((f32x4){hv[i][0] * rstd * w0[0], hv[i][1] * rstd * w0[1], hv[i][2] * rstd * w0[2], hv[i][3] * rstd * w0[3]}, (f32x4*)o);
            __builtin_nontemporal_store((f32x4){hv[i][4] * rstd * w1[0], hv[i][5] * rstd * w1[1], hv[i][6] * rstd * w1[2], hv[i][7] * rstd * w1[3]}, (f32x4*)(o + 4)); }
    }
}
struct Args { const float* in[16]; float* out; unsigned char* ws; int ph_lo, ph_hi, li, pad; };
__global__ void __launch_bounds__(NWAVES * 64, 2) hymba_fwd(Args args) {
    extern __shared__ __attribute__((aligned(16))) unsigned char lds[];
    Frame F;
    F.lds = (LAS unsigned char*)lds;
    F.tid = threadIdx.x; F.lane = F.tid & 63; F.wave = __builtin_amdgcn_readfirstlane(F.tid >> 6); F.G = gridDim.x; F.bid = blockIdx.x;
    unsigned char* ws = args.ws;
    gu32* ctl = (gu32*)(ws + WS_CTL);
    F.x = args.in[0]; F.p = args.in[1]; F.norm_w = args.in[2]; F.w_in = args.in[3]; F.conv_w = args.in[4]; F.conv_b = args.in[5]; F.b_i = args.in[6]; F.b_f = args.in[7];
    F.ml_nw = args.in[8]; F.hg_lb = args.in[9]; F.hg_nw = args.in[10]; F.w_out = args.in[11]; F.pe_nw = args.in[12]; F.w_pg = args.in[13]; F.w_pe = args.in[14]; F.fin_nw = args.in[15];
    F.out = args.out;
    F.Wt_in = (bf16*)(ws + WS_WIN); F.WoT = (bf16*)(ws + WS_WO); F.WgT = (bf16*)(ws + WS_WG); F.WeT = (bf16*)(ws + WS_WE); F.PB = (bf16*)(ws + WS_PB);
    F.U = (bf16*)(ws + WS_U); F.Y = (bf16*)(ws + WS_Y); F.PROJ = (bf16*)(ws + WS_PROJ); F.HB = (bf16*)(ws + WS_PROJ); F.EB = (bf16*)(ws + WS_PROJ + 128 * MiB); F.VT = (bf16*)(ws + WS_VT);
    F.Cm = (bf16*)args.out; F.Ch = (bf16*)args.out + (size_t)64 * MiB;
    F.gates = (float*)(ws + WS_GATES); F.bcum = (float*)(ws + WS_BCUM); F.msc = (float*)(ws + WS_MSC); F.nst = (float*)(ws + WS_NST); F.gdec = (float*)(ws + WS_GDEC); F.ebr = (float*)(ws + WS_EBR); F.carry = (float*)(ws + WS_CARRY);
    F.ssqh = (float*)(ws + WS_SSQH); F.ssq2 = (float*)(ws + WS_SSQ2); F.QC = (bf16*)(ws + WS_QC); F.KC = (bf16*)(ws + WS_KC); F.HQT = (bf16*)(ws + WS_HQT); F.HKT = (bf16*)(ws + WS_HKT); F.HQ2 = (bf16*)(ws + WS_HQ2);
    for (int u = F.tid; u < (LDS_BYTES - LDSCTL_OFF) / 4; u += NWAVES * 64) ((LAS unsigned*)(F.lds + LDSCTL_OFF))[u] = 0u;
    __syncthreads();
    XcdBarrier bar; bar.bar = (unsigned*)(ctl + CW_BAR); bar.x = 0; bar.st = nullptr;
    if (N_LAUNCHES != PER_PHASE) bar = xcd_barrier_post((unsigned*)(ctl + CW_BAR), (volatile LAS unsigned*)(F.lds + MISC_OFF) + 8);
#define GRID_BAR() do { if (N_LAUNCHES == PER_PHASE) { if (F.tid == 0) __hip_atomic_store(ctl + CW_TMO, 0xBADBA0u, RLX_AGENT); } else { xcd_barrier(bar); } } while (0)
    const int lo = args.ph_lo, hi = args.ph_hi;
#ifndef PROBE_TS
#define PROBE_TS (-1)
#endif
#ifndef PROBE_TB
#define PROBE_TB (PROBE_TS + 1)
#endif
    volatile LAS unsigned long long* tsl = (volatile LAS unsigned long long*)(F.lds + LDSCTL_OFF + 512);
#define STAMP(k) do { if (PROBE_TS >= 0 && F.tid == 0) tsl[k] = __builtin_amdgcn_s_memrealtime(); } while (0)
    STAMP(0);
#define IN(k) (lo <= (k) && (k) < hi)
#define BOTH(k) (IN(k) && IN((k) + 1))
#ifndef GEMM_ALIGN
#define GEMM_ALIGN true
#endif
#ifndef GEMM_SP2
#define GEMM_SP2 true
#endif
#ifndef PROBE_KIND
#define PROBE_KIND 0
#endif
#ifndef PROBE_DOUBLE
#define PROBE_DOUBLE 0
#endif
    if (IN(0)) { p0_prologue(F);
#if PROBE_DOUBLE & 1
        __syncthreads(); p0_prologue(F);
#endif
        if (BOTH(0)) { GRID_BAR(); STAMP(1); } }
    int vcu = F.bid;
    if (N_LAUNCHES != PER_PHASE && lo == 0) { volatile LAS unsigned* st = (volatile LAS unsigned*)(F.lds + MISC_OFF) + 8; if (st[2] != 0u && F.G == 256) vcu = (int)(st[3] * 8u + bar.x); }
    if (IN(1)) {
#if PROBE_KIND == 10
        { pg8::Gemm g{F.U, F.Wt_in, M, NNAT, DM}; pg8::StaticOrder S; S.init(M, NNAT, F.G, vcu); pg8::EpiNull E;
          pg8::gemm_phase<pg8::EpiNull, pg8::StaticOrder, true, true, false, 0, false, false, true>(F.lds, g, S, E); }
#elif PROBE_KIND == 12
        { pg8::Gemm g{F.U, F.Wt_in, M, NNAT, DM}; pg8::StaticOrder S; S.init(M, NNAT, F.G, vcu); pg8::EpiNull E;
          pg8::gemm_phase<pg8::EpiNull, pg8::StaticOrder, true, true, false, 0, true, false, false, true>(F.lds, g, S, E); }
#elif PROBE_KIND == 13
        { f32x16 acc[8]; bf16x8 a, b;
#pragma unroll
          for (int i = 0; i < 8; ++i) acc[i] = zero16();
#pragma unroll
          for (int i = 0; i < 8; ++i) { a[i] = (short)(F.tid + i); b[i] = (short)(F.lane * 3 + i); }
          for (int it = 0; it < 12 * 32 * 8; ++it) {
#pragma unroll
              for (int i = 0; i < 8; ++i) acc[i] = mfma32(a, b, acc[i]);
          }
#pragma unroll
          for (int i = 0; i < 8; ++i) asm volatile("" :: "v"(acc[i])); }
#elif PROBE_KIND == 11
        { pg8::Gemm g{F.U, F.Wt_in, M, NNAT, DM}; pg8::StaticOrder S; S.init(M, NNAT, F.G, vcu); pg8::EpiNull E;
          pg8::gemm_phase<pg8::EpiNull, pg8::StaticOrder, true, true>(F.lds, g, S, E); }
#endif
#if PROBE_DOUBLE & 2
        { pg8::Gemm g{F.U, F.Wt_in, M, NNAT, DM}; pg8::StaticOrder S; S.init(M, NNAT, F.G, vcu);
          pg8::EpiProj E{F.PROJ, NNAT / 256, PC_OZ / 256, PC_OZ / 256 + 8, PC_HG / 256};
          pg8::gemm_phase<pg8::EpiProj, pg8::StaticOrder, GEMM_ALIGN, GEMM_SP2>(F.lds, g, S, E); }
        { pg8::Gemm g{F.Wt_in + (size_t)NNAT * DM, F.U, NTR, M, DM}; pg8::StaticOrder S; S.init(NTR, M, F.G, vcu);
          pg8::EpiBf16T E{F.VT, M / 256};
          pg8::gemm_phase<pg8::EpiBf16T, pg8::StaticOrder, GEMM_ALIGN, GEMM_SP2>(F.lds, g, S, E); }
#endif
        { pg8::Gemm g{F.U, F.Wt_in, M, NNAT, DM}; pg8::StaticOrder S; S.init(M, NNAT, F.G, vcu);
          pg8::EpiProj E{F.PROJ, NNAT / 256, PC_OZ / 256, PC_OZ / 256 + 8, PC_HG / 256};
          pg8::gemm_phase<pg8::EpiProj, pg8::StaticOrder, GEMM_ALIGN, GEMM_SP2>(F.lds, g, S, E); }
        { pg8::Gemm g{F.Wt_in + (size_t)NNAT * DM, F.U, NTR, M, DM}; pg8::StaticOrder S; S.init(NTR, M, F.G, vcu);
          pg8::EpiBf16T E{F.VT, M / 256};
          pg8::gemm_phase<pg8::EpiBf16T, pg8::StaticOrder, GEMM_ALIGN, GEMM_SP2>(F.lds, g, S, E); }
        if (BOTH(1)) { GRID_BAR(); STAMP(2); }
    }
    if (N_LAUNCHES == PER_PHASE) {
        if (IN(2)) for (int sl = 0; sl < NSLAB; ++sl) pa_phase(F, sl * CPS, tsl);
        if (IN(3)) scan_phase(F, 0, NCH);
        if (IN(4)) for (int sl = 0; sl < NSLAB; ++sl) r2_phase(F, sl * CPS, tsl);
    } else if (IN(2)) {
        for (int sl = 0; sl < NSLAB; ++sl) {
            pa_phase(F, sl * CPS, tsl); STAMP(10); GRID_BAR(); STAMP(11);
            scan_phase(F, sl * CPS, (sl + 1) * CPS); STAMP(12); GRID_BAR(); STAMP(13);
            r2_phase(F, sl * CPS, tsl); if (sl + 1 < NSLAB) GRID_BAR();
        }
        STAMP(3); STAMP(4);
        GRID_BAR(); STAMP(5);
    }
    if (IN(5)) {
        { pg8::Gemm g{F.Y, F.WoT, M, DM, DM}; pg8::StaticOrder S; S.init(M, DM, F.G, vcu);
          pg8::EpiRes E{F.U, F.gates + (WS_RMS - WS_GATES) / 4, F.norm_w, F.HB, (unsigned char*)F.HB + HB8_OFF, F.ssqh, DM, DM / 256};
          pg8::gemm_phase<pg8::EpiRes, pg8::StaticOrder, GEMM_ALIGN, GEMM_SP2>(F.lds, g, S, E); }
        { pg8::Gemm g{F.PB, F.WeT, M, DM, PE}; pg8::StaticOrder S; S.init(M, DM, F.G, vcu);
          pg8::EpiBf16T E{F.EB, DM / 256};
          pg8::gemm_phase<pg8::EpiBf16T, pg8::StaticOrder, GEMM_ALIGN, GEMM_SP2>(F.lds, g, S, E); }
        if (BOTH(5)) { GRID_BAR(); STAMP(6); }
    }
    if (IN(6)) {
        pg8::Gemm g{(const bf16*)((const unsigned char*)F.HB + HB8_OFF), F.WgT, M, DM, DM / 2}; pg8::StaticOrder S; S.init(M, DM, F.G, vcu);
        pg8::EpiGate E{F.EB, F.HB, F.ssqh, DM / 256, 1.0f / DM, EPS, 1.0f / (WG_SCALE * HB8_SCALE)};
        pg8::gemm_phase<pg8::EpiGate, pg8::StaticOrder, GEMM_ALIGN, GEMM_SP2, false, 0, false, 2, false, false, true>(F.lds, g, S, E);
        if (BOTH(6)) { GRID_BAR(); STAMP(7); }
    }
    float oscale = 1.0f;
    if (PROBE_TS >= 0) { __syncthreads(); const float f = (float)(tsl[PROBE_TB] - tsl[PROBE_TS]) / (float)(tsl[7] - tsl[0]); oscale = 1.0f + sqrtf(fmaxf(f - PROBE_F0, 0.f) * 1e-3f); }
    if (IN(7)) final_norm(F, oscale);
#undef IN
#undef BOTH
}

#ifdef DBG_DUMP_AFTER
__global__ void dbg_dump(const unsigned char* wsb, float* out, int mode) {
    const unsigned short* a = (const unsigned short*)(wsb + (mode == 0 ? WS_PROJ : WS_U)); const unsigned short* b = (const unsigned short*)(wsb + WS_VT);
    size_t i = (size_t)blockIdx.x * blockDim.x + threadIdx.x;
    const size_t n = (size_t)M * DM;
    for (; i < n; i += (size_t)gridDim.x * blockDim.x) {
        float v;
        if (mode == 0) v = bf2f(a[3 * i]) + bf2f(a[3 * i + 1]) + bf2f(a[3 * i + 2]) + bf2f(b[i]);
        else v = bf2f(a[i]);
        out[i] = v;
    }
}
#endif
extern "C" void kernel_launch(void* const* d_in, const int* in_sizes, int n_in, void* d_out, int out_size, void* d_ws, size_t ws_size, hipStream_t stream) {
    static int grid = 0;
    if (grid == 0) {
        if (n_in != 16 || in_sizes[0] != M * DM || out_size != M * DM || ws_size < WS_END) { fprintf(stderr, "kernel_launch: unexpected shapes (n_in %d, in0 %d, out %d, ws %zu); nothing launched\n", n_in, n_in > 0 ? in_sizes[0] : -1, out_size, ws_size); grid = -1; return; }
        int dev = 0, cus = 0, per_cu = 0;
        if (hipGetDevice(&dev) != hipSuccess || hipDeviceGetAttribute(&cus, hipDeviceAttributeMultiprocessorCount, dev) != hipSuccess) { grid = -1; return; }
        if (hipFuncSetAttribute((const void*)hymba_fwd, hipFuncAttributeMaxDynamicSharedMemorySize, LDS_BYTES) != hipSuccess) { fprintf(stderr, "kernel_launch: hipFuncSetAttribute failed\n"); grid = -1; return; }
        if (hipOccupancyMaxActiveBlocksPerMultiprocessor(&per_cu, (const void*)hymba_fwd, NWAVES * 64, LDS_BYTES) != hipSuccess || per_cu < 1)
            fprintf(stderr, "kernel_launch: note: occupancy query reports %d workgroups per CU\n", per_cu);
        (void)hipGetLastError();
        grid = cus < 256 ? cus : 256;
        if (grid != 256) fprintf(stderr, "kernel_launch: %d CUs: this kernel is written for a 256-CU device; results will be wrong\n", cus);
    }
    if (grid < 0) return;
    if (hipMemsetAsync((char*)d_ws + WS_CTL, 0, CTL_ZERO_BYTES, stream) != hipSuccess) { fprintf(stderr, "kernel_launch: hipMemsetAsync failed\n"); return; }
    Args a{};
    for (int i = 0; i < 16; ++i) a.in[i] = (const float*)d_in[i];
    a.out = (float*)d_out; a.ws = (unsigned char*)d_ws;
    for (int li = 0; li < N_LAUNCHES; ++li) {
#ifdef DBG_DUMP_AFTER
        if (li > DBG_DUMP_AFTER) { if (DBG_DUMP_AFTER != 2 && DBG_DUMP_AFTER != 3) hipLaunchKernelGGL(dbg_dump, dim3(2048), dim3(256), 0, stream, (const unsigned char*)d_ws, (float*)d_out, DBG_DUMP_AFTER == 1 ? 0 : 1);
            break; }
#endif
        a.ph_lo = (N_LAUNCHES == PER_PHASE) ? li : 0; a.ph_hi = (N_LAUNCHES == PER_PHASE) ? li + 1 : PER_PHASE; a.li = li;
        hipLaunchKernelGGL(hymba_fwd, dim3(grid), dim3(NWAVES * 64), LDS_BYTES, stream, a);
        const hipError_t le = hipPeekAtLastError();
        if (le != hipSuccess) { fprintf(stderr, "kernel_launch: launch %d failed: %s\n", li, hipGetErrorName(le)); break; }
    }
}
```

```cpp
#include <hip/hip_runtime.h>
#include <cstdio>
#include <cstdint>
namespace pg8 {
#define PG8_LAS __attribute__((address_space(3)))
typedef unsigned short bf16_t;
typedef short bf16x8 __attribute__((ext_vector_type(8)));
typedef float f32x4 __attribute__((ext_vector_type(4)));
typedef unsigned u32x4 __attribute__((ext_vector_type(4)));
constexpr int BM = 256, BK = 64, HALF = 128, HTB = HALF * BK * 2  , STAGE_BYTES = 8 * HTB, NXCD = 8, WGM = 8;

__host__ __device__ __forceinline__ int lds_byte(int r, int c) { const int st = (r >> 4) * 2 + (c >> 5), rr = r & 15, cc = c & 31, ob = rr * 64 + cc * 2; return st * 1024 + (ob ^ (((ob >> 9) & 1) << 5)); }
__host__ __device__ __forceinline__ void stage_rc(int b, int& R, int& C) { const int st = b / 1024, sb = b % 1024, swz = sb ^ (((sb >> 9) & 1) << 5); R = (st >> 1) * 16 + swz / 64; C = (st & 1) * 32 + (swz % 64) / 2; }
__host__ __device__ __forceinline__ int perm32(int rho) { const int n = rho >> 4, i = rho & 15; return 8 * (i >> 2) + 4 * n + (i & 3); }

struct Unit { int pm, pn; };
struct Gemm { const bf16_t* A; const bf16_t* Bt; int M, N, K; };

struct StaticOrder {
    int nM, nN, nwg, G, c;
    __host__ __device__ void init(int M, int N, int G_, int c_) { nM = M / BM; nN = N / BM; nwg = nM * nN; G = G_; c = c_; }
    __host__ __device__ bool next(int i, Unit& u) const {
        const long L = (long)i * G + c; if (L >= nwg) return false;
        int wgid = (int)L; { const int q = nwg / NXCD, r = nwg % NXCD, xcd = wgid % NXCD, off = wgid / NXCD; wgid = (xcd < r ? xcd * (q + 1) : r * (q + 1) + (xcd - r) * q) + off; }
        const int nig = WGM * nN, gid = wgid / nig, fm = gid * WGM, gsz = (nM - fm) < WGM ? (nM - fm) : WGM;
        u.pm = fm + ((wgid % nig) % gsz); u.pn = (wgid % nig) / gsz; return true;
    }
    __device__ __forceinline__ void a_ready(const Unit&) const {}
    __device__ __forceinline__ void done(const Unit&) const {}
};

typedef unsigned u32x2 __attribute__((ext_vector_type(2)));
typedef int i32x4_ __attribute__((ext_vector_type(4)));
typedef int i32x8_ __attribute__((ext_vector_type(8)));
typedef long i64x2_ __attribute__((ext_vector_type(2)));
__device__ __forceinline__ i32x8_ cat8(bf16x8 a, bf16x8 b) { const i32x4_ x = __builtin_bit_cast(i32x4_, a), y = __builtin_bit_cast(i32x4_, b); return __builtin_shufflevector(x, y, 0, 1, 2, 3, 4, 5, 6, 7); }
__device__ __forceinline__ void mfma_fp8_inplace(f32x4& acc, i32x8_ a, i32x8_ b, int scale) {
    asm volatile("v_mfma_scale_f32_16x16x128_f8f6f4 %0, %1, %2, %0, %3, %3 op_sel_hi:[0,0,0]" : "+v"(acc) : "v"(a), "v"(b), "v"(scale));
}
__device__ __forceinline__ unsigned cvt_pk4_fp8(float a, float b, float c, float d) { int w = __builtin_amdgcn_cvt_pk_fp8_f32(a, b, 0, false); w = __builtin_amdgcn_cvt_pk_fp8_f32(c, d, w, true); return (unsigned)w; }
__device__ __forceinline__ unsigned cvt_pk_bf16(float lo, float hi) { unsigned r; asm volatile("v_cvt_pk_bf16_f32 %0, %1, %2" : "=v"(r) : "v"(lo), "v"(hi)); return r; }
typedef float f32x2 __attribute__((ext_vector_type(2)));
__device__ __forceinline__ f32x2 gelu_pk(f32x2 v) {
    const f32x2 av = __builtin_elementwise_abs(v), d = av * 0.2316418882f + 1.0f;
    f32x2 t; t.x = __builtin_amdgcn_rcpf(d.x); t.y = __builtin_amdgcn_rcpf(d.y);
    f32x2 q = t * 0.5307027145f + (-0.7265760135f); q = q * t + 0.7107068705f; q = q * t + (-0.142248368f); q = q * t + 0.127414796f; q = q * t;
    const f32x2 s = (v * v) * (-0.72134752044f);
    f32x2 e; e.x = __builtin_amdgcn_exp2f(s.x); e.y = __builtin_amdgcn_exp2f(s.y);
    const f32x2 m = v * (q * e), r = v - m;
    f32x2 o; o.x = v.x < 0.f ? m.x : r.x; o.y = v.y < 0.f ? m.y : r.y; return o;
}

template <int ACT  > struct EpiBf16 {
    static constexpr bool PERM = true, AFTER_DRAIN = false; static_assert(ACT == 0 || ACT == 1, "EpiBf16: ACT is 0 (none) or 1 (gelu_pk)");
    bf16_t* O; int ldc; const float* bias; int split_cols; size_t split_stride; float scale0;
    __device__ __forceinline__ void operator()(const f32x4 (&acc)[2][2][4][2], const Unit& u, int wr, int wc, int fr, int fq) const {
        const int row0 = u.pm * BM + wr * 64 + fr; int colt = u.pn * BM; bf16_t* base = O;
        float sc = 1.f; if (split_cols) { const int t = colt / split_cols; base += (size_t)t * split_stride; colt -= t * split_cols; if (t == 0) sc = scale0; }
        const int col0 = colt + wc * 32 + 8 * fq, bcol0 = u.pn * BM + wc * 32 + 8 * fq;
        f32x4 bv[2][2];
#pragma unroll
        for (int bj = 0; bj < 2; ++bj)
#pragma unroll
            for (int n = 0; n < 2; ++n) bv[bj][n] = bias ? *(const f32x4*)(bias + bcol0 + bj * HALF + 4 * n) : (f32x4){0.f, 0.f, 0.f, 0.f};
#pragma unroll
        for (int ai = 0; ai < 2; ++ai)
#pragma unroll
            for (int m = 0; m < 4; ++m) { bf16_t* rowp = base + (size_t)(row0 + ai * HALF + m * 16) * ldc + col0;
#pragma unroll
                for (int bj = 0; bj < 2; ++bj) { f32x4 v0 = acc[ai][bj][m][0] + bv[bj][0], v1 = acc[ai][bj][m][1] + bv[bj][1];
                    if (ACT == 1) { f32x2 a = gelu_pk((f32x2){v0[0], v0[1]}), b = gelu_pk((f32x2){v0[2], v0[3]}), c = gelu_pk((f32x2){v1[0], v1[1]}), d = gelu_pk((f32x2){v1[2], v1[3]});
                        v0 = (f32x4){a.x, a.y, b.x, b.y}; v1 = (f32x4){c.x, c.y, d.x, d.y}; }
                    v0 = v0 * sc; v1 = v1 * sc; u32x4 w; w.x = cvt_pk_bf16(v0[0], v0[1]); w.y = cvt_pk_bf16(v0[2], v0[3]); w.z = cvt_pk_bf16(v1[0], v1[1]); w.w = cvt_pk_bf16(v1[2], v1[3]);
                    __builtin_nontemporal_store(w, (u32x4*)(rowp + bj * HALF)); } }
    }
};
__device__ __forceinline__ float bf_lo(unsigned w) { return __uint_as_float(w << 16); }
__device__ __forceinline__ float bf_hi(unsigned w) { return __uint_as_float(w & 0xffff0000u); }
__device__ __forceinline__ float fast_sigmoid(float x) { return __builtin_amdgcn_rcpf(1.0f + __expf(-x)); }
struct EpiBf16T {
    static constexpr bool PERM = true, AFTER_DRAIN = false;
    bf16_t* O; int nN;
    __device__ __forceinline__ void operator()(const f32x4 (&acc)[2][2][4][2], const Unit& u, int wr, int wc, int fr, int fq) const {
        bf16_t* tile = O + (size_t)(u.pm * nN + u.pn) * 65536 + (wr * 64 + fr) * 256 + wc * 32 + 8 * fq;
#pragma unroll
        for (int ai = 0; ai < 2; ++ai)
#pragma unroll
            for (int m = 0; m < 4; ++m) { bf16_t* rowp = tile + (ai * HALF + m * 16) * 256;
#pragma unroll
                for (int bj = 0; bj < 2; ++bj) { const f32x4 v0 = acc[ai][bj][m][0], v1 = acc[ai][bj][m][1];
                    u32x4 w; w.x = cvt_pk_bf16(v0[0], v0[1]); w.y = cvt_pk_bf16(v0[2], v0[3]); w.z = cvt_pk_bf16(v1[0], v1[1]); w.w = cvt_pk_bf16(v1[2], v1[3]);
                    *(u32x4*)(rowp + bj * HALF) = w; } }
    }
};
struct EpiProj {
    static constexpr bool PERM = true, AFTER_DRAIN = false;
    bf16_t* O; int nN, oz_lo, oz_hi, silu_lo;
    __device__ __forceinline__ void operator()(const f32x4 (&acc)[2][2][4][2], const Unit& u, int wr, int wc, int fr, int fq) const {
        bf16_t* tile = O + (size_t)(u.pm * nN + u.pn) * 65536 + (wr * 64 + fr) * 256 + wc * 32 + 8 * fq;
        if (u.pn >= oz_lo && u.pn < oz_hi) {
#pragma unroll
            for (int ai = 0; ai < 2; ++ai)
#pragma unroll
                for (int m = 0; m < 4; ++m) { float g[8];
#pragma unroll
                    for (int n = 0; n < 2; ++n)
#pragma unroll
                        for (int k = 0; k < 4; ++k) { const float o = acc[ai][0][m][n][k], z = acc[ai][1][m][n][k]; g[4 * n + k] = z * __builtin_amdgcn_rcpf((1.0f + __expf(-o)) * (1.0f + __expf(-z))); }
                    u32x4 w; w.x = cvt_pk_bf16(g[0], g[1]); w.y = cvt_pk_bf16(g[2], g[3]); w.z = cvt_pk_bf16(g[4], g[5]); w.w = cvt_pk_bf16(g[6], g[7]);
                    *(u32x4*)(tile + (ai * HALF + m * 16) * 256) = w; }
        } else if (u.pn >= silu_lo) {
#pragma unroll
            for (int ai = 0; ai < 2; ++ai)
#pragma unroll
                for (int m = 0; m < 4; ++m) { bf16_t* rowp = tile + (ai * HALF + m * 16) * 256;
#pragma unroll
                    for (int bj = 0; bj < 2; ++bj) { f32x4 v0 = acc[ai][bj][m][0], v1 = acc[ai][bj][m][1];
#pragma unroll
                        for (int k = 0; k < 4; ++k) { v0[k] = v0[k] * fast_sigmoid(v0[k]); v1[k] = v1[k] * fast_sigmoid(v1[k]); }
                        u32x4 w; w.x = cvt_pk_bf16(v0[0], v0[1]); w.y = cvt_pk_bf16(v0[2], v0[3]); w.z = cvt_pk_bf16(v1[0], v1[1]); w.w = cvt_pk_bf16(v1[2], v1[3]);
                        *(u32x4*)(rowp + bj * HALF) = w; } }
        } else {
#pragma unroll
            for (int ai = 0; ai < 2; ++ai)
#pragma unroll
                for (int m = 0; m < 4; ++m) { bf16_t* rowp = tile + (ai * HALF + m * 16) * 256;
#pragma unroll
                    for (int bj = 0; bj < 2; ++bj) { const f32x4 v0 = acc[ai][bj][m][0], v1 = acc[ai][bj][m][1];
                        u32x4 w; w.x = cvt_pk_bf16(v0[0], v0[1]); w.y = cvt_pk_bf16(v0[2], v0[3]); w.z = cvt_pk_bf16(v1[0], v1[1]); w.w = cvt_pk_bf16(v1[2], v1[3]);
                        *(u32x4*)(rowp + bj * HALF) = w; } }
        }
    }
};
struct EpiRes {
    static constexpr bool PERM = true, AFTER_DRAIN = false;
    const bf16_t* ub; const float* rms; const float* nw; bf16_t* hb; unsigned char* hb8; float* ssq; int ldc, nN;
    __device__ __forceinline__ void operator()(const f32x4 (&acc)[2][2][4][2], const Unit& u, int wr, int wc, int fr, int fq) const {
        const int row0 = u.pm * BM + wr * 64 + fr, col0 = u.pn * BM + wc * 32 + 8 * fq;
        const size_t toff = (size_t)(u.pm * nN + u.pn) * 65536 + (wr * 64 + fr) * 256 + wc * 32 + 8 * fq;
        f32x4 inw[2][2];
#pragma unroll
        for (int bj = 0; bj < 2; ++bj)
#pragma unroll
            for (int n = 0; n < 2; ++n) { const f32x4 w = *(const f32x4*)(nw + col0 + bj * HALF + 4 * n); inw[bj][n] = (f32x4){__builtin_amdgcn_rcpf(w[0]), __builtin_amdgcn_rcpf(w[1]), __builtin_amdgcn_rcpf(w[2]), __builtin_amdgcn_rcpf(w[3])}; }
#pragma unroll
        for (int ai = 0; ai < 2; ++ai) {
            u32x4 xv[4][2]; float rm[4];
#pragma unroll
            for (int m = 0; m < 4; ++m) { const size_t off = (size_t)(row0 + ai * HALF + m * 16) * ldc + col0; rm[m] = rms[row0 + ai * HALF + m * 16];
#pragma unroll
                for (int bj = 0; bj < 2; ++bj) xv[m][bj] = *(const u32x4*)(ub + off + bj * HALF); }
#pragma unroll
            for (int m = 0; m < 4; ++m) { const int row = row0 + ai * HALF + m * 16; const size_t to = toff + (ai * HALF + m * 16) * 256; float ss = 0.f;
#pragma unroll
                for (int bj = 0; bj < 2; ++bj) {
                    const u32x4 xw = xv[m][bj];
                    const f32x4 h0 = (f32x4){bf_lo(xw.x), bf_hi(xw.x), bf_lo(xw.y), bf_hi(xw.y)} * inw[bj][0] * rm[m] + acc[ai][bj][m][0], h1 = (f32x4){bf_lo(xw.z), bf_hi(xw.z), bf_lo(xw.w), bf_hi(xw.w)} * inw[bj][1] * rm[m] + acc[ai][bj][m][1];
                    ss += (h0[0] * h0[0] + h0[1] * h0[1]) + (h0[2] * h0[2] + h0[3] * h0[3]) + (h1[0] * h1[0] + h1[1] * h1[1]) + (h1[2] * h1[2] + h1[3] * h1[3]);
                    u32x4 w; w.x = cvt_pk_bf16(h0[0], h0[1]); w.y = cvt_pk_bf16(h0[2], h0[3]); w.z = cvt_pk_bf16(h1[0], h1[1]); w.w = cvt_pk_bf16(h1[2], h1[3]);
                    *(u32x4*)(hb + to + bj * HALF) = w;
                    u32x2 w8; w8.x = cvt_pk4_fp8(h0[0] * 16.0f, h0[1] * 16.0f, h0[2] * 16.0f, h0[3] * 16.0f); w8.y = cvt_pk4_fp8(h1[0] * 16.0f, h1[1] * 16.0f, h1[2] * 16.0f, h1[3] * 16.0f);
                    *(u32x2*)(hb8 + to + bj * HALF) = w8; }
                ss += __shfl_xor(ss, 16); ss += __shfl_xor(ss, 32);
                if (fq == 0) atomicAdd(ssq + row, ss); }
        }
    }
};
struct EpiGate {
    static constexpr bool PERM = true, AFTER_DRAIN = false;
    bf16_t* e; const bf16_t* hb; float* ssq_h; int nN; float inv_n, eps, ascale;
    __device__ __forceinline__ void operator()(const f32x4 (&acc)[2][2][4][2], const Unit& u, int wr, int wc, int fr, int fq) const {
        const int row0 = u.pm * BM + wr * 64 + fr;
        const size_t toff = (size_t)(u.pm * nN + u.pn) * 65536 + (wr * 64 + fr) * 256 + wc * 32 + 8 * fq;
#pragma unroll
        for (int ai = 0; ai < 2; ++ai) {
            u32x4 ev[4][2], hv[4][2]; float sq[4];
#pragma unroll
            for (int m = 0; m < 4; ++m) { const size_t to = toff + (ai * HALF + m * 16) * 256;
                sq[m] = __hip_atomic_load(ssq_h + row0 + ai * HALF + m * 16, __ATOMIC_RELAXED, __HIP_MEMORY_SCOPE_AGENT);
#pragma unroll
                for (int bj = 0; bj < 2; ++bj) { ev[m][bj] = *(const u32x4*)(e + to + bj * HALF); hv[m][bj] = *(const u32x4*)(hb + to + bj * HALF); } }
#pragma unroll
            for (int m = 0; m < 4; ++m) { const size_t to = toff + (ai * HALF + m * 16) * 256;
                const float rstd = __builtin_amdgcn_rsqf(sq[m] * inv_n + eps) * ascale;
#pragma unroll
                for (int bj = 0; bj < 2; ++bj) { const u32x4 v = ev[m][bj], h = hv[m][bj];
                    const f32x4 a0 = acc[ai][bj][m][0] * rstd, a1 = acc[ai][bj][m][1] * rstd;
                    u32x4 w;
                    w.x = cvt_pk_bf16(bf_lo(h.x) + fast_sigmoid(a0[0]) * bf_lo(v.x), bf_hi(h.x) + fast_sigmoid(a0[1]) * bf_hi(v.x)); w.y = cvt_pk_bf16(bf_lo(h.y) + fast_sigmoid(a0[2]) * bf_lo(v.y), bf_hi(h.y) + fast_sigmoid(a0[3]) * bf_hi(v.y));
                    w.z = cvt_pk_bf16(bf_lo(h.z) + fast_sigmoid(a1[0]) * bf_lo(v.z), bf_hi(h.z) + fast_sigmoid(a1[1]) * bf_hi(v.z)); w.w = cvt_pk_bf16(bf_lo(h.w) + fast_sigmoid(a1[2]) * bf_lo(v.w), bf_hi(h.w) + fast_sigmoid(a1[3]) * bf_hi(v.w));
                    *(u32x4*)(e + to + bj * HALF) = w; } }
        }
    }
};
struct EpiNull {
    static constexpr bool PERM = true, AFTER_DRAIN = false;
    __device__ __forceinline__ void operator()(const f32x4 (&acc)[2][2][4][2], const Unit& u, int wr, int wc, int fr, int fq) const {
#pragma unroll
        for (int ai = 0; ai < 2; ++ai)
#pragma unroll
            for (int bj = 0; bj < 2; ++bj)
#pragma unroll
                for (int m = 0; m < 4; ++m)
#pragma unroll
                    for (int n = 0; n < 2; ++n) asm volatile("" :: "v"(acc[ai][bj][m][n]));
    }
};
struct SameTileOrder {
    int c, n;
    __device__ bool next(int i, Unit& u) const { if (i >= n) return false; u.pm = c & 7; u.pn = i % 24; return true; }
    __device__ __forceinline__ void a_ready(const Unit&) const {}
    __device__ __forceinline__ void done(const Unit&) const {}
};
struct EpiScratch {
    static constexpr bool PERM = true, AFTER_DRAIN = false;
    bf16_t* O0; int per_unit;
    __device__ __forceinline__ void operator()(const f32x4 (&acc)[2][2][4][2], const Unit& u, int wr, int wc, int fr, int fq) const {
        bf16_t* O = O0 + (per_unit ? (size_t)(u.pm * 24 + u.pn) * 65536 : (size_t)0);
        const int row0 = wr * 64 + fr, col0 = wc * 32 + 8 * fq;
#pragma unroll
        for (int ai = 0; ai < 2; ++ai)
#pragma unroll
            for (int m = 0; m < 4; ++m) { bf16_t* rowp = O + (size_t)(row0 + ai * HALF + m * 16) * 256 + col0;
#pragma unroll
                for (int bj = 0; bj < 2; ++bj) { const f32x4 v0 = acc[ai][bj][m][0], v1 = acc[ai][bj][m][1];
                    u32x4 w; w.x = cvt_pk_bf16(v0[0], v0[1]); w.y = cvt_pk_bf16(v0[2], v0[3]); w.z = cvt_pk_bf16(v1[0], v1[1]); w.w = cvt_pk_bf16(v1[2], v1[3]);
                    *(u32x4*)(rowp + bj * HALF) = w; } }
    }
};
template <class Epi, class Sched, bool ALIGN_EPI = false, bool SP2 = false, bool PROBE_K0 = false, int PF = 0, bool NOSTAGE = false, int ABLK = 0, bool NOWAIT = false, bool NOREAD = false, bool FP8 = false>
__device__ __forceinline__ void gemm_phase(PG8_LAS unsigned char* lds, const Gemm g, const Sched& S, const Epi& E) {
    int tid_ = threadIdx.x; asm volatile("" : "+v"(tid_));
    const int tid = tid_, wid = __builtin_amdgcn_readfirstlane(tid >> 6), lane = tid & 63, wr = wid >> 2, wc = wid & 3, fr = lane & 15, fq = lane >> 4;
    const int K = g.K, nt = K / BK;
    unsigned voffA[2], voffB[2];
#pragma unroll
    for (int i = 0; i < 2; ++i) { int R, C; stage_rc(tid * 16 + i * 8192, R, C); const int Rb = Epi::PERM ? ((R & ~31) + perm32(R & 31)) : R;
        voffA[i] = (unsigned)(R * (ABLK == 2 ? 128 : ABLK == 1 ? 256 : K) + C) * 2u; voffB[i] = (unsigned)(Rb * K + C) * 2u; }
    const size_t kstep = PROBE_K0 ? (size_t)0 : (size_t)(BK * 2);
    const size_t hstepB = (size_t)HALF * K * 2, hstepA = ABLK == 2 ? (size_t)HALF * 256 : ABLK == 1 ? (size_t)HALF * 256 * 2 : hstepB;
    const size_t tstep = 2 * hstepB;
    static_assert(!(ABLK && PF > 0), "L2 warming is not written for the blocked A layout");
    const unsigned pfoff = (unsigned)((wid & 3) * 64 + lane) * (unsigned)K * 2u;
    const unsigned pflds = (unsigned)STAGE_BYTES + 1024u + (unsigned)wid * 256u;
    const unsigned ldsw = (unsigned)wid * 1024u;
    const int aoff = lds_byte(wr * 64 + fr, fq * 8), boff = lds_byte(wc * 32 + fr, fq * 8);
#define PG8_SA(b, h) (((b) * 2 + (h)) * HTB)
#define PG8_SB(b, h) ((4 + (b) * 2 + (h)) * HTB)
#define PG8_STAGE(bufoff, gbase, voff) do { if constexpr (!NOSTAGE) _Pragma("unroll") for (int _i = 0; _i < 2; ++_i) \
        __builtin_amdgcn_global_load_lds((const unsigned*)((const char*)(gbase) + (voff)[_i]), (PG8_LAS unsigned*)(lds + (bufoff) + ldsw + _i * 8192), 16, 0, 0); } while (0)
#define PG8_LDA(dst, b, h) do { if constexpr (!NOREAD) _Pragma("unroll") for (int m = 0; m < 4; ++m) _Pragma("unroll") for (int k = 0; k < 2; ++k) dst[m][k] = *(const PG8_LAS bf16x8*)(lds + PG8_SA(b, h) + aoff + m * 2048 + k * 1024); } while (0)
#define PG8_LDB(dst, b, h) do { if constexpr (!NOREAD) _Pragma("unroll") for (int n = 0; n < 2; ++n) _Pragma("unroll") for (int k = 0; k < 2; ++k) dst[n][k] = *(const PG8_LAS bf16x8*)(lds + PG8_SB(b, h) + boff + n * 2048 + k * 1024); } while (0)
#define PG8_MMA(ai, bj, At, Bt) do { __builtin_amdgcn_s_setprio(1); _Pragma("unroll") for (int m = 0; m < 4; ++m) _Pragma("unroll") for (int n = 0; n < 2; ++n) { \
        if constexpr (FP8 && FP8_MX) mfma_fp8_inplace(acc[ai][bj][m][n], cat8(Bt[n][0], Bt[n][1]), cat8(At[m][0], At[m][1]), one_scale); \
        else if constexpr (FP8) { _Pragma("unroll") for (int k = 0; k < 2; ++k) { const i64x2_ bb = __builtin_bit_cast(i64x2_, Bt[n][k]), aa = __builtin_bit_cast(i64x2_, At[m][k]); \
            acc[ai][bj][m][n] = __builtin_amdgcn_mfma_f32_16x16x32_fp8_fp8(bb[0], aa[0], acc[ai][bj][m][n], 0, 0, 0); acc[ai][bj][m][n] = __builtin_amdgcn_mfma_f32_16x16x32_fp8_fp8(bb[1], aa[1], acc[ai][bj][m][n], 0, 0, 0); } } \
        else { _Pragma("unroll") for (int k = 0; k < 2; ++k) acc[ai][bj][m][n] = __builtin_amdgcn_mfma_f32_16x16x32_bf16(Bt[n][k], At[m][k], acc[ai][bj][m][n], 0, 0, 0); } } __builtin_amdgcn_s_setprio(0); } while (0)
#define PG8_WAIT_V(n) asm volatile("s_waitcnt vmcnt(" #n ")" ::: "memory")
#define PG8_WARM(kt) do { if constexpr (PF > 0) { const int _kt = (kt); const char* _p = (wid < 4) ? ((_kt < nt) ? cA + (size_t)_kt * kstep : nA + (size_t)((_kt - nt) < nt ? (_kt - nt) : nt - 1) * kstep) : ((_kt < nt) ? cB + (size_t)_kt * kstep : nB + (size_t)((_kt - nt) < nt ? (_kt - nt) : nt - 1) * kstep); \
        __builtin_amdgcn_global_load_lds((const unsigned*)(_p + pfoff), (PG8_LAS unsigned*)(lds + pflds), 4, 0, 0); } } while (0)
#define PG8_WAIT_VK() do { if constexpr (NOWAIT) {} else if constexpr (PF > 0) PG8_WAIT_V(9); else PG8_WAIT_V(8); } while (0)
#define PG8_WAIT_L(n) asm volatile("s_waitcnt lgkmcnt(" #n ")" ::: "memory")
#define PG8_BAR __builtin_amdgcn_s_barrier()
#define PG8_SCHED __builtin_amdgcn_sched_barrier(0)
    constexpr bool FP8_MX = true;
    const int one_scale = 0x7f7f7f7f;
    Unit cur, nxt; int ui = 0;
    if (!S.next(0, cur)) return;
    f32x4 acc[2][2][4][2];
#pragma unroll
    for (int a = 0; a < 2; ++a)
#pragma unroll
        for (int b = 0; b < 2; ++b)
#pragma unroll
            for (int m = 0; m < 4; ++m)
#pragma unroll
                for (int n = 0; n < 2; ++n) acc[a][b][m][n] = (f32x4){0.f, 0.f, 0.f, 0.f};
    bf16x8 At[4][2], B0[2][2], B1[2][2];
    if constexpr (NOREAD) {
#pragma unroll
        for (int i = 0; i < 8; ++i) { const bf16x8 v = {(short)(0x3f80 + lane + i), (short)(0x3f00 + i), (short)(0xbf80 + lane), (short)0x3e80, (short)(0x3f80 + i), (short)0xbf00, (short)(0x3f81 + lane), (short)0x3f00}; At[i & 3][i >> 2] = v; if (i < 4) { B0[i & 1][i >> 1] = v; B1[i & 1][i >> 1] = v; } }
    }
    const char* cA = (const char*)g.A + (size_t)cur.pm * tstep; const char* cB = (const char*)g.Bt + (size_t)cur.pn * tstep;
    S.a_ready(cur);
    if constexpr (SP2) {
        PG8_STAGE(PG8_SB(0, 0), cB, voffB); PG8_STAGE(PG8_SB(0, 1), cB + hstepB, voffB); PG8_STAGE(PG8_SA(0, 0), cA, voffA); PG8_STAGE(PG8_SA(0, 1), cA + hstepA, voffA);
        if (wr == 1) PG8_BAR;
        PG8_WAIT_V(2); PG8_BAR;
        PG8_STAGE(PG8_SB(1, 0), cB + kstep, voffB); PG8_STAGE(PG8_SA(1, 0), cA + kstep, voffA); PG8_STAGE(PG8_SB(1, 1), cB + hstepB + kstep, voffB);
        PG8_WAIT_V(6); PG8_BAR;
    } else {
        PG8_STAGE(PG8_SB(0, 0), cB, voffB); PG8_STAGE(PG8_SA(0, 0), cA, voffA); PG8_STAGE(PG8_SB(0, 1), cB + hstepB, voffB); PG8_STAGE(PG8_SA(0, 1), cA + hstepA, voffA);
        if (wr == 1) PG8_BAR;
        PG8_WAIT_V(4); PG8_BAR;
        PG8_STAGE(PG8_SB(1, 0), cB + kstep, voffB); PG8_STAGE(PG8_SA(1, 0), cA + kstep, voffA); PG8_STAGE(PG8_SB(1, 1), cB + hstepB + kstep, voffB);
        PG8_WAIT_V(6); PG8_BAR;
    }
    for (;;) {
        const bool has_next = S.next(ui + 1, nxt);
        const char* nA = has_next ? (const char*)g.A + (size_t)nxt.pm * tstep : cA; const char* nB = has_next ? (const char*)g.Bt + (size_t)nxt.pn * tstep : cB;
        for (int t = 0; t < nt; t += 2) {
            const bool last = (t == nt - 2);
            const char* a1 = cA + (ABLK == 2 ? (size_t)((t + 1) >> 1) * 65536 + (size_t)((t + 1) & 1) * 128 : ABLK == 1 ? (size_t)((t + 1) >> 2) * 131072 + (size_t)((t + 1) & 3) * 128 : (size_t)(t + 1) * kstep);
            const char* a2 = last ? nA : cA + (ABLK == 2 ? (size_t)((t + 2) >> 1) * 65536 + (size_t)((t + 2) & 1) * 128 : ABLK == 1 ? (size_t)((t + 2) >> 2) * 131072 + (size_t)((t + 2) & 3) * 128 : (size_t)(t + 2) * kstep); const char* b2 = last ? nB : cB + (size_t)(t + 2) * kstep;
            const char* a3 = a2 + kstep; const char* b3 = b2 + kstep;
            if (last && has_next) S.a_ready(nxt);
            if constexpr (SP2) {
            PG8_LDB(B0, 0, 0); PG8_LDB(B1, 0, 1); PG8_SCHED; PG8_LDA(At, 0, 0); PG8_STAGE(PG8_SA(1, 1), a1 + hstepA, voffA); PG8_WARM(t + 2 + PF);
            PG8_WAIT_VK(); PG8_WAIT_L(0); PG8_BAR; PG8_MMA(0, 0, At, B0); PG8_MMA(0, 1, At, B1); PG8_BAR; PG8_SCHED;
            PG8_LDA(At, 0, 1); PG8_STAGE(PG8_SB(0, 0), b2, voffB); PG8_STAGE(PG8_SB(0, 1), b2 + hstepB, voffB); PG8_STAGE(PG8_SA(0, 0), a2, voffA);
            PG8_WAIT_VK(); PG8_WAIT_L(0); PG8_BAR; PG8_MMA(1, 0, At, B0); PG8_MMA(1, 1, At, B1); PG8_BAR; PG8_SCHED;
            PG8_LDB(B0, 1, 0); PG8_LDB(B1, 1, 1); PG8_SCHED; PG8_LDA(At, 1, 0); PG8_STAGE(PG8_SA(0, 1), a2 + hstepA, voffA); PG8_WARM(t + 3 + PF);
            PG8_WAIT_VK(); PG8_WAIT_L(0); PG8_BAR; PG8_MMA(0, 0, At, B0); PG8_MMA(0, 1, At, B1); PG8_BAR; PG8_SCHED;
            PG8_LDA(At, 1, 1); PG8_STAGE(PG8_SB(1, 0), b3, voffB); PG8_STAGE(PG8_SB(1, 1), b3 + hstepB, voffB); PG8_STAGE(PG8_SA(1, 0), a3, voffA);
            PG8_WAIT_VK(); PG8_WAIT_L(0); PG8_BAR; PG8_MMA(1, 0, At, B0); PG8_MMA(1, 1, At, B1); PG8_BAR; PG8_SCHED;
            } else {
            PG8_LDB(B0, 0, 0); PG8_SCHED; PG8_LDA(At, 0, 0); PG8_STAGE(PG8_SA(1, 1), a1 + hstepA, voffA);
            PG8_WAIT_L(8); PG8_BAR; PG8_WAIT_L(0); PG8_MMA(0, 0, At, B0); PG8_BAR; PG8_SCHED;
            PG8_LDB(B1, 0, 1); PG8_STAGE(PG8_SB(0, 0), b2, voffB);
            PG8_BAR; PG8_WAIT_L(0); PG8_MMA(0, 1, At, B1); PG8_BAR;
            PG8_LDA(At, 0, 1); PG8_STAGE(PG8_SA(0, 0), a2, voffA);
            PG8_BAR; PG8_WAIT_L(0); PG8_MMA(1, 0, At, B0); PG8_BAR; PG8_SCHED;
            PG8_STAGE(PG8_SB(0, 1), b2 + hstepB, voffB);
            PG8_WAIT_V(6); PG8_BAR; PG8_MMA(1, 1, At, B1); PG8_BAR;
            PG8_LDB(B0, 1, 0); PG8_SCHED; PG8_LDA(At, 1, 0); PG8_STAGE(PG8_SA(0, 1), a2 + hstepA, voffA);
            PG8_WAIT_L(8); PG8_BAR; PG8_WAIT_L(0); PG8_MMA(0, 0, At, B0); PG8_BAR; PG8_SCHED;
            PG8_LDB(B1, 1, 1); PG8_STAGE(PG8_SB(1, 0), b3, voffB);
            PG8_BAR; PG8_WAIT_L(0); PG8_MMA(0, 1, At, B1); PG8_BAR;
            PG8_LDA(At, 1, 1); PG8_STAGE(PG8_SA(1, 0), a3, voffA);
            PG8_BAR; PG8_WAIT_L(0); PG8_MMA(1, 0, At, B0); PG8_BAR; PG8_SCHED;
            PG8_STAGE(PG8_SB(1, 1), b3 + hstepB, voffB);
            PG8_WAIT_V(6); PG8_BAR; PG8_MMA(1, 1, At, B1); PG8_BAR;
            }
        }
        if constexpr (FP8 && FP8_MX) asm volatile("s_nop 15\n\ts_nop 15" ::: "memory");
        if constexpr (ALIGN_EPI) { if (wr == 0) PG8_BAR; }
        if constexpr (!Epi::AFTER_DRAIN) { E(acc, cur, wr, wc, fr, fq); S.done(cur); }
        if (!has_next) break;
#pragma unroll
        for (int a = 0; a < 2; ++a)
#pragma unroll
            for (int b = 0; b < 2; ++b)
#pragma unroll
                for (int m = 0; m < 4; ++m)
#pragma unroll
                    for (int n = 0; n < 2; ++n) acc[a][b][m][n] = (f32x4){0.f, 0.f, 0.f, 0.f};
        cur = nxt; cA = nA; cB = nB; ++ui;
        if constexpr (ALIGN_EPI) { if (wr == 1) PG8_BAR; }
    }
    PG8_WAIT_V(0);
    if constexpr (!ALIGN_EPI) { if (wr == 0) PG8_BAR; }
    PG8_BAR;
    if constexpr (Epi::AFTER_DRAIN) { E.fused(acc, cur, wr, wc, fr, fq, lds, wid, lane); S.done(cur); }
#undef PG8_SA
#undef PG8_SB
#undef PG8_STAGE
#undef PG8_LDA
#undef PG8_LDB
#undef PG8_MMA
#undef PG8_WAIT_V
#undef PG8_WARM
#undef PG8_WAIT_VK
#undef PG8_WAIT_L
#undef PG8_BAR
#undef PG8_SCHED
}
}
constexpr int NWAVES = 8, NTHR = 512;
#ifndef MK_N_LAUNCHES
#define MK_N_LAUNCHES 1
#define PROBE_DOUBLE 0
#define PROBE_KIND 0
#define PROBE_TS (-1)
#define PROBE_TB (PROBE_TS + 1)
#define PROBE_F0 0.0f
#endif
constexpr int N_LAUNCHES = MK_N_LAUNCHES;
constexpr int PER_PHASE = 8;
constexpr int BATCH = 2, SEQ = 16384, DM = 2048, M = BATCH * SEQ, NCH = SEQ / 64;
constexpr int IN_COLS = 8200, PE = 256, NNAT = 6144, NTR = 2048;
constexpr float EPS = 1e-6f;
constexpr int PC_Q = 0, PC_K = 512, PC_OZ = 1024  , PC_HQ = 3072, PC_HF = 4096, PC_HG = 5120;
constexpr size_t MiB = 1u << 20;
constexpr size_t WS_CTL = 0, CTL_ZERO_BYTES = 1 * MiB;
constexpr size_t WS_SSQH = 256 * 1024, WS_SSQ2 = 512 * 1024;
constexpr size_t WS_WIN = 2 * MiB, WS_WO = 34 * MiB, WS_WG = 42 * MiB, WS_WE = 50 * MiB;
constexpr size_t WS_GATES = 52 * MiB;
constexpr size_t WS_BCUM = 53 * MiB;
constexpr size_t WS_MSC = 54 * MiB;
constexpr size_t WS_NST = 55 * MiB;
constexpr size_t WS_GDEC = 56 * MiB;
constexpr size_t WS_EBR = 58 * MiB;
constexpr size_t WS_CARRY = 976 * MiB;
constexpr size_t WS_RMS = 59 * MiB;
constexpr size_t WS_Y = 784 * MiB;
constexpr size_t WS_PB = 64 * MiB;
constexpr size_t WS_U = 80 * MiB;
constexpr size_t WS_PROJ = 208 * MiB;
constexpr size_t WS_VT = 592 * MiB;
constexpr size_t WS_QC = 720 * MiB, WS_KC = 752 * MiB;
constexpr size_t WS_HQT = 784 * MiB, WS_HKT = 848 * MiB, WS_HQ2 = 912 * MiB;
constexpr size_t WS_END = 984 * MiB;
constexpr int CW_TMO = 0, CW_BAR = 4096;
constexpr int RING_BYTES = 131072, LDSCTL_OFF = RING_BYTES, MISC_OFF = LDSCTL_OFF + 320, LDS_BYTES = 147456;

#define GAS __attribute__((address_space(1)))
#define LAS __attribute__((address_space(3)))
typedef unsigned short bf16;
typedef unsigned v4u __attribute__((ext_vector_type(4)));
typedef unsigned v2u __attribute__((ext_vector_type(2)));
typedef float f32x4 __attribute__((ext_vector_type(4)));
typedef float v2f __attribute__((ext_vector_type(2)));
typedef float f32x16 __attribute__((ext_vector_type(16)));
typedef short bf16x8 __attribute__((ext_vector_type(8)));
typedef GAS unsigned gu32;
#define RLX_AGENT __ATOMIC_RELAXED, __HIP_MEMORY_SCOPE_AGENT
#define LDS_WAIT() asm volatile("s_waitcnt lgkmcnt(0)" ::: "memory")
#define VM_WAIT() asm volatile("s_waitcnt vmcnt(0)" ::: "memory")
typedef __bf16 bf16x2_t __attribute__((ext_vector_type(2)));
__device__ __forceinline__ unsigned pk2(float lo, float hi) { bf16x2_t v; v[0] = (__bf16)lo; v[1] = (__bf16)hi; return __builtin_bit_cast(unsigned, v); }
__device__ __forceinline__ float bf2f(bf16 v) { return __uint_as_float((unsigned)v << 16); }
__device__ __forceinline__ float blo(unsigned w) { return __uint_as_float(w << 16); }
__device__ __forceinline__ float bhi(unsigned w) { return __uint_as_float(w & 0xffff0000u); }
__device__ __forceinline__ float frcp(float x) { return __builtin_amdgcn_rcpf(x); }
__device__ __forceinline__ float frsq(float x) { return __builtin_amdgcn_rsqf(x); }
__device__ __forceinline__ float fexp(float x) { return __expf(x); }
__device__ __forceinline__ float flog(float x) { return __logf(x); }
__device__ __forceinline__ float sigm(float x) { return frcp(1.0f + __expf(-x)); }

#define XB_TMO      128
#define XB_XCNT(j)  (256  + 64 * (j))
#define XB_XSUB(j)  (1280 + 64 * (j))
#define XB_XGEN(j)  (2304 + 64 * (j))
#define XB_TOP      3328
#define XB_TOPGEN   3392
#define XCD_BAR_WORDS 3456
#define XB_SPIN_CAP (1u << 18)
__device__ __forceinline__ unsigned xb_ld(unsigned* p)              { return __hip_atomic_load(p, __ATOMIC_RELAXED, __HIP_MEMORY_SCOPE_AGENT); }
__device__ __forceinline__ unsigned xb_add(unsigned* p, unsigned v) { return __hip_atomic_fetch_add(p, v, __ATOMIC_RELAXED, __HIP_MEMORY_SCOPE_AGENT); }
__device__ __forceinline__ unsigned xb_xcc_id() { return (unsigned)__builtin_amdgcn_s_getreg((3 << 11) | 20) & 0xFu; }
#define XB_SPIN(cond, bar) do { unsigned _sp = 0; while (cond) { __builtin_amdgcn_s_sleep(1); \
    if ((++_sp & 255u) == 0u) { if (xb_ld(&(bar)[XB_TMO])) break; if (_sp > XB_SPIN_CAP) { atomicAdd(&(bar)[XB_TMO], 1u); break; } } } } while (0)
struct XcdBarrier { unsigned* bar; unsigned x; volatile LAS unsigned* st; };
__device__ __forceinline__ XcdBarrier xcd_barrier_post(unsigned* bar, volatile LAS unsigned* st) {
    XcdBarrier b; b.bar = bar; b.x = xb_xcc_id(); b.st = st;
    if (threadIdx.x == 0) st[3] = xb_add(&bar[XB_XCNT(b.x)], 1u);
    return b;
}
__device__ __forceinline__ void xcd_barrier_complete(unsigned* bar, unsigned x, unsigned& nloc, unsigned& nx, unsigned& even) {
    const unsigned G = gridDim.x * gridDim.y * gridDim.z;
    unsigned sum, cnt, mine, sp = 0u, ev;
    for (;;) {
        sum = 0u; cnt = 0u; mine = 0u; ev = 1u;
#pragma unroll
        for (unsigned j = 0; j < 16; ++j) { const unsigned c = xb_ld(&bar[XB_XCNT(j)]); sum += c; cnt += (c > 0u) ? 1u : 0u; mine = (j == x) ? c : mine; ev &= (j < 8u) ? (c * 8u == G ? 1u : 0u) : (c == 0u ? 1u : 0u); }
        if (sum == G) break;
        __builtin_amdgcn_s_sleep(1);
        if ((++sp & 255u) == 0u) { if (xb_ld(&bar[XB_TMO])) break; if (sp > XB_SPIN_CAP) { atomicAdd(&bar[XB_TMO], 1u); break; } }
    }
    nloc = mine > 0u ? mine : 1u; nx = cnt > 0u ? cnt : 1u; even = (sum == G) ? ev : 0u;
}
__device__ __forceinline__ void xcd_barrier(const XcdBarrier& b) {
    asm volatile("s_waitcnt vmcnt(0)" ::: "memory");
    __syncthreads();
    if (threadIdx.x == 0) {
        unsigned* bar = b.bar;
        __builtin_amdgcn_s_waitcnt(0);
        unsigned nloc = b.st[0], nx = b.st[1];
        if (nloc == 0u) { unsigned even; xcd_barrier_complete(bar, b.x, nloc, nx, even); b.st[0] = nloc; b.st[1] = nx; b.st[2] = even; }
        const unsigned old = xb_add(&bar[XB_XSUB(b.x)], 1u);
        const unsigned gen = old / nloc;
        if (old + 1u == (gen + 1u) * nloc) {
            __builtin_amdgcn_fence(__ATOMIC_RELEASE, "agent");
            asm volatile("s_waitcnt vmcnt(0)" ::: "memory");
            const unsigned og = xb_add(&bar[XB_TOP], 1u);
            const unsigned tg = og / nx;
            if (og + 1u == (tg + 1u) * nx) xb_add(&bar[XB_TOPGEN], 1u);
            else XB_SPIN(xb_ld(&bar[XB_TOPGEN]) == tg, bar);
            __builtin_amdgcn_fence(__ATOMIC_ACQUIRE, "agent");
            xb_add(&bar[XB_XGEN(b.x)], 1u);
            asm volatile("s_waitcnt vmcnt(0)" ::: "memory");
        } else {
            XB_SPIN(xb_ld(&bar[XB_XGEN(b.x)]) == gen, bar);
            __builtin_amdgcn_fence(__ATOMIC_ACQUIRE, "agent");
            asm volatile("s_waitcnt vmcnt(0)" ::: "memory");
        }
    }
    __syncthreads();
}

struct Frame {
    LAS unsigned char* lds;
    int tid, lane, wave, G, bid;
    const float *x, *p, *norm_w, *w_in, *conv_w, *conv_b, *b_i, *b_f, *ml_nw, *hg_lb, *hg_nw, *w_out, *pe_nw, *w_pg, *w_pe, *fin_nw;
    float* out;
    bf16 *Wt_in, *WoT, *WgT, *WeT, *PB, *U, *Y, *PROJ, *HB, *EB, *VT, *Cm, *Ch, *QC, *KC, *HQT, *HKT, *HQ2;
    float *gates, *bcum, *msc, *nst, *gdec, *ebr, *carry, *ssqh, *ssq2;
};
__device__ __forceinline__ size_t proj_off(int m, int n) { return ((size_t)((m >> 8) * 24 + (n >> 8)) << 16) + (size_t)((m & 255) * 256 + (n & 255)); }
__device__ __forceinline__ size_t vt_off(int v, int m) { return ((size_t)((v >> 8) * 128 + (m >> 8)) << 16) + (size_t)((v & 255) * 256 + (m & 255)); }
__device__ __forceinline__ float wave_sum(float v) {
#pragma unroll
    for (int o = 1; o < 64; o <<= 1) v += __shfl_xor(v, o);
    return v;
}
__device__ __forceinline__ float wave_max(float v) {
#pragma unroll
    for (int o = 1; o < 64; o <<= 1) v = fmaxf(v, __shfl_xor(v, o));
    return v;
}
__device__ __forceinline__ float wave_scan_sum(float v, int lane) {
#pragma unroll
    for (int o = 1; o < 64; o <<= 1) { const float y = __shfl_up(v, o); if (lane >= o) v += y; }
    return v;
}
__device__ __forceinline__ float wave_scan_max(float v, int lane) {
#pragma unroll
    for (int o = 1; o < 64; o <<= 1) { const float y = __shfl_up(v, o); if (lane >= o) v = fmaxf(v, y); }
    return v;
}
__device__ __forceinline__ int opaque_i(int v) { asm volatile("" : "+v"(v)); return v; }
__device__ __forceinline__ f32x16 mfma32(bf16x8 a, bf16x8 b, f32x16 c) { return __builtin_amdgcn_mfma_f32_32x32x16_bf16(a, b, c, 0, 0, 0); }
__device__ __forceinline__ f32x16 zero16() { f32x16 z;
#pragma unroll
    for (int i = 0; i < 16; ++i) z[i] = 0.f;
    return z; }

constexpr float WG_SCALE = 256.0f, HB8_SCALE = 16.0f;
constexpr size_t HB8_OFF = 256 * MiB;
__device__ __forceinline__ void p0_transpose_item(const float* W, int ldw, int src_col, int K, bf16* WT, int dst_row, const float* kscale, LAS float* scr, int k0, int lane) {
#pragma unroll 8
    for (int i = 0; i < 32; ++i) { const int kk = 2 * i + (lane >> 5); float v = W[(size_t)(k0 + kk) * ldw + src_col + (lane & 31)]; if (kscale) v *= kscale[k0 + kk]; scr[kk * 33 + (lane & 31)] = v; }
    LDS_WAIT(); asm volatile("" ::: "memory");
    const int c = lane & 7;
#pragma unroll
    for (int j = 0; j < 4; ++j) { const int n = (lane >> 3) + 8 * j; const LAS float* s = scr + (8 * c) * 33 + n;
        v4u o; o.x = pk2(s[0 * 33], s[1 * 33]); o.y = pk2(s[2 * 33], s[3 * 33]); o.z = pk2(s[4 * 33], s[5 * 33]); o.w = pk2(s[6 * 33], s[7 * 33]);
        *(v4u*)(WT + (size_t)(dst_row + n) * K + k0 + 8 * c) = o; }
    LDS_WAIT(); asm volatile("" ::: "memory");
}
__device__ __forceinline__ void p0_transpose_item_fp8(const float* W, int ldw, int src_col, int K, unsigned char* WT, int dst_row, const float* kscale, float scale, LAS float* scr, int k0, int lane) {
#pragma unroll 8
    for (int i = 0; i < 32; ++i) { const int kk = 2 * i + (lane >> 5); const float v = W[(size_t)(k0 + kk) * ldw + src_col + (lane & 31)] * (kscale[k0 + kk] * scale); scr[kk * 33 + (lane & 31)] = v; }
    LDS_WAIT(); asm volatile("" ::: "memory");
    const int c = lane & 7;
#pragma unroll
    for (int j = 0; j < 4; ++j) { const int n = (lane >> 3) + 8 * j; const LAS float* s = scr + (8 * c) * 33 + n;
        v2u o; o.x = pg8::cvt_pk4_fp8(s[0 * 33], s[1 * 33], s[2 * 33], s[3 * 33]); o.y = pg8::cvt_pk4_fp8(s[4 * 33], s[5 * 33], s[6 * 33], s[7 * 33]);
        *(v2u*)(WT + (size_t)(dst_row + n) * K + k0 + 8 * c) = o; }
    LDS_WAIT(); asm volatile("" ::: "memory");
}
__device__ __forceinline__ int win_src_col(int r) { if (r >= 1024 && r < 3072) { const int q = r - 1024, i = q >> 8, rr = q & 255; return rr < 128 ? 2048 + 128 * i + rr : 3072 + 128 * i + (rr - 128); }
    return r < 1024 ? r : r < 5120 ? r + 1032 : r < 6144 ? r + 2056 : r < 7168 ? r - 5120 : r - 1016; }
__device__ __forceinline__ void p0_prologue(const Frame& F) {
    LAS float* scr = (LAS float*)(F.lds + F.wave * 16384);
    const int gw = F.bid * NWAVES + F.wave, NGW = F.G * NWAVES, lane = F.lane;
    for (int it = gw; it < 12544; it += NGW) {
        int r = it;
        if (r < 8192) { const int kb = r >> 8, nb = r & 255; p0_transpose_item(F.w_in, IN_COLS, win_src_col(nb * 32), DM, F.Wt_in, nb * 32, nullptr, scr, kb * 64, lane); continue; } r -= 8192;
        if (r < 2048) { const int kb = r >> 6, nb = r & 63; p0_transpose_item(F.w_out, DM, nb * 32, DM, F.WoT, nb * 32, nullptr, scr, kb * 64, lane); continue; } r -= 2048;
        if (r < 2048) { const int kb = r >> 6, nb = r & 63; p0_transpose_item_fp8(F.w_pg, DM, nb * 32, DM, (unsigned char*)F.WgT, nb * 32, F.pe_nw, WG_SCALE, scr, kb * 64, lane); continue; } r -= 2048;
        { const int kb = r >> 6, nb = r & 63; p0_transpose_item(F.w_pe, DM, nb * 32, PE, F.WeT, nb * 32, nullptr, scr, kb * 64, lane); }
    }
    for (int idx = F.bid * NTHR + F.tid; idx < M * PE / 4; idx += F.G * NTHR) { const f32x4 v = ((const f32x4*)F.p)[idx]; v2u o; o.x = pk2(v[0], v[1]); o.y = pk2(v[2], v[3]); ((v2u*)F.PB)[idx] = o; }
    __syncthreads();
    LAS float* Wg = (LAS float*)F.lds;
    for (int k = F.tid; k < DM; k += NTHR) { const f32x4 a = *(const f32x4*)(F.w_in + (size_t)k * IN_COLS + 4096), b = *(const f32x4*)(F.w_in + (size_t)k * IN_COLS + 4100);
        Wg[0 * DM + k] = a[0]; Wg[1 * DM + k] = a[1]; Wg[2 * DM + k] = a[2]; Wg[3 * DM + k] = a[3]; Wg[4 * DM + k] = b[0]; Wg[5 * DM + k] = b[1]; Wg[6 * DM + k] = b[2]; Wg[7 * DM + k] = b[3]; }
    __syncthreads();
    const f32x4* nwp = (const f32x4*)F.norm_w + lane;
    const float gbias = lane < 4 ? F.b_i[lane & 3] : F.b_f[lane & 3];
    for (int m = gw; m < M; m += NGW) {
        asm volatile("" ::: "memory");
        const f32x4* xr = (const f32x4*)(F.x + (size_t)m * DM) + lane;
        f32x4 t[8]; float ss = 0.f; float ga[8];
#pragma unroll
        for (int c = 0; c < 8; ++c) ga[c] = 0.f;
#pragma unroll
        for (int j = 0; j < 8; ++j) { const f32x4 v = __builtin_nontemporal_load(xr + 64 * j); ss += (v[0] * v[0] + v[1] * v[1]) + (v[2] * v[2] + v[3] * v[3]); t[j] = v * nwp[64 * j]; }
#pragma unroll
        for (int j = 0; j < 8; ++j)
#pragma unroll
            for (int c = 0; c < 8; ++c) { const f32x4 w = *(const LAS f32x4*)(Wg + c * DM + 4 * lane + 256 * j); ga[c] += (t[j][0] * w[0] + t[j][1] * w[1]) + (t[j][2] * w[2] + t[j][3] * w[3]); }
        ss = wave_sum(ss); const float rstd = 1.0f / sqrtf(ss * (1.0f / DM) + EPS);
#pragma unroll
        for (int c = 0; c < 8; ++c) ga[c] = wave_sum(ga[c]) * rstd;
        v2u* uo = (v2u*)(F.U + (size_t)m * DM) + lane;
#pragma unroll
        for (int j = 0; j < 8; ++j) { const f32x4 q = t[j] * rstd; v2u o; o.x = pk2(q[0], q[1]); o.y = pk2(q[2], q[3]); uo[64 * j] = o; }
        float gv = ga[0];
        gv = lane == 1 ? ga[1] : gv; gv = lane == 2 ? ga[2] : gv; gv = lane == 3 ? ga[3] : gv; gv = lane == 4 ? ga[4] : gv; gv = lane == 5 ? ga[5] : gv; gv = lane == 6 ? ga[6] : gv; gv = lane == 7 ? ga[7] : gv;
        if (lane < 8) F.gates[(size_t)m * 8 + lane] = gv + gbias;
        if (lane == 8) F.gates[(WS_RMS - WS_GATES) / 4 + m] = 1.0f / rstd;
    }
}
__device__ __forceinline__ v4u ld16(const bf16* p) { return __builtin_nontemporal_load((const v4u*)p); }
__device__ __forceinline__ void st_bf(LAS bf16* p, float v) { *p = (bf16)(pk2(v, v) & 0xffffu); }
__device__ __forceinline__ void conv_lds_16(const float (&cw)[5], const LAS bf16* col, float scale, float (&out)[16]) {
    float r0 = bf2f(col[0]), r1 = bf2f(col[136]), r2 = bf2f(col[272]);
#pragma unroll
    for (int jj = 0; jj < 16; ++jj) { const float xv = bf2f(col[(jj + 3) * 136]); const float cv = cw[4] + cw[0] * r0 + cw[1] * r1 + cw[2] * r2 + cw[3] * xv; r0 = r1; r1 = r2; r2 = xv; out[jj] = cv * sigm(cv) * scale; }
}
__device__ __forceinline__ void conv_inplace_32(const float (&cw)[5], LAS bf16* col, float t0, float t1, float t2, float scale) {
    float r0 = bf2f(col[0]), r1 = bf2f(col[136]), r2 = bf2f(col[272]);
#pragma unroll
    for (int jj = 0; jj < 32; ++jj) { const float xv = jj < 29 ? bf2f(col[(jj + 3) * 136]) : (jj == 29 ? t0 : jj == 30 ? t1 : t2); const float cv = cw[4] + cw[0] * r0 + cw[1] * r1 + cw[2] * r2 + cw[3] * xv; r0 = r1; r1 = r2; r2 = xv; st_bf(col + jj * 136, cv * sigm(cv) * scale); }
}
constexpr int NCH2 = SEQ / 128;
constexpr size_t ST_PAD = 2048 + 128, CM_US = 256 * 128 + ST_PAD, CH_US = 128 * 128 + ST_PAD;
constexpr int PA_KR = 0, PA_KT = 36864, PA_F32 = 71680;
struct PaM { v4u rk[4], hk; float ig[2], fp[2]; bf16x8 bfr[8]; float cwk[5]; };
__device__ __forceinline__ void pa_mlstm_load(const Frame& F, int bh, int C, PaM& L) {
    const int b = bh >> 2, h = bh & 3, m0 = b * SEQ + C * 128, tid = opaque_i(F.tid), lane = tid & 63, wave = F.wave, r32 = lane & 31, hi = lane >> 5;
    L.hk = (v4u){0u, 0u, 0u, 0u}; L.ig[0] = 0.f; L.ig[1] = 0.f; L.fp[0] = 0.f; L.fp[1] = 0.f;
#pragma unroll
    for (int i = 0; i < 4; ++i) { const int idx = tid + 512 * i, row = idx >> 4, ch = idx & 15; L.rk[i] = ld16(F.PROJ + proj_off(m0 + row, PC_K + h * 128) + ch * 8); }
    if (tid < 48 && C != 0) { const int row = tid >> 4, ch = tid & 15; L.hk = ld16(F.PROJ + proj_off(m0 - 3 + row, PC_K + h * 128) + ch * 8); }
    if (wave == 0) {
#pragma unroll
        for (int hf = 0; hf < 2; ++hf) { L.ig[hf] = F.gates[(size_t)(m0 + 64 * hf + lane) * 8 + h]; L.fp[hf] = F.gates[(size_t)(m0 + 64 * hf + lane) * 8 + 4 + h]; } }
    const bf16* vt = F.VT + vt_off(h * 256 + 32 * wave + r32, m0) + 8 * hi;
#pragma unroll
    for (int ks = 0; ks < 8; ++ks) L.bfr[ks] = *(const bf16x8*)(vt + 16 * ks);
    const int chk = 512 + h * 128 + (tid & 127);
#pragma unroll
    for (int i = 0; i < 4; ++i) L.cwk[i] = F.conv_w[i * 1024 + chk];
    L.cwk[4] = F.conv_b[chk];
}
__device__ __forceinline__ void pa_mlstm_fill(const Frame& F, const PaM& L) {
    const int tid = opaque_i(F.tid);
    LAS bf16* KR = (LAS bf16*)(F.lds + PA_KR);
#pragma unroll
    for (int i = 0; i < 4; ++i) { const int idx = tid + 512 * i, row = idx >> 4, ch = idx & 15; *(LAS v4u*)(KR + (row + 3) * 136 + ch * 8) = L.rk[i]; }
    if (tid < 48) { const int row = tid >> 4, ch = tid & 15; *(LAS v4u*)(KR + row * 136 + ch * 8) = L.hk; }
}
__device__ __forceinline__ void pa_mlstm_gates(const Frame& F, int bh, int C, const PaM& L) {
    const int unit = bh * NCH2 + C, lane = opaque_i(F.lane);
    LAS float* wl = (LAS float*)(F.lds + PA_F32);
    if (F.wave == 0) {
        const float lf0 = fminf(L.fp[0], 0.f) - flog(1.0f + fexp(-fabsf(L.fp[0]))), lf1 = fminf(L.fp[1], 0.f) - flog(1.0f + fexp(-fabsf(L.fp[1])));
        const float b0 = wave_scan_sum(lf0, lane), t0 = __shfl(b0, 63), b1 = t0 + wave_scan_sum(lf1, lane);
        const float g = __shfl(b1, 63);
        const float a0 = g - b0 + L.ig[0], a1 = g - b1 + L.ig[1];
        const float ml = wave_max(fmaxf(a0, a1));
        wl[lane] = fexp(a0 - ml); wl[64 + lane] = fexp(a1 - ml);
        F.bcum[(size_t)bh * SEQ + C * 128 + lane] = b0; F.bcum[(size_t)bh * SEQ + C * 128 + 64 + lane] = b1;
        if (lane == 0) { F.msc[unit * 4 + 0] = g; F.msc[unit * 4 + 1] = ml; }
    }
}
__device__ __forceinline__ void pa_mlstm_compute(const Frame& F, int bh, int C, const PaM& L) {
    const int unit = bh * NCH2 + C, tid = opaque_i(F.tid), lane = tid & 63, wave = F.wave, r32 = lane & 31, hi = lane >> 5;
    LAS bf16 *KR = (LAS bf16*)(F.lds + PA_KR), *kT = (LAS bf16*)(F.lds + PA_KT);
    LAS float* wl = (LAS float*)(F.lds + PA_F32); LAS float* nsum = wl + 128;
    const int d = tid & 127, jq = tid >> 7;
    float ns = 0.f;
    __syncthreads();
#pragma unroll
    for (int s = 0; s < 2; ++s) {
        float kv[16];
        conv_lds_16(L.cwk, KR + (32 * jq + 16 * s) * 136 + d, 0.08838834764831845f, kv);
        unsigned pk[8];
#pragma unroll
        for (int jj = 0; jj < 16; ++jj) { kv[jj] *= wl[32 * jq + 16 * s + jj]; ns += kv[jj]; }
#pragma unroll
        for (int i = 0; i < 8; ++i) pk[i] = pk2(kv[2 * i], kv[2 * i + 1]);
        LAS v4u* dst = (LAS v4u*)(kT + d * 136 + 32 * jq + 16 * s);
        dst[0] = (v4u){pk[0], pk[1], pk[2], pk[3]}; dst[1] = (v4u){pk[4], pk[5], pk[6], pk[7]};
    }
    nsum[jq * 128 + d] = ns;
    __syncthreads();
    if (tid < 128) F.nst[(size_t)unit * 128 + tid] = (nsum[tid] + nsum[128 + tid]) + (nsum[256 + tid] + nsum[384 + tid]);
    {
        f32x16 acc[4];
#pragma unroll
        for (int i = 0; i < 4; ++i) acc[i] = zero16();
#pragma unroll
        for (int ks = 0; ks < 8; ++ks)
#pragma unroll
            for (int dt = 0; dt < 4; ++dt) { const bf16x8 afr = *(const LAS bf16x8*)(kT + (32 * dt + r32) * 136 + 16 * ks + 8 * hi); acc[dt] = mfma32(afr, L.bfr[ks], acc[dt]); }
        LAS bf16* pt = (LAS bf16*)(F.lds + PA_KR) + wave * (32 * 72);
        bf16* dst = F.Cm + (size_t)unit * CM_US + (32 * wave) * 128;
#pragma unroll
        for (int rd = 0; rd < 2; ++rd) {
#pragma unroll
            for (int i = 0; i < 2; ++i)
#pragma unroll
                for (int q = 0; q < 4; ++q) { const int dt = 2 * rd + i; v2u w; w.x = pk2(acc[dt][4 * q], acc[dt][4 * q + 1]); w.y = pk2(acc[dt][4 * q + 2], acc[dt][4 * q + 3]); *(LAS v2u*)(pt + r32 * 72 + 32 * i + 8 * q + 4 * hi) = w; }
            LDS_WAIT();
#pragma unroll
            for (int k = 0; k < 4; ++k) { const int row = 8 * k + (lane >> 3), ch = lane & 7; *(v4u*)(dst + (size_t)row * 128 + 64 * rd + ch * 8) = *(const LAS v4u*)(pt + row * 72 + ch * 8); }
            LDS_WAIT();
        }
    }
    __syncthreads();
}
constexpr int PH_FR = 0, PH_KT = 34816, PH_F32 = 69632, PH_PATCH = 73728;
struct PaH { v4u rf[4]; bf16x8 bfr[8]; float lb0, lb1; };
__device__ __forceinline__ void pa_hgrn2_load(const Frame& F, int bh, int C, PaH& L) {
    const int b = bh >> 3, h = bh & 7, m0 = b * SEQ + C * 128, tid = opaque_i(F.tid), lane = tid & 63, wave = F.wave, r32 = lane & 31, hi = lane >> 5, vt_i = wave & 3;
#pragma unroll
    for (int i = 0; i < 4; ++i) { const int idx = tid + 512 * i, row = idx >> 4, ch = idx & 15; L.rf[i] = ld16(F.PROJ + proj_off(m0 + row, PC_HF + h * 128) + ch * 8); }
    const bf16* vt = F.VT + vt_off(1024 + h * 128 + 32 * vt_i + r32, m0) + 8 * hi;
#pragma unroll
    for (int ks = 0; ks < 8; ++ks) L.bfr[ks] = *(const bf16x8*)(vt + 16 * ks);
    const int e = 2 * (tid & 63);
    L.lb0 = F.hg_lb[1024 + h * 128 + e] - F.hg_lb[h * 128 + e]; L.lb1 = F.hg_lb[1024 + h * 128 + e + 1] - F.hg_lb[h * 128 + e + 1];
}
__device__ __forceinline__ void pa_hgrn2_fill(const Frame& F, const PaH& L) {
    const int tid = opaque_i(F.tid);
    LAS bf16* FR = (LAS bf16*)(F.lds + PH_FR);
#pragma unroll
    for (int i = 0; i < 4; ++i) { const int idx = tid + 512 * i, row = idx >> 4, ch = idx & 15; *(LAS v4u*)(FR + row * 136 + ch * 8) = L.rf[i]; }
}
__device__ __forceinline__ void pa_hgrn2_compute(const Frame& F, int bh, int C, const PaH& L) {
    const int unit = bh * NCH2 + C, tid = opaque_i(F.tid), lane = tid & 63, wave = F.wave, r32 = lane & 31, hi = lane >> 5;
    LAS bf16 *FR = (LAS bf16*)(F.lds + PH_FR), *kT = (LAS bf16*)(F.lds + PH_KT);
    LAS float* seg = (LAS float*)(F.lds + PH_F32);
    const int vt_i = wave & 3, et0 = 2 * (wave >> 2);
    const int e = 2 * (tid & 63), g8 = tid >> 6;
    const float lb0 = frcp(1.0f + fexp(L.lb0)), lb1 = frcp(1.0f + fexp(L.lb1));
    __syncthreads();
    float k0[16], k1[16]; float suf0 = 1.0f, suf1 = 1.0f;
#pragma unroll
    for (int jj = 0; jj < 16; ++jj) { const unsigned w = *(const LAS unsigned*)(FR + (16 * g8 + jj) * 136 + e); k0[jj] = lb0 + (1.0f - lb0) * sigm(blo(w)); k1[jj] = lb1 + (1.0f - lb1) * sigm(bhi(w)); }
#pragma unroll
    for (int jj = 15; jj >= 0; --jj) { const float f0 = k0[jj], f1 = k1[jj]; k0[jj] = (1.0f - f0) * suf0; k1[jj] = (1.0f - f1) * suf1; suf0 *= f0; suf1 *= f1; }
    *(LAS v2f*)(seg + g8 * 128 + e) = (v2f){suf0, suf1};
    __syncthreads();
    {
        float la0 = 1.0f, la1 = 1.0f, tot0 = 1.0f, tot1 = 1.0f, br0 = 1.0f, br1 = 1.0f;
#pragma unroll
        for (int g = 0; g < 8; ++g) { const v2f sv = *(const LAS v2f*)(seg + g * 128 + e); tot0 *= sv[0]; tot1 *= sv[1]; if (g < 4) { br0 *= sv[0]; br1 *= sv[1]; } if (g > g8) { la0 *= sv[0]; la1 *= sv[1]; } }
#pragma unroll
        for (int c = 0; c < 2; ++c) { LAS v4u* dst = (LAS v4u*)(kT + (e + c) * 136 + 16 * g8); const float la = c ? la1 : la0;
#pragma unroll
            for (int i4 = 0; i4 < 2; ++i4) { unsigned pk[4];
#pragma unroll
                for (int i = 0; i < 4; ++i) { const int j0 = 8 * i4 + 2 * i; pk[i] = c ? pk2(k1[j0] * la, k1[j0 + 1] * la) : pk2(k0[j0] * la, k0[j0 + 1] * la); }
                dst[i4] = (v4u){pk[0], pk[1], pk[2], pk[3]}; } }
        if (g8 == 0) { *(v2f*)(F.gdec + (size_t)unit * 128 + e) = (v2f){tot0, tot1}; *(v2f*)(F.ebr + (size_t)unit * 128 + e) = (v2f){br0, br1}; }
    }
    __syncthreads();
    {
        f32x16 acc[2]; acc[0] = zero16(); acc[1] = zero16();
#pragma unroll
        for (int ks = 0; ks < 8; ++ks)
#pragma unroll
            for (int i = 0; i < 2; ++i) { const bf16x8 afr = *(const LAS bf16x8*)(kT + (32 * (et0 + i) + r32) * 136 + 16 * ks + 8 * hi); acc[i] = mfma32(afr, L.bfr[ks], acc[i]); }
        LAS bf16* pt = (LAS bf16*)(F.lds + PH_PATCH) + wave * (32 * 72);
#pragma unroll
        for (int i = 0; i < 2; ++i)
#pragma unroll
            for (int q = 0; q < 4; ++q) { v2u w; w.x = pk2(acc[i][4 * q], acc[i][4 * q + 1]); w.y = pk2(acc[i][4 * q + 2], acc[i][4 * q + 3]); *(LAS v2u*)(pt + r32 * 72 + 32 * i + 8 * q + 4 * hi) = w; }
        LDS_WAIT();
        bf16* dst = F.Ch + (size_t)unit * CH_US + (32 * vt_i) * 128 + 32 * et0;
#pragma unroll
        for (int k = 0; k < 4; ++k) { const int row = 8 * k + (lane >> 3), ch = lane & 7; *(v4u*)(dst + (size_t)row * 128 + ch * 8) = *(const LAS v4u*)(pt + row * 72 + ch * 8); }
    }
    __syncthreads();
}
constexpr int NSLAB = 1, CPS = NCH / NSLAB, CPS_SH = 8;
static_assert(CPS == (1 << CPS_SH) && NSLAB == 1, "slab size; the 128-token HGRN2 units are written for one slab");
__device__ __forceinline__ void pa_phase(const Frame& F, int c_lo, volatile LAS unsigned long long* tsl) {
    { PaM cur; int id = F.bid; pa_mlstm_load(F, id >> 7, id & 127, cur);
      for (; id < 8 * NCH2; id += F.G) { const int nid = (id + F.G < 8 * NCH2) ? id + F.G : id;
          pa_mlstm_fill(F, cur); pa_mlstm_gates(F, id >> 7, id & 127, cur);
          PaM nxt; pa_mlstm_load(F, nid >> 7, nid & 127, nxt);
          pa_mlstm_compute(F, id >> 7, id & 127, cur); cur = nxt; } }
    if (PROBE_TS >= 0 && F.tid == 0) tsl[9] = __builtin_amdgcn_s_memrealtime();
    { PaH cur; int id = F.bid; pa_hgrn2_load(F, id >> 7, id & 127, cur);
      for (; id < 16 * NCH2; id += F.G) { const int nid = (id + F.G < 16 * NCH2) ? id + F.G : id;
          pa_hgrn2_fill(F, cur);
          PaH nxt; pa_hgrn2_load(F, nid >> 7, nid & 127, nxt);
          pa_hgrn2_compute(F, id >> 7, id & 127, cur); cur = nxt; } }
}
__device__ __forceinline__ void unpack8(const v4u k, float (&o)[8]) { o[0] = blo(k.x); o[1] = bhi(k.x); o[2] = blo(k.y); o[3] = bhi(k.y); o[4] = blo(k.z); o[5] = bhi(k.z); o[6] = blo(k.w); o[7] = bhi(k.w); }
__device__ __forceinline__ v4u pack8(const float (&s)[8]) { v4u o; o.x = pk2(s[0], s[1]); o.y = pk2(s[2], s[3]); o.z = pk2(s[4], s[5]); o.w = pk2(s[6], s[7]); return o; }
__device__ __forceinline__ void scan_phase(const Frame& F, int c_lo, int c_hi) {
    typedef float f32x2 __attribute__((ext_vector_type(2)));
    constexpr int SB = 16;
    const int lane_ = opaque_i(F.lane);
    const int item = ((F.bid * 4 + (F.wave >> 1)) << 6) + lane_;
    const int gt = (F.wave & 1) ? 65536 + item : item;
    if ((F.wave & 1) == 0) {
        const int bh = gt >> 13, v = (gt >> 5) & 255, dg = gt & 31;
        bf16* ptr = F.Cm + (size_t)(bh * NCH2) * CM_US + v * 128 + dg * 4;
        float* ms = F.msc + (size_t)bh * NCH2 * 4;
        const int wq = (item >> 6) & 127;
        float* np = F.nst + (size_t)bh * NCH2 * 128 + wq;
        const bool nth = (lane_ == 0);
        bf16* ptr_s = ptr; asm volatile("" : "+v"(ptr_s));
        float C0 = 0.f, C1 = 0.f, C2 = 0.f, C3 = 0.f, n0 = 0.f, m = 0.f;
        float* cr = F.carry + (size_t)gt * 12;
        if (c_lo != 0) { const f32x4 a = *(const f32x4*)cr; C0 = a[0]; C1 = a[1]; C2 = a[2]; C3 = a[3]; n0 = cr[4]; m = cr[8]; }
        for (int c0 = c_lo >> 1; c0 < (c_hi >> 1); c0 += SB) {
            v2u K[SB]; f32x2 gm[SB]; float nl[SB];
#pragma unroll
            for (int i = 0; i < SB; ++i) { K[i] = *(const v2u*)(ptr + (size_t)(c0 + i) * CM_US); gm[i] = *(const f32x2*)(ms + (c0 + i) * 4); }
            if (nth) {
#pragma unroll
                for (int i = 0; i < SB; ++i) nl[i] = np[(c0 + i) * 128];
            }
#pragma unroll
            for (int i = 0; i < SB; ++i) { const int c = c0 + i;
                const float g = gm[i][0], ml = gm[i][1];
                const float mn = fmaxf(g + m, ml), ws = fexp(g + m - mn), fl = fexp(ml - mn);
                v2u o; o.x = pk2(C0, C1); o.y = pk2(C2, C3); *(v2u*)(ptr_s + (size_t)c * CM_US) = o;
                C0 = ws * C0 + fl * blo(K[i].x); C1 = ws * C1 + fl * bhi(K[i].x); C2 = ws * C2 + fl * blo(K[i].y); C3 = ws * C3 + fl * bhi(K[i].y);
                if (nth) {
                    np[c * 128] = n0;
                    n0 = ws * n0 + fl * nl[i];
                    if (wq == 0) ms[c * 4 + 2] = m;
                }
                m = mn; }
        }
        if (c_hi != NCH) { *(f32x4*)cr = (f32x4){C0, C1, C2, C3}; cr[4] = n0; cr[8] = m; }
    } else {
        const int g2 = gt - 65536, bh = g2 >> 12, v = (g2 >> 5) & 127, eg = g2 & 31;
        bf16* ptr = F.Ch + (size_t)(bh * NCH2) * CH_US + v * 128 + eg * 4;
        const float* gd = F.gdec + (size_t)bh * NCH2 * 128 + eg * 4;
        const float* eb = F.ebr + (size_t)bh * NCH2 * 128 + eg * 4;
        bf16* ptr_s = ptr; asm volatile("" : "+v"(ptr_s));
        float S0 = 0.f, S1 = 0.f, S2 = 0.f, S3 = 0.f;
        float* cr = F.carry + (size_t)gt * 12;
        if (c_lo != 0) { const f32x4 a = *(const f32x4*)cr; S0 = a[0]; S1 = a[1]; S2 = a[2]; S3 = a[3]; }
        for (int c0 = c_lo >> 1; c0 < (c_hi >> 1); c0 += SB) {
            v2u K[SB]; f32x4 D[SB], E[SB];
#pragma unroll
            for (int i = 0; i < SB; ++i) { K[i] = *(const v2u*)(ptr + (size_t)(c0 + i) * CH_US); D[i] = *(const f32x4*)(gd + (c0 + i) * 128); E[i] = *(const f32x4*)(eb + (c0 + i) * 128); }
#pragma unroll
            for (int i = 0; i < SB; ++i) { const int c = c0 + i;
                v2u o; o.x = pk2(S0 * E[i][0], S1 * E[i][1]); o.y = pk2(S2 * E[i][2], S3 * E[i][3]); *(v2u*)(ptr_s + (size_t)c * CH_US) = o;
                S0 = D[i][0] * S0 + blo(K[i].x); S1 = D[i][1] * S1 + bhi(K[i].x); S2 = D[i][2] * S2 + blo(K[i].y); S3 = D[i][3] * S3 + bhi(K[i].y); }
        }
        if (c_hi != NCH) *(f32x4*)cr = (f32x4){S0, S1, S2, S3};
    }
}
template <int MODE>
__device__ __forceinline__ void score_tiles(const Frame& F, const LAS bf16* Kt, const LAS bf16* Qt, LAS bf16* Sc, const LAS float* bm, const LAS float* uu, LAS float* dnA, LAS float* dnB) {
    const int wave = F.wave, lane = opaque_i(F.lane), r32 = lane & 31, hi = lane >> 5;
    if (wave < 3) {
        const int jt = (wave == 2) ? 1 : 0, tt = (wave >= 1) ? 1 : 0;
        f32x16 acc = zero16();
#pragma unroll
        for (int ks = 0; ks < 8; ++ks) { const bf16x8 a = *(const LAS bf16x8*)(Kt + (32 * jt + r32) * 136 + 16 * ks + 8 * hi), bq = *(const LAS bf16x8*)(Qt + (32 * tt + r32) * 136 + 16 * ks + 8 * hi); acc = mfma32(a, bq, acc); }
        const int t = 32 * tt + r32; float rs = 0.f; float bmt = 0.f; if (MODE == 1) bmt = bm[t];
#pragma unroll
        for (int q = 0; q < 4; ++q) { const int j0 = 32 * jt + 8 * q + 4 * hi; float vv[4];
            f32x4 u4 = (f32x4){0.f, 0.f, 0.f, 0.f}; if (MODE == 1) u4 = *(const LAS f32x4*)(uu + j0);
#pragma unroll
            for (int i = 0; i < 4; ++i) { float val = acc[4 * q + i]; if (MODE == 1) val *= __expf(fminf(bmt + u4[i], 0.f)); val = (j0 + i <= t) ? val : 0.f; vv[i] = val; rs += val; }
            v2u w; w.x = pk2(vv[0], vv[1]); w.y = pk2(vv[2], vv[3]); *(LAS v2u*)(Sc + t * 72 + j0) = w; }
        if (MODE == 1) { rs += __shfl_xor(rs, 32); if (hi == 0) { if (jt == 0) dnA[t] = rs; else dnB[t] = rs; } }
    } else if (wave == 3) {
        for (int idx = lane; idx < 128; idx += 64) { const int t = idx >> 2, part = idx & 3; *(LAS v4u*)(Sc + t * 72 + 32 + 8 * part) = (v4u){0u, 0u, 0u, 0u}; }
        if (MODE == 1 && lane < 32) dnB[lane] = 0.f;
    }
}
constexpr int RM_KS = 0, RM_QS = 35840, RM_SC = 71680, RM_OT = 89088, RM_F32 = 122880;
struct RmH { v4u hq, hk; };
struct RmA { v4u rq[4], rk[4]; float bj0, bj1, ig0, ig1, mc, ncv; };
struct RmB { bf16x8 avt[8], acs[8]; v4u ro[2][4]; };
__device__ __forceinline__ void r2m_loadA(const Frame& F, int bh, int C, RmA& L) {
    const int b = bh >> 2, h = bh & 3, m0 = b * SEQ + C * 128, unit = bh * NCH2 + C, tid = opaque_i(F.tid), lane = tid & 63, wave = F.wave;
#pragma unroll
    for (int i = 0; i < 4; ++i) { const int idx = tid + 512 * i, row = idx >> 4, ch = idx & 15;
        L.rq[i] = ld16(F.PROJ + proj_off(m0 + row, PC_Q + h * 128) + ch * 8); L.rk[i] = ld16(F.PROJ + proj_off(m0 + row, PC_K + h * 128) + ch * 8); }
    L.bj0 = 0.f; L.bj1 = 0.f; L.ig0 = 0.f; L.ig1 = 0.f; L.mc = 0.f; L.ncv = 0.f;
    if (wave == 0) { L.bj0 = F.bcum[(size_t)bh * SEQ + C * 128 + lane]; L.bj1 = F.bcum[(size_t)bh * SEQ + C * 128 + 64 + lane]; L.ig0 = F.gates[(size_t)(m0 + lane) * 8 + h]; L.ig1 = F.gates[(size_t)(m0 + 64 + lane) * 8 + h]; L.mc = F.msc[unit * 4 + 2]; }
    else if (wave < 3) L.ncv = F.nst[(size_t)unit * 128 + tid - 64];
}
__device__ __forceinline__ void r2m_loadH(const Frame& F, int bh, int C, RmH& L) {
    const int b = bh >> 2, h = bh & 3, m0 = b * SEQ + C * 128, tid = opaque_i(F.tid);
    L.hq = (v4u){0u, 0u, 0u, 0u}; L.hk = (v4u){0u, 0u, 0u, 0u};
    if (tid < 48 && C != 0) { const int row = tid >> 4, ch = tid & 15; L.hq = ld16(F.PROJ + proj_off(m0 - 3 + row, PC_Q + h * 128) + ch * 8); L.hk = ld16(F.PROJ + proj_off(m0 - 3 + row, PC_K + h * 128) + ch * 8); }
}
__device__ __forceinline__ void r2m_loadB(const Frame& F, int bh, int C, RmB& L) {
    const int b = bh >> 2, h = bh & 3, m0 = b * SEQ + C * 128, unit = bh * NCH2 + C, tid = opaque_i(F.tid), lane = tid & 63, wave = F.wave, r32 = lane & 31, hi = lane >> 5;
#pragma unroll
    for (int th = 0; th < 2; ++th)
#pragma unroll
        for (int i = 0; i < 4; ++i) { const int idx = tid + 512 * i, row = idx >> 5, ch = idx & 31;
            L.ro[th][i] = ld16(F.PROJ + proj_off(m0 + 64 * th + row, PC_OZ + 512 * h + 256 * (ch >> 4)) + (ch & 15) * 8); }
    const bf16* vt = F.VT + vt_off(h * 256 + 32 * wave + r32, m0) + 8 * hi;
#pragma unroll
    for (int ks = 0; ks < 8; ++ks) L.avt[ks] = *(const bf16x8*)(vt + 16 * ks);
    const bf16* cs = F.Cm + (size_t)unit * CM_US + (32 * wave + r32) * 128 + 8 * hi;
#pragma unroll
    for (int ks = 0; ks < 8; ++ks) L.acs[ks] = *(const bf16x8*)(cs + 16 * ks);
}
__device__ __forceinline__ void r2m_unit(const Frame& F, int bh, int C, const RmA& A, const RmB& B, const RmH& H, int nbh, int nC, RmA& NA, RmB& NB, RmH& NH) {
    const int b = bh >> 2, h = bh & 3, m0 = b * SEQ + C * 128, tid = opaque_i(F.tid), lane = tid & 63, wave = F.wave, r32 = lane & 31, hi = lane >> 5;
    LAS bf16 *Ks = (LAS bf16*)(F.lds + RM_KS), *Qs = (LAS bf16*)(F.lds + RM_QS), *Sc = (LAS bf16*)(F.lds + RM_SC), *OT = (LAS bf16*)(F.lds + RM_OT);
    LAS float* fb = (LAS float*)(F.lds + RM_F32);
    LAS float *bm = fb, *uu = fb + 128, *wi = fb + 256, *emt = fb + 384, *qn = fb + 512, *dn = fb + 640, *nc = fb + 896, *hn = fb + 1024;
    bf16x8 avt[8], acs[8]; v4u ro1[4];
#pragma unroll
    for (int ks = 0; ks < 8; ++ks) { avt[ks] = B.avt[ks]; acs[ks] = B.acs[ks]; }
#pragma unroll
    for (int q = 0; q < 4; ++q) ro1[q] = B.ro[1][q];
    const float bj0 = A.bj0, bj1 = A.bj1, ig0 = A.ig0, ig1 = A.ig1, mc = A.mc, ncv = A.ncv;
#pragma unroll
    for (int i = 0; i < 4; ++i) { const int idx = tid + 512 * i, row = idx >> 4, ch = idx & 15; *(LAS v4u*)(Qs + (row + 3) * 136 + ch * 8) = A.rq[i]; *(LAS v4u*)(Ks + (row + 3) * 136 + ch * 8) = A.rk[i]; }
    if (tid < 48) { const int row = tid >> 4, ch = tid & 15; *(LAS v4u*)(Qs + row * 136 + ch * 8) = H.hq; *(LAS v4u*)(Ks + row * 136 + ch * 8) = H.hk; }
#pragma unroll
    for (int i = 0; i < 4; ++i) { const int idx = tid + 512 * i, row = idx >> 5, ch = idx & 31; *(LAS v4u*)(OT + row * 264 + ch * 8) = B.ro[0][i]; }
    if (wave == 0) {
        const float u0 = ig0 - bj0, u1 = ig1 - bj1;
        const float p0 = wave_scan_max(u0, lane), p1 = fmaxf(__shfl(p0, 63), wave_scan_max(u1, lane));
        const float mt0 = bj0 + fmaxf(mc, p0), mt1 = bj1 + fmaxf(mc, p1);
        bm[lane] = bj0 - mt0; uu[lane] = u0; wi[lane] = fexp(bj0 + mc - mt0); emt[lane] = fexp(-mt0);
        bm[64 + lane] = bj1 - mt1; uu[64 + lane] = u1; wi[64 + lane] = fexp(bj1 + mc - mt1); emt[64 + lane] = fexp(-mt1);
    } else if (wave < 3) nc[tid - 64] = ncv;
    r2m_loadA(F, nbh, nC, NA);
    __syncthreads();
    {
        const int d = tid & 127, jq = tid >> 7;
        float cwq[5], cwk[5];
        { const int chq = h * 128 + d, chk = 512 + chq;
#pragma unroll
          for (int i = 0; i < 4; ++i) { cwq[i] = F.conv_w[i * 1024 + chq]; cwk[i] = F.conv_w[i * 1024 + chk]; }
          cwq[4] = F.conv_b[chq]; cwk[4] = F.conv_b[chk]; }
        LAS bf16 *qc = Qs + (32 * jq) * 136 + d, *kc = Ks + (32 * jq) * 136 + d;
        const float tq0 = bf2f(qc[32 * 136]), tq1 = bf2f(qc[33 * 136]), tq2 = bf2f(qc[34 * 136]), tk0 = bf2f(kc[32 * 136]), tk1 = bf2f(kc[33 * 136]), tk2 = bf2f(kc[34 * 136]);
        __syncthreads();
        conv_inplace_32(cwq, qc, tq0, tq1, tq2, 1.0f);
        conv_inplace_32(cwk, kc, tk0, tk1, tk2, 0.08838834764831845f);
    }
    __syncthreads();
    {
        const int t = tid >> 2, part = tid & 3; float dot = 0.f;
#pragma unroll
        for (int i = 0; i < 4; ++i) { const int d0 = 32 * part + 8 * i; const v4u qv = *(const LAS v4u*)(Qs + t * 136 + d0); float qf[8]; unpack8(qv, qf);
#pragma unroll
            for (int k = 0; k < 8; ++k) dot += qf[k] * nc[d0 + k]; }
        dot += __shfl_xor(dot, 1); dot += __shfl_xor(dot, 2); if (part == 0) qn[t] = dot;
    }
#pragma unroll
    for (int th = 0; th < 2; ++th) {
        {
            int jt, st; bool zero = false, act = true;
            if (th == 0) { jt = (wave == 2) ? 1 : 0; st = (wave >= 1) ? 1 : 0; zero = (wave == 3); act = (wave < 4); if (zero) { jt = 1; st = 0; } }
            else { jt = (wave < 4) ? (wave >> 1) : (wave < 6 ? 2 : 3); st = (wave < 4) ? (wave & 1) : (wave == 4 ? 0 : 1); zero = (wave == 7); if (zero) { jt = 3; st = 0; } }
            if (act && !zero) {
                f32x16 acc = zero16();
#pragma unroll
                for (int ks = 0; ks < 8; ++ks) { const bf16x8 a = *(const LAS bf16x8*)(Ks + (32 * jt + r32) * 136 + 16 * ks + 8 * hi), bq = *(const LAS bf16x8*)(Qs + (64 * th + 32 * st + r32) * 136 + 16 * ks + 8 * hi); acc = mfma32(a, bq, acc); }
                const int tl = 32 * st + r32, tg = 64 * th + tl; const float bmt = bm[tg]; float rs = 0.f;
#pragma unroll
                for (int q = 0; q < 4; ++q) { const int j0 = 32 * jt + 8 * q + 4 * hi; float vv[4]; const f32x4 u4 = *(const LAS f32x4*)(uu + j0);
#pragma unroll
                    for (int i = 0; i < 4; ++i) { const float val = (j0 + i <= tg) ? acc[4 * q + i] * __expf(fminf(bmt + u4[i], 0.f)) : 0.f; vv[i] = val; rs += val; }
                    v2u w; w.x = pk2(vv[0], vv[1]); w.y = pk2(vv[2], vv[3]); *(LAS v2u*)(Sc + tl * 136 + j0) = w; }
                rs += __shfl_xor(rs, 32); if (hi == 0) dn[jt * 64 + tl] = rs;
            } else if (act) {
                for (int idx = lane; idx < 128; idx += 64) { const int tl = 32 * st + (idx >> 2), part = idx & 3; *(LAS v4u*)(Sc + tl * 136 + 32 * jt + 8 * part) = (v4u){0u, 0u, 0u, 0u}; }
                if (lane < 32) dn[jt * 64 + 32 * st + lane] = 0.f;
            }
            if (th == 0 && wave >= 4 && wave < 6) dn[(wave - 2) * 64 + lane] = 0.f;
        }
        __syncthreads();
        f32x4 nw[4];
        { const float* nwp = F.ml_nw + h * 256 + 32 * wave + 4 * hi;
          asm volatile("" ::: "memory");
#pragma unroll
          for (int q = 0; q < 4; ++q) nw[q] = *(const f32x4*)(nwp + 8 * q); }
        f32x16 accA[2], accB[2]; accA[0] = zero16(); accA[1] = zero16(); accB[0] = zero16(); accB[1] = zero16();
#pragma unroll
        for (int ks = 0; ks < 8; ++ks) if (ks < 4 * (th + 1))
#pragma unroll
            for (int tt = 0; tt < 2; ++tt) { const bf16x8 bq = *(const LAS bf16x8*)(Sc + (32 * tt + r32) * 136 + 16 * ks + 8 * hi); accA[tt] = mfma32(avt[ks], bq, accA[tt]); }
#pragma unroll
        for (int ks = 0; ks < 8; ++ks)
#pragma unroll
            for (int tt = 0; tt < 2; ++tt) { const bf16x8 bq = *(const LAS bf16x8*)(Qs + (64 * th + 32 * tt + r32) * 136 + 16 * ks + 8 * hi); accB[tt] = mfma32(acs[ks], bq, accB[tt]); }
        if (th == 1) r2m_loadB(F, nbh, nC, NB);
#pragma unroll
        for (int tt = 0; tt < 2; ++tt) { const int tl = 32 * tt + r32, tg = 64 * th + tl; const float wit = wi[tg];
            const float den = (dn[tl] + dn[64 + tl]) + (dn[128 + tl] + dn[192 + tl]) + wit * qn[tg]; const float inv = frcp(fmaxf(fabsf(den), emt[tg])); float ssp = 0.f;
#pragma unroll
            for (int r = 0; r < 16; ++r) { const float hv = (accA[tt][r] + wit * accB[tt][r]) * inv; accA[tt][r] = hv; ssp += hv * hv; }
            ssp += __shfl_xor(ssp, 32); if (hi == 0) hn[wave * 64 + tl] = ssp; }
        __syncthreads();
        if (th == 1) r2m_loadH(F, nbh, nC, NH);
#pragma unroll
        for (int tt = 0; tt < 2; ++tt) { const int tl = 32 * tt + r32; float tot = 0.f;
#pragma unroll
            for (int w = 0; w < 8; ++w) tot += hn[w * 64 + tl];
            const float rstd = frsq(tot * (1.0f / 256.0f) + EPS);
            const int v0 = 32 * wave + 4 * hi;
#pragma unroll
            for (int q = 0; q < 4; ++q) { LAS v2u* op = (LAS v2u*)(OT + tl * 264 + v0 + 8 * q); const v2u o4 = *op;
                const float y0 = accA[tt][4 * q] * rstd * nw[q][0] * blo(o4.x), y1 = accA[tt][4 * q + 1] * rstd * nw[q][1] * bhi(o4.x);
                const float y2 = accA[tt][4 * q + 2] * rstd * nw[q][2] * blo(o4.y), y3 = accA[tt][4 * q + 3] * rstd * nw[q][3] * bhi(o4.y);
                v2u w; w.x = pk2(y0, y1); w.y = pk2(y2, y3); *op = w; } }
        __syncthreads();
#pragma unroll
        for (int i = 0; i < 4; ++i) { const int idx = tid + 512 * i, row = idx >> 5, ch = idx & 31; *(v4u*)(F.Y + (size_t)(m0 + 64 * th + row) * DM + h * 256 + ch * 8) = *(const LAS v4u*)(OT + row * 264 + ch * 8); }
        __syncthreads();
        if (th == 0) {
#pragma unroll
            for (int i = 0; i < 4; ++i) { const int idx = tid + 512 * i, row = idx >> 5, ch = idx & 31; *(LAS v4u*)(OT + row * 264 + ch * 8) = ro1[i]; }
        }
    }
}
constexpr int RH_QT = 0, RH_KT = 34816, RH_GT = 69632, RH_SC = 104448, RH_F32 = 121856;
struct RhL { v4u rq[4], rf[4], rg[4]; float lbd0, lbd1; };
__device__ __forceinline__ void r2h_load(const Frame& F, int bh, int C, RhL& L) {
    const int b = bh >> 3, h = bh & 7, m0 = b * SEQ + C * 128, tid = opaque_i(F.tid);
#pragma unroll
    for (int i = 0; i < 4; ++i) { const int idx = tid + 512 * i, row = idx >> 4, ch = idx & 15;
        L.rq[i] = ld16(F.PROJ + proj_off(m0 + row, PC_HQ + h * 128) + ch * 8); L.rf[i] = ld16(F.PROJ + proj_off(m0 + row, PC_HF + h * 128) + ch * 8); L.rg[i] = ld16(F.PROJ + proj_off(m0 + row, PC_HG + h * 128) + ch * 8); }
    { const int e = 2 * (tid & 63); L.lbd0 = F.hg_lb[1024 + h * 128 + e] - F.hg_lb[h * 128 + e]; L.lbd1 = F.hg_lb[1024 + h * 128 + e + 1] - F.hg_lb[h * 128 + e + 1]; }
}
__device__ __forceinline__ void r2h_fill(const Frame& F, const RhL& L) {
    const int tid = opaque_i(F.tid);
    LAS bf16 *Qt = (LAS bf16*)(F.lds + RH_QT), *Kt = (LAS bf16*)(F.lds + RH_KT), *GT = (LAS bf16*)(F.lds + RH_GT);
#pragma unroll
    for (int i = 0; i < 4; ++i) { const int idx = tid + 512 * i, row = idx >> 4, ch = idx & 15; const int lo = row * 136 + ch * 8;
        *(LAS v4u*)(Qt + lo) = L.rq[i]; *(LAS v4u*)(Kt + lo) = L.rf[i]; *(LAS v4u*)(GT + lo) = L.rg[i]; }
}
__device__ __forceinline__ void r2h_compute(const Frame& F, int bh, int C, float lbd0, float lbd1) {
    const int b = bh >> 3, h = bh & 7, m0 = b * SEQ + C * 128, unit = bh * NCH2 + C, tid = opaque_i(F.tid), lane = tid & 63, wave = F.wave, r32 = lane & 31, hi = lane >> 5;
    LAS bf16 *Qt = (LAS bf16*)(F.lds + RH_QT), *Kt = (LAS bf16*)(F.lds + RH_KT), *GT = (LAS bf16*)(F.lds + RH_GT), *Sc = (LAS bf16*)(F.lds + RH_SC);
    LAS float* hn = (LAS float*)(F.lds + RH_F32);
    LAS float* seg = hn + 256;
    const int vt_i = wave & 3, tt = wave >> 2, t = 32 * tt + r32;
    bf16x8 avt[8], ast[8]; f32x4 nw[4];
    { const bf16* vt = F.VT + vt_off(1024 + h * 128 + 32 * vt_i + r32, m0) + 8 * hi;
#pragma unroll
      for (int ks = 0; ks < 8; ++ks) avt[ks] = *(const bf16x8*)(vt + 16 * ks);
      const bf16* cs = F.Ch + (size_t)unit * CH_US + (32 * vt_i + r32) * 128 + 8 * hi;
#pragma unroll
      for (int ks = 0; ks < 8; ++ks) ast[ks] = *(const bf16x8*)(cs + 16 * ks);
      const float* nwp = F.hg_nw + h * 128 + 32 * vt_i + 4 * hi;
#pragma unroll
      for (int q = 0; q < 4; ++q) nw[q] = *(const f32x4*)(nwp + 8 * q); }
    __syncthreads();
    {
        const int e = 2 * (tid & 63), g8 = tid >> 6;
        const float lb0 = frcp(1.0f + fexp(lbd0)), lb1 = frcp(1.0f + fexp(lbd1));
        float y0[16], y1[16], f0[16], f1[16];
#pragma unroll
        for (int jj = 0; jj < 16; ++jj) { const unsigned w = *(const LAS unsigned*)(Kt + (16 * g8 + jj) * 136 + e); f0[jj] = lb0 + (1.0f - lb0) * sigm(blo(w)); f1[jj] = lb1 + (1.0f - lb1) * sigm(bhi(w)); }
        float run0 = 1.0f, run1 = 1.0f;
        if (g8 < 4) {
#pragma unroll
            for (int jj = 15; jj >= 0; --jj) { y0[jj] = run0; y1[jj] = run1; run0 *= f0[jj]; run1 *= f1[jj]; }
        } else {
#pragma unroll
            for (int jj = 0; jj < 16; ++jj) { run0 *= f0[jj]; run1 *= f1[jj]; y0[jj] = run0; y1[jj] = run1; }
        }
        *(LAS v2f*)(seg + g8 * 128 + e) = (v2f){run0, run1};
        __syncthreads();
        float o0 = 1.0f, o1 = 1.0f;
#pragma unroll
        for (int g = 1; g < 7; ++g) { const bool use = (g8 < 4) ? (g > g8 && g < 4) : (g >= 4 && g < g8); if (use) { const v2f sv = *(const LAS v2f*)(seg + g * 128 + e); o0 *= sv[0]; o1 *= sv[1]; } }
#pragma unroll
        for (int jj = 0; jj < 16; ++jj) { const int j = 16 * g8 + jj; const float ya = y0[jj] * o0, yb = y1[jj] * o1, ra = frcp(ya), rb = frcp(yb);
            const unsigned qw = *(const LAS unsigned*)(Qt + j * 136 + e);
            *(LAS unsigned*)(Qt + j * 136 + e) = pk2(blo(qw) * (g8 < 4 ? ra : ya), bhi(qw) * (g8 < 4 ? rb : yb));
            *(LAS unsigned*)(Kt + j * 136 + e) = pk2((1.0f - f0[jj]) * (g8 < 4 ? ya : ra), (1.0f - f1[jj]) * (g8 < 4 ? yb : rb)); }
    }
    __syncthreads();
#pragma unroll
    for (int th = 0; th < 2; ++th) {
        {
            int jt, st; bool zero = false, act = true;
            if (th == 0) { jt = (wave == 2) ? 1 : 0; st = (wave >= 1) ? 1 : 0; zero = (wave == 3); act = (wave < 4); if (zero) { jt = 1; st = 0; } }
            else { jt = (wave < 4) ? (wave >> 1) : (wave < 6 ? 2 : 3); st = (wave < 4) ? (wave & 1) : (wave == 4 ? 0 : 1); zero = (wave == 7); if (zero) { jt = 3; st = 0; } }
            if (act && !zero) {
                f32x16 acc = zero16();
#pragma unroll
                for (int ks = 0; ks < 8; ++ks) { const bf16x8 a = *(const LAS bf16x8*)(Kt + (32 * jt + r32) * 136 + 16 * ks + 8 * hi), bq = *(const LAS bf16x8*)(Qt + (64 * th + 32 * st + r32) * 136 + 16 * ks + 8 * hi); acc = mfma32(a, bq, acc); }
                const int tl = 32 * st + r32, tg = 64 * th + tl;
#pragma unroll
                for (int q = 0; q < 4; ++q) { const int j0 = 32 * jt + 8 * q + 4 * hi; float vv[4];
#pragma unroll
                    for (int i = 0; i < 4; ++i) vv[i] = (j0 + i <= tg) ? acc[4 * q + i] : 0.f;
                    v2u w; w.x = pk2(vv[0], vv[1]); w.y = pk2(vv[2], vv[3]); *(LAS v2u*)(Sc + tl * 136 + j0) = w; }
            } else if (act) {
                for (int idx = lane; idx < 128; idx += 64) { const int tl = 32 * st + (idx >> 2), part = idx & 3; *(LAS v4u*)(Sc + tl * 136 + 32 * jt + 8 * part) = (v4u){0u, 0u, 0u, 0u}; }
            }
        }
        __syncthreads();
        f32x16 acc = zero16();
#pragma unroll
        for (int ks = 0; ks < 8; ++ks) if (ks < 4 * (th + 1)) { const bf16x8 bq = *(const LAS bf16x8*)(Sc + t * 136 + 16 * ks + 8 * hi); acc = mfma32(avt[ks], bq, acc); }
#pragma unroll
        for (int ks = 0; ks < 8; ++ks) { const bf16x8 bq = *(const LAS bf16x8*)(Qt + (64 * th + t) * 136 + 16 * ks + 8 * hi); acc = mfma32(ast[ks], bq, acc); }
        { float ssp = 0.f;
#pragma unroll
          for (int r = 0; r < 16; ++r) ssp += acc[r] * acc[r];
          ssp += __shfl_xor(ssp, 32); if (hi == 0) hn[vt_i * 64 + t] = ssp; }
        __syncthreads();
        LAS bf16* YT = Qt + 64 * th * 136;
        {
            const float tot = (hn[t] + hn[64 + t]) + (hn[128 + t] + hn[192 + t]);
            const float rstd = frsq(tot * (1.0f / 128.0f) + EPS);
            const int v0 = 32 * vt_i + 4 * hi;
#pragma unroll
            for (int q = 0; q < 4; ++q) { const v2u g4 = *(const LAS v2u*)(GT + (64 * th + t) * 136 + v0 + 8 * q);
                const float g0 = blo(g4.x), g1 = bhi(g4.x), g2 = blo(g4.y), g3 = bhi(g4.y);
                const float y0 = acc[4 * q] * rstd * nw[q][0] * g0, y1 = acc[4 * q + 1] * rstd * nw[q][1] * g1;
                const float y2 = acc[4 * q + 2] * rstd * nw[q][2] * g2, y3 = acc[4 * q + 3] * rstd * nw[q][3] * g3;
                v2u w; w.x = pk2(y0, y1); w.y = pk2(y2, y3); *(LAS v2u*)(YT + t * 136 + v0 + 8 * q) = w; }
        }
        __syncthreads();
#pragma unroll
        for (int i = 0; i < 2; ++i) { const int idx = tid + 512 * i, row = idx >> 4, ch = idx & 15; *(v4u*)(F.Y + (size_t)(m0 + 64 * th + row) * DM + 1024 + h * 128 + ch * 8) = *(const LAS v4u*)(YT + row * 136 + ch * 8); }
        __syncthreads();
    }
}
__device__ __forceinline__ void r2_phase(const Frame& F, int c_lo, volatile LAS unsigned long long* tsl) {
#define R2_BH(id) ((id) >> CPS_SH)
#define R2_C(id) (c_lo + ((id) & (CPS - 1)))
    { RmA curA; RmB curB; RmH curH; int id = F.bid; r2m_loadA(F, id >> 7, id & 127, curA); r2m_loadH(F, id >> 7, id & 127, curH); r2m_loadB(F, id >> 7, id & 127, curB);
      for (; id < 8 * NCH2; id += F.G) { const int nid = (id + F.G < 8 * NCH2) ? id + F.G : id;
          RmA nxtA; RmB nxtB; RmH nxtH; r2m_unit(F, id >> 7, id & 127, curA, curB, curH, nid >> 7, nid & 127, nxtA, nxtB, nxtH); curA = nxtA; curB = nxtB; curH = nxtH; } }
    if (PROBE_TS >= 0 && F.tid == 0) tsl[8] = __builtin_amdgcn_s_memrealtime();
    { RhL cur; int id = F.bid; r2h_load(F, id >> 7, id & 127, cur);
      for (; id < 16 * NCH2; id += F.G) { const int nid = (id + F.G < 16 * NCH2) ? id + F.G : id;
          r2h_fill(F, cur); const float lbd0 = cur.lbd0, lbd1 = cur.lbd1;
          RhL nxt; r2h_load(F, nid >> 7, nid & 127, nxt);
          r2h_compute(F, id >> 7, id & 127, lbd0, lbd1); cur = nxt; } }
#undef R2_BH
#undef R2_C
}
__device__ __forceinline__ void final_norm(const Frame& F, float oscale) {
    int lane; asm volatile("v_mbcnt_lo_u32_b32 %0, -1, 0\n\tv_mbcnt_hi_u32_b32 %0, -1, %0" : "=v"(lane));
    const int gw = F.bid * NWAVES + F.wave, NGW = F.G * NWAVES;
    const int sub = lane >> 5, l8 = (lane & 31) * 8;
    for (int m = gw; m < M; m += NGW) {
        const size_t base = (((size_t)(m >> 8) * 8) << 16) + (size_t)(m & 255) * 256 + l8;
        float hv[4][8]; float ss = 0.f;
#pragma unroll
        for (int i = 0; i < 4; ++i) { const size_t off = base + ((size_t)(2 * i + sub) << 16); const v4u g = __builtin_nontemporal_load((const v4u*)(F.EB + off));
            hv[i][0] = blo(g.x); hv[i][1] = bhi(g.x); hv[i][2] = blo(g.y); hv[i][3] = bhi(g.y);
            hv[i][4] = blo(g.z); hv[i][5] = bhi(g.z); hv[i][6] = blo(g.w); hv[i][7] = bhi(g.w);
#pragma unroll
            for (int k = 0; k < 8; ++k) ss += hv[i][k] * hv[i][k]; }
        ss = wave_sum(ss);
        const float rstd = oscale / sqrtf(ss * (1.0f / DM) + EPS);
#pragma unroll
        for (int i = 0; i < 4; ++i) { const int col = (2 * i + sub) * 256 + l8; const f32x4 w0 = *(const f32x4*)(F.fin_nw + col), w1 = *(const f32x4*)(F.fin_nw + col + 4);
            float* o = F.out + (size_t)m * DM + col;
            __builtin_nontemporal_store((f32x4){hv[i][0] * rstd * w0[0], hv[i][1] * rstd * w0[1], hv[i][2] * rstd * w0[2], hv[i][3] * rstd * w0[3]}, (f32x4*)o);
            __builtin_nontemporal_store((f32x4){hv[i][4] * rstd * w1[0], hv[i][5] * rstd * w1[1], hv[i][6] * rstd * w1[2], hv[i][7] * rstd * w1[3]}, (f32x4*)(o + 4)); }
    }
}
struct Args { const float* in[16]; float* out; unsigned char* ws; int ph_lo, ph_hi, li, pad; };
__global__ void __launch_bounds__(NWAVES * 64, 2) hymba_fwd(Args args) {
    extern __shared__ __attribute__((aligned(16))) unsigned char lds[];
    Frame F;
    F.lds = (LAS unsigned char*)lds;
    F.tid = threadIdx.x; F.lane = F.tid & 63; F.wave = __builtin_amdgcn_readfirstlane(F.tid >> 6); F.G = gridDim.x; F.bid = blockIdx.x;
    unsigned char* ws = args.ws;
    gu32* ctl = (gu32*)(ws + WS_CTL);
    F.x = args.in[0]; F.p = args.in[1]; F.norm_w = args.in[2]; F.w_in = args.in[3]; F.conv_w = args.in[4]; F.conv_b = args.in[5]; F.b_i = args.in[6]; F.b_f = args.in[7];
    F.ml_nw = args.in[8]; F.hg_lb = args.in[9]; F.hg_nw = args.in[10]; F.w_out = args.in[11]; F.pe_nw = args.in[12]; F.w_pg = args.in[13]; F.w_pe = args.in[14]; F.fin_nw = args.in[15];
    F.out = args.out;
    F.Wt_in = (bf16*)(ws + WS_WIN); F.WoT = (bf16*)(ws + WS_WO); F.WgT = (bf16*)(ws + WS_WG); F.WeT = (bf16*)(ws + WS_WE); F.PB = (bf16*)(ws + WS_PB);
    F.U = (bf16*)(ws + WS_U); F.Y = (bf16*)(ws + WS_Y); F.PROJ = (bf16*)(ws + WS_PROJ); F.HB = (bf16*)(ws + WS_PROJ); F.EB = (bf16*)(ws + WS_PROJ + 128 * MiB); F.VT = (bf16*)(ws + WS_VT);
    F.Cm = (bf16*)args.out; F.Ch = (bf16*)args.out + (size_t)64 * MiB;
    F.gates = (float*)(ws + WS_GATES); F.bcum = (float*)(ws + WS_BCUM); F.msc = (float*)(ws + WS_MSC); F.nst = (float*)(ws + WS_NST); F.gdec = (float*)(ws + WS_GDEC); F.ebr = (float*)(ws + WS_EBR); F.carry = (float*)(ws + WS_CARRY);
    F.ssqh = (float*)(ws + WS_SSQH); F.ssq2 = (float*)(ws + WS_SSQ2); F.QC = (bf16*)(ws + WS_QC); F.KC = (bf16*)(ws + WS_KC); F.HQT = (bf16*)(ws + WS_HQT); F.HKT = (bf16*)(ws + WS_HKT); F.HQ2 = (bf16*)(ws + WS_HQ2);
    for (int u = F.tid; u < (LDS_BYTES - LDSCTL_OFF) / 4; u += NWAVES * 64) ((LAS unsigned*)(F.lds + LDSCTL_OFF))[u] = 0u;
    __syncthreads();
    XcdBarrier bar; bar.bar = (unsigned*)(ctl + CW_BAR); bar.x = 0; bar.st = nullptr;
    if (N_LAUNCHES != PER_PHASE) bar = xcd_barrier_post((unsigned*)(ctl + CW_BAR), (volatile LAS unsigned*)(F.lds + MISC_OFF) + 8);
#define GRID_BAR() do { if (N_LAUNCHES == PER_PHASE) { if (F.tid == 0) __hip_atomic_store(ctl + CW_TMO, 0xBADBA0u, RLX_AGENT); } else { xcd_barrier(bar); } } while (0)
    const int lo = args.ph_lo, hi = args.ph_hi;
#ifndef PROBE_TS
#define PROBE_TS (-1)
#endif
#ifndef PROBE_TB
#define PROBE_TB (PROBE_TS + 1)
#endif
    volatile LAS unsigned long long* tsl = (volatile LAS unsigned long long*)(F.lds + LDSCTL_OFF + 512);
#define STAMP(k) do { if (PROBE_TS >= 0 && F.tid == 0) tsl[k] = __builtin_amdgcn_s_memrealtime(); } while (0)
    STAMP(0);
#define IN(k) (lo <= (k) && (k) < hi)
#define BOTH(k) (IN(k) && IN((k) + 1))
#ifndef GEMM_ALIGN
#define GEMM_ALIGN true
#endif
#ifndef GEMM_SP2
#define GEMM_SP2 true
#endif
#ifndef PROBE_KIND
#define PROBE_KIND 0
#endif
#ifndef PROBE_DOUBLE
#define PROBE_DOUBLE 0
#endif
    if (IN(0)) { p0_prologue(F);
#if PROBE_DOUBLE & 1
        __syncthreads(); p0_prologue(F);
#endif
        if (BOTH(0)) { STAMP(17); GRID_BAR(); STAMP(1); } }
    int vcu = F.bid;
    if (N_LAUNCHES != PER_PHASE && lo == 0) { volatile LAS unsigned* st = (volatile LAS unsigned*)(F.lds + MISC_OFF) + 8; if (st[2] != 0u && F.G == 256) vcu = (int)(st[3] * 8u + bar.x); }
    if (IN(1)) {
#if PROBE_KIND == 10
        { pg8::Gemm g{F.U, F.Wt_in, M, NNAT, DM}; pg8::StaticOrder S; S.init(M, NNAT, F.G, vcu); pg8::EpiNull E;
          pg8::gemm_phase<pg8::EpiNull, pg8::StaticOrder, true, true, false, 0, false, false, true>(F.lds, g, S, E); }
#elif PROBE_KIND == 12
        { pg8::Gemm g{F.U, F.Wt_in, M, NNAT, DM}; pg8::StaticOrder S; S.init(M, NNAT, F.G, vcu); pg8::EpiNull E;
          pg8::gemm_phase<pg8::EpiNull, pg8::StaticOrder, true, true, false, 0, true, false, false, true>(F.lds, g, S, E); }
#elif PROBE_KIND == 13
        { f32x16 acc[8]; bf16x8 a, b;
#pragma unroll
          for (int i = 0; i < 8; ++i) acc[i] = zero16();
#pragma unroll
          for (int i = 0; i < 8; ++i) { a[i] = (short)(F.tid + i); b[i] = (short)(F.lane * 3 + i); }
          for (int it = 0; it < 12 * 32 * 8; ++it) {
#pragma unroll
              for (int i = 0; i < 8; ++i) acc[i] = mfma32(a, b, acc[i]);
          }
#pragma unroll
          for (int i = 0; i < 8; ++i) asm volatile("" :: "v"(acc[i])); }
#elif PROBE_KIND == 11
        { pg8::Gemm g{F.U, F.Wt_in, M, NNAT, DM}; pg8::StaticOrder S; S.init(M, NNAT, F.G, vcu); pg8::EpiNull E;
          pg8::gemm_phase<pg8::EpiNull, pg8::StaticOrder, true, true>(F.lds, g, S, E); }
#endif
#if PROBE_DOUBLE & 2
        { pg8::Gemm g{F.U, F.Wt_in, M, NNAT, DM}; pg8::StaticOrder S; S.init(M, NNAT, F.G, vcu);
          pg8::EpiProj E{F.PROJ, NNAT / 256, PC_OZ / 256, PC_OZ / 256 + 8, PC_HG / 256};
          pg8::gemm_phase<pg8::EpiProj, pg8::StaticOrder, GEMM_ALIGN, GEMM_SP2>(F.lds, g, S, E); }
        { pg8::Gemm g{F.Wt_in + (size_t)NNAT * DM, F.U, NTR, M, DM}; pg8::StaticOrder S; S.init(NTR, M, F.G, vcu);
          pg8::EpiBf16T E{F.VT, M / 256};
          pg8::gemm_phase<pg8::EpiBf16T, pg8::StaticOrder, GEMM_ALIGN, GEMM_SP2>(F.lds, g, S, E); }
#endif
        { pg8::Gemm g{F.U, F.Wt_in, M, NNAT, DM}; pg8::StaticOrder S; S.init(M, NNAT, F.G, vcu);
          pg8::EpiProj E{F.PROJ, NNAT / 256, PC_OZ / 256, PC_OZ / 256 + 8, PC_HG / 256};
          pg8::gemm_phase<pg8::EpiProj, pg8::StaticOrder, GEMM_ALIGN, GEMM_SP2>(F.lds, g, S, E); }
        { pg8::Gemm g{F.Wt_in + (size_t)NNAT * DM, F.U, NTR, M, DM}; pg8::StaticOrder S; S.init(NTR, M, F.G, vcu);
          pg8::EpiBf16T E{F.VT, M / 256};
          pg8::gemm_phase<pg8::EpiBf16T, pg8::StaticOrder, GEMM_ALIGN, GEMM_SP2>(F.lds, g, S, E); }
        if (BOTH(1)) { STAMP(14); GRID_BAR(); STAMP(2); }
    }
    if (N_LAUNCHES == PER_PHASE) {
        if (IN(2)) for (int sl = 0; sl < NSLAB; ++sl) pa_phase(F, sl * CPS, tsl);
        if (IN(3)) scan_phase(F, 0, NCH);
        if (IN(4)) for (int sl = 0; sl < NSLAB; ++sl) r2_phase(F, sl * CPS, tsl);
    } else if (IN(2)) {
        for (int sl = 0; sl < NSLAB; ++sl) {
            pa_phase(F, sl * CPS, tsl); STAMP(10); GRID_BAR(); STAMP(11);
            scan_phase(F, sl * CPS, (sl + 1) * CPS); STAMP(12); GRID_BAR(); STAMP(13);
            r2_phase(F, sl * CPS, tsl); if (sl + 1 < NSLAB) GRID_BAR();
        }
        STAMP(3); STAMP(4);
        GRID_BAR(); STAMP(5);
    }
    if (IN(5)) {
        { pg8::Gemm g{F.Y, F.WoT, M, DM, DM}; pg8::StaticOrder S; S.init(M, DM, F.G, vcu);
          pg8::EpiRes E{F.U, F.gates + (WS_RMS - WS_GATES) / 4, F.norm_w, F.HB, (unsigned char*)F.HB + HB8_OFF, F.ssqh, DM, DM / 256};
          pg8::gemm_phase<pg8::EpiRes, pg8::StaticOrder, GEMM_ALIGN, GEMM_SP2>(F.lds, g, S, E); }
        { pg8::Gemm g{F.PB, F.WeT, M, DM, PE}; pg8::StaticOrder S; S.init(M, DM, F.G, vcu);
          pg8::EpiBf16T E{F.EB, DM / 256};
          pg8::gemm_phase<pg8::EpiBf16T, pg8::StaticOrder, GEMM_ALIGN, GEMM_SP2>(F.lds, g, S, E); }
        if (BOTH(5)) { STAMP(15); GRID_BAR(); STAMP(6); }
    }
    if (IN(6)) {
        pg8::Gemm g{(const bf16*)((const unsigned char*)F.HB + HB8_OFF), F.WgT, M, DM, DM / 2}; pg8::StaticOrder S; S.init(M, DM, F.G, vcu);
        pg8::EpiGate E{F.EB, F.HB, F.ssqh, DM / 256, 1.0f / DM, EPS, 1.0f / (WG_SCALE * HB8_SCALE)};
        pg8::gemm_phase<pg8::EpiGate, pg8::StaticOrder, GEMM_ALIGN, GEMM_SP2, false, 0, false, 2, false, false, true>(F.lds, g, S, E);
        if (BOTH(6)) { STAMP(16); GRID_BAR(); STAMP(7); }
    }
    float oscale = 1.0f;
    if (PROBE_TS >= 0) { __syncthreads(); const float f = (float)(tsl[PROBE_TB] - tsl[PROBE_TS]) / (float)(tsl[7] - tsl[0]); oscale = 1.0f + sqrtf(fmaxf(f - PROBE_F0, 0.f) * 1e-3f); }
    if (IN(7)) final_norm(F, oscale);
#undef IN
#undef BOTH
}

#ifdef DBG_DUMP_AFTER
__global__ void dbg_dump(const unsigned char* wsb, float* out, int mode) {
    const unsigned short* a = (const unsigned short*)(wsb + (mode == 0 ? WS_PROJ : WS_U)); const unsigned short* b = (const unsigned short*)(wsb + WS_VT);
    size_t i = (size_t)blockIdx.x * blockDim.x + threadIdx.x;
    const size_t n = (size_t)M * DM;
    for (; i < n; i += (size_t)gridDim.x * blockDim.x) {
        float v;
        if (mode == 0) v = bf2f(a[3 * i]) + bf2f(a[3 * i + 1]) + bf2f(a[3 * i + 2]) + bf2f(b[i]);
        else v = bf2f(a[i]);
        out[i] = v;
    }
}
#endif
extern "C" void kernel_launch(void* const* d_in, const int* in_sizes, int n_in, void* d_out, int out_size, void* d_ws, size_t ws_size, hipStream_t stream) {
    static int grid = 0;
    if (grid == 0) {
        if (n_in != 16 || in_sizes[0] != M * DM || out_size != M * DM || ws_size < WS_END) { fprintf(stderr, "kernel_launch: unexpected shapes (n_in %d, in0 %d, out %d, ws %zu); nothing launched\n", n_in, n_in > 0 ? in_sizes[0] : -1, out_size, ws_size); grid = -1; return; }
        int dev = 0, cus = 0, per_cu = 0;
        if (hipGetDevice(&dev) != hipSuccess || hipDeviceGetAttribute(&cus, hipDeviceAttributeMultiprocessorCount, dev) != hipSuccess) { grid = -1; return; }
        if (hipFuncSetAttribute((const void*)hymba_fwd, hipFuncAttributeMaxDynamicSharedMemorySize, LDS_BYTES) != hipSuccess) { fprintf(stderr, "kernel_launch: hipFuncSetAttribute failed\n"); grid = -1; return; }
        if (hipOccupancyMaxActiveBlocksPerMultiprocessor(&per_cu, (const void*)hymba_fwd, NWAVES * 64, LDS_BYTES) != hipSuccess || per_cu < 1)
            fprintf(stderr, "kernel_launch: note: occupancy query reports %d workgroups per CU\n", per_cu);
        (void)hipGetLastError();
        grid = cus < 256 ? cus : 256;
        if (grid != 256) fprintf(stderr, "kernel_launch: %d CUs: this kernel is written for a 256-CU device; results will be wrong\n", cus);
    }
    if (grid < 0) return;
    if (hipMemsetAsync((char*)d_ws + WS_CTL, 0, CTL_ZERO_BYTES, stream) != hipSuccess) { fprintf(stderr, "kernel_launch: hipMemsetAsync failed\n"); return; }
    Args a{};
    for (int i = 0; i < 16; ++i) a.in[i] = (const float*)d_in[i];
    a.out = (float*)d_out; a.ws = (unsigned char*)d_ws;
    for (int li = 0; li < N_LAUNCHES; ++li) {
#ifdef DBG_DUMP_AFTER
        if (li > DBG_DUMP_AFTER) { if (DBG_DUMP_AFTER != 2 && DBG_DUMP_AFTER != 3) hipLaunchKernelGGL(dbg_dump, dim3(2048), dim3(256), 0, stream, (const unsigned char*)d_ws, (float*)d_out, DBG_DUMP_AFTER == 1 ? 0 : 1);
            break; }
#endif
        a.ph_lo = (N_LAUNCHES == PER_PHASE) ? li : 0; a.ph_hi = (N_LAUNCHES == PER_PHASE) ? li + 1 : PER_PHASE; a.li = li;
        hipLaunchKernelGGL(hymba_fwd, dim3(grid), dim3(NWAVES * 64), LDS_BYTES, stream, a);
        const hipError_t le = hipPeekAtLastError();
        if (le != hipSuccess) { fprintf(stderr, "kernel_launch: launch %d failed: %s\n", li, hipGetErrorName(le)); break; }
    }
}
```

```cpp
#include <hip/hip_runtime.h>
#include <cstdio>
#include <cstdint>
namespace pg8 {
#define PG8_LAS __attribute__((address_space(3)))
typedef unsigned short bf16_t;
typedef short bf16x8 __attribute__((ext_vector_type(8)));
typedef float f32x4 __attribute__((ext_vector_type(4)));
typedef unsigned u32x4 __attribute__((ext_vector_type(4)));
constexpr int BM = 256, BK = 64, HALF = 128, HTB = HALF * BK * 2  , STAGE_BYTES = 8 * HTB, NXCD = 8, WGM = 8;

__host__ __device__ __forceinline__ int lds_byte(int r, int c) { const int st = (r >> 4) * 2 + (c >> 5), rr = r & 15, cc = c & 31, ob = rr * 64 + cc * 2; return st * 1024 + (ob ^ (((ob >> 9) & 1) << 5)); }
__host__ __device__ __forceinline__ void stage_rc(int b, int& R, int& C) { const int st = b / 1024, sb = b % 1024, swz = sb ^ (((sb >> 9) & 1) << 5); R = (st >> 1) * 16 + swz / 64; C = (st & 1) * 32 + (swz % 64) / 2; }
__host__ __device__ __forceinline__ int perm32(int rho) { const int n = rho >> 4, i = rho & 15; return 8 * (i >> 2) + 4 * n + (i & 3); }

struct Unit { int pm, pn; };
struct Gemm { const bf16_t* A; const bf16_t* Bt; int M, N, K; };

struct StaticOrder {
    int nM, nN, nwg, G, c;
    __host__ __device__ void init(int M, int N, int G_, int c_) { nM = M / BM; nN = N / BM; nwg = nM * nN; G = G_; c = c_; }
    __host__ __device__ bool next(int i, Unit& u) const {
        const long L = (long)i * G + c; if (L >= nwg) return false;
        int wgid = (int)L; { const int q = nwg / NXCD, r = nwg % NXCD, xcd = wgid % NXCD, off = wgid / NXCD; wgid = (xcd < r ? xcd * (q + 1) : r * (q + 1) + (xcd - r) * q) + off; }
        const int nig = WGM * nN, gid = wgid / nig, fm = gid * WGM, gsz = (nM - fm) < WGM ? (nM - fm) : WGM;
        u.pm = fm + ((wgid % nig) % gsz); u.pn = (wgid % nig) / gsz; return true;
    }
    __device__ __forceinline__ void a_ready(const Unit&) const {}
    __device__ __forceinline__ void done(const Unit&) const {}
};

typedef unsigned u32x2 __attribute__((ext_vector_type(2)));
typedef int i32x4_ __attribute__((ext_vector_type(4)));
typedef int i32x8_ __attribute__((ext_vector_type(8)));
typedef long i64x2_ __attribute__((ext_vector_type(2)));
__device__ __forceinline__ i32x8_ cat8(bf16x8 a, bf16x8 b) { const i32x4_ x = __builtin_bit_cast(i32x4_, a), y = __builtin_bit_cast(i32x4_, b); return __builtin_shufflevector(x, y, 0, 1, 2, 3, 4, 5, 6, 7); }
__device__ __forceinline__ void mfma_fp8_inplace(f32x4& acc, i32x8_ a, i32x8_ b, int scale) {
    asm volatile("v_mfma_scale_f32_16x16x128_f8f6f4 %0, %1, %2, %0, %3, %3 op_sel_hi:[0,0,0]" : "+v"(acc) : "v"(a), "v"(b), "v"(scale));
}
__device__ __forceinline__ unsigned cvt_pk4_fp8(float a, float b, float c, float d) { int w = __builtin_amdgcn_cvt_pk_fp8_f32(a, b, 0, false); w = __builtin_amdgcn_cvt_pk_fp8_f32(c, d, w, true); return (unsigned)w; }
__device__ __forceinline__ unsigned cvt_pk_bf16(float lo, float hi) { unsigned r; asm volatile("v_cvt_pk_bf16_f32 %0, %1, %2" : "=v"(r) : "v"(lo), "v"(hi)); return r; }
typedef float f32x2 __attribute__((ext_vector_type(2)));
__device__ __forceinline__ f32x2 gelu_pk(f32x2 v) {
    const f32x2 av = __builtin_elementwise_abs(v), d = av * 0.2316418882f + 1.0f;
    f32x2 t; t.x = __builtin_amdgcn_rcpf(d.x); t.y = __builtin_amdgcn_rcpf(d.y);
    f32x2 q = t * 0.5307027145f + (-0.7265760135f); q = q * t + 0.7107068705f; q = q * t + (-0.142248368f); q = q * t + 0.127414796f; q = q * t;
    const f32x2 s = (v * v) * (-0.72134752044f);
    f32x2 e; e.x = __builtin_amdgcn_exp2f(s.x); e.y = __builtin_amdgcn_exp2f(s.y);
    const f32x2 m = v * (q * e), r = v - m;
    f32x2 o; o.x = v.x < 0.f ? m.x : r.x; o.y = v.y < 0.f ? m.y : r.y; return o;
}

template <int ACT  > struct EpiBf16 {
    static constexpr bool PERM = true, AFTER_DRAIN = false; static_assert(ACT == 0 || ACT == 1, "EpiBf16: ACT is 0 (none) or 1 (gelu_pk)");
    bf16_t* O; int ldc; const float* bias; int split_cols; size_t split_stride; float scale0;
    __device__ __forceinline__ void operator()(const f32x4 (&acc)[2][2][4][2], const Unit& u, int wr, int wc, int fr, int fq) const {
        const int row0 = u.pm * BM + wr * 64 + fr; int colt = u.pn * BM; bf16_t* base = O;
        float sc = 1.f; if (split_cols) { const int t = colt / split_cols; base += (size_t)t * split_stride; colt -= t * split_cols; if (t == 0) sc = scale0; }
        const int col0 = colt + wc * 32 + 8 * fq, bcol0 = u.pn * BM + wc * 32 + 8 * fq;
        f32x4 bv[2][2];
#pragma unroll
        for (int bj = 0; bj < 2; ++bj)
#pragma unroll
            for (int n = 0; n < 2; ++n) bv[bj][n] = bias ? *(const f32x4*)(bias + bcol0 + bj * HALF + 4 * n) : (f32x4){0.f, 0.f, 0.f, 0.f};
#pragma unroll
        for (int ai = 0; ai < 2; ++ai)
#pragma unroll
            for (int m = 0; m < 4; ++m) { bf16_t* rowp = base + (size_t)(row0 + ai * HALF + m * 16) * ldc + col0;
#pragma unroll
                for (int bj = 0; bj < 2; ++bj) { f32x4 v0 = acc[ai][bj][m][0] + bv[bj][0], v1 = acc[ai][bj][m][1] + bv[bj][1];
                    if (ACT == 1) { f32x2 a = gelu_pk((f32x2){v0[0], v0[1]}), b = gelu_pk((f32x2){v0[2], v0[3]}), c = gelu_pk((f32x2){v1[0], v1[1]}), d = gelu_pk((f32x2){v1[2], v1[3]});
                        v0 = (f32x4){a.x, a.y, b.x, b.y}; v1 = (f32x4){c.x, c.y, d.x, d.y}; }
                    v0 = v0 * sc; v1 = v1 * sc; u32x4 w; w.x = cvt_pk_bf16(v0[0], v0[1]); w.y = cvt_pk_bf16(v0[2], v0[3]); w.z = cvt_pk_bf16(v1[0], v1[1]); w.w = cvt_pk_bf16(v1[2], v1[3]);
                    __builtin_nontemporal_store(w, (u32x4*)(rowp + bj * HALF)); } }
    }
};
__device__ __forceinline__ float bf_lo(unsigned w) { return __uint_as_float(w << 16); }
__device__ __forceinline__ float bf_hi(unsigned w) { return __uint_as_float(w & 0xffff0000u); }
__device__ __forceinline__ float fast_sigmoid(float x) { return __builtin_amdgcn_rcpf(1.0f + __expf(-x)); }
struct EpiBf16T {
    static constexpr bool PERM = true, AFTER_DRAIN = false;
    bf16_t* O; int nN;
    __device__ __forceinline__ void operator()(const f32x4 (&acc)[2][2][4][2], const Unit& u, int wr, int wc, int fr, int fq) const {
        bf16_t* tile = O + (size_t)(u.pm * nN + u.pn) * 65536 + (wr * 64 + fr) * 256 + wc * 32 + 8 * fq;
#pragma unroll
        for (int ai = 0; ai < 2; ++ai)
#pragma unroll
            for (int m = 0; m < 4; ++m) { bf16_t* rowp = tile + (ai * HALF + m * 16) * 256;
#pragma unroll
                for (int bj = 0; bj < 2; ++bj) { const f32x4 v0 = acc[ai][bj][m][0], v1 = acc[ai][bj][m][1];
                    u32x4 w; w.x = cvt_pk_bf16(v0[0], v0[1]); w.y = cvt_pk_bf16(v0[2], v0[3]); w.z = cvt_pk_bf16(v1[0], v1[1]); w.w = cvt_pk_bf16(v1[2], v1[3]);
                    *(u32x4*)(rowp + bj * HALF) = w; } }
    }
};
struct EpiBf16TS {
    static constexpr bool PERM = true, AFTER_DRAIN = false;
    bf16_t* O; int nN;
    __device__ __forceinline__ void operator()(const f32x4 (&acc)[2][2][4][2], const Unit& u, int wr, int wc, int fr, int fq) const {
        bf16_t* tile = O + (size_t)(u.pm * nN + u.pn) * 65536 + (wr * 64 + fr) * 128 + wc * 32 + 8 * fq;
#pragma unroll
        for (int ai = 0; ai < 2; ++ai)
#pragma unroll
            for (int m = 0; m < 4; ++m) { bf16_t* rowp = tile + (ai * HALF + m * 16) * 128;
#pragma unroll
                for (int bj = 0; bj < 2; ++bj) { const f32x4 v0 = acc[ai][bj][m][0], v1 = acc[ai][bj][m][1];
                    u32x4 w; w.x = cvt_pk_bf16(v0[0], v0[1]); w.y = cvt_pk_bf16(v0[2], v0[3]); w.z = cvt_pk_bf16(v1[0], v1[1]); w.w = cvt_pk_bf16(v1[2], v1[3]);
                    *(u32x4*)(rowp + bj * 32768) = w; } }
    }
};
struct EpiProj {
    static constexpr bool PERM = true, AFTER_DRAIN = false;
    bf16_t* O; int nN, oz_lo, oz_hi, silu_lo;
    __device__ __forceinline__ void operator()(const f32x4 (&acc)[2][2][4][2], const Unit& u, int wr, int wc, int fr, int fq) const {
        bf16_t* tile = O + (size_t)(u.pm * nN + u.pn) * 65536 + (wr * 64 + fr) * 128 + wc * 32 + 8 * fq;
        if (u.pn >= oz_lo && u.pn < oz_hi) {
#pragma unroll
            for (int ai = 0; ai < 2; ++ai)
#pragma unroll
                for (int m = 0; m < 4; ++m) { float g[8];
#pragma unroll
                    for (int n = 0; n < 2; ++n)
#pragma unroll
                        for (int k = 0; k < 4; ++k) { const float o = acc[ai][0][m][n][k], z = acc[ai][1][m][n][k]; g[4 * n + k] = z * __builtin_amdgcn_rcpf((1.0f + __expf(-o)) * (1.0f + __expf(-z))); }
                    u32x4 w; w.x = cvt_pk_bf16(g[0], g[1]); w.y = cvt_pk_bf16(g[2], g[3]); w.z = cvt_pk_bf16(g[4], g[5]); w.w = cvt_pk_bf16(g[6], g[7]);
                    *(u32x4*)(tile + (ai * HALF + m * 16) * 128) = w; }
        } else if (u.pn >= silu_lo) {
#pragma unroll
            for (int ai = 0; ai < 2; ++ai)
#pragma unroll
                for (int m = 0; m < 4; ++m) { bf16_t* rowp = tile + (ai * HALF + m * 16) * 128;
#pragma unroll
                    for (int bj = 0; bj < 2; ++bj) { f32x4 v0 = acc[ai][bj][m][0], v1 = acc[ai][bj][m][1];
#pragma unroll
                        for (int k = 0; k < 4; ++k) { v0[k] = v0[k] * fast_sigmoid(v0[k]); v1[k] = v1[k] * fast_sigmoid(v1[k]); }
                        u32x4 w; w.x = cvt_pk_bf16(v0[0], v0[1]); w.y = cvt_pk_bf16(v0[2], v0[3]); w.z = cvt_pk_bf16(v1[0], v1[1]); w.w = cvt_pk_bf16(v1[2], v1[3]);
                        *(u32x4*)(rowp + bj * 32768) = w; } }
        } else {
#pragma unroll
            for (int ai = 0; ai < 2; ++ai)
#pragma unroll
                for (int m = 0; m < 4; ++m) { bf16_t* rowp = tile + (ai * HALF + m * 16) * 128;
#pragma unroll
                    for (int bj = 0; bj < 2; ++bj) { const f32x4 v0 = acc[ai][bj][m][0], v1 = acc[ai][bj][m][1];
                        u32x4 w; w.x = cvt_pk_bf16(v0[0], v0[1]); w.y = cvt_pk_bf16(v0[2], v0[3]); w.z = cvt_pk_bf16(v1[0], v1[1]); w.w = cvt_pk_bf16(v1[2], v1[3]);
                        *(u32x4*)(rowp + bj * 32768) = w; } }
        }
    }
};
struct EpiRes {
    static constexpr bool PERM = true, AFTER_DRAIN = false;
    const bf16_t* ub; const float* rms; const float* nw; bf16_t* hb; unsigned char* hb8; float* ssq; int ldc, nN;
    __device__ __forceinline__ void operator()(const f32x4 (&acc)[2][2][4][2], const Unit& u, int wr, int wc, int fr, int fq) const {
        const int row0 = u.pm * BM + wr * 64 + fr, col0 = u.pn * BM + wc * 32 + 8 * fq;
        const size_t toff = (size_t)(u.pm * nN + u.pn) * 65536 + (wr * 64 + fr) * 256 + wc * 32 + 8 * fq;
        f32x4 inw[2][2];
#pragma unroll
        for (int bj = 0; bj < 2; ++bj)
#pragma unroll
            for (int n = 0; n < 2; ++n) { const f32x4 w = *(const f32x4*)(nw + col0 + bj * HALF + 4 * n); inw[bj][n] = (f32x4){__builtin_amdgcn_rcpf(w[0]), __builtin_amdgcn_rcpf(w[1]), __builtin_amdgcn_rcpf(w[2]), __builtin_amdgcn_rcpf(w[3])}; }
#pragma unroll
        for (int ai = 0; ai < 2; ++ai) {
            u32x4 xv[4][2]; float rm[4];
#pragma unroll
            for (int m = 0; m < 4; ++m) { const size_t off = (size_t)(row0 + ai * HALF + m * 16) * ldc + col0; rm[m] = rms[row0 + ai * HALF + m * 16];
#pragma unroll
                for (int bj = 0; bj < 2; ++bj) xv[m][bj] = *(const u32x4*)(ub + off + bj * HALF); }
#pragma unroll
            for (int m = 0; m < 4; ++m) { const int row = row0 + ai * HALF + m * 16; const size_t to = toff + (ai * HALF + m * 16) * 256; float ss = 0.f;
#pragma unroll
                for (int bj = 0; bj < 2; ++bj) {
                    const u32x4 xw = xv[m][bj];
                    const f32x4 h0 = (f32x4){bf_lo(xw.x), bf_hi(xw.x), bf_lo(xw.y), bf_hi(xw.y)} * inw[bj][0] * rm[m] + acc[ai][bj][m][0], h1 = (f32x4){bf_lo(xw.z), bf_hi(xw.z), bf_lo(xw.w), bf_hi(xw.w)} * inw[bj][1] * rm[m] + acc[ai][bj][m][1];
                    ss += (h0[0] * h0[0] + h0[1] * h0[1]) + (h0[2] * h0[2] + h0[3] * h0[3]) + (h1[0] * h1[0] + h1[1] * h1[1]) + (h1[2] * h1[2] + h1[3] * h1[3]);
                    u32x4 w; w.x = cvt_pk_bf16(h0[0], h0[1]); w.y = cvt_pk_bf16(h0[2], h0[3]); w.z = cvt_pk_bf16(h1[0], h1[1]); w.w = cvt_pk_bf16(h1[2], h1[3]);
                    *(u32x4*)(hb + to + bj * HALF) = w;
                    u32x2 w8; w8.x = cvt_pk4_fp8(h0[0] * 16.0f, h0[1] * 16.0f, h0[2] * 16.0f, h0[3] * 16.0f); w8.y = cvt_pk4_fp8(h1[0] * 16.0f, h1[1] * 16.0f, h1[2] * 16.0f, h1[3] * 16.0f);
                    *(u32x2*)(hb8 + to + bj * HALF) = w8; }
                ss += __shfl_xor(ss, 16); ss += __shfl_xor(ss, 32);
                if (fq == 0) atomicAdd(ssq + row, ss); }
        }
    }
};
struct EpiGate {
    static constexpr bool PERM = true, AFTER_DRAIN = false;
    bf16_t* e; const bf16_t* hb; float* ssq_h; int nN; float inv_n, eps, ascale;
    __device__ __forceinline__ void operator()(const f32x4 (&acc)[2][2][4][2], const Unit& u, int wr, int wc, int fr, int fq) const {
        const int row0 = u.pm * BM + wr * 64 + fr;
        const size_t toff = (size_t)(u.pm * nN + u.pn) * 65536 + (wr * 64 + fr) * 256 + wc * 32 + 8 * fq;
#pragma unroll
        for (int ai = 0; ai < 2; ++ai) {
            u32x4 ev[4][2], hv[4][2]; float sq[4];
#pragma unroll
            for (int m = 0; m < 4; ++m) { const size_t to = toff + (ai * HALF + m * 16) * 256;
                sq[m] = __hip_atomic_load(ssq_h + row0 + ai * HALF + m * 16, __ATOMIC_RELAXED, __HIP_MEMORY_SCOPE_AGENT);
#pragma unroll
                for (int bj = 0; bj < 2; ++bj) { ev[m][bj] = *(const u32x4*)(e + to + bj * HALF); hv[m][bj] = *(const u32x4*)(hb + to + bj * HALF); } }
#pragma unroll
            for (int m = 0; m < 4; ++m) { const size_t to = toff + (ai * HALF + m * 16) * 256;
                const float rstd = __builtin_amdgcn_rsqf(sq[m] * inv_n + eps) * ascale;
#pragma unroll
                for (int bj = 0; bj < 2; ++bj) { const u32x4 v = ev[m][bj], h = hv[m][bj];
                    const f32x4 a0 = acc[ai][bj][m][0] * rstd, a1 = acc[ai][bj][m][1] * rstd;
                    u32x4 w;
                    w.x = cvt_pk_bf16(bf_lo(h.x) + fast_sigmoid(a0[0]) * bf_lo(v.x), bf_hi(h.x) + fast_sigmoid(a0[1]) * bf_hi(v.x)); w.y = cvt_pk_bf16(bf_lo(h.y) + fast_sigmoid(a0[2]) * bf_lo(v.y), bf_hi(h.y) + fast_sigmoid(a0[3]) * bf_hi(v.y));
                    w.z = cvt_pk_bf16(bf_lo(h.z) + fast_sigmoid(a1[0]) * bf_lo(v.z), bf_hi(h.z) + fast_sigmoid(a1[1]) * bf_hi(v.z)); w.w = cvt_pk_bf16(bf_lo(h.w) + fast_sigmoid(a1[2]) * bf_lo(v.w), bf_hi(h.w) + fast_sigmoid(a1[3]) * bf_hi(v.w));
                    *(u32x4*)(e + to + bj * HALF) = w; } }
        }
    }
};
struct EpiNull {
    static constexpr bool PERM = true, AFTER_DRAIN = false;
    __device__ __forceinline__ void operator()(const f32x4 (&acc)[2][2][4][2], const Unit& u, int wr, int wc, int fr, int fq) const {
#pragma unroll
        for (int ai = 0; ai < 2; ++ai)
#pragma unroll
            for (int bj = 0; bj < 2; ++bj)
#pragma unroll
                for (int m = 0; m < 4; ++m)
#pragma unroll
                    for (int n = 0; n < 2; ++n) asm volatile("" :: "v"(acc[ai][bj][m][n]));
    }
};
struct SameTileOrder {
    int c, n;
    __device__ bool next(int i, Unit& u) const { if (i >= n) return false; u.pm = c & 7; u.pn = i % 24; return true; }
    __device__ __forceinline__ void a_ready(const Unit&) const {}
    __device__ __forceinline__ void done(const Unit&) const {}
};
struct EpiScratch {
    static constexpr bool PERM = true, AFTER_DRAIN = false;
    bf16_t* O0; int per_unit;
    __device__ __forceinline__ void operator()(const f32x4 (&acc)[2][2][4][2], const Unit& u, int wr, int wc, int fr, int fq) const {
        bf16_t* O = O0 + (per_unit ? (size_t)(u.pm * 24 + u.pn) * 65536 : (size_t)0);
        const int row0 = wr * 64 + fr, col0 = wc * 32 + 8 * fq;
#pragma unroll
        for (int ai = 0; ai < 2; ++ai)
#pragma unroll
            for (int m = 0; m < 4; ++m) { bf16_t* rowp = O + (size_t)(row0 + ai * HALF + m * 16) * 256 + col0;
#pragma unroll
                for (int bj = 0; bj < 2; ++bj) { const f32x4 v0 = acc[ai][bj][m][0], v1 = acc[ai][bj][m][1];
                    u32x4 w; w.x = cvt_pk_bf16(v0[0], v0[1]); w.y = cvt_pk_bf16(v0[2], v0[3]); w.z = cvt_pk_bf16(v1[0], v1[1]); w.w = cvt_pk_bf16(v1[2], v1[3]);
                    *(u32x4*)(rowp + bj * HALF) = w; } }
    }
};
template <class Epi, class Sched, bool ALIGN_EPI = false, bool SP2 = false, bool PROBE_K0 = false, int PF = 0, bool NOSTAGE = false, int ABLK = 0, bool NOWAIT = false, bool NOREAD = false, bool FP8 = false>
__device__ __forceinline__ void gemm_phase(PG8_LAS unsigned char* lds, const Gemm g, const Sched& S, const Epi& E) {
    int tid_ = threadIdx.x; asm volatile("" : "+v"(tid_));
    const int tid = tid_, wid = __builtin_amdgcn_readfirstlane(tid >> 6), lane = tid & 63, wr = wid >> 2, wc = wid & 3, fr = lane & 15, fq = lane >> 4;
    const int K = g.K, nt = K / BK;
    unsigned voffA[2], voffB[2];
#pragma unroll
    for (int i = 0; i < 2; ++i) { int R, C; stage_rc(tid * 16 + i * 8192, R, C); const int Rb = Epi::PERM ? ((R & ~31) + perm32(R & 31)) : R;
        voffA[i] = (unsigned)(R * (ABLK == 2 ? 128 : ABLK == 1 ? 256 : K) + C) * 2u; voffB[i] = (unsigned)(Rb * K + C) * 2u; }
    const size_t kstep = PROBE_K0 ? (size_t)0 : (size_t)(BK * 2);
    const size_t hstepB = (size_t)HALF * K * 2, hstepA = ABLK == 2 ? (size_t)HALF * 256 : ABLK == 1 ? (size_t)HALF * 256 * 2 : hstepB;
    const size_t tstep = 2 * hstepB;
    static_assert(!(ABLK && PF > 0), "L2 warming is not written for the blocked A layout");
    const unsigned pfoff = (unsigned)((wid & 3) * 64 + lane) * (unsigned)K * 2u;
    const unsigned pflds = (unsigned)STAGE_BYTES + 1024u + (unsigned)wid * 256u;
    const unsigned ldsw = (unsigned)wid * 1024u;
    const int aoff = lds_byte(wr * 64 + fr, fq * 8), boff = lds_byte(wc * 32 + fr, fq * 8);
#define PG8_SA(b, h) (((b) * 2 + (h)) * HTB)
#define PG8_SB(b, h) ((4 + (b) * 2 + (h)) * HTB)
#define PG8_STAGE(bufoff, gbase, voff) do { if constexpr (!NOSTAGE) _Pragma("unroll") for (int _i = 0; _i < 2; ++_i) \
        __builtin_amdgcn_global_load_lds((const unsigned*)((const char*)(gbase) + (voff)[_i]), (PG8_LAS unsigned*)(lds + (bufoff) + ldsw + _i * 8192), 16, 0, 0); } while (0)
#define PG8_LDA(dst, b, h) do { if constexpr (!NOREAD) _Pragma("unroll") for (int m = 0; m < 4; ++m) _Pragma("unroll") for (int k = 0; k < 2; ++k) dst[m][k] = *(const PG8_LAS bf16x8*)(lds + PG8_SA(b, h) + aoff + m * 2048 + k * 1024); } while (0)
#define PG8_LDB(dst, b, h) do { if constexpr (!NOREAD) _Pragma("unroll") for (int n = 0; n < 2; ++n) _Pragma("unroll") for (int k = 0; k < 2; ++k) dst[n][k] = *(const PG8_LAS bf16x8*)(lds + PG8_SB(b, h) + boff + n * 2048 + k * 1024); } while (0)
#define PG8_MMA(ai, bj, At, Bt) do { __builtin_amdgcn_s_setprio(1); _Pragma("unroll") for (int m = 0; m < 4; ++m) _Pragma("unroll") for (int n = 0; n < 2; ++n) { \
        if constexpr (FP8 && FP8_MX) mfma_fp8_inplace(acc[ai][bj][m][n], cat8(Bt[n][0], Bt[n][1]), cat8(At[m][0], At[m][1]), one_scale); \
        else if constexpr (FP8) { _Pragma("unroll") for (int k = 0; k < 2; ++k) { const i64x2_ bb = __builtin_bit_cast(i64x2_, Bt[n][k]), aa = __builtin_bit_cast(i64x2_, At[m][k]); \
            acc[ai][bj][m][n] = __builtin_amdgcn_mfma_f32_16x16x32_fp8_fp8(bb[0], aa[0], acc[ai][bj][m][n], 0, 0, 0); acc[ai][bj][m][n] = __builtin_amdgcn_mfma_f32_16x16x32_fp8_fp8(bb[1], aa[1], acc[ai][bj][m][n], 0, 0, 0); } } \
        else { _Pragma("unroll") for (int k = 0; k < 2; ++k) acc[ai][bj][m][n] = __builtin_amdgcn_mfma_f32_16x16x32_bf16(Bt[n][k], At[m][k], acc[ai][bj][m][n], 0, 0, 0); } } __builtin_amdgcn_s_setprio(0); } while (0)
#define PG8_WAIT_V(n) asm volatile("s_waitcnt vmcnt(" #n ")" ::: "memory")
#define PG8_WARM(kt) do { if constexpr (PF > 0) { const int _kt = (kt); const char* _p = (wid < 4) ? ((_kt < nt) ? cA + (size_t)_kt * kstep : nA + (size_t)((_kt - nt) < nt ? (_kt - nt) : nt - 1) * kstep) : ((_kt < nt) ? cB + (size_t)_kt * kstep : nB + (size_t)((_kt - nt) < nt ? (_kt - nt) : nt - 1) * kstep); \
        __builtin_amdgcn_global_load_lds((const unsigned*)(_p + pfoff), (PG8_LAS unsigned*)(lds + pflds), 4, 0, 0); } } while (0)
#define PG8_WAIT_VK() do { if constexpr (NOWAIT) {} else if constexpr (PF > 0) PG8_WAIT_V(9); else PG8_WAIT_V(8); } while (0)
#define PG8_WAIT_L(n) asm volatile("s_waitcnt lgkmcnt(" #n ")" ::: "memory")
#define PG8_BAR __builtin_amdgcn_s_barrier()
#define PG8_SCHED __builtin_amdgcn_sched_barrier(0)
    constexpr bool FP8_MX = true;
    const int one_scale = 0x7f7f7f7f;
    Unit cur, nxt; int ui = 0;
    if (!S.next(0, cur)) return;
    f32x4 acc[2][2][4][2];
#pragma unroll
    for (int a = 0; a < 2; ++a)
#pragma unroll
        for (int b = 0; b < 2; ++b)
#pragma unroll
            for (int m = 0; m < 4; ++m)
#pragma unroll
                for (int n = 0; n < 2; ++n) acc[a][b][m][n] = (f32x4){0.f, 0.f, 0.f, 0.f};
    bf16x8 At[4][2], B0[2][2], B1[2][2];
    if constexpr (NOREAD) {
#pragma unroll
        for (int i = 0; i < 8; ++i) { const bf16x8 v = {(short)(0x3f80 + lane + i), (short)(0x3f00 + i), (short)(0xbf80 + lane), (short)0x3e80, (short)(0x3f80 + i), (short)0xbf00, (short)(0x3f81 + lane), (short)0x3f00}; At[i & 3][i >> 2] = v; if (i < 4) { B0[i & 1][i >> 1] = v; B1[i & 1][i >> 1] = v; } }
    }
    const char* cA = (const char*)g.A + (size_t)cur.pm * tstep; const char* cB = (const char*)g.Bt + (size_t)cur.pn * tstep;
    S.a_ready(cur);
    if constexpr (SP2) {
        PG8_STAGE(PG8_SB(0, 0), cB, voffB); PG8_STAGE(PG8_SB(0, 1), cB + hstepB, voffB); PG8_STAGE(PG8_SA(0, 0), cA, voffA); PG8_STAGE(PG8_SA(0, 1), cA + hstepA, voffA);
        if (wr == 1) PG8_BAR;
        PG8_WAIT_V(2); PG8_BAR;
        PG8_STAGE(PG8_SB(1, 0), cB + kstep, voffB); PG8_STAGE(PG8_SA(1, 0), cA + kstep, voffA); PG8_STAGE(PG8_SB(1, 1), cB + hstepB + kstep, voffB);
        PG8_WAIT_V(6); PG8_BAR;
    } else {
        PG8_STAGE(PG8_SB(0, 0), cB, voffB); PG8_STAGE(PG8_SA(0, 0), cA, voffA); PG8_STAGE(PG8_SB(0, 1), cB + hstepB, voffB); PG8_STAGE(PG8_SA(0, 1), cA + hstepA, voffA);
        if (wr == 1) PG8_BAR;
        PG8_WAIT_V(4); PG8_BAR;
        PG8_STAGE(PG8_SB(1, 0), cB + kstep, voffB); PG8_STAGE(PG8_SA(1, 0), cA + kstep, voffA); PG8_STAGE(PG8_SB(1, 1), cB + hstepB + kstep, voffB);
        PG8_WAIT_V(6); PG8_BAR;
    }
    for (;;) {
        const bool has_next = S.next(ui + 1, nxt);
        const char* nA = has_next ? (const char*)g.A + (size_t)nxt.pm * tstep : cA; const char* nB = has_next ? (const char*)g.Bt + (size_t)nxt.pn * tstep : cB;
        for (int t = 0; t < nt; t += 2) {
            const bool last = (t == nt - 2);
            const char* a1 = cA + (ABLK == 2 ? (size_t)((t + 1) >> 1) * 65536 + (size_t)((t + 1) & 1) * 128 : ABLK == 1 ? (size_t)((t + 1) >> 2) * 131072 + (size_t)((t + 1) & 3) * 128 : (size_t)(t + 1) * kstep);
            const char* a2 = last ? nA : cA + (ABLK == 2 ? (size_t)((t + 2) >> 1) * 65536 + (size_t)((t + 2) & 1) * 128 : ABLK == 1 ? (size_t)((t + 2) >> 2) * 131072 + (size_t)((t + 2) & 3) * 128 : (size_t)(t + 2) * kstep); const char* b2 = last ? nB : cB + (size_t)(t + 2) * kstep;
            const char* a3 = a2 + kstep; const char* b3 = b2 + kstep;
            if (last && has_next) S.a_ready(nxt);
            if constexpr (SP2) {
            PG8_LDB(B0, 0, 0); PG8_LDB(B1, 0, 1); PG8_SCHED; PG8_LDA(At, 0, 0); PG8_STAGE(PG8_SA(1, 1), a1 + hstepA, voffA); PG8_WARM(t + 2 + PF);
            PG8_WAIT_VK(); PG8_WAIT_L(0); PG8_BAR; PG8_MMA(0, 0, At, B0); PG8_MMA(0, 1, At, B1); PG8_BAR; PG8_SCHED;
            PG8_LDA(At, 0, 1); PG8_STAGE(PG8_SB(0, 0), b2, voffB); PG8_STAGE(PG8_SB(0, 1), b2 + hstepB, voffB); PG8_STAGE(PG8_SA(0, 0), a2, voffA);
            PG8_WAIT_VK(); PG8_WAIT_L(0); PG8_BAR; PG8_MMA(1, 0, At, B0); PG8_MMA(1, 1, At, B1); PG8_BAR; PG8_SCHED;
            PG8_LDB(B0, 1, 0); PG8_LDB(B1, 1, 1); PG8_SCHED; PG8_LDA(At, 1, 0); PG8_STAGE(PG8_SA(0, 1), a2 + hstepA, voffA); PG8_WARM(t + 3 + PF);
            PG8_WAIT_VK(); PG8_WAIT_L(0); PG8_BAR; PG8_MMA(0, 0, At, B0); PG8_MMA(0, 1, At, B1); PG8_BAR; PG8_SCHED;
            PG8_LDA(At, 1, 1); PG8_STAGE(PG8_SB(1, 0), b3, voffB); PG8_STAGE(PG8_SB(1, 1), b3 + hstepB, voffB); PG8_STAGE(PG8_SA(1, 0), a3, voffA);
            PG8_WAIT_VK(); PG8_WAIT_L(0); PG8_BAR; PG8_MMA(1, 0, At, B0); PG8_MMA(1, 1, At, B1); PG8_BAR; PG8_SCHED;
            } else {
            PG8_LDB(B0, 0, 0); PG8_SCHED; PG8_LDA(At, 0, 0); PG8_STAGE(PG8_SA(1, 1), a1 + hstepA, voffA);
            PG8_WAIT_L(8); PG8_BAR; PG8_WAIT_L(0); PG8_MMA(0, 0, At, B0); PG8_BAR; PG8_SCHED;
            PG8_LDB(B1, 0, 1); PG8_STAGE(PG8_SB(0, 0), b2, voffB);
            PG8_BAR; PG8_WAIT_L(0); PG8_MMA(0, 1, At, B1); PG8_BAR;
            PG8_LDA(At, 0, 1); PG8_STAGE(PG8_SA(0, 0), a2, voffA);
            PG8_BAR; PG8_WAIT_L(0); PG8_MMA(1, 0, At, B0); PG8_BAR; PG8_SCHED;
            PG8_STAGE(PG8_SB(0, 1), b2 + hstepB, voffB);
            PG8_WAIT_V(6); PG8_BAR; PG8_MMA(1, 1, At, B1); PG8_BAR;
            PG8_LDB(B0, 1, 0); PG8_SCHED; PG8_LDA(At, 1, 0); PG8_STAGE(PG8_SA(0, 1), a2 + hstepA, voffA);
            PG8_WAIT_L(8); PG8_BAR; PG8_WAIT_L(0); PG8_MMA(0, 0, At, B0); PG8_BAR; PG8_SCHED;
            PG8_LDB(B1, 1, 1); PG8_STAGE(PG8_SB(1, 0), b3, voffB);
            PG8_BAR; PG8_WAIT_L(0); PG8_MMA(0, 1, At, B1); PG8_BAR;
            PG8_LDA(At, 1, 1); PG8_STAGE(PG8_SA(1, 0), a3, voffA);
            PG8_BAR; PG8_WAIT_L(0); PG8_MMA(1, 0, At, B0); PG8_BAR; PG8_SCHED;
            PG8_STAGE(PG8_SB(1, 1), b3 + hstepB, voffB);
            PG8_WAIT_V(6); PG8_BAR; PG8_MMA(1, 1, At, B1); PG8_BAR;
            }
        }
        if constexpr (FP8 && FP8_MX) asm volatile("s_nop 15\n\ts_nop 15" ::: "memory");
        if constexpr (ALIGN_EPI) { if (wr == 0) PG8_BAR; }
        if constexpr (!Epi::AFTER_DRAIN) {
            int le; asm volatile("v_mbcnt_lo_u32_b32 %0, -1, 0\n\tv_mbcnt_hi_u32_b32 %0, -1, %0" : "=v"(le));
            E(acc, cur, wr, wc, le & 15, le >> 4); S.done(cur); }
        if (!has_next) break;
#pragma unroll
        for (int a = 0; a < 2; ++a)
#pragma unroll
            for (int b = 0; b < 2; ++b)
#pragma unroll
                for (int m = 0; m < 4; ++m)
#pragma unroll
                    for (int n = 0; n < 2; ++n) acc[a][b][m][n] = (f32x4){0.f, 0.f, 0.f, 0.f};
        cur = nxt; cA = nA; cB = nB; ++ui;
        if constexpr (ALIGN_EPI) { if (wr == 1) PG8_BAR; }
    }
    PG8_WAIT_V(0);
    if constexpr (!ALIGN_EPI) { if (wr == 0) PG8_BAR; }
    PG8_BAR;
    if constexpr (Epi::AFTER_DRAIN) { E.fused(acc, cur, wr, wc, fr, fq, lds, wid, lane); S.done(cur); }
#undef PG8_SA
#undef PG8_SB
#undef PG8_STAGE
#undef PG8_LDA
#undef PG8_LDB
#undef PG8_MMA
#undef PG8_WAIT_V
#undef PG8_WARM
#undef PG8_WAIT_VK
#undef PG8_WAIT_L
#undef PG8_BAR
#undef PG8_SCHED
}
}
constexpr int NWAVES = 8, NTHR = 512;
#ifndef MK_N_LAUNCHES
#define MK_N_LAUNCHES 1
#define PROBE_DOUBLE 0
#define PROBE_KIND 0
#define PROBE_TS (-1)
#define PROBE_TB (PROBE_TS + 1)
#define PROBE_F0 0.0f
#endif
constexpr int N_LAUNCHES = MK_N_LAUNCHES;
constexpr int PER_PHASE = 8;
constexpr int BATCH = 2, SEQ = 16384, DM = 2048, M = BATCH * SEQ, NCH = SEQ / 64;
constexpr int IN_COLS = 8200, PE = 256, NNAT = 6144, NTR = 2048;
constexpr float EPS = 1e-6f;
constexpr int PC_Q = 0, PC_K = 512, PC_OZ = 1024  , PC_HQ = 3072, PC_HF = 4096, PC_HG = 5120;
constexpr size_t MiB = 1u << 20;
constexpr size_t WS_CTL = 0, CTL_ZERO_BYTES = 1 * MiB;
constexpr size_t WS_SSQH = 256 * 1024, WS_SSQ2 = 512 * 1024;
constexpr size_t WS_WIN = 2 * MiB, WS_WO = 34 * MiB, WS_WG = 42 * MiB, WS_WE = 50 * MiB;
constexpr size_t WS_GATES = 52 * MiB;
constexpr size_t WS_BCUM = 53 * MiB;
constexpr size_t WS_MSC = 54 * MiB;
constexpr size_t WS_NST = 55 * MiB;
constexpr size_t WS_GDEC = 56 * MiB;
constexpr size_t WS_EBR = 58 * MiB;
constexpr size_t WS_CARRY = 976 * MiB;
constexpr size_t WS_RMS = 59 * MiB;
constexpr size_t WS_Y = 784 * MiB;
constexpr size_t WS_PB = 64 * MiB;
constexpr size_t WS_U = 80 * MiB;
constexpr size_t WS_PROJ = 208 * MiB;
constexpr size_t WS_VT = 592 * MiB;
constexpr size_t WS_QC = 720 * MiB, WS_KC = 752 * MiB;
constexpr size_t WS_HQT = 784 * MiB, WS_HKT = 848 * MiB, WS_HQ2 = 912 * MiB;
constexpr size_t WS_END = 984 * MiB;
constexpr int CW_TMO = 0, CW_BAR = 4096;
constexpr int RING_BYTES = 131072, LDSCTL_OFF = RING_BYTES, MISC_OFF = LDSCTL_OFF + 320, LDS_BYTES = 147456;

#define GAS __attribute__((address_space(1)))
#define LAS __attribute__((address_space(3)))
typedef unsigned short bf16;
typedef unsigned v4u __attribute__((ext_vector_type(4)));
typedef unsigned v2u __attribute__((ext_vector_type(2)));
typedef float f32x4 __attribute__((ext_vector_type(4)));
typedef float v2f __attribute__((ext_vector_type(2)));
typedef float f32x16 __attribute__((ext_vector_type(16)));
typedef short bf16x8 __attribute__((ext_vector_type(8)));
typedef GAS unsigned gu32;
#define RLX_AGENT __ATOMIC_RELAXED, __HIP_MEMORY_SCOPE_AGENT
#define LDS_WAIT() asm volatile("s_waitcnt lgkmcnt(0)" ::: "memory")
#define VM_WAIT() asm volatile("s_waitcnt vmcnt(0)" ::: "memory")
typedef __bf16 bf16x2_t __attribute__((ext_vector_type(2)));
__device__ __forceinline__ unsigned pk2(float lo, float hi) { bf16x2_t v; v[0] = (__bf16)lo; v[1] = (__bf16)hi; return __builtin_bit_cast(unsigned, v); }
__device__ __forceinline__ float bf2f(bf16 v) { return __uint_as_float((unsigned)v << 16); }
__device__ __forceinline__ float blo(unsigned w) { return __uint_as_float(w << 16); }
__device__ __forceinline__ float bhi(unsigned w) { return __uint_as_float(w & 0xffff0000u); }
__device__ __forceinline__ float frcp(float x) { return __builtin_amdgcn_rcpf(x); }
__device__ __forceinline__ float frsq(float x) { return __builtin_amdgcn_rsqf(x); }
__device__ __forceinline__ float fexp(float x) { return __expf(x); }
__device__ __forceinline__ float flog(float x) { return __logf(x); }
__device__ __forceinline__ float sigm(float x) { return frcp(1.0f + __expf(-x)); }

#define XB_TMO      128
#define XB_XCNT(j)  (256  + 64 * (j))
#define XB_XSUB(j)  (1280 + 64 * (j))
#define XB_XGEN(j)  (2304 + 64 * (j))
#define XB_TOP      3328
#define XB_TOPGEN   3392
#define XCD_BAR_WORDS 3456
#define XB_SPIN_CAP (1u << 18)
__device__ __forceinline__ unsigned xb_ld(unsigned* p)              { return __hip_atomic_load(p, __ATOMIC_RELAXED, __HIP_MEMORY_SCOPE_AGENT); }
__device__ __forceinline__ unsigned xb_add(unsigned* p, unsigned v) { return __hip_atomic_fetch_add(p, v, __ATOMIC_RELAXED, __HIP_MEMORY_SCOPE_AGENT); }
__device__ __forceinline__ unsigned xb_xcc_id() { return (unsigned)__builtin_amdgcn_s_getreg((3 << 11) | 20) & 0xFu; }
#define XB_SPIN(cond, bar) do { unsigned _sp = 0; while (cond) { __builtin_amdgcn_s_sleep(1); \
    if ((++_sp & 255u) == 0u) { if (xb_ld(&(bar)[XB_TMO])) break; if (_sp > XB_SPIN_CAP) { atomicAdd(&(bar)[XB_TMO], 1u); break; } } } } while (0)
struct XcdBarrier { unsigned* bar; unsigned x; volatile LAS unsigned* st; };
__device__ __forceinline__ XcdBarrier xcd_barrier_post(unsigned* bar, volatile LAS unsigned* st) {
    XcdBarrier b; b.bar = bar; b.x = xb_xcc_id(); b.st = st;
    if (threadIdx.x == 0) st[3] = xb_add(&bar[XB_XCNT(b.x)], 1u);
    return b;
}
__device__ __forceinline__ void xcd_barrier_complete(unsigned* bar, unsigned x, unsigned& nloc, unsigned& nx, unsigned& even) {
    const unsigned G = gridDim.x * gridDim.y * gridDim.z;
    unsigned sum, cnt, mine, sp = 0u, ev;
    for (;;) {
        sum = 0u; cnt = 0u; mine = 0u; ev = 1u;
#pragma unroll
        for (unsigned j = 0; j < 16; ++j) { const unsigned c = xb_ld(&bar[XB_XCNT(j)]); sum += c; cnt += (c > 0u) ? 1u : 0u; mine = (j == x) ? c : mine; ev &= (j < 8u) ? (c * 8u == G ? 1u : 0u) : (c == 0u ? 1u : 0u); }
        if (sum == G) break;
        __builtin_amdgcn_s_sleep(1);
        if ((++sp & 255u) == 0u) { if (xb_ld(&bar[XB_TMO])) break; if (sp > XB_SPIN_CAP) { atomicAdd(&bar[XB_TMO], 1u); break; } }
    }
    nloc = mine > 0u ? mine : 1u; nx = cnt > 0u ? cnt : 1u; even = (sum == G) ? ev : 0u;
}
__device__ __forceinline__ void xcd_barrier(const XcdBarrier& b) {
    asm volatile("s_waitcnt vmcnt(0)" ::: "memory");
    __syncthreads();
    if (threadIdx.x == 0) {
        unsigned* bar = b.bar;
        __builtin_amdgcn_s_waitcnt(0);
        unsigned nloc = b.st[0], nx = b.st[1];
        if (nloc == 0u) { unsigned even; xcd_barrier_complete(bar, b.x, nloc, nx, even); b.st[0] = nloc; b.st[1] = nx; b.st[2] = even; }
        const unsigned old = xb_add(&bar[XB_XSUB(b.x)], 1u);
        const unsigned gen = old / nloc;
        if (old + 1u == (gen + 1u) * nloc) {
            __builtin_amdgcn_fence(__ATOMIC_RELEASE, "agent");
            asm volatile("s_waitcnt vmcnt(0)" ::: "memory");
            const unsigned og = xb_add(&bar[XB_TOP], 1u);
            const unsigned tg = og / nx;
            if (og + 1u == (tg + 1u) * nx) xb_add(&bar[XB_TOPGEN], 1u);
            else XB_SPIN(xb_ld(&bar[XB_TOPGEN]) == tg, bar);
            __builtin_amdgcn_fence(__ATOMIC_ACQUIRE, "agent");
            xb_add(&bar[XB_XGEN(b.x)], 1u);
            asm volatile("s_waitcnt vmcnt(0)" ::: "memory");
        } else {
            XB_SPIN(xb_ld(&bar[XB_XGEN(b.x)]) == gen, bar);
            __builtin_amdgcn_fence(__ATOMIC_ACQUIRE, "agent");
            asm volatile("s_waitcnt vmcnt(0)" ::: "memory");
        }
    }
    __syncthreads();
}

struct Frame {
    LAS unsigned char* lds;
    int tid, lane, wave, G, bid;
    const float *x, *p, *norm_w, *w_in, *conv_w, *conv_b, *b_i, *b_f, *ml_nw, *hg_lb, *hg_nw, *w_out, *pe_nw, *w_pg, *w_pe, *fin_nw;
    float* out;
    bf16 *Wt_in, *WoT, *WgT, *WeT, *PB, *U, *Y, *PROJ, *HB, *EB, *VT, *Cm, *Ch, *QC, *KC, *HQT, *HKT, *HQ2;
    float *gates, *bcum, *msc, *nst, *gdec, *ebr, *carry, *ssqh, *ssq2;
};
__device__ __forceinline__ size_t proj_off(int m, int n) { return ((size_t)((m >> 8) * 24 + (n >> 8)) << 16) + (size_t)(((n & 128) << 8) + (m & 255) * 128 + (n & 127)); }
__device__ __forceinline__ size_t vt_off(int v, int m) { return ((size_t)((v >> 8) * 128 + (m >> 8)) << 16) + (size_t)(((m & 128) << 8) + (v & 255) * 128 + (m & 127)); }
__device__ __forceinline__ float wave_sum(float v) {
#pragma unroll
    for (int o = 1; o < 64; o <<= 1) v += __shfl_xor(v, o);
    return v;
}
__device__ __forceinline__ float wave_max(float v) {
#pragma unroll
    for (int o = 1; o < 64; o <<= 1) v = fmaxf(v, __shfl_xor(v, o));
    return v;
}
__device__ __forceinline__ float wave_scan_sum(float v, int lane) {
#pragma unroll
    for (int o = 1; o < 64; o <<= 1) { const float y = __shfl_up(v, o); if (lane >= o) v += y; }
    return v;
}
__device__ __forceinline__ float wave_scan_max(float v, int lane) {
#pragma unroll
    for (int o = 1; o < 64; o <<= 1) { const float y = __shfl_up(v, o); if (lane >= o) v = fmaxf(v, y); }
    return v;
}
__device__ __forceinline__ int opaque_i(int v) { asm volatile("" : "+v"(v)); return v; }
__device__ __forceinline__ f32x16 mfma32(bf16x8 a, bf16x8 b, f32x16 c) { return __builtin_amdgcn_mfma_f32_32x32x16_bf16(a, b, c, 0, 0, 0); }
__device__ __forceinline__ f32x16 zero16() { f32x16 z;
#pragma unroll
    for (int i = 0; i < 16; ++i) z[i] = 0.f;
    return z; }

constexpr float WG_SCALE = 256.0f, HB8_SCALE = 16.0f;
constexpr size_t HB8_OFF = 256 * MiB;
__device__ __forceinline__ void p0_transpose_item(const float* W, int ldw, int src_col, int K, bf16* WT, int dst_row, const float* kscale, LAS float* scr, int k0, int lane) {
#pragma unroll 8
    for (int i = 0; i < 32; ++i) { const int kk = 2 * i + (lane >> 5); float v = W[(size_t)(k0 + kk) * ldw + src_col + (lane & 31)]; if (kscale) v *= kscale[k0 + kk]; scr[kk * 33 + (lane & 31)] = v; }
    LDS_WAIT(); asm volatile("" ::: "memory");
    const int c = lane & 7;
#pragma unroll
    for (int j = 0; j < 4; ++j) { const int n = (lane >> 3) + 8 * j; const LAS float* s = scr + (8 * c) * 33 + n;
        v4u o; o.x = pk2(s[0 * 33], s[1 * 33]); o.y = pk2(s[2 * 33], s[3 * 33]); o.z = pk2(s[4 * 33], s[5 * 33]); o.w = pk2(s[6 * 33], s[7 * 33]);
        *(v4u*)(WT + (size_t)(dst_row + n) * K + k0 + 8 * c) = o; }
    LDS_WAIT(); asm volatile("" ::: "memory");
}
__device__ __forceinline__ void p0_transpose_item_fp8(const float* W, int ldw, int src_col, int K, unsigned char* WT, int dst_row, const float* kscale, float scale, LAS float* scr, int k0, int lane) {
#pragma unroll 8
    for (int i = 0; i < 32; ++i) { const int kk = 2 * i + (lane >> 5); const float v = W[(size_t)(k0 + kk) * ldw + src_col + (lane & 31)] * (kscale[k0 + kk] * scale); scr[kk * 33 + (lane & 31)] = v; }
    LDS_WAIT(); asm volatile("" ::: "memory");
    const int c = lane & 7;
#pragma unroll
    for (int j = 0; j < 4; ++j) { const int n = (lane >> 3) + 8 * j; const LAS float* s = scr + (8 * c) * 33 + n;
        v2u o; o.x = pg8::cvt_pk4_fp8(s[0 * 33], s[1 * 33], s[2 * 33], s[3 * 33]); o.y = pg8::cvt_pk4_fp8(s[4 * 33], s[5 * 33], s[6 * 33], s[7 * 33]);
        *(v2u*)(WT + (size_t)(dst_row + n) * K + k0 + 8 * c) = o; }
    LDS_WAIT(); asm volatile("" ::: "memory");
}
__device__ __forceinline__ int win_src_col(int r) { if (r >= 1024 && r < 3072) { const int q = r - 1024, i = q >> 8, rr = q & 255; return rr < 128 ? 2048 + 128 * i + rr : 3072 + 128 * i + (rr - 128); }
    return r < 1024 ? r : r < 5120 ? r + 1032 : r < 6144 ? r + 2056 : r < 7168 ? r - 5120 : r - 1016; }
__device__ __forceinline__ void p0_prologue(const Frame& F) {
    LAS float* scr = (LAS float*)(F.lds + F.wave * 16384);
    const int gw = F.bid * NWAVES + F.wave, NGW = F.G * NWAVES, lane = F.lane;
    for (int it = gw; it < 12544; it += NGW) {
        int r = it;
        if (r < 8192) { const int kb = r >> 8, nb = r & 255; p0_transpose_item(F.w_in, IN_COLS, win_src_col(nb * 32), DM, F.Wt_in, nb * 32, nullptr, scr, kb * 64, lane); continue; } r -= 8192;
        if (r < 2048) { const int kb = r >> 6, nb = r & 63; p0_transpose_item(F.w_out, DM, nb * 32, DM, F.WoT, nb * 32, nullptr, scr, kb * 64, lane); continue; } r -= 2048;
        if (r < 2048) { const int kb = r >> 6, nb = r & 63; p0_transpose_item_fp8(F.w_pg, DM, nb * 32, DM, (unsigned char*)F.WgT, nb * 32, F.pe_nw, WG_SCALE, scr, kb * 64, lane); continue; } r -= 2048;
        { const int kb = r >> 6, nb = r & 63; p0_transpose_item(F.w_pe, DM, nb * 32, PE, F.WeT, nb * 32, nullptr, scr, kb * 64, lane); }
    }
    for (int idx = F.bid * NTHR + F.tid; idx < M * PE / 4; idx += F.G * NTHR) { const f32x4 v = ((const f32x4*)F.p)[idx]; v2u o; o.x = pk2(v[0], v[1]); o.y = pk2(v[2], v[3]); ((v2u*)F.PB)[idx] = o; }
    __syncthreads();
    LAS float* Wg = (LAS float*)F.lds;
    for (int k = F.tid; k < DM; k += NTHR) { const f32x4 a = *(const f32x4*)(F.w_in + (size_t)k * IN_COLS + 4096), b = *(const f32x4*)(F.w_in + (size_t)k * IN_COLS + 4100);
        Wg[0 * DM + k] = a[0]; Wg[1 * DM + k] = a[1]; Wg[2 * DM + k] = a[2]; Wg[3 * DM + k] = a[3]; Wg[4 * DM + k] = b[0]; Wg[5 * DM + k] = b[1]; Wg[6 * DM + k] = b[2]; Wg[7 * DM + k] = b[3]; }
    __syncthreads();
    const f32x4* nwp = (const f32x4*)F.norm_w + lane;
    const float gbias = lane < 4 ? F.b_i[lane & 3] : F.b_f[lane & 3];
    for (int m = gw; m < M; m += NGW) {
        asm volatile("" ::: "memory");
        const f32x4* xr = (const f32x4*)(F.x + (size_t)m * DM) + lane;
        f32x4 t[8]; float ss = 0.f; float ga[8];
#pragma unroll
        for (int c = 0; c < 8; ++c) ga[c] = 0.f;
#pragma unroll
        for (int j = 0; j < 8; ++j) { const f32x4 v = __builtin_nontemporal_load(xr + 64 * j); ss += (v[0] * v[0] + v[1] * v[1]) + (v[2] * v[2] + v[3] * v[3]); t[j] = v * nwp[64 * j]; }
#pragma unroll
        for (int j = 0; j < 8; ++j)
#pragma unroll
            for (int c = 0; c < 8; ++c) { const f32x4 w = *(const LAS f32x4*)(Wg + c * DM + 4 * lane + 256 * j); ga[c] += (t[j][0] * w[0] + t[j][1] * w[1]) + (t[j][2] * w[2] + t[j][3] * w[3]); }
        ss = wave_sum(ss); const float rstd = 1.0f / sqrtf(ss * (1.0f / DM) + EPS);
#pragma unroll
        for (int c = 0; c < 8; ++c) ga[c] = wave_sum(ga[c]) * rstd;
        v2u* uo = (v2u*)(F.U + (size_t)m * DM) + lane;
#pragma unroll
        for (int j = 0; j < 8; ++j) { const f32x4 q = t[j] * rstd; v2u o; o.x = pk2(q[0], q[1]); o.y = pk2(q[2], q[3]); uo[64 * j] = o; }
        float gv = ga[0];
        gv = lane == 1 ? ga[1] : gv; gv = lane == 2 ? ga[2] : gv; gv = lane == 3 ? ga[3] : gv; gv = lane == 4 ? ga[4] : gv; gv = lane == 5 ? ga[5] : gv; gv = lane == 6 ? ga[6] : gv; gv = lane == 7 ? ga[7] : gv;
        if (lane < 8) F.gates[(size_t)m * 8 + lane] = gv + gbias;
        if (lane == 8) F.gates[(WS_RMS - WS_GATES) / 4 + m] = 1.0f / rstd;
    }
}
__device__ __forceinline__ v4u ld16(const bf16* p) { return __builtin_nontemporal_load((const v4u*)p); }
__device__ __forceinline__ void st_bf(LAS bf16* p, float v) { *p = (bf16)(pk2(v, v) & 0xffffu); }
__device__ __forceinline__ void conv_lds_16(const float (&cw)[5], const LAS bf16* col, float scale, float (&out)[16]) {
    float r0 = bf2f(col[0]), r1 = bf2f(col[136]), r2 = bf2f(col[272]);
#pragma unroll
    for (int jj = 0; jj < 16; ++jj) { const float xv = bf2f(col[(jj + 3) * 136]); const float cv = cw[4] + cw[0] * r0 + cw[1] * r1 + cw[2] * r2 + cw[3] * xv; r0 = r1; r1 = r2; r2 = xv; out[jj] = cv * sigm(cv) * scale; }
}
__device__ __forceinline__ void conv_inplace_32(const float (&cw)[5], LAS bf16* col, float t0, float t1, float t2, float scale) {
    float r0 = bf2f(col[0]), r1 = bf2f(col[136]), r2 = bf2f(col[272]);
#pragma unroll
    for (int jj = 0; jj < 32; ++jj) { const float xv = jj < 29 ? bf2f(col[(jj + 3) * 136]) : (jj == 29 ? t0 : jj == 30 ? t1 : t2); const float cv = cw[4] + cw[0] * r0 + cw[1] * r1 + cw[2] * r2 + cw[3] * xv; r0 = r1; r1 = r2; r2 = xv; st_bf(col + jj * 136, cv * sigm(cv) * scale); }
}
constexpr int NCH2 = SEQ / 128;
constexpr size_t ST_PAD = 2048 + 128, CM_US = 256 * 128 + ST_PAD, CH_US = 128 * 128 + ST_PAD;
constexpr int PA_KR = 0, PA_KT = 36864, PA_F32 = 71680;
struct PaM { v4u rk[4], hk; float ig[2], fp[2]; bf16x8 bfr[8]; float cwk[5]; };
__device__ __forceinline__ void pa_mlstm_load(const Frame& F, int bh, int C, PaM& L) {
    const int b = bh >> 2, h = bh & 3, m0 = b * SEQ + C * 128, tid = opaque_i(F.tid), lane = tid & 63, wave = F.wave, r32 = lane & 31, hi = lane >> 5;
    L.hk = (v4u){0u, 0u, 0u, 0u}; L.ig[0] = 0.f; L.ig[1] = 0.f; L.fp[0] = 0.f; L.fp[1] = 0.f;
#pragma unroll
    for (int i = 0; i < 4; ++i) { const int idx = tid + 512 * i, row = idx >> 4, ch = idx & 15; L.rk[i] = ld16(F.PROJ + proj_off(m0 + row, PC_K + h * 128) + ch * 8); }
    if (tid < 48 && C != 0) { const int row = tid >> 4, ch = tid & 15; L.hk = ld16(F.PROJ + proj_off(m0 - 3 + row, PC_K + h * 128) + ch * 8); }
    if (wave == 0) {
#pragma unroll
        for (int hf = 0; hf < 2; ++hf) { L.ig[hf] = F.gates[(size_t)(m0 + 64 * hf + lane) * 8 + h]; L.fp[hf] = F.gates[(size_t)(m0 + 64 * hf + lane) * 8 + 4 + h]; } }
    const bf16* vt = F.VT + vt_off(h * 256 + 32 * wave + r32, m0) + 8 * hi;
#pragma unroll
    for (int ks = 0; ks < 8; ++ks) L.bfr[ks] = *(const bf16x8*)(vt + 16 * ks);
    const int chk = 512 + h * 128 + (tid & 127);
#pragma unroll
    for (int i = 0; i < 4; ++i) L.cwk[i] = F.conv_w[i * 1024 + chk];
    L.cwk[4] = F.conv_b[chk];
}
__device__ __forceinline__ void pa_mlstm_fill(const Frame& F, const PaM& L) {
    const int tid = opaque_i(F.tid);
    LAS bf16* KR = (LAS bf16*)(F.lds + PA_KR);
#pragma unroll
    for (int i = 0; i < 4; ++i) { const int idx = tid + 512 * i, row = idx >> 4, ch = idx & 15; *(LAS v4u*)(KR + (row + 3) * 136 + ch * 8) = L.rk[i]; }
    if (tid < 48) { const int row = tid >> 4, ch = tid & 15; *(LAS v4u*)(KR + row * 136 + ch * 8) = L.hk; }
}
__device__ __forceinline__ void pa_mlstm_gates(const Frame& F, int bh, int C, const PaM& L) {
    const int unit = bh * NCH2 + C, lane = opaque_i(F.lane);
    LAS float* wl = (LAS float*)(F.lds + PA_F32);
    if (F.wave == 0) {
        const float lf0 = fminf(L.fp[0], 0.f) - flog(1.0f + fexp(-fabsf(L.fp[0]))), lf1 = fminf(L.fp[1], 0.f) - flog(1.0f + fexp(-fabsf(L.fp[1])));
        const float b0 = wave_scan_sum(lf0, lane), t0 = __shfl(b0, 63), b1 = t0 + wave_scan_sum(lf1, lane);
        const float g = __shfl(b1, 63);
        const float a0 = g - b0 + L.ig[0], a1 = g - b1 + L.ig[1];
        const float ml = wave_max(fmaxf(a0, a1));
        wl[lane] = fexp(a0 - ml); wl[64 + lane] = fexp(a1 - ml);
        F.bcum[(size_t)bh * SEQ + C * 128 + lane] = b0; F.bcum[(size_t)bh * SEQ + C * 128 + 64 + lane] = b1;
        if (lane == 0) { F.msc[unit * 4 + 0] = g; F.msc[unit * 4 + 1] = ml; }
    }
}
__device__ __forceinline__ void pa_mlstm_compute(const Frame& F, int bh, int C, const PaM& L) {
    const int unit = bh * NCH2 + C, tid = opaque_i(F.tid), lane = tid & 63, wave = F.wave, r32 = lane & 31, hi = lane >> 5;
    LAS bf16 *KR = (LAS bf16*)(F.lds + PA_KR), *kT = (LAS bf16*)(F.lds + PA_KT);
    LAS float* wl = (LAS float*)(F.lds + PA_F32); LAS float* nsum = wl + 128;
    const int d = tid & 127, jq = tid >> 7;
    float ns = 0.f;
    __syncthreads();
#pragma unroll
    for (int s = 0; s < 2; ++s) {
        float kv[16];
        conv_lds_16(L.cwk, KR + (32 * jq + 16 * s) * 136 + d, 0.08838834764831845f, kv);
        unsigned pk[8];
#pragma unroll
        for (int jj = 0; jj < 16; ++jj) { kv[jj] *= wl[32 * jq + 16 * s + jj]; ns += kv[jj]; }
#pragma unroll
        for (int i = 0; i < 8; ++i) pk[i] = pk2(kv[2 * i], kv[2 * i + 1]);
        LAS v4u* dst = (LAS v4u*)(kT + d * 136 + 32 * jq + 16 * s);
        dst[0] = (v4u){pk[0], pk[1], pk[2], pk[3]}; dst[1] = (v4u){pk[4], pk[5], pk[6], pk[7]};
    }
    nsum[jq * 128 + d] = ns;
    __syncthreads();
    if (tid < 128) F.nst[(size_t)unit * 128 + tid] = (nsum[tid] + nsum[128 + tid]) + (nsum[256 + tid] + nsum[384 + tid]);
    {
        f32x16 acc[4];
#pragma unroll
        for (int i = 0; i < 4; ++i) acc[i] = zero16();
#pragma unroll
        for (int ks = 0; ks < 8; ++ks)
#pragma unroll
            for (int dt = 0; dt < 4; ++dt) { const bf16x8 afr = *(const LAS bf16x8*)(kT + (32 * dt + r32) * 136 + 16 * ks + 8 * hi); acc[dt] = mfma32(afr, L.bfr[ks], acc[dt]); }
        LAS bf16* pt = (LAS bf16*)(F.lds + PA_KR) + wave * (32 * 72);
        bf16* dst = F.Cm + (size_t)unit * CM_US + (32 * wave) * 128;
#pragma unroll
        for (int rd = 0; rd < 2; ++rd) {
#pragma unroll
            for (int i = 0; i < 2; ++i)
#pragma unroll
                for (int q = 0; q < 4; ++q) { const int dt = 2 * rd + i; v2u w; w.x = pk2(acc[dt][4 * q], acc[dt][4 * q + 1]); w.y = pk2(acc[dt][4 * q + 2], acc[dt][4 * q + 3]); *(LAS v2u*)(pt + r32 * 72 + 32 * i + 8 * q + 4 * hi) = w; }
            LDS_WAIT();
#pragma unroll
            for (int k = 0; k < 4; ++k) { const int row = 8 * k + (lane >> 3), ch = lane & 7; *(v4u*)(dst + (size_t)row * 128 + 64 * rd + ch * 8) = *(const LAS v4u*)(pt + row * 72 + ch * 8); }
            LDS_WAIT();
        }
    }
    __syncthreads();
}
constexpr int PH_FR = 0, PH_KT = 34816, PH_F32 = 69632, PH_PATCH = 73728;
struct PaH { v4u rf[4]; bf16x8 bfr[8]; float lb0, lb1; };
__device__ __forceinline__ void pa_hgrn2_load(const Frame& F, int bh, int C, PaH& L) {
    const int b = bh >> 3, h = bh & 7, m0 = b * SEQ + C * 128, tid = opaque_i(F.tid), lane = tid & 63, wave = F.wave, r32 = lane & 31, hi = lane >> 5, vt_i = wave & 3;
#pragma unroll
    for (int i = 0; i < 4; ++i) { const int idx = tid + 512 * i, row = idx >> 4, ch = idx & 15; L.rf[i] = ld16(F.PROJ + proj_off(m0 + row, PC_HF + h * 128) + ch * 8); }
    const bf16* vt = F.VT + vt_off(1024 + h * 128 + 32 * vt_i + r32, m0) + 8 * hi;
#pragma unroll
    for (int ks = 0; ks < 8; ++ks) L.bfr[ks] = *(const bf16x8*)(vt + 16 * ks);
    const int e = 2 * (tid & 63);
    L.lb0 = F.hg_lb[1024 + h * 128 + e] - F.hg_lb[h * 128 + e]; L.lb1 = F.hg_lb[1024 + h * 128 + e + 1] - F.hg_lb[h * 128 + e + 1];
}
__device__ __forceinline__ void pa_hgrn2_fill(const Frame& F, const PaH& L) {
    const int tid = opaque_i(F.tid);
    LAS bf16* FR = (LAS bf16*)(F.lds + PH_FR);
#pragma unroll
    for (int i = 0; i < 4; ++i) { const int idx = tid + 512 * i, row = idx >> 4, ch = idx & 15; *(LAS v4u*)(FR + row * 136 + ch * 8) = L.rf[i]; }
}
__device__ __forceinline__ void pa_hgrn2_compute(const Frame& F, int bh, int C, const PaH& L) {
    const int unit = bh * NCH2 + C, tid = opaque_i(F.tid), lane = tid & 63, wave = F.wave, r32 = lane & 31, hi = lane >> 5;
    LAS bf16 *FR = (LAS bf16*)(F.lds + PH_FR), *kT = (LAS bf16*)(F.lds + PH_KT);
    LAS float* seg = (LAS float*)(F.lds + PH_F32);
    const int vt_i = wave & 3, et0 = 2 * (wave >> 2);
    const int e = 2 * (tid & 63), g8 = tid >> 6;
    const float lb0 = frcp(1.0f + fexp(L.lb0)), lb1 = frcp(1.0f + fexp(L.lb1));
    __syncthreads();
    float k0[16], k1[16]; float suf0 = 1.0f, suf1 = 1.0f;
#pragma unroll
    for (int jj = 0; jj < 16; ++jj) { const unsigned w = *(const LAS unsigned*)(FR + (16 * g8 + jj) * 136 + e); k0[jj] = lb0 + (1.0f - lb0) * sigm(blo(w)); k1[jj] = lb1 + (1.0f - lb1) * sigm(bhi(w)); }
#pragma unroll
    for (int jj = 15; jj >= 0; --jj) { const float f0 = k0[jj], f1 = k1[jj]; k0[jj] = (1.0f - f0) * suf0; k1[jj] = (1.0f - f1) * suf1; suf0 *= f0; suf1 *= f1; }
    *(LAS v2f*)(seg + g8 * 128 + e) = (v2f){suf0, suf1};
    __syncthreads();
    {
        float la0 = 1.0f, la1 = 1.0f, tot0 = 1.0f, tot1 = 1.0f, br0 = 1.0f, br1 = 1.0f;
#pragma unroll
        for (int g = 0; g < 8; ++g) { const v2f sv = *(const LAS v2f*)(seg + g * 128 + e); tot0 *= sv[0]; tot1 *= sv[1]; if (g < 4) { br0 *= sv[0]; br1 *= sv[1]; } if (g > g8) { la0 *= sv[0]; la1 *= sv[1]; } }
#pragma unroll
        for (int c = 0; c < 2; ++c) { LAS v4u* dst = (LAS v4u*)(kT + (e + c) * 136 + 16 * g8); const float la = c ? la1 : la0;
#pragma unroll
            for (int i4 = 0; i4 < 2; ++i4) { unsigned pk[4];
#pragma unroll
                for (int i = 0; i < 4; ++i) { const int j0 = 8 * i4 + 2 * i; pk[i] = c ? pk2(k1[j0] * la, k1[j0 + 1] * la) : pk2(k0[j0] * la, k0[j0 + 1] * la); }
                dst[i4] = (v4u){pk[0], pk[1], pk[2], pk[3]}; } }
        if (g8 == 0) { *(v2f*)(F.gdec + (size_t)unit * 128 + e) = (v2f){tot0, tot1}; *(v2f*)(F.ebr + (size_t)unit * 128 + e) = (v2f){br0, br1}; }
    }
    __syncthreads();
    {
        f32x16 acc[2]; acc[0] = zero16(); acc[1] = zero16();
#pragma unroll
        for (int ks = 0; ks < 8; ++ks)
#pragma unroll
            for (int i = 0; i < 2; ++i) { const bf16x8 afr = *(const LAS bf16x8*)(kT + (32 * (et0 + i) + r32) * 136 + 16 * ks + 8 * hi); acc[i] = mfma32(afr, L.bfr[ks], acc[i]); }
        LAS bf16* pt = (LAS bf16*)(F.lds + PH_PATCH) + wave * (32 * 72);
#pragma unroll
        for (int i = 0; i < 2; ++i)
#pragma unroll
            for (int q = 0; q < 4; ++q) { v2u w; w.x = pk2(acc[i][4 * q], acc[i][4 * q + 1]); w.y = pk2(acc[i][4 * q + 2], acc[i][4 * q + 3]); *(LAS v2u*)(pt + r32 * 72 + 32 * i + 8 * q + 4 * hi) = w; }
        LDS_WAIT();
        bf16* dst = F.Ch + (size_t)unit * CH_US + (32 * vt_i) * 128 + 32 * et0;
#pragma unroll
        for (int k = 0; k < 4; ++k) { const int row = 8 * k + (lane >> 3), ch = lane & 7; *(v4u*)(dst + (size_t)row * 128 + ch * 8) = *(const LAS v4u*)(pt + row * 72 + ch * 8); }
    }
    __syncthreads();
}
constexpr int NSLAB = 1, CPS = NCH / NSLAB, CPS_SH = 8;
static_assert(CPS == (1 << CPS_SH) && NSLAB == 1, "slab size; the 128-token HGRN2 units are written for one slab");
__device__ __forceinline__ void pa_phase(const Frame& F, int c_lo, volatile LAS unsigned long long* tsl) {
    { PaM cur; int id = F.bid; pa_mlstm_load(F, id >> 7, id & 127, cur);
      for (; id < 8 * NCH2; id += F.G) { const int nid = (id + F.G < 8 * NCH2) ? id + F.G : id;
          pa_mlstm_fill(F, cur); pa_mlstm_gates(F, id >> 7, id & 127, cur);
          PaM nxt; pa_mlstm_load(F, nid >> 7, nid & 127, nxt);
          pa_mlstm_compute(F, id >> 7, id & 127, cur); cur = nxt; } }
    if (PROBE_TS >= 0 && F.tid == 0) tsl[9] = __builtin_amdgcn_s_memrealtime();
    { PaH cur; int id = F.bid; pa_hgrn2_load(F, id >> 7, id & 127, cur);
      for (; id < 16 * NCH2; id += F.G) { const int nid = (id + F.G < 16 * NCH2) ? id + F.G : id;
          pa_hgrn2_fill(F, cur);
          PaH nxt; pa_hgrn2_load(F, nid >> 7, nid & 127, nxt);
          pa_hgrn2_compute(F, id >> 7, id & 127, cur); cur = nxt; } }
}
__device__ __forceinline__ void unpack8(const v4u k, float (&o)[8]) { o[0] = blo(k.x); o[1] = bhi(k.x); o[2] = blo(k.y); o[3] = bhi(k.y); o[4] = blo(k.z); o[5] = bhi(k.z); o[6] = blo(k.w); o[7] = bhi(k.w); }
__device__ __forceinline__ v4u pack8(const float (&s)[8]) { v4u o; o.x = pk2(s[0], s[1]); o.y = pk2(s[2], s[3]); o.z = pk2(s[4], s[5]); o.w = pk2(s[6], s[7]); return o; }
__device__ __forceinline__ void scan_phase(const Frame& F, int c_lo, int c_hi) {
    typedef float f32x2 __attribute__((ext_vector_type(2)));
    constexpr int SB = 16;
    const int lane_ = opaque_i(F.lane);
    const int item = ((F.bid * 4 + (F.wave >> 1)) << 6) + lane_;
    const int gt = (F.wave & 1) ? 65536 + item : item;
    if ((F.wave & 1) == 0) {
        const int bh = gt >> 13, v = (gt >> 5) & 255, dg = gt & 31;
        bf16* ptr = F.Cm + (size_t)(bh * NCH2) * CM_US + v * 128 + dg * 4;
        float* ms = F.msc + (size_t)bh * NCH2 * 4;
        const int wq = (item >> 6) & 127;
        float* np = F.nst + (size_t)bh * NCH2 * 128 + wq;
        const bool nth = (lane_ == 0);
        bf16* ptr_s = ptr; asm volatile("" : "+v"(ptr_s));
        float C0 = 0.f, C1 = 0.f, C2 = 0.f, C3 = 0.f, n0 = 0.f, m = 0.f;
        float* cr = F.carry + (size_t)gt * 12;
        if (c_lo != 0) { const f32x4 a = *(const f32x4*)cr; C0 = a[0]; C1 = a[1]; C2 = a[2]; C3 = a[3]; n0 = cr[4]; m = cr[8]; }
        for (int c0 = c_lo >> 1; c0 < (c_hi >> 1); c0 += SB) {
            v2u K[SB]; f32x2 gm[SB]; float nl[SB];
#pragma unroll
            for (int i = 0; i < SB; ++i) { K[i] = *(const v2u*)(ptr + (size_t)(c0 + i) * CM_US); gm[i] = *(const f32x2*)(ms + (c0 + i) * 4); }
            if (nth) {
#pragma unroll
                for (int i = 0; i < SB; ++i) nl[i] = np[(c0 + i) * 128];
            }
#pragma unroll
            for (int i = 0; i < SB; ++i) { const int c = c0 + i;
                const float g = gm[i][0], ml = gm[i][1];
                const float mn = fmaxf(g + m, ml), ws = fexp(g + m - mn), fl = fexp(ml - mn);
                v2u o; o.x = pk2(C0, C1); o.y = pk2(C2, C3); *(v2u*)(ptr_s + (size_t)c * CM_US) = o;
                C0 = ws * C0 + fl * blo(K[i].x); C1 = ws * C1 + fl * bhi(K[i].x); C2 = ws * C2 + fl * blo(K[i].y); C3 = ws * C3 + fl * bhi(K[i].y);
                if (nth) {
                    np[c * 128] = n0;
                    n0 = ws * n0 + fl * nl[i];
                    if (wq == 0) ms[c * 4 + 2] = m;
                }
                m = mn; }
        }
        if (c_hi != NCH) { *(f32x4*)cr = (f32x4){C0, C1, C2, C3}; cr[4] = n0; cr[8] = m; }
    } else {
        const int g2 = gt - 65536, bh = g2 >> 12, v = (g2 >> 5) & 127, eg = g2 & 31;
        bf16* ptr = F.Ch + (size_t)(bh * NCH2) * CH_US + v * 128 + eg * 4;
        const float* gd = F.gdec + (size_t)bh * NCH2 * 128 + eg * 4;
        const float* eb = F.ebr + (size_t)bh * NCH2 * 128 + eg * 4;
        bf16* ptr_s = ptr; asm volatile("" : "+v"(ptr_s));
        float S0 = 0.f, S1 = 0.f, S2 = 0.f, S3 = 0.f;
        float* cr = F.carry + (size_t)gt * 12;
        if (c_lo != 0) { const f32x4 a = *(const f32x4*)cr; S0 = a[0]; S1 = a[1]; S2 = a[2]; S3 = a[3]; }
        for (int c0 = c_lo >> 1; c0 < (c_hi >> 1); c0 += SB) {
            v2u K[SB]; f32x4 D[SB], E[SB];
#pragma unroll
            for (int i = 0; i < SB; ++i) { K[i] = *(const v2u*)(ptr + (size_t)(c0 + i) * CH_US); D[i] = *(const f32x4*)(gd + (c0 + i) * 128); E[i] = *(const f32x4*)(eb + (c0 + i) * 128); }
#pragma unroll
            for (int i = 0; i < SB; ++i) { const int c = c0 + i;
                v2u o; o.x = pk2(S0 * E[i][0], S1 * E[i][1]); o.y = pk2(S2 * E[i][2], S3 * E[i][3]); *(v2u*)(ptr_s + (size_t)c * CH_US) = o;
                S0 = D[i][0] * S0 + blo(K[i].x); S1 = D[i][1] * S1 + bhi(K[i].x); S2 = D[i][2] * S2 + blo(K[i].y); S3 = D[i][3] * S3 + bhi(K[i].y); }
        }
        if (c_hi != NCH) *(f32x4*)cr = (f32x4){S0, S1, S2, S3};
    }
}
template <int MODE>
__device__ __forceinline__ void score_tiles(const Frame& F, const LAS bf16* Kt, const LAS bf16* Qt, LAS bf16* Sc, const LAS float* bm, const LAS float* uu, LAS float* dnA, LAS float* dnB) {
    const int wave = F.wave, lane = opaque_i(F.lane), r32 = lane & 31, hi = lane >> 5;
    if (wave < 3) {
        const int jt = (wave == 2) ? 1 : 0, tt = (wave >= 1) ? 1 : 0;
        f32x16 acc = zero16();
#pragma unroll
        for (int ks = 0; ks < 8; ++ks) { const bf16x8 a = *(const LAS bf16x8*)(Kt + (32 * jt + r32) * 136 + 16 * ks + 8 * hi), bq = *(const LAS bf16x8*)(Qt + (32 * tt + r32) * 136 + 16 * ks + 8 * hi); acc = mfma32(a, bq, acc); }
        const int t = 32 * tt + r32; float rs = 0.f; float bmt = 0.f; if (MODE == 1) bmt = bm[t];
#pragma unroll
        for (int q = 0; q < 4; ++q) { const int j0 = 32 * jt + 8 * q + 4 * hi; float vv[4];
            f32x4 u4 = (f32x4){0.f, 0.f, 0.f, 0.f}; if (MODE == 1) u4 = *(const LAS f32x4*)(uu + j0);
#pragma unroll
            for (int i = 0; i < 4; ++i) { float val = acc[4 * q + i]; if (MODE == 1) val *= __expf(fminf(bmt + u4[i], 0.f)); val = (j0 + i <= t) ? val : 0.f; vv[i] = val; rs += val; }
            v2u w; w.x = pk2(vv[0], vv[1]); w.y = pk2(vv[2], vv[3]); *(LAS v2u*)(Sc + t * 72 + j0) = w; }
        if (MODE == 1) { rs += __shfl_xor(rs, 32); if (hi == 0) { if (jt == 0) dnA[t] = rs; else dnB[t] = rs; } }
    } else if (wave == 3) {
        for (int idx = lane; idx < 128; idx += 64) { const int t = idx >> 2, part = idx & 3; *(LAS v4u*)(Sc + t * 72 + 32 + 8 * part) = (v4u){0u, 0u, 0u, 0u}; }
        if (MODE == 1 && lane < 32) dnB[lane] = 0.f;
    }
}
constexpr int RM_KS = 0, RM_QS = 35840, RM_SC = 71680, RM_OT = 89088, RM_F32 = 122880;
struct RmH { v4u hq, hk; };
struct RmA { v4u rq[4], rk[4]; float bj0, bj1, ig0, ig1, mc, ncv; };
struct RmB { bf16x8 avt[8], acs[8]; v4u ro[2][4]; };
__device__ __forceinline__ void r2m_loadA(const Frame& F, int bh, int C, RmA& L) {
    const int b = bh >> 2, h = bh & 3, m0 = b * SEQ + C * 128, unit = bh * NCH2 + C, tid = opaque_i(F.tid), lane = tid & 63, wave = F.wave;
#pragma unroll
    for (int i = 0; i < 4; ++i) { const int idx = tid + 512 * i, row = idx >> 4, ch = idx & 15;
        L.rq[i] = ld16(F.PROJ + proj_off(m0 + row, PC_Q + h * 128) + ch * 8); L.rk[i] = ld16(F.PROJ + proj_off(m0 + row, PC_K + h * 128) + ch * 8); }
    L.bj0 = 0.f; L.bj1 = 0.f; L.ig0 = 0.f; L.ig1 = 0.f; L.mc = 0.f; L.ncv = 0.f;
    if (wave == 0) { L.bj0 = F.bcum[(size_t)bh * SEQ + C * 128 + lane]; L.bj1 = F.bcum[(size_t)bh * SEQ + C * 128 + 64 + lane]; L.ig0 = F.gates[(size_t)(m0 + lane) * 8 + h]; L.ig1 = F.gates[(size_t)(m0 + 64 + lane) * 8 + h]; L.mc = F.msc[unit * 4 + 2]; }
    else if (wave < 3) L.ncv = F.nst[(size_t)unit * 128 + tid - 64];
}
__device__ __forceinline__ void r2m_loadH(const Frame& F, int bh, int C, RmH& L) {
    const int b = bh >> 2, h = bh & 3, m0 = b * SEQ + C * 128, tid = opaque_i(F.tid);
    L.hq = (v4u){0u, 0u, 0u, 0u}; L.hk = (v4u){0u, 0u, 0u, 0u};
    if (tid < 48 && C != 0) { const int row = tid >> 4, ch = tid & 15; L.hq = ld16(F.PROJ + proj_off(m0 - 3 + row, PC_Q + h * 128) + ch * 8); L.hk = ld16(F.PROJ + proj_off(m0 - 3 + row, PC_K + h * 128) + ch * 8); }
}
__device__ __forceinline__ void r2m_loadB(const Frame& F, int bh, int C, RmB& L) {
    const int b = bh >> 2, h = bh & 3, m0 = b * SEQ + C * 128, unit = bh * NCH2 + C, tid = opaque_i(F.tid), lane = tid & 63, wave = F.wave, r32 = lane & 31, hi = lane >> 5;
#pragma unroll
    for (int th = 0; th < 2; ++th)
#pragma unroll
        for (int i = 0; i < 4; ++i) { const int idx = tid + 512 * i, row = idx >> 5, ch = idx & 31;
            L.ro[th][i] = ld16(F.PROJ + proj_off(m0 + 64 * th + row, PC_OZ + 512 * h + 256 * (ch >> 4)) + (ch & 15) * 8); }
    const bf16* vt = F.VT + vt_off(h * 256 + 32 * wave + r32, m0) + 8 * hi;
#pragma unroll
    for (int ks = 0; ks < 8; ++ks) L.avt[ks] = *(const bf16x8*)(vt + 16 * ks);
    const bf16* cs = F.Cm + (size_t)unit * CM_US + (32 * wave + r32) * 128 + 8 * hi;
#pragma unroll
    for (int ks = 0; ks < 8; ++ks) L.acs[ks] = *(const bf16x8*)(cs + 16 * ks);
}
__device__ __forceinline__ void r2m_unit(const Frame& F, int bh, int C, const RmA& A, const RmB& B, const RmH& H, int nbh, int nC, RmA& NA, RmB& NB, RmH& NH) {
    const int b = bh >> 2, h = bh & 3, m0 = b * SEQ + C * 128, tid = opaque_i(F.tid), lane = tid & 63, wave = F.wave, r32 = lane & 31, hi = lane >> 5;
    LAS bf16 *Ks = (LAS bf16*)(F.lds + RM_KS), *Qs = (LAS bf16*)(F.lds + RM_QS), *Sc = (LAS bf16*)(F.lds + RM_SC), *OT = (LAS bf16*)(F.lds + RM_OT);
    LAS float* fb = (LAS float*)(F.lds + RM_F32);
    LAS float *bm = fb, *uu = fb + 128, *wi = fb + 256, *emt = fb + 384, *qn = fb + 512, *dn = fb + 640, *nc = fb + 896, *hn = fb + 1024;
    bf16x8 avt[8], acs[8]; v4u ro1[4];
#pragma unroll
    for (int ks = 0; ks < 8; ++ks) { avt[ks] = B.avt[ks]; acs[ks] = B.acs[ks]; }
#pragma unroll
    for (int q = 0; q < 4; ++q) ro1[q] = B.ro[1][q];
    const float bj0 = A.bj0, bj1 = A.bj1, ig0 = A.ig0, ig1 = A.ig1, mc = A.mc, ncv = A.ncv;
#pragma unroll
    for (int i = 0; i < 4; ++i) { const int idx = tid + 512 * i, row = idx >> 4, ch = idx & 15; *(LAS v4u*)(Qs + (row + 3) * 136 + ch * 8) = A.rq[i]; *(LAS v4u*)(Ks + (row + 3) * 136 + ch * 8) = A.rk[i]; }
    if (tid < 48) { const int row = tid >> 4, ch = tid & 15; *(LAS v4u*)(Qs + row * 136 + ch * 8) = H.hq; *(LAS v4u*)(Ks + row * 136 + ch * 8) = H.hk; }
#pragma unroll
    for (int i = 0; i < 4; ++i) { const int idx = tid + 512 * i, row = idx >> 5, ch = idx & 31; *(LAS v4u*)(OT + row * 264 + ch * 8) = B.ro[0][i]; }
    if (wave == 0) {
        const float u0 = ig0 - bj0, u1 = ig1 - bj1;
        const float p0 = wave_scan_max(u0, lane), p1 = fmaxf(__shfl(p0, 63), wave_scan_max(u1, lane));
        const float mt0 = bj0 + fmaxf(mc, p0), mt1 = bj1 + fmaxf(mc, p1);
        bm[lane] = bj0 - mt0; uu[lane] = u0; wi[lane] = fexp(bj0 + mc - mt0); emt[lane] = fexp(-mt0);
        bm[64 + lane] = bj1 - mt1; uu[64 + lane] = u1; wi[64 + lane] = fexp(bj1 + mc - mt1); emt[64 + lane] = fexp(-mt1);
    } else if (wave < 3) nc[tid - 64] = ncv;
    r2m_loadA(F, nbh, nC, NA);
    __syncthreads();
    {
        const int d = tid & 127, jq = tid >> 7;
        float cwq[5], cwk[5];
        { const int chq = h * 128 + d, chk = 512 + chq;
#pragma unroll
          for (int i = 0; i < 4; ++i) { cwq[i] = F.conv_w[i * 1024 + chq]; cwk[i] = F.conv_w[i * 1024 + chk]; }
          cwq[4] = F.conv_b[chq]; cwk[4] = F.conv_b[chk]; }
        LAS bf16 *qc = Qs + (32 * jq) * 136 + d, *kc = Ks + (32 * jq) * 136 + d;
        const float tq0 = bf2f(qc[32 * 136]), tq1 = bf2f(qc[33 * 136]), tq2 = bf2f(qc[34 * 136]), tk0 = bf2f(kc[32 * 136]), tk1 = bf2f(kc[33 * 136]), tk2 = bf2f(kc[34 * 136]);
        __syncthreads();
        conv_inplace_32(cwq, qc, tq0, tq1, tq2, 1.0f);
        conv_inplace_32(cwk, kc, tk0, tk1, tk2, 0.08838834764831845f);
    }
    __syncthreads();
    {
        const int t = tid >> 2, part = tid & 3; float dot = 0.f;
#pragma unroll
        for (int i = 0; i < 4; ++i) { const int d0 = 32 * part + 8 * i; const v4u qv = *(const LAS v4u*)(Qs + t * 136 + d0); float qf[8]; unpack8(qv, qf);
#pragma unroll
            for (int k = 0; k < 8; ++k) dot += qf[k] * nc[d0 + k]; }
        dot += __shfl_xor(dot, 1); dot += __shfl_xor(dot, 2); if (part == 0) qn[t] = dot;
    }
#pragma unroll
    for (int th = 0; th < 2; ++th) {
        {
            int jt, st; bool zero = false, act = true;
            if (th == 0) { jt = (wave == 2) ? 1 : 0; st = (wave >= 1) ? 1 : 0; zero = (wave == 3); act = (wave < 4); if (zero) { jt = 1; st = 0; } }
            else { jt = (wave < 4) ? (wave >> 1) : (wave < 6 ? 2 : 3); st = (wave < 4) ? (wave & 1) : (wave == 4 ? 0 : 1); zero = (wave == 7); if (zero) { jt = 3; st = 0; } }
            if (act && !zero) {
                f32x16 acc = zero16();
#pragma unroll
                for (int ks = 0; ks < 8; ++ks) { const bf16x8 a = *(const LAS bf16x8*)(Ks + (32 * jt + r32) * 136 + 16 * ks + 8 * hi), bq = *(const LAS bf16x8*)(Qs + (64 * th + 32 * st + r32) * 136 + 16 * ks + 8 * hi); acc = mfma32(a, bq, acc); }
                const int tl = 32 * st + r32, tg = 64 * th + tl; const float bmt = bm[tg]; float rs = 0.f;
#pragma unroll
                for (int q = 0; q < 4; ++q) { const int j0 = 32 * jt + 8 * q + 4 * hi; float vv[4]; const f32x4 u4 = *(const LAS f32x4*)(uu + j0);
#pragma unroll
                    for (int i = 0; i < 4; ++i) { const float val = (j0 + i <= tg) ? acc[4 * q + i] * __expf(fminf(bmt + u4[i], 0.f)) : 0.f; vv[i] = val; rs += val; }
                    v2u w; w.x = pk2(vv[0], vv[1]); w.y = pk2(vv[2], vv[3]); *(LAS v2u*)(Sc + tl * 136 + j0) = w; }
                rs += __shfl_xor(rs, 32); if (hi == 0) dn[jt * 64 + tl] = rs;
            } else if (act) {
                for (int idx = lane; idx < 128; idx += 64) { const int tl = 32 * st + (idx >> 2), part = idx & 3; *(LAS v4u*)(Sc + tl * 136 + 32 * jt + 8 * part) = (v4u){0u, 0u, 0u, 0u}; }
                if (lane < 32) dn[jt * 64 + 32 * st + lane] = 0.f;
            }
            if (th == 0 && wave >= 4 && wave < 6) dn[(wave - 2) * 64 + lane] = 0.f;
        }
        __syncthreads();
        f32x4 nw[4];
        { const float* nwp = F.ml_nw + h * 256 + 32 * wave + 4 * hi;
          asm volatile("" ::: "memory");
#pragma unroll
          for (int q = 0; q < 4; ++q) nw[q] = *(const f32x4*)(nwp + 8 * q); }
        f32x16 accA[2], accB[2]; accA[0] = zero16(); accA[1] = zero16(); accB[0] = zero16(); accB[1] = zero16();
#pragma unroll
        for (int ks = 0; ks < 8; ++ks) if (ks < 4 * (th + 1))
#pragma unroll
            for (int tt = 0; tt < 2; ++tt) { const bf16x8 bq = *(const LAS bf16x8*)(Sc + (32 * tt + r32) * 136 + 16 * ks + 8 * hi); accA[tt] = mfma32(avt[ks], bq, accA[tt]); }
#pragma unroll
        for (int ks = 0; ks < 8; ++ks)
#pragma unroll
            for (int tt = 0; tt < 2; ++tt) { const bf16x8 bq = *(const LAS bf16x8*)(Qs + (64 * th + 32 * tt + r32) * 136 + 16 * ks + 8 * hi); accB[tt] = mfma32(acs[ks], bq, accB[tt]); }
        if (th == 1) r2m_loadB(F, nbh, nC, NB);
#pragma unroll
        for (int tt = 0; tt < 2; ++tt) { const int tl = 32 * tt + r32, tg = 64 * th + tl; const float wit = wi[tg];
            const float den = (dn[tl] + dn[64 + tl]) + (dn[128 + tl] + dn[192 + tl]) + wit * qn[tg]; const float inv = frcp(fmaxf(fabsf(den), emt[tg])); float ssp = 0.f;
#pragma unroll
            for (int r = 0; r < 16; ++r) { const float hv = (accA[tt][r] + wit * accB[tt][r]) * inv; accA[tt][r] = hv; ssp += hv * hv; }
            ssp += __shfl_xor(ssp, 32); if (hi == 0) hn[wave * 64 + tl] = ssp; }
        __syncthreads();
        if (th == 1) r2m_loadH(F, nbh, nC, NH);
#pragma unroll
        for (int tt = 0; tt < 2; ++tt) { const int tl = 32 * tt + r32; float tot = 0.f;
#pragma unroll
            for (int w = 0; w < 8; ++w) tot += hn[w * 64 + tl];
            const float rstd = frsq(tot * (1.0f / 256.0f) + EPS);
            const int v0 = 32 * wave + 4 * hi;
#pragma unroll
            for (int q = 0; q < 4; ++q) { LAS v2u* op = (LAS v2u*)(OT + tl * 264 + v0 + 8 * q); const v2u o4 = *op;
                const float y0 = accA[tt][4 * q] * rstd * nw[q][0] * blo(o4.x), y1 = accA[tt][4 * q + 1] * rstd * nw[q][1] * bhi(o4.x);
                const float y2 = accA[tt][4 * q + 2] * rstd * nw[q][2] * blo(o4.y), y3 = accA[tt][4 * q + 3] * rstd * nw[q][3] * bhi(o4.y);
                v2u w; w.x = pk2(y0, y1); w.y = pk2(y2, y3); *op = w; } }
        __syncthreads();
#pragma unroll
        for (int i = 0; i < 4; ++i) { const int idx = tid + 512 * i, row = idx >> 5, ch = idx & 31; *(v4u*)(F.Y + (size_t)(m0 + 64 * th + row) * DM + h * 256 + ch * 8) = *(const LAS v4u*)(OT + row * 264 + ch * 8); }
        __syncthreads();
        if (th == 0) {
#pragma unroll
            for (int i = 0; i < 4; ++i) { const int idx = tid + 512 * i, row = idx >> 5, ch = idx & 31; *(LAS v4u*)(OT + row * 264 + ch * 8) = ro1[i]; }
        }
    }
}
constexpr int RH_QT = 0, RH_KT = 34816, RH_GT = 69632, RH_SC = 104448, RH_F32 = 121856;
struct RhL { v4u rq[4], rf[4], rg[4]; float lbd0, lbd1; };
__device__ __forceinline__ void r2h_load(const Frame& F, int bh, int C, RhL& L) {
    const int b = bh >> 3, h = bh & 7, m0 = b * SEQ + C * 128, tid = opaque_i(F.tid);
#pragma unroll
    for (int i = 0; i < 4; ++i) { const int idx = tid + 512 * i, row = idx >> 4, ch = idx & 15;
        L.rq[i] = ld16(F.PROJ + proj_off(m0 + row, PC_HQ + h * 128) + ch * 8); L.rf[i] = ld16(F.PROJ + proj_off(m0 + row, PC_HF + h * 128) + ch * 8); L.rg[i] = ld16(F.PROJ + proj_off(m0 + row, PC_HG + h * 128) + ch * 8); }
    { const int e = 2 * (tid & 63); L.lbd0 = F.hg_lb[1024 + h * 128 + e] - F.hg_lb[h * 128 + e]; L.lbd1 = F.hg_lb[1024 + h * 128 + e + 1] - F.hg_lb[h * 128 + e + 1]; }
}
__device__ __forceinline__ void r2h_fill(const Frame& F, const RhL& L) {
    const int tid = opaque_i(F.tid);
    LAS bf16 *Qt = (LAS bf16*)(F.lds + RH_QT), *Kt = (LAS bf16*)(F.lds + RH_KT), *GT = (LAS bf16*)(F.lds + RH_GT);
#pragma unroll
    for (int i = 0; i < 4; ++i) { const int idx = tid + 512 * i, row = idx >> 4, ch = idx & 15; const int lo = row * 136 + ch * 8;
        *(LAS v4u*)(Qt + lo) = L.rq[i]; *(LAS v4u*)(Kt + lo) = L.rf[i]; *(LAS v4u*)(GT + lo) = L.rg[i]; }
}
__device__ __forceinline__ void r2h_compute(const Frame& F, int bh, int C, float lbd0, float lbd1) {
    const int b = bh >> 3, h = bh & 7, m0 = b * SEQ + C * 128, unit = bh * NCH2 + C, tid = opaque_i(F.tid), lane = tid & 63, wave = F.wave, r32 = lane & 31, hi = lane >> 5;
    LAS bf16 *Qt = (LAS bf16*)(F.lds + RH_QT), *Kt = (LAS bf16*)(F.lds + RH_KT), *GT = (LAS bf16*)(F.lds + RH_GT), *Sc = (LAS bf16*)(F.lds + RH_SC);
    LAS float* hn = (LAS float*)(F.lds + RH_F32);
    LAS float* seg = hn + 256;
    const int vt_i = wave & 3, tt = wave >> 2, t = 32 * tt + r32;
    bf16x8 avt[8], ast[8]; f32x4 nw[4];
    { const bf16* vt = F.VT + vt_off(1024 + h * 128 + 32 * vt_i + r32, m0) + 8 * hi;
#pragma unroll
      for (int ks = 0; ks < 8; ++ks) avt[ks] = *(const bf16x8*)(vt + 16 * ks);
      const bf16* cs = F.Ch + (size_t)unit * CH_US + (32 * vt_i + r32) * 128 + 8 * hi;
#pragma unroll
      for (int ks = 0; ks < 8; ++ks) ast[ks] = *(const bf16x8*)(cs + 16 * ks);
      const float* nwp = F.hg_nw + h * 128 + 32 * vt_i + 4 * hi;
#pragma unroll
      for (int q = 0; q < 4; ++q) nw[q] = *(const f32x4*)(nwp + 8 * q); }
    __syncthreads();
    {
        const int e = 2 * (tid & 63), g8 = tid >> 6;
        const float lb0 = frcp(1.0f + fexp(lbd0)), lb1 = frcp(1.0f + fexp(lbd1));
        float y0[16], y1[16], f0[16], f1[16];
#pragma unroll
        for (int jj = 0; jj < 16; ++jj) { const unsigned w = *(const LAS unsigned*)(Kt + (16 * g8 + jj) * 136 + e); f0[jj] = lb0 + (1.0f - lb0) * sigm(blo(w)); f1[jj] = lb1 + (1.0f - lb1) * sigm(bhi(w)); }
        float run0 = 1.0f, run1 = 1.0f;
        if (g8 < 4) {
#pragma unroll
            for (int jj = 15; jj >= 0; --jj) { y0[jj] = run0; y1[jj] = run1; run0 *= f0[jj]; run1 *= f1[jj]; }
        } else {
#pragma unroll
            for (int jj = 0; jj < 16; ++jj) { run0 *= f0[jj]; run1 *= f1[jj]; y0[jj] = run0; y1[jj] = run1; }
        }
        *(LAS v2f*)(seg + g8 * 128 + e) = (v2f){run0, run1};
        __syncthreads();
        float o0 = 1.0f, o1 = 1.0f;
#pragma unroll
        for (int g = 1; g < 7; ++g) { const bool use = (g8 < 4) ? (g > g8 && g < 4) : (g >= 4 && g < g8); if (use) { const v2f sv = *(const LAS v2f*)(seg + g * 128 + e); o0 *= sv[0]; o1 *= sv[1]; } }
#pragma unroll
        for (int jj = 0; jj < 16; ++jj) { const int j = 16 * g8 + jj; const float ya = y0[jj] * o0, yb = y1[jj] * o1, ra = frcp(ya), rb = frcp(yb);
            const unsigned qw = *(const LAS unsigned*)(Qt + j * 136 + e);
            *(LAS unsigned*)(Qt + j * 136 + e) = pk2(blo(qw) * (g8 < 4 ? ra : ya), bhi(qw) * (g8 < 4 ? rb : yb));
            *(LAS unsigned*)(Kt + j * 136 + e) = pk2((1.0f - f0[jj]) * (g8 < 4 ? ya : ra), (1.0f - f1[jj]) * (g8 < 4 ? yb : rb)); }
    }
    __syncthreads();
#pragma unroll
    for (int th = 0; th < 2; ++th) {
        {
            int jt, st; bool zero = false, act = true;
            if (th == 0) { jt = (wave == 2) ? 1 : 0; st = (wave >= 1) ? 1 : 0; zero = (wave == 3); act = (wave < 4); if (zero) { jt = 1; st = 0; } }
            else { jt = (wave < 4) ? (wave >> 1) : (wave < 6 ? 2 : 3); st = (wave < 4) ? (wave & 1) : (wave == 4 ? 0 : 1); zero = (wave == 7); if (zero) { jt = 3; st = 0; } }
            if (act && !zero) {
                f32x16 acc = zero16();
#pragma unroll
                for (int ks = 0; ks < 8; ++ks) { const bf16x8 a = *(const LAS bf16x8*)(Kt + (32 * jt + r32) * 136 + 16 * ks + 8 * hi), bq = *(const LAS bf16x8*)(Qt + (64 * th + 32 * st + r32) * 136 + 16 * ks + 8 * hi); acc = mfma32(a, bq, acc); }
                const int tl = 32 * st + r32, tg = 64 * th + tl;
#pragma unroll
                for (int q = 0; q < 4; ++q) { const int j0 = 32 * jt + 8 * q + 4 * hi; float vv[4];
#pragma unroll
                    for (int i = 0; i < 4; ++i) vv[i] = (j0 + i <= tg) ? acc[4 * q + i] : 0.f;
                    v2u w; w.x = pk2(vv[0], vv[1]); w.y = pk2(vv[2], vv[3]); *(LAS v2u*)(Sc + tl * 136 + j0) = w; }
            } else if (act) {
                for (int idx = lane; idx < 128; idx += 64) { const int tl = 32 * st + (idx >> 2), part = idx & 3; *(LAS v4u*)(Sc + tl * 136 + 32 * jt + 8 * part) = (v4u){0u, 0u, 0u, 0u}; }
            }
        }
        __syncthreads();
        f32x16 acc = zero16();
#pragma unroll
        for (int ks = 0; ks < 8; ++ks) if (ks < 4 * (th + 1)) { const bf16x8 bq = *(const LAS bf16x8*)(Sc + t * 136 + 16 * ks + 8 * hi); acc = mfma32(avt[ks], bq, acc); }
#pragma unroll
        for (int ks = 0; ks < 8; ++ks) { const bf16x8 bq = *(const LAS bf16x8*)(Qt + (64 * th + t) * 136 + 16 * ks + 8 * hi); acc = mfma32(ast[ks], bq, acc); }
        { float ssp = 0.f;
#pragma unroll
          for (int r = 0; r < 16; ++r) ssp += acc[r] * acc[r];
          ssp += __shfl_xor(ssp, 32); if (hi == 0) hn[vt_i * 64 + t] = ssp; }
        __syncthreads();
        LAS bf16* YT = Qt + 64 * th * 136;
        {
            const float tot = (hn[t] + hn[64 + t]) + (hn[128 + t] + hn[192 + t]);
            const float rstd = frsq(tot * (1.0f / 128.0f) + EPS);
            const int v0 = 32 * vt_i + 4 * hi;
#pragma unroll
            for (int q = 0; q < 4; ++q) { const v2u g4 = *(const LAS v2u*)(GT + (64 * th + t) * 136 + v0 + 8 * q);
                const float g0 = blo(g4.x), g1 = bhi(g4.x), g2 = blo(g4.y), g3 = bhi(g4.y);
                const float y0 = acc[4 * q] * rstd * nw[q][0] * g0, y1 = acc[4 * q + 1] * rstd * nw[q][1] * g1;
                const float y2 = acc[4 * q + 2] * rstd * nw[q][2] * g2, y3 = acc[4 * q + 3] * rstd * nw[q][3] * g3;
                v2u w; w.x = pk2(y0, y1); w.y = pk2(y2, y3); *(LAS v2u*)(YT + t * 136 + v0 + 8 * q) = w; }
        }
        __syncthreads();
#pragma unroll
        for (int i = 0; i < 2; ++i) { const int idx = tid + 512 * i, row = idx >> 4, ch = idx & 15; *(v4u*)(F.Y + (size_t)(m0 + 64 * th + row) * DM + 1024 + h * 128 + ch * 8) = *(const LAS v4u*)(YT + row * 136 + ch * 8); }
        __syncthreads();
    }
}
__device__ __forceinline__ void r2_phase(const Frame& F, int c_lo, volatile LAS unsigned long long* tsl) {
#define R2_BH(id) ((id) >> CPS_SH)
#define R2_C(id) (c_lo + ((id) & (CPS - 1)))
    { RmA curA; RmB curB; RmH curH; int id = F.bid; r2m_loadA(F, id >> 7, id & 127, curA); r2m_loadH(F, id >> 7, id & 127, curH); r2m_loadB(F, id >> 7, id & 127, curB);
      for (; id < 8 * NCH2; id += F.G) { const int nid = (id + F.G < 8 * NCH2) ? id + F.G : id;
          RmA nxtA; RmB nxtB; RmH nxtH; r2m_unit(F, id >> 7, id & 127, curA, curB, curH, nid >> 7, nid & 127, nxtA, nxtB, nxtH); curA = nxtA; curB = nxtB; curH = nxtH; } }
    if (PROBE_TS >= 0 && F.tid == 0) tsl[8] = __builtin_amdgcn_s_memrealtime();
    { RhL cur; int id = F.bid; r2h_load(F, id >> 7, id & 127, cur);
      for (; id < 16 * NCH2; id += F.G) { const int nid = (id + F.G < 16 * NCH2) ? id + F.G : id;
          r2h_fill(F, cur); const float lbd0 = cur.lbd0, lbd1 = cur.lbd1;
          RhL nxt; r2h_load(F, nid >> 7, nid & 127, nxt);
          r2h_compute(F, id >> 7, id & 127, lbd0, lbd1); cur = nxt; } }
#undef R2_BH
#undef R2_C
}
__device__ __forceinline__ void final_norm(const Frame& F, float oscale) {
    int lane; asm volatile("v_mbcnt_lo_u32_b32 %0, -1, 0\n\tv_mbcnt_hi_u32_b32 %0, -1, %0" : "=v"(lane));
    const int gw = F.bid * NWAVES + F.wave, NGW = F.G * NWAVES;
    const int sub = lane >> 5, l8 = (lane & 31) * 8;
    for (int m = gw; m < M; m += NGW) {
        const size_t base = (((size_t)(m >> 8) * 8) << 16) + (size_t)(m & 255) * 256 + l8;
        float hv[4][8]; float ss = 0.f;
#pragma unroll
        for (int i = 0; i < 4; ++i) { const size_t off = base + ((size_t)(2 * i + sub) << 16); const v4u g = __builtin_nontemporal_load((const v4u*)(F.EB + off));
            hv[i][0] = blo(g.x); hv[i][1] = bhi(g.x); hv[i][2] = blo(g.y); hv[i][3] = bhi(g.y);
            hv[i][4] = blo(g.z); hv[i][5] = bhi(g.z); hv[i][6] = blo(g.w); hv[i][7] = bhi(g.w);
#pragma unroll
            for (int k = 0; k < 8; ++k) ss += hv[i][k] * hv[i][k]; }
        ss = wave_sum(ss);
        const float rstd = oscale / sqrtf(ss * (1.0f / DM) + EPS);
#pragma unroll
        for (int i = 0; i < 4; ++i) { const int col = (2 * i + sub) * 256 + l8; const f32x4 w0 = *(const f32x4*)(F.fin_nw + col), w1 = *(const f32x4*)(F.fin_nw + col + 4);
            float* o = F.out + (size_t)m * DM + col;
            __builtin_nontemporal_store((f32x4){hv[i][0] * rstd * w0[0], hv[i][1] * rstd * w0[1], hv[i][2] * rstd * w0[2], hv[i][3] * rstd * w0[3]}, (f32x4*)o);
            __builtin_nontemporal_store((f32x4){hv[i][4] * rstd * w1[0], hv[i][5] * rstd * w1[1], hv[i][6] * rstd * w1[2], hv[i][7] * rstd * w1[3]}, (f32x4*)(o + 4)); }
    }
}
struct Args { const float* in[16]; float* out; unsigned char* ws; int ph_lo, ph_hi, li, pad; };
__global__ void __launch_bounds__(NWAVES * 64, 2) hymba_fwd(Args args) {
    extern __shared__ __attribute__((aligned(16))) unsigned char lds[];
    Frame F;
    F.lds = (LAS unsigned char*)lds;
    F.tid = threadIdx.x; F.lane = F.tid & 63; F.wave = __builtin_amdgcn_readfirstlane(F.tid >> 6); F.G = gridDim.x; F.bid = blockIdx.x;
    unsigned char* ws = args.ws;
    gu32* ctl = (gu32*)(ws + WS_CTL);
    F.x = args.in[0]; F.p = args.in[1]; F.norm_w = args.in[2]; F.w_in = args.in[3]; F.conv_w = args.in[4]; F.conv_b = args.in[5]; F.b_i = args.in[6]; F.b_f = args.in[7];
    F.ml_nw = args.in[8]; F.hg_lb = args.in[9]; F.hg_nw = args.in[10]; F.w_out = args.in[11]; F.pe_nw = args.in[12]; F.w_pg = args.in[13]; F.w_pe = args.in[14]; F.fin_nw = args.in[15];
    F.out = args.out;
    F.Wt_in = (bf16*)(ws + WS_WIN); F.WoT = (bf16*)(ws + WS_WO); F.WgT = (bf16*)(ws + WS_WG); F.WeT = (bf16*)(ws + WS_WE); F.PB = (bf16*)(ws + WS_PB);
    F.U = (bf16*)(ws + WS_U); F.Y = (bf16*)(ws + WS_Y); F.PROJ = (bf16*)(ws + WS_PROJ); F.HB = (bf16*)(ws + WS_PROJ); F.EB = (bf16*)(ws + WS_PROJ + 128 * MiB); F.VT = (bf16*)(ws + WS_VT);
    F.Cm = (bf16*)args.out; F.Ch = (bf16*)args.out + (size_t)64 * MiB;
    F.gates = (float*)(ws + WS_GATES); F.bcum = (float*)(ws + WS_BCUM); F.msc = (float*)(ws + WS_MSC); F.nst = (float*)(ws + WS_NST); F.gdec = (float*)(ws + WS_GDEC); F.ebr = (float*)(ws + WS_EBR); F.carry = (float*)(ws + WS_CARRY);
    F.ssqh = (float*)(ws + WS_SSQH); F.ssq2 = (float*)(ws + WS_SSQ2); F.QC = (bf16*)(ws + WS_QC); F.KC = (bf16*)(ws + WS_KC); F.HQT = (bf16*)(ws + WS_HQT); F.HKT = (bf16*)(ws + WS_HKT); F.HQ2 = (bf16*)(ws + WS_HQ2);
    for (int u = F.tid; u < (LDS_BYTES - LDSCTL_OFF) / 4; u += NWAVES * 64) ((LAS unsigned*)(F.lds + LDSCTL_OFF))[u] = 0u;
    __syncthreads();
    XcdBarrier bar; bar.bar = (unsigned*)(ctl + CW_BAR); bar.x = 0; bar.st = nullptr;
    if (N_LAUNCHES != PER_PHASE) bar = xcd_barrier_post((unsigned*)(ctl + CW_BAR), (volatile LAS unsigned*)(F.lds + MISC_OFF) + 8);
#define GRID_BAR() do { if (N_LAUNCHES == PER_PHASE) { if (F.tid == 0) __hip_atomic_store(ctl + CW_TMO, 0xBADBA0u, RLX_AGENT); } else { xcd_barrier(bar); } } while (0)
    const int lo = args.ph_lo, hi = args.ph_hi;
#ifndef PROBE_TS
#define PROBE_TS (-1)
#endif
#ifndef PROBE_TB
#define PROBE_TB (PROBE_TS + 1)
#endif
    volatile LAS unsigned long long* tsl = (volatile LAS unsigned long long*)(F.lds + LDSCTL_OFF + 512);
#define STAMP(k) do { if (PROBE_TS >= 0 && F.tid == 0) tsl[k] = __builtin_amdgcn_s_memrealtime(); } while (0)
    STAMP(0);
#define IN(k) (lo <= (k) && (k) < hi)
#define BOTH(k) (IN(k) && IN((k) + 1))
#ifndef GEMM_ALIGN
#define GEMM_ALIGN true
#endif
#ifndef GEMM_SP2
#define GEMM_SP2 true
#endif
#ifndef PROBE_KIND
#define PROBE_KIND 0
#endif
#ifndef PROBE_DOUBLE
#define PROBE_DOUBLE 0
#endif
    if (IN(0)) { p0_prologue(F);
#if PROBE_DOUBLE & 1
        __syncthreads(); p0_prologue(F);
#endif
        if (BOTH(0)) { STAMP(17); GRID_BAR(); STAMP(1); } }
    int vcu = F.bid;
    if (N_LAUNCHES != PER_PHASE && lo == 0) { volatile LAS unsigned* st = (volatile LAS unsigned*)(F.lds + MISC_OFF) + 8; if (st[2] != 0u && F.G == 256) vcu = (int)(st[3] * 8u + bar.x); }
    if (IN(1)) {
#if PROBE_KIND == 10
        { pg8::Gemm g{F.U, F.Wt_in, M, NNAT, DM}; pg8::StaticOrder S; S.init(M, NNAT, F.G, vcu); pg8::EpiNull E;
          pg8::gemm_phase<pg8::EpiNull, pg8::StaticOrder, true, true, false, 0, false, false, true>(F.lds, g, S, E); }
#elif PROBE_KIND == 12
        { pg8::Gemm g{F.U, F.Wt_in, M, NNAT, DM}; pg8::StaticOrder S; S.init(M, NNAT, F.G, vcu); pg8::EpiNull E;
          pg8::gemm_phase<pg8::EpiNull, pg8::StaticOrder, true, true, false, 0, true, false, false, true>(F.lds, g, S, E); }
#elif PROBE_KIND == 13
        { f32x16 acc[8]; bf16x8 a, b;
#pragma unroll
          for (int i = 0; i < 8; ++i) acc[i] = zero16();
#pragma unroll
          for (int i = 0; i < 8; ++i) { a[i] = (short)(F.tid + i); b[i] = (short)(F.lane * 3 + i); }
          for (int it = 0; it < 12 * 32 * 8; ++it) {
#pragma unroll
              for (int i = 0; i < 8; ++i) acc[i] = mfma32(a, b, acc[i]);
          }
#pragma unroll
          for (int i = 0; i < 8; ++i) asm volatile("" :: "v"(acc[i])); }
#elif PROBE_KIND == 11
        { pg8::Gemm g{F.U, F.Wt_in, M, NNAT, DM}; pg8::StaticOrder S; S.init(M, NNAT, F.G, vcu); pg8::EpiNull E;
          pg8::gemm_phase<pg8::EpiNull, pg8::StaticOrder, true, true>(F.lds, g, S, E); }
#endif
#if PROBE_DOUBLE & 2
        { pg8::Gemm g{F.U, F.Wt_in, M, NNAT, DM}; pg8::StaticOrder S; S.init(M, NNAT, F.G, vcu);
          pg8::EpiProj E{F.PROJ, NNAT / 256, PC_OZ / 256, PC_OZ / 256 + 8, PC_HG / 256};
          pg8::gemm_phase<pg8::EpiProj, pg8::StaticOrder, GEMM_ALIGN, GEMM_SP2>(F.lds, g, S, E); }
        { pg8::Gemm g{F.Wt_in + (size_t)NNAT * DM, F.U, NTR, M, DM}; pg8::StaticOrder S; S.init(NTR, M, F.G, vcu);
          pg8::EpiBf16T E{F.VT, M / 256};
          pg8::gemm_phase<pg8::EpiBf16T, pg8::StaticOrder, GEMM_ALIGN, GEMM_SP2>(F.lds, g, S, E); }
#endif
        { pg8::Gemm g{F.U, F.Wt_in, M, NNAT, DM}; pg8::StaticOrder S; S.init(M, NNAT, F.G, vcu);
          pg8::EpiProj E{F.PROJ, NNAT / 256, PC_OZ / 256, PC_OZ / 256 + 8, PC_HG / 256};
          pg8::gemm_phase<pg8::EpiProj, pg8::StaticOrder, GEMM_ALIGN, GEMM_SP2>(F.lds, g, S, E); }
        { pg8::Gemm g{F.Wt_in + (size_t)NNAT * DM, F.U, NTR, M, DM}; pg8::StaticOrder S; S.init(NTR, M, F.G, vcu);
          pg8::EpiBf16TS E{F.VT, M / 256};
          pg8::gemm_phase<pg8::EpiBf16TS, pg8::StaticOrder, GEMM_ALIGN, GEMM_SP2>(F.lds, g, S, E); }
        if (BOTH(1)) { STAMP(14); GRID_BAR(); STAMP(2); }
    }
    if (N_LAUNCHES == PER_PHASE) {
        if (IN(2)) for (int sl = 0; sl < NSLAB; ++sl) pa_phase(F, sl * CPS, tsl);
        if (IN(3)) scan_phase(F, 0, NCH);
        if (IN(4)) for (int sl = 0; sl < NSLAB; ++sl) r2_phase(F, sl * CPS, tsl);
    } else if (IN(2)) {
        for (int sl = 0; sl < NSLAB; ++sl) {
            pa_phase(F, sl * CPS, tsl); STAMP(10); GRID_BAR(); STAMP(11);
            scan_phase(F, sl * CPS, (sl + 1) * CPS); STAMP(12); GRID_BAR(); STAMP(13);
            r2_phase(F, sl * CPS, tsl); if (sl + 1 < NSLAB) GRID_BAR();
        }
        STAMP(3); STAMP(4);
        GRID_BAR(); STAMP(5);
    }
    if (IN(5)) {
        { pg8::Gemm g{F.Y, F.WoT, M, DM, DM}; pg8::StaticOrder S; S.init(M, DM, F.G, vcu);
          pg8::EpiRes E{F.U, F.gates + (WS_RMS - WS_GATES) / 4, F.norm_w, F.HB, (unsigned char*)F.HB + HB8_OFF, F.ssqh, DM, DM / 256};
          pg8::gemm_phase<pg8::EpiRes, pg8::StaticOrder, GEMM_ALIGN, GEMM_SP2>(F.lds, g, S, E); }
        { pg8::Gemm g{F.PB, F.WeT, M, DM, PE}; pg8::StaticOrder S; S.init(M, DM, F.G, vcu);
          pg8::EpiBf16T E{F.EB, DM / 256};
          pg8::gemm_phase<pg8::EpiBf16T, pg8::StaticOrder, GEMM_ALIGN, GEMM_SP2>(F.lds, g, S, E); }
        if (BOTH(5)) { STAMP(15); GRID_BAR(); STAMP(6); }
    }
    if (IN(6)) {
        pg8::Gemm g{(const bf16*)((const unsigned char*)F.HB + HB8_OFF), F.WgT, M, DM, DM / 2}; pg8::StaticOrder S; S.init(M, DM, F.G, vcu);
        pg8::EpiGate E{F.EB, F.HB, F.ssqh, DM / 256, 1.0f / DM, EPS, 1.0f / (WG_SCALE * HB8_SCALE)};
        pg8::gemm_phase<pg8::EpiGate, pg8::StaticOrder, GEMM_ALIGN, GEMM_SP2, false, 0, false, 2, false, false, true>(F.lds, g, S, E);
        if (BOTH(6)) { STAMP(16); GRID_BAR(); STAMP(7); }
    }
    float oscale = 1.0f;
    if (PROBE_TS >= 0) { __syncthreads(); const float f = (float)(tsl[PROBE_TB] - tsl[PROBE_TS]) / (float)(tsl[7] - tsl[0]); oscale = 1.0f + sqrtf(fmaxf(f - PROBE_F0, 0.f) * 1e-3f); }
    if (IN(7)) final_norm(F, oscale);
#undef IN
#undef BOTH
}

#ifdef DBG_DUMP_AFTER
__global__ void dbg_dump(const unsigned char* wsb, float* out, int mode) {
    const unsigned short* a = (const unsigned short*)(wsb + (mode == 0 ? WS_PROJ : WS_U)); const unsigned short* b = (const unsigned short*)(wsb + WS_VT);
    size_t i = (size_t)blockIdx.x * blockDim.x + threadIdx.x;
    const size_t n = (size_t)M * DM;
    for (; i < n; i += (size_t)gridDim.x * blockDim.x) {
        float v;
        if (mode == 0) v = bf2f(a[3 * i]) + bf2f(a[3 * i + 1]) + bf2f(a[3 * i + 2]) + bf2f(b[i]);
        else v = bf2f(a[i]);
        out[i] = v;
    }
}
#endif
extern "C" void kernel_launch(void* const* d_in, const int* in_sizes, int n_in, void* d_out, int out_size, void* d_ws, size_t ws_size, hipStream_t stream) {
    static int grid = 0;
    if (grid == 0) {
        if (n_in != 16 || in_sizes[0] != M * DM || out_size != M * DM || ws_size < WS_END) { fprintf(stderr, "kernel_launch: unexpected shapes (n_in %d, in0 %d, out %d, ws %zu); nothing launched\n", n_in, n_in > 0 ? in_sizes[0] : -1, out_size, ws_size); grid = -1; return; }
        int dev = 0, cus = 0, per_cu = 0;
        if (hipGetDevice(&dev) != hipSuccess || hipDeviceGetAttribute(&cus, hipDeviceAttributeMultiprocessorCount, dev) != hipSuccess) { grid = -1; return; }
        if (hipFuncSetAttribute((const void*)hymba_fwd, hipFuncAttributeMaxDynamicSharedMemorySize, LDS_BYTES) != hipSuccess) { fprintf(stderr, "kernel_launch: hipFuncSetAttribute failed\n"); grid = -1; return; }
        if (hipOccupancyMaxActiveBlocksPerMultiprocessor(&per_cu, (const void*)hymba_fwd, NWAVES * 64, LDS_BYTES) != hipSuccess || per_cu < 1)
            fprintf(stderr, "kernel_launch: note: occupancy query reports %d workgroups per CU\n", per_cu);
        (void)hipGetLastError();
        grid = cus < 256 ? cus : 256;
        if (grid != 256) fprintf(stderr, "kernel_launch: %d CUs: this kernel is written for a 256-CU device; results will be wrong\n", cus);
    }
    if (grid < 0) return;
    if (hipMemsetAsync((char*)d_ws + WS_CTL, 0, CTL_ZERO_BYTES, stream) != hipSuccess) { fprintf(stderr, "kernel_launch: hipMemsetAsync failed\n"); return; }
    Args a{};
    for (int i = 0; i < 16; ++i) a.in[i] = (const float*)d_in[i];
    a.out = (float*)d_out; a.ws = (unsigned char*)d_ws;
    for (int li = 0; li < N_LAUNCHES; ++li) {
#ifdef DBG_DUMP_AFTER
        if (li > DBG_DUMP_AFTER) { if (DBG_DUMP_AFTER != 2 && DBG_DUMP_AFTER != 3) hipLaunchKernelGGL(dbg_dump, dim3(2048), dim3(256), 0, stream, (const unsigned char*)d_ws, (float*)d_out, DBG_DUMP_AFTER == 1 ? 0 : 1);
            break; }
#endif
        a.ph_lo = (N_LAUNCHES == PER_PHASE) ? li : 0; a.ph_hi = (N_LAUNCHES == PER_PHASE) ? li + 1 : PER_PHASE; a.li = li;
        hipLaunchKernelGGL(hymba_fwd, dim3(grid), dim3(NWAVES * 64), LDS_BYTES, stream, a);
        const hipError_t le = hipPeekAtLastError();
        if (le != hipSuccess) { fprintf(stderr, "kernel_launch: launch %d failed: %s\n", li, hipGetErrorName(le)); break; }
    }
}
```

```cpp
#include <hip/hip_runtime.h>
#include <cstdio>
#include <cstdint>
namespace pg8 {
#define PG8_LAS __attribute__((address_space(3)))
typedef unsigned short bf16_t;
typedef short bf16x8 __attribute__((ext_vector_type(8)));
typedef float f32x4 __attribute__((ext_vector_type(4)));
typedef unsigned u32x4 __attribute__((ext_vector_type(4)));
constexpr int BM = 256, BK = 64, HALF = 128, HTB = HALF * BK * 2  , STAGE_BYTES = 8 * HTB, NXCD = 8, WGM = 8;

__host__ __device__ __forceinline__ int lds_byte(int r, int c) { const int st = (r >> 4) * 2 + (c >> 5), rr = r & 15, cc = c & 31, ob = rr * 64 + cc * 2; return st * 1024 + (ob ^ (((ob >> 9) & 1) << 5)); }
__host__ __device__ __forceinline__ void stage_rc(int b, int& R, int& C) { const int st = b / 1024, sb = b % 1024, swz = sb ^ (((sb >> 9) & 1) << 5); R = (st >> 1) * 16 + swz / 64; C = (st & 1) * 32 + (swz % 64) / 2; }
__host__ __device__ __forceinline__ int perm32(int rho) { const int n = rho >> 4, i = rho & 15; return 8 * (i >> 2) + 4 * n + (i & 3); }

struct Unit { int pm, pn; };
struct Gemm { const bf16_t* A; const bf16_t* Bt; int M, N, K; };

struct StaticOrder {
    int nM, nN, nwg, G, c;
    __host__ __device__ void init(int M, int N, int G_, int c_) { nM = M / BM; nN = N / BM; nwg = nM * nN; G = G_; c = c_; }
    __host__ __device__ bool next(int i, Unit& u) const {
        const long L = (long)i * G + c; if (L >= nwg) return false;
        int wgid = (int)L; { const int q = nwg / NXCD, r = nwg % NXCD, xcd = wgid % NXCD, off = wgid / NXCD; wgid = (xcd < r ? xcd * (q + 1) : r * (q + 1) + (xcd - r) * q) + off; }
        const int nig = WGM * nN, gid = wgid / nig, fm = gid * WGM, gsz = (nM - fm) < WGM ? (nM - fm) : WGM;
        u.pm = fm + ((wgid % nig) % gsz); u.pn = (wgid % nig) / gsz; return true;
    }
    __device__ __forceinline__ void a_ready(const Unit&) const {}
    __device__ __forceinline__ void done(const Unit&) const {}
};

typedef unsigned u32x2 __attribute__((ext_vector_type(2)));
typedef int i32x4_ __attribute__((ext_vector_type(4)));
typedef int i32x8_ __attribute__((ext_vector_type(8)));
typedef long i64x2_ __attribute__((ext_vector_type(2)));
__device__ __forceinline__ i32x8_ cat8(bf16x8 a, bf16x8 b) { const i32x4_ x = __builtin_bit_cast(i32x4_, a), y = __builtin_bit_cast(i32x4_, b); return __builtin_shufflevector(x, y, 0, 1, 2, 3, 4, 5, 6, 7); }
__device__ __forceinline__ void mfma_fp8_inplace(f32x4& acc, i32x8_ a, i32x8_ b, int scale) {
    asm volatile("v_mfma_scale_f32_16x16x128_f8f6f4 %0, %1, %2, %0, %3, %3 op_sel_hi:[0,0,0]" : "+v"(acc) : "v"(a), "v"(b), "v"(scale));
}
__device__ __forceinline__ unsigned cvt_pk4_fp8(float a, float b, float c, float d) { int w = __builtin_amdgcn_cvt_pk_fp8_f32(a, b, 0, false); w = __builtin_amdgcn_cvt_pk_fp8_f32(c, d, w, true); return (unsigned)w; }
__device__ __forceinline__ unsigned cvt_pk_bf16(float lo, float hi) { unsigned r; asm volatile("v_cvt_pk_bf16_f32 %0, %1, %2" : "=v"(r) : "v"(lo), "v"(hi)); return r; }
typedef float f32x2 __attribute__((ext_vector_type(2)));
__device__ __forceinline__ f32x2 gelu_pk(f32x2 v) {
    const f32x2 av = __builtin_elementwise_abs(v), d = av * 0.2316418882f + 1.0f;
    f32x2 t; t.x = __builtin_amdgcn_rcpf(d.x); t.y = __builtin_amdgcn_rcpf(d.y);
    f32x2 q = t * 0.5307027145f + (-0.7265760135f); q = q * t + 0.7107068705f; q = q * t + (-0.142248368f); q = q * t + 0.127414796f; q = q * t;
    const f32x2 s = (v * v) * (-0.72134752044f);
    f32x2 e; e.x = __builtin_amdgcn_exp2f(s.x); e.y = __builtin_amdgcn_exp2f(s.y);
    const f32x2 m = v * (q * e), r = v - m;
    f32x2 o; o.x = v.x < 0.f ? m.x : r.x; o.y = v.y < 0.f ? m.y : r.y; return o;
}

template <int ACT  > struct EpiBf16 {
    static constexpr bool PERM = true, AFTER_DRAIN = false; static_assert(ACT == 0 || ACT == 1, "EpiBf16: ACT is 0 (none) or 1 (gelu_pk)");
    bf16_t* O; int ldc; const float* bias; int split_cols; size_t split_stride; float scale0;
    __device__ __forceinline__ void operator()(const f32x4 (&acc)[2][2][4][2], const Unit& u, int wr, int wc, int fr, int fq) const {
        const int row0 = u.pm * BM + wr * 64 + fr; int colt = u.pn * BM; bf16_t* base = O;
        float sc = 1.f; if (split_cols) { const int t = colt / split_cols; base += (size_t)t * split_stride; colt -= t * split_cols; if (t == 0) sc = scale0; }
        const int col0 = colt + wc * 32 + 8 * fq, bcol0 = u.pn * BM + wc * 32 + 8 * fq;
        f32x4 bv[2][2];
#pragma unroll
        for (int bj = 0; bj < 2; ++bj)
#pragma unroll
            for (int n = 0; n < 2; ++n) bv[bj][n] = bias ? *(const f32x4*)(bias + bcol0 + bj * HALF + 4 * n) : (f32x4){0.f, 0.f, 0.f, 0.f};
#pragma unroll
        for (int ai = 0; ai < 2; ++ai)
#pragma unroll
            for (int m = 0; m < 4; ++m) { bf16_t* rowp = base + (size_t)(row0 + ai * HALF + m * 16) * ldc + col0;
#pragma unroll
                for (int bj = 0; bj < 2; ++bj) { f32x4 v0 = acc[ai][bj][m][0] + bv[bj][0], v1 = acc[ai][bj][m][1] + bv[bj][1];
                    if (ACT == 1) { f32x2 a = gelu_pk((f32x2){v0[0], v0[1]}), b = gelu_pk((f32x2){v0[2], v0[3]}), c = gelu_pk((f32x2){v1[0], v1[1]}), d = gelu_pk((f32x2){v1[2], v1[3]});
                        v0 = (f32x4){a.x, a.y, b.x, b.y}; v1 = (f32x4){c.x, c.y, d.x, d.y}; }
                    v0 = v0 * sc; v1 = v1 * sc; u32x4 w; w.x = cvt_pk_bf16(v0[0], v0[1]); w.y = cvt_pk_bf16(v0[2], v0[3]); w.z = cvt_pk_bf16(v1[0], v1[1]); w.w = cvt_pk_bf16(v1[2], v1[3]);
                    __builtin_nontemporal_store(w, (u32x4*)(rowp + bj * HALF)); } }
    }
};
__device__ __forceinline__ float bf_lo(unsigned w) { return __uint_as_float(w << 16); }
__device__ __forceinline__ float bf_hi(unsigned w) { return __uint_as_float(w & 0xffff0000u); }
__device__ __forceinline__ float fast_sigmoid(float x) { return __builtin_amdgcn_rcpf(1.0f + __expf(-x)); }
struct EpiBf16T {
    static constexpr bool PERM = true, AFTER_DRAIN = false;
    bf16_t* O; int nN;
    __device__ __forceinline__ void operator()(const f32x4 (&acc)[2][2][4][2], const Unit& u, int wr, int wc, int fr, int fq) const {
        bf16_t* tile = O + (size_t)(u.pm * nN + u.pn) * 65536 + (wr * 64 + fr) * 256 + wc * 32 + 8 * fq;
#pragma unroll
        for (int ai = 0; ai < 2; ++ai)
#pragma unroll
            for (int m = 0; m < 4; ++m) { bf16_t* rowp = tile + (ai * HALF + m * 16) * 256;
#pragma unroll
                for (int bj = 0; bj < 2; ++bj) { const f32x4 v0 = acc[ai][bj][m][0], v1 = acc[ai][bj][m][1];
                    u32x4 w; w.x = cvt_pk_bf16(v0[0], v0[1]); w.y = cvt_pk_bf16(v0[2], v0[3]); w.z = cvt_pk_bf16(v1[0], v1[1]); w.w = cvt_pk_bf16(v1[2], v1[3]);
                    *(u32x4*)(rowp + bj * HALF) = w; } }
    }
};
struct EpiBf16TS {
    static constexpr bool PERM = true, AFTER_DRAIN = false;
    bf16_t* O; int nN;
    __device__ __forceinline__ void operator()(const f32x4 (&acc)[2][2][4][2], const Unit& u, int wr, int wc, int fr, int fq) const {
        bf16_t* tile = O + (size_t)(u.pm * nN + u.pn) * 65536 + (wr * 64 + fr) * 128 + wc * 32 + 8 * fq;
#pragma unroll
        for (int ai = 0; ai < 2; ++ai)
#pragma unroll
            for (int m = 0; m < 4; ++m) { bf16_t* rowp = tile + (ai * HALF + m * 16) * 128;
#pragma unroll
                for (int bj = 0; bj < 2; ++bj) { const f32x4 v0 = acc[ai][bj][m][0], v1 = acc[ai][bj][m][1];
                    u32x4 w; w.x = cvt_pk_bf16(v0[0], v0[1]); w.y = cvt_pk_bf16(v0[2], v0[3]); w.z = cvt_pk_bf16(v1[0], v1[1]); w.w = cvt_pk_bf16(v1[2], v1[3]);
                    *(u32x4*)(rowp + bj * 32768) = w; } }
    }
};
struct EpiProj {
    static constexpr bool PERM = true, AFTER_DRAIN = false;
    bf16_t* O; int nN, oz_lo, oz_hi, silu_lo;
    __device__ __forceinline__ void operator()(const f32x4 (&acc)[2][2][4][2], const Unit& u, int wr, int wc, int fr, int fq) const {
        bf16_t* tile = O + (size_t)(u.pm * nN + u.pn) * 65536 + (wr * 64 + fr) * 128 + wc * 32 + 8 * fq;
        if (u.pn >= oz_lo && u.pn < oz_hi) {
#pragma unroll
            for (int ai = 0; ai < 2; ++ai)
#pragma unroll
                for (int m = 0; m < 4; ++m) { float g[8];
#pragma unroll
                    for (int n = 0; n < 2; ++n)
#pragma unroll
                        for (int k = 0; k < 4; ++k) { const float o = acc[ai][0][m][n][k], z = acc[ai][1][m][n][k]; g[4 * n + k] = z * __builtin_amdgcn_rcpf((1.0f + __expf(-o)) * (1.0f + __expf(-z))); }
                    u32x4 w; w.x = cvt_pk_bf16(g[0], g[1]); w.y = cvt_pk_bf16(g[2], g[3]); w.z = cvt_pk_bf16(g[4], g[5]); w.w = cvt_pk_bf16(g[6], g[7]);
                    *(u32x4*)(tile + (ai * HALF + m * 16) * 128) = w; }
        } else if (u.pn >= silu_lo) {
#pragma unroll
            for (int ai = 0; ai < 2; ++ai)
#pragma unroll
                for (int m = 0; m < 4; ++m) { bf16_t* rowp = tile + (ai * HALF + m * 16) * 128;
#pragma unroll
                    for (int bj = 0; bj < 2; ++bj) { f32x4 v0 = acc[ai][bj][m][0], v1 = acc[ai][bj][m][1];
#pragma unroll
                        for (int k = 0; k < 4; ++k) { v0[k] = v0[k] * fast_sigmoid(v0[k]); v1[k] = v1[k] * fast_sigmoid(v1[k]); }
                        u32x4 w; w.x = cvt_pk_bf16(v0[0], v0[1]); w.y = cvt_pk_bf16(v0[2], v0[3]); w.z = cvt_pk_bf16(v1[0], v1[1]); w.w = cvt_pk_bf16(v1[2], v1[3]);
                        *(u32x4*)(rowp + bj * 32768) = w; } }
        } else {
#pragma unroll
            for (int ai = 0; ai < 2; ++ai)
#pragma unroll
                for (int m = 0; m < 4; ++m) { bf16_t* rowp = tile + (ai * HALF + m * 16) * 128;
#pragma unroll
                    for (int bj = 0; bj < 2; ++bj) { const f32x4 v0 = acc[ai][bj][m][0], v1 = acc[ai][bj][m][1];
                        u32x4 w; w.x = cvt_pk_bf16(v0[0], v0[1]); w.y = cvt_pk_bf16(v0[2], v0[3]); w.z = cvt_pk_bf16(v1[0], v1[1]); w.w = cvt_pk_bf16(v1[2], v1[3]);
                        *(u32x4*)(rowp + bj * 32768) = w; } }
        }
    }
};
struct EpiRes {
    static constexpr bool PERM = true, AFTER_DRAIN = false;
    const bf16_t* ub; const float* rms; const float* nw; bf16_t* hb; unsigned char* hb8; float* ssq; int ldc, nN;
    __device__ __forceinline__ void operator()(const f32x4 (&acc)[2][2][4][2], const Unit& u, int wr, int wc, int fr, int fq) const {
        const int row0 = u.pm * BM + wr * 64 + fr, col0 = u.pn * BM + wc * 32 + 8 * fq;
        const size_t toff = (size_t)(u.pm * nN + u.pn) * 65536 + (wr * 64 + fr) * 256 + wc * 32 + 8 * fq;
        f32x4 inw[2][2];
#pragma unroll
        for (int bj = 0; bj < 2; ++bj)
#pragma unroll
            for (int n = 0; n < 2; ++n) { const f32x4 w = *(const f32x4*)(nw + col0 + bj * HALF + 4 * n); inw[bj][n] = (f32x4){__builtin_amdgcn_rcpf(w[0]), __builtin_amdgcn_rcpf(w[1]), __builtin_amdgcn_rcpf(w[2]), __builtin_amdgcn_rcpf(w[3])}; }
#pragma unroll
        for (int ai = 0; ai < 2; ++ai) {
            u32x4 xv[4][2]; float rm[4];
#pragma unroll
            for (int m = 0; m < 4; ++m) { const size_t off = (size_t)(row0 + ai * HALF + m * 16) * ldc + col0; rm[m] = rms[row0 + ai * HALF + m * 16];
#pragma unroll
                for (int bj = 0; bj < 2; ++bj) xv[m][bj] = *(const u32x4*)(ub + off + bj * HALF); }
#pragma unroll
            for (int m = 0; m < 4; ++m) { const int row = row0 + ai * HALF + m * 16; const size_t to = toff + (ai * HALF + m * 16) * 256; float ss = 0.f;
#pragma unroll
                for (int bj = 0; bj < 2; ++bj) {
                    const u32x4 xw = xv[m][bj];
                    const f32x4 h0 = (f32x4){bf_lo(xw.x), bf_hi(xw.x), bf_lo(xw.y), bf_hi(xw.y)} * inw[bj][0] * rm[m] + acc[ai][bj][m][0], h1 = (f32x4){bf_lo(xw.z), bf_hi(xw.z), bf_lo(xw.w), bf_hi(xw.w)} * inw[bj][1] * rm[m] + acc[ai][bj][m][1];
                    ss += (h0[0] * h0[0] + h0[1] * h0[1]) + (h0[2] * h0[2] + h0[3] * h0[3]) + (h1[0] * h1[0] + h1[1] * h1[1]) + (h1[2] * h1[2] + h1[3] * h1[3]);
                    u32x4 w; w.x = cvt_pk_bf16(h0[0], h0[1]); w.y = cvt_pk_bf16(h0[2], h0[3]); w.z = cvt_pk_bf16(h1[0], h1[1]); w.w = cvt_pk_bf16(h1[2], h1[3]);
                    *(u32x4*)(hb + to + bj * HALF) = w;
                    u32x2 w8; w8.x = cvt_pk4_fp8(h0[0] * 16.0f, h0[1] * 16.0f, h0[2] * 16.0f, h0[3] * 16.0f); w8.y = cvt_pk4_fp8(h1[0] * 16.0f, h1[1] * 16.0f, h1[2] * 16.0f, h1[3] * 16.0f);
                    *(u32x2*)(hb8 + to + bj * HALF) = w8; }
                ss += __shfl_xor(ss, 16); ss += __shfl_xor(ss, 32);
                if (fq == 0) atomicAdd(ssq + row, ss); }
        }
    }
};
struct EpiGate {
    static constexpr bool PERM = true, AFTER_DRAIN = false;
    bf16_t* e; const bf16_t* hb; float* ssq_h; int nN; float inv_n, eps, ascale;
    __device__ __forceinline__ void operator()(const f32x4 (&acc)[2][2][4][2], const Unit& u, int wr, int wc, int fr, int fq) const {
        const int row0 = u.pm * BM + wr * 64 + fr;
        const size_t toff = (size_t)(u.pm * nN + u.pn) * 65536 + (wr * 64 + fr) * 256 + wc * 32 + 8 * fq;
#pragma unroll
        for (int ai = 0; ai < 2; ++ai) {
            u32x4 ev[4][2], hv[4][2]; float sq[4];
#pragma unroll
            for (int m = 0; m < 4; ++m) { const size_t to = toff + (ai * HALF + m * 16) * 256;
                sq[m] = __hip_atomic_load(ssq_h + row0 + ai * HALF + m * 16, __ATOMIC_RELAXED, __HIP_MEMORY_SCOPE_AGENT);
#pragma unroll
                for (int bj = 0; bj < 2; ++bj) { ev[m][bj] = *(const u32x4*)(e + to + bj * HALF); hv[m][bj] = *(const u32x4*)(hb + to + bj * HALF); } }
#pragma unroll
            for (int m = 0; m < 4; ++m) { const size_t to = toff + (ai * HALF + m * 16) * 256;
                const float rstd = __builtin_amdgcn_rsqf(sq[m] * inv_n + eps) * ascale;
#pragma unroll
                for (int bj = 0; bj < 2; ++bj) { const u32x4 v = ev[m][bj], h = hv[m][bj];
                    const f32x4 a0 = acc[ai][bj][m][0] * rstd, a1 = acc[ai][bj][m][1] * rstd;
                    u32x4 w;
                    w.x = cvt_pk_bf16(bf_lo(h.x) + fast_sigmoid(a0[0]) * bf_lo(v.x), bf_hi(h.x) + fast_sigmoid(a0[1]) * bf_hi(v.x)); w.y = cvt_pk_bf16(bf_lo(h.y) + fast_sigmoid(a0[2]) * bf_lo(v.y), bf_hi(h.y) + fast_sigmoid(a0[3]) * bf_hi(v.y));
                    w.z = cvt_pk_bf16(bf_lo(h.z) + fast_sigmoid(a1[0]) * bf_lo(v.z), bf_hi(h.z) + fast_sigmoid(a1[1]) * bf_hi(v.z)); w.w = cvt_pk_bf16(bf_lo(h.w) + fast_sigmoid(a1[2]) * bf_lo(v.w), bf_hi(h.w) + fast_sigmoid(a1[3]) * bf_hi(v.w));
                    *(u32x4*)(e + to + bj * HALF) = w; } }
        }
    }
};
struct EpiNull {
    static constexpr bool PERM = true, AFTER_DRAIN = false;
    __device__ __forceinline__ void operator()(const f32x4 (&acc)[2][2][4][2], const Unit& u, int wr, int wc, int fr, int fq) const {
#pragma unroll
        for (int ai = 0; ai < 2; ++ai)
#pragma unroll
            for (int bj = 0; bj < 2; ++bj)
#pragma unroll
                for (int m = 0; m < 4; ++m)
#pragma unroll
                    for (int n = 0; n < 2; ++n) asm volatile("" :: "v"(acc[ai][bj][m][n]));
    }
};
struct SameTileOrder {
    int c, n;
    __device__ bool next(int i, Unit& u) const { if (i >= n) return false; u.pm = c & 7; u.pn = i % 24; return true; }
    __device__ __forceinline__ void a_ready(const Unit&) const {}
    __device__ __forceinline__ void done(const Unit&) const {}
};
struct EpiScratch {
    static constexpr bool PERM = true, AFTER_DRAIN = false;
    bf16_t* O0; int per_unit;
    __device__ __forceinline__ void operator()(const f32x4 (&acc)[2][2][4][2], const Unit& u, int wr, int wc, int fr, int fq) const {
        bf16_t* O = O0 + (per_unit ? (size_t)(u.pm * 24 + u.pn) * 65536 : (size_t)0);
        const int row0 = wr * 64 + fr, col0 = wc * 32 + 8 * fq;
#pragma unroll
        for (int ai = 0; ai < 2; ++ai)
#pragma unroll
            for (int m = 0; m < 4; ++m) { bf16_t* rowp = O + (size_t)(row0 + ai * HALF + m * 16) * 256 + col0;
#pragma unroll
                for (int bj = 0; bj < 2; ++bj) { const f32x4 v0 = acc[ai][bj][m][0], v1 = acc[ai][bj][m][1];
                    u32x4 w; w.x = cvt_pk_bf16(v0[0], v0[1]); w.y = cvt_pk_bf16(v0[2], v0[3]); w.z = cvt_pk_bf16(v1[0], v1[1]); w.w = cvt_pk_bf16(v1[2], v1[3]);
                    *(u32x4*)(rowp + bj * HALF) = w; } }
    }
};
template <class Epi, class Sched, bool ALIGN_EPI = false, bool SP2 = false, bool PROBE_K0 = false, int PF = 0, bool NOSTAGE = false, int ABLK = 0, bool NOWAIT = false, bool NOREAD = false, bool FP8 = false>
__device__ __forceinline__ void gemm_phase(PG8_LAS unsigned char* lds, const Gemm g, const Sched& S, const Epi& E) {
    int tid_ = threadIdx.x; asm volatile("" : "+v"(tid_));
    const int tid = tid_, wid = __builtin_amdgcn_readfirstlane(tid >> 6), lane = tid & 63, wr = wid >> 2, wc = wid & 3, fr = lane & 15, fq = lane >> 4;
    const int K = g.K, nt = K / BK;
    unsigned voffA[2], voffB[2];
#pragma unroll
    for (int i = 0; i < 2; ++i) { int R, C; stage_rc(tid * 16 + i * 8192, R, C); const int Rb = Epi::PERM ? ((R & ~31) + perm32(R & 31)) : R;
        voffA[i] = (unsigned)(R * (ABLK == 2 ? 128 : ABLK == 1 ? 256 : K) + C) * 2u; voffB[i] = (unsigned)(Rb * K + C) * 2u; }
    const size_t kstep = PROBE_K0 ? (size_t)0 : (size_t)(BK * 2);
    const size_t hstepB = (size_t)HALF * K * 2, hstepA = ABLK == 2 ? (size_t)HALF * 256 : ABLK == 1 ? (size_t)HALF * 256 * 2 : hstepB;
    const size_t tstep = 2 * hstepB;
    static_assert(!(ABLK && PF > 0), "L2 warming is not written for the blocked A layout");
    const unsigned pfoff = (unsigned)((wid & 3) * 64 + lane) * (unsigned)K * 2u;
    const unsigned pflds = (unsigned)STAGE_BYTES + 1024u + (unsigned)wid * 256u;
    const unsigned ldsw = (unsigned)wid * 1024u;
    const int aoff = lds_byte(wr * 64 + fr, fq * 8), boff = lds_byte(wc * 32 + fr, fq * 8);
#define PG8_SA(b, h) (((b) * 2 + (h)) * HTB)
#define PG8_SB(b, h) ((4 + (b) * 2 + (h)) * HTB)
#define PG8_STAGE(bufoff, gbase, voff) do { if constexpr (!NOSTAGE) _Pragma("unroll") for (int _i = 0; _i < 2; ++_i) \
        __builtin_amdgcn_global_load_lds((const unsigned*)((const char*)(gbase) + (voff)[_i]), (PG8_LAS unsigned*)(lds + (bufoff) + ldsw + _i * 8192), 16, 0, 0); } while (0)
#define PG8_LDA(dst, b, h) do { if constexpr (!NOREAD) _Pragma("unroll") for (int m = 0; m < 4; ++m) _Pragma("unroll") for (int k = 0; k < 2; ++k) dst[m][k] = *(const PG8_LAS bf16x8*)(lds + PG8_SA(b, h) + aoff + m * 2048 + k * 1024); } while (0)
#define PG8_LDB(dst, b, h) do { if constexpr (!NOREAD) _Pragma("unroll") for (int n = 0; n < 2; ++n) _Pragma("unroll") for (int k = 0; k < 2; ++k) dst[n][k] = *(const PG8_LAS bf16x8*)(lds + PG8_SB(b, h) + boff + n * 2048 + k * 1024); } while (0)
#define PG8_MMA(ai, bj, At, Bt) do { __builtin_amdgcn_s_setprio(1); _Pragma("unroll") for (int m = 0; m < 4; ++m) _Pragma("unroll") for (int n = 0; n < 2; ++n) { \
        if constexpr (FP8 && FP8_MX) mfma_fp8_inplace(acc[ai][bj][m][n], cat8(Bt[n][0], Bt[n][1]), cat8(At[m][0], At[m][1]), one_scale); \
        else if constexpr (FP8) { _Pragma("unroll") for (int k = 0; k < 2; ++k) { const i64x2_ bb = __builtin_bit_cast(i64x2_, Bt[n][k]), aa = __builtin_bit_cast(i64x2_, At[m][k]); \
            acc[ai][bj][m][n] = __builtin_amdgcn_mfma_f32_16x16x32_fp8_fp8(bb[0], aa[0], acc[ai][bj][m][n], 0, 0, 0); acc[ai][bj][m][n] = __builtin_amdgcn_mfma_f32_16x16x32_fp8_fp8(bb[1], aa[1], acc[ai][bj][m][n], 0, 0, 0); } } \
        else { _Pragma("unroll") for (int k = 0; k < 2; ++k) acc[ai][bj][m][n] = __builtin_amdgcn_mfma_f32_16x16x32_bf16(Bt[n][k], At[m][k], acc[ai][bj][m][n], 0, 0, 0); } } __builtin_amdgcn_s_setprio(0); } while (0)
#define PG8_WAIT_V(n) asm volatile("s_waitcnt vmcnt(" #n ")" ::: "memory")
#define PG8_WARM(kt) do { if constexpr (PF > 0) { const int _kt = (kt); const char* _p = (wid < 4) ? ((_kt < nt) ? cA + (size_t)_kt * kstep : nA + (size_t)((_kt - nt) < nt ? (_kt - nt) : nt - 1) * kstep) : ((_kt < nt) ? cB + (size_t)_kt * kstep : nB + (size_t)((_kt - nt) < nt ? (_kt - nt) : nt - 1) * kstep); \
        __builtin_amdgcn_global_load_lds((const unsigned*)(_p + pfoff), (PG8_LAS unsigned*)(lds + pflds), 4, 0, 0); } } while (0)
#define PG8_WAIT_VK() do { if constexpr (NOWAIT) {} else if constexpr (PF > 0) PG8_WAIT_V(9); else PG8_WAIT_V(8); } while (0)
#define PG8_WAIT_L(n) asm volatile("s_waitcnt lgkmcnt(" #n ")" ::: "memory")
#define PG8_BAR __builtin_amdgcn_s_barrier()
#define PG8_SCHED __builtin_amdgcn_sched_barrier(0)
    constexpr bool FP8_MX = true;
    const int one_scale = 0x7f7f7f7f;
    Unit cur, nxt; int ui = 0;
    if (!S.next(0, cur)) return;
    f32x4 acc[2][2][4][2];
#pragma unroll
    for (int a = 0; a < 2; ++a)
#pragma unroll
        for (int b = 0; b < 2; ++b)
#pragma unroll
            for (int m = 0; m < 4; ++m)
#pragma unroll
                for (int n = 0; n < 2; ++n) acc[a][b][m][n] = (f32x4){0.f, 0.f, 0.f, 0.f};
    bf16x8 At[4][2], B0[2][2], B1[2][2];
    if constexpr (NOREAD) {
#pragma unroll
        for (int i = 0; i < 8; ++i) { const bf16x8 v = {(short)(0x3f80 + lane + i), (short)(0x3f00 + i), (short)(0xbf80 + lane), (short)0x3e80, (short)(0x3f80 + i), (short)0xbf00, (short)(0x3f81 + lane), (short)0x3f00}; At[i & 3][i >> 2] = v; if (i < 4) { B0[i & 1][i >> 1] = v; B1[i & 1][i >> 1] = v; } }
    }
    const char* cA = (const char*)g.A + (size_t)cur.pm * tstep; const char* cB = (const char*)g.Bt + (size_t)cur.pn * tstep;
    S.a_ready(cur);
    if constexpr (SP2) {
        PG8_STAGE(PG8_SB(0, 0), cB, voffB); PG8_STAGE(PG8_SB(0, 1), cB + hstepB, voffB); PG8_STAGE(PG8_SA(0, 0), cA, voffA); PG8_STAGE(PG8_SA(0, 1), cA + hstepA, voffA);
        if (wr == 1) PG8_BAR;
        PG8_WAIT_V(2); PG8_BAR;
        PG8_STAGE(PG8_SB(1, 0), cB + kstep, voffB); PG8_STAGE(PG8_SA(1, 0), cA + kstep, voffA); PG8_STAGE(PG8_SB(1, 1), cB + hstepB + kstep, voffB);
        PG8_WAIT_V(6); PG8_BAR;
    } else {
        PG8_STAGE(PG8_SB(0, 0), cB, voffB); PG8_STAGE(PG8_SA(0, 0), cA, voffA); PG8_STAGE(PG8_SB(0, 1), cB + hstepB, voffB); PG8_STAGE(PG8_SA(0, 1), cA + hstepA, voffA);
        if (wr == 1) PG8_BAR;
        PG8_WAIT_V(4); PG8_BAR;
        PG8_STAGE(PG8_SB(1, 0), cB + kstep, voffB); PG8_STAGE(PG8_SA(1, 0), cA + kstep, voffA); PG8_STAGE(PG8_SB(1, 1), cB + hstepB + kstep, voffB);
        PG8_WAIT_V(6); PG8_BAR;
    }
    for (;;) {
        const bool has_next = S.next(ui + 1, nxt);
        const char* nA = has_next ? (const char*)g.A + (size_t)nxt.pm * tstep : cA; const char* nB = has_next ? (const char*)g.Bt + (size_t)nxt.pn * tstep : cB;
        for (int t = 0; t < nt; t += 2) {
            const bool last = (t == nt - 2);
            const char* a1 = cA + (ABLK == 2 ? (size_t)((t + 1) >> 1) * 65536 + (size_t)((t + 1) & 1) * 128 : ABLK == 1 ? (size_t)((t + 1) >> 2) * 131072 + (size_t)((t + 1) & 3) * 128 : (size_t)(t + 1) * kstep);
            const char* a2 = last ? nA : cA + (ABLK == 2 ? (size_t)((t + 2) >> 1) * 65536 + (size_t)((t + 2) & 1) * 128 : ABLK == 1 ? (size_t)((t + 2) >> 2) * 131072 + (size_t)((t + 2) & 3) * 128 : (size_t)(t + 2) * kstep); const char* b2 = last ? nB : cB + (size_t)(t + 2) * kstep;
            const char* a3 = a2 + kstep; const char* b3 = b2 + kstep;
            if (last && has_next) S.a_ready(nxt);
            if constexpr (SP2) {
            PG8_LDB(B0, 0, 0); PG8_LDB(B1, 0, 1); PG8_SCHED; PG8_LDA(At, 0, 0); PG8_STAGE(PG8_SA(1, 1), a1 + hstepA, voffA); PG8_WARM(t + 2 + PF);
            PG8_WAIT_VK(); PG8_WAIT_L(0); PG8_BAR; PG8_MMA(0, 0, At, B0); PG8_MMA(0, 1, At, B1); PG8_BAR; PG8_SCHED;
            PG8_LDA(At, 0, 1); PG8_STAGE(PG8_SB(0, 0), b2, voffB); PG8_STAGE(PG8_SB(0, 1), b2 + hstepB, voffB); PG8_STAGE(PG8_SA(0, 0), a2, voffA);
            PG8_WAIT_VK(); PG8_WAIT_L(0); PG8_BAR; PG8_MMA(1, 0, At, B0); PG8_MMA(1, 1, At, B1); PG8_BAR; PG8_SCHED;
            PG8_LDB(B0, 1, 0); PG8_LDB(B1, 1, 1); PG8_SCHED; PG8_LDA(At, 1, 0); PG8_STAGE(PG8_SA(0, 1), a2 + hstepA, voffA); PG8_WARM(t + 3 + PF);
            PG8_WAIT_VK(); PG8_WAIT_L(0); PG8_BAR; PG8_MMA(0, 0, At, B0); PG8_MMA(0, 1, At, B1); PG8_BAR; PG8_SCHED;
            PG8_LDA(At, 1, 1); PG8_STAGE(PG8_SB(1, 0), b3, voffB); PG8_STAGE(PG8_SB(1, 1), b3 + hstepB, voffB); PG8_STAGE(PG8_SA(1, 0), a3, voffA);
            PG8_WAIT_VK(); PG8_WAIT_L(0); PG8_BAR; PG8_MMA(1, 0, At, B0); PG8_MMA(1, 1, At, B1); PG8_BAR; PG8_SCHED;
            } else {
            PG8_LDB(B0, 0, 0); PG8_SCHED; PG8_LDA(At, 0, 0); PG8_STAGE(PG8_SA(1, 1), a1 + hstepA, voffA);
            PG8_WAIT_L(8); PG8_BAR; PG8_WAIT_L(0); PG8_MMA(0, 0, At, B0); PG8_BAR; PG8_SCHED;
            PG8_LDB(B1, 0, 1); PG8_STAGE(PG8_SB(0, 0), b2, voffB);
            PG8_BAR; PG8_WAIT_L(0); PG8_MMA(0, 1, At, B1); PG8_BAR;
            PG8_LDA(At, 0, 1); PG8_STAGE(PG8_SA(0, 0), a2, voffA);
            PG8_BAR; PG8_WAIT_L(0); PG8_MMA(1, 0, At, B0); PG8_BAR; PG8_SCHED;
            PG8_STAGE(PG8_SB(0, 1), b2 + hstepB, voffB);
            PG8_WAIT_V(6); PG8_BAR; PG8_MMA(1, 1, At, B1); PG8_BAR;
            PG8_LDB(B0, 1, 0); PG8_SCHED; PG8_LDA(At, 1, 0); PG8_STAGE(PG8_SA(0, 1), a2 + hstepA, voffA);
            PG8_WAIT_L(8); PG8_BAR; PG8_WAIT_L(0); PG8_MMA(0, 0, At, B0); PG8_BAR; PG8_SCHED;
            PG8_LDB(B1, 1, 1); PG8_STAGE(PG8_SB(1, 0), b3, voffB);
            PG8_BAR; PG8_WAIT_L(0); PG8_MMA(0, 1, At, B1); PG8_BAR;
            PG8_LDA(At, 1, 1); PG8_STAGE(PG8_SA(1, 0), a3, voffA);
            PG8_BAR; PG8_WAIT_L(0); PG8_MMA(1, 0, At, B0); PG8_BAR; PG8_SCHED;
            PG8_STAGE(PG8_SB(1, 1), b3 + hstepB, voffB);
            PG8_WAIT_V(6); PG8_BAR; PG8_MMA(1, 1, At, B1); PG8_BAR;
            }
        }
        if constexpr (FP8 && FP8_MX) asm volatile("s_nop 15\n\ts_nop 15" ::: "memory");
        if constexpr (ALIGN_EPI) { if (wr == 0) PG8_BAR; }
        if constexpr (!Epi::AFTER_DRAIN) {
            int le; asm volatile("v_mbcnt_lo_u32_b32 %0, -1, 0\n\tv_mbcnt_hi_u32_b32 %0, -1, %0" : "=v"(le));
            E(acc, cur, wr, wc, le & 15, le >> 4); S.done(cur); }
        if (!has_next) break;
#pragma unroll
        for (int a = 0; a < 2; ++a)
#pragma unroll
            for (int b = 0; b < 2; ++b)
#pragma unroll
                for (int m = 0; m < 4; ++m)
#pragma unroll
                    for (int n = 0; n < 2; ++n) acc[a][b][m][n] = (f32x4){0.f, 0.f, 0.f, 0.f};
        cur = nxt; cA = nA; cB = nB; ++ui;
        if constexpr (ALIGN_EPI) { if (wr == 1) PG8_BAR; }
    }
    PG8_WAIT_V(0);
    if constexpr (!ALIGN_EPI) { if (wr == 0) PG8_BAR; }
    PG8_BAR;
    if constexpr (Epi::AFTER_DRAIN) { E.fused(acc, cur, wr, wc, fr, fq, lds, wid, lane); S.done(cur); }
#undef PG8_SA
#undef PG8_SB
#undef PG8_STAGE
#undef PG8_LDA
#undef PG8_LDB
#undef PG8_MMA
#undef PG8_WAIT_V
#undef PG8_WARM
#undef PG8_WAIT_VK
#undef PG8_WAIT_L
#undef PG8_BAR
#undef PG8_SCHED
}
}
constexpr int NWAVES = 8, NTHR = 512;
#ifndef MK_N_LAUNCHES
#define MK_N_LAUNCHES 1
#define PROBE_DOUBLE 0
#define PROBE_KIND 0
#define PROBE_TS (-1)
#define PROBE_TB (PROBE_TS + 1)
#define PROBE_P7W 0
constexpr bool P7_NTL = false, P7_NTS = true, P7_PF = false;
#define PROBE_F0 0.0f
#endif
constexpr int N_LAUNCHES = MK_N_LAUNCHES;
constexpr int PER_PHASE = 8;
constexpr int BATCH = 2, SEQ = 16384, DM = 2048, M = BATCH * SEQ, NCH = SEQ / 64;
constexpr int IN_COLS = 8200, PE = 256, NNAT = 6144, NTR = 2048;
constexpr float EPS = 1e-6f;
constexpr int PC_Q = 0, PC_K = 512, PC_OZ = 1024  , PC_HQ = 3072, PC_HF = 4096, PC_HG = 5120;
constexpr size_t MiB = 1u << 20;
constexpr size_t WS_CTL = 0, CTL_ZERO_BYTES = 1 * MiB;
constexpr size_t WS_SSQH = 256 * 1024, WS_SSQ2 = 512 * 1024;
constexpr size_t WS_WIN = 2 * MiB, WS_WO = 34 * MiB, WS_WG = 42 * MiB, WS_WE = 50 * MiB;
constexpr size_t WS_GATES = 52 * MiB;
constexpr size_t WS_BCUM = 53 * MiB;
constexpr size_t WS_MSC = 54 * MiB;
constexpr size_t WS_NST = 55 * MiB;
constexpr size_t WS_GDEC = 56 * MiB;
constexpr size_t WS_EBR = 58 * MiB;
constexpr size_t WS_CARRY = 976 * MiB;
constexpr size_t WS_RMS = 59 * MiB;
constexpr size_t WS_Y = 784 * MiB;
constexpr size_t WS_PB = 64 * MiB;
constexpr size_t WS_U = 80 * MiB;
constexpr size_t WS_PROJ = 208 * MiB;
constexpr size_t WS_VT = 592 * MiB;
constexpr size_t WS_QC = 720 * MiB, WS_KC = 752 * MiB;
constexpr size_t WS_HQT = 784 * MiB, WS_HKT = 848 * MiB, WS_HQ2 = 912 * MiB;
constexpr size_t WS_END = 984 * MiB;
constexpr int CW_TMO = 0, CW_BAR = 4096;
constexpr int RING_BYTES = 131072, LDSCTL_OFF = RING_BYTES, MISC_OFF = LDSCTL_OFF + 320, LDS_BYTES = 147456;

#define GAS __attribute__((address_space(1)))
#define LAS __attribute__((address_space(3)))
typedef unsigned short bf16;
typedef unsigned v4u __attribute__((ext_vector_type(4)));
typedef unsigned v2u __attribute__((ext_vector_type(2)));
typedef float f32x4 __attribute__((ext_vector_type(4)));
typedef float v2f __attribute__((ext_vector_type(2)));
typedef float f32x16 __attribute__((ext_vector_type(16)));
typedef short bf16x8 __attribute__((ext_vector_type(8)));
typedef GAS unsigned gu32;
#define RLX_AGENT __ATOMIC_RELAXED, __HIP_MEMORY_SCOPE_AGENT
#define LDS_WAIT() asm volatile("s_waitcnt lgkmcnt(0)" ::: "memory")
#define VM_WAIT() asm volatile("s_waitcnt vmcnt(0)" ::: "memory")
typedef __bf16 bf16x2_t __attribute__((ext_vector_type(2)));
__device__ __forceinline__ unsigned pk2(float lo, float hi) { bf16x2_t v; v[0] = (__bf16)lo; v[1] = (__bf16)hi; return __builtin_bit_cast(unsigned, v); }
__device__ __forceinline__ float bf2f(bf16 v) { return __uint_as_float((unsigned)v << 16); }
__device__ __forceinline__ float blo(unsigned w) { return __uint_as_float(w << 16); }
__device__ __forceinline__ float bhi(unsigned w) { return __uint_as_float(w & 0xffff0000u); }
__device__ __forceinline__ float frcp(float x) { return __builtin_amdgcn_rcpf(x); }
__device__ __forceinline__ float frsq(float x) { return __builtin_amdgcn_rsqf(x); }
__device__ __forceinline__ float fexp(float x) { return __expf(x); }
__device__ __forceinline__ float flog(float x) { return __logf(x); }
__device__ __forceinline__ float sigm(float x) { return frcp(1.0f + __expf(-x)); }

#define XB_TMO      128
#define XB_XCNT(j)  (256  + 64 * (j))
#define XB_XSUB(j)  (1280 + 64 * (j))
#define XB_XGEN(j)  (2304 + 64 * (j))
#define XB_TOP      3328
#define XB_TOPGEN   3392
#define XCD_BAR_WORDS 3456
#define XB_SPIN_CAP (1u << 18)
__device__ __forceinline__ unsigned xb_ld(unsigned* p)              { return __hip_atomic_load(p, __ATOMIC_RELAXED, __HIP_MEMORY_SCOPE_AGENT); }
__device__ __forceinline__ unsigned xb_add(unsigned* p, unsigned v) { return __hip_atomic_fetch_add(p, v, __ATOMIC_RELAXED, __HIP_MEMORY_SCOPE_AGENT); }
__device__ __forceinline__ unsigned xb_xcc_id() { return (unsigned)__builtin_amdgcn_s_getreg((3 << 11) | 20) & 0xFu; }
#define XB_SPIN(cond, bar) do { unsigned _sp = 0; while (cond) { __builtin_amdgcn_s_sleep(1); \
    if ((++_sp & 255u) == 0u) { if (xb_ld(&(bar)[XB_TMO])) break; if (_sp > XB_SPIN_CAP) { atomicAdd(&(bar)[XB_TMO], 1u); break; } } } } while (0)
struct XcdBarrier { unsigned* bar; unsigned x; volatile LAS unsigned* st; };
__device__ __forceinline__ XcdBarrier xcd_barrier_post(unsigned* bar, volatile LAS unsigned* st) {
    XcdBarrier b; b.bar = bar; b.x = xb_xcc_id(); b.st = st;
    if (threadIdx.x == 0) st[3] = xb_add(&bar[XB_XCNT(b.x)], 1u);
    return b;
}
__device__ __forceinline__ void xcd_barrier_complete(unsigned* bar, unsigned x, unsigned& nloc, unsigned& nx, unsigned& even) {
    const unsigned G = gridDim.x * gridDim.y * gridDim.z;
    unsigned sum, cnt, mine, sp = 0u, ev;
    for (;;) {
        sum = 0u; cnt = 0u; mine = 0u; ev = 1u;
#pragma unroll
        for (unsigned j = 0; j < 16; ++j) { const unsigned c = xb_ld(&bar[XB_XCNT(j)]); sum += c; cnt += (c > 0u) ? 1u : 0u; mine = (j == x) ? c : mine; ev &= (j < 8u) ? (c * 8u == G ? 1u : 0u) : (c == 0u ? 1u : 0u); }
        if (sum == G) break;
        __builtin_amdgcn_s_sleep(1);
        if ((++sp & 255u) == 0u) { if (xb_ld(&bar[XB_TMO])) break; if (sp > XB_SPIN_CAP) { atomicAdd(&bar[XB_TMO], 1u); break; } }
    }
    nloc = mine > 0u ? mine : 1u; nx = cnt > 0u ? cnt : 1u; even = (sum == G) ? ev : 0u;
}
__device__ __forceinline__ void xcd_barrier(const XcdBarrier& b) {
    asm volatile("s_waitcnt vmcnt(0)" ::: "memory");
    __syncthreads();
    if (threadIdx.x == 0) {
        unsigned* bar = b.bar;
        __builtin_amdgcn_s_waitcnt(0);
        unsigned nloc = b.st[0], nx = b.st[1];
        if (nloc == 0u) { unsigned even; xcd_barrier_complete(bar, b.x, nloc, nx, even); b.st[0] = nloc; b.st[1] = nx; b.st[2] = even; }
        const unsigned old = xb_add(&bar[XB_XSUB(b.x)], 1u);
        const unsigned gen = old / nloc;
        if (old + 1u == (gen + 1u) * nloc) {
            __builtin_amdgcn_fence(__ATOMIC_RELEASE, "agent");
            asm volatile("s_waitcnt vmcnt(0)" ::: "memory");
            const unsigned og = xb_add(&bar[XB_TOP], 1u);
            const unsigned tg = og / nx;
            if (og + 1u == (tg + 1u) * nx) xb_add(&bar[XB_TOPGEN], 1u);
            else XB_SPIN(xb_ld(&bar[XB_TOPGEN]) == tg, bar);
            __builtin_amdgcn_fence(__ATOMIC_ACQUIRE, "agent");
            asm volatile("s_waitcnt vmcnt(0)" ::: "memory");
        } else {
            XB_SPIN(xb_ld(&bar[XB_TOPGEN]) == gen, bar);
            __builtin_amdgcn_fence(__ATOMIC_ACQUIRE, "agent");
            asm volatile("s_waitcnt vmcnt(0)" ::: "memory");
        }
    }
    __syncthreads();
}

struct Frame {
    LAS unsigned char* lds;
    int tid, lane, wave, G, bid;
    const float *x, *p, *norm_w, *w_in, *conv_w, *conv_b, *b_i, *b_f, *ml_nw, *hg_lb, *hg_nw, *w_out, *pe_nw, *w_pg, *w_pe, *fin_nw;
    float* out;
    bf16 *Wt_in, *WoT, *WgT, *WeT, *PB, *U, *Y, *PROJ, *HB, *EB, *VT, *Cm, *Ch, *QC, *KC, *HQT, *HKT, *HQ2;
    float *gates, *bcum, *msc, *nst, *gdec, *ebr, *carry, *ssqh, *ssq2;
};
__device__ __forceinline__ size_t proj_off(int m, int n) { return ((size_t)((m >> 8) * 24 + (n >> 8)) << 16) + (size_t)(((n & 128) << 8) + (m & 255) * 128 + (n & 127)); }
__device__ __forceinline__ size_t vt_off(int v, int m) { return ((size_t)((v >> 8) * 128 + (m >> 8)) << 16) + (size_t)(((m & 128) << 8) + (v & 255) * 128 + (m & 127)); }
__device__ __forceinline__ float wave_sum(float v) {
#pragma unroll
    for (int o = 1; o < 64; o <<= 1) v += __shfl_xor(v, o);
    return v;
}
__device__ __forceinline__ float wave_max(float v) {
#pragma unroll
    for (int o = 1; o < 64; o <<= 1) v = fmaxf(v, __shfl_xor(v, o));
    return v;
}
__device__ __forceinline__ float wave_scan_sum(float v, int lane) {
#pragma unroll
    for (int o = 1; o < 64; o <<= 1) { const float y = __shfl_up(v, o); if (lane >= o) v += y; }
    return v;
}
__device__ __forceinline__ float wave_scan_max(float v, int lane) {
#pragma unroll
    for (int o = 1; o < 64; o <<= 1) { const float y = __shfl_up(v, o); if (lane >= o) v = fmaxf(v, y); }
    return v;
}
__device__ __forceinline__ int opaque_i(int v) { asm volatile("" : "+v"(v)); return v; }
__device__ __forceinline__ f32x16 mfma32(bf16x8 a, bf16x8 b, f32x16 c) { return __builtin_amdgcn_mfma_f32_32x32x16_bf16(a, b, c, 0, 0, 0); }
__device__ __forceinline__ f32x16 zero16() { f32x16 z;
#pragma unroll
    for (int i = 0; i < 16; ++i) z[i] = 0.f;
    return z; }

constexpr float WG_SCALE = 256.0f, HB8_SCALE = 16.0f;
constexpr size_t HB8_OFF = 256 * MiB;
__device__ __forceinline__ void p0_transpose_item(const float* W, int ldw, int src_col, int K, bf16* WT, int dst_row, const float* kscale, LAS float* scr, int k0, int lane) {
#pragma unroll 8
    for (int i = 0; i < 32; ++i) { const int kk = 2 * i + (lane >> 5); float v = W[(size_t)(k0 + kk) * ldw + src_col + (lane & 31)]; if (kscale) v *= kscale[k0 + kk]; scr[kk * 33 + (lane & 31)] = v; }
    LDS_WAIT(); asm volatile("" ::: "memory");
    const int c = lane & 7;
#pragma unroll
    for (int j = 0; j < 4; ++j) { const int n = (lane >> 3) + 8 * j; const LAS float* s = scr + (8 * c) * 33 + n;
        v4u o; o.x = pk2(s[0 * 33], s[1 * 33]); o.y = pk2(s[2 * 33], s[3 * 33]); o.z = pk2(s[4 * 33], s[5 * 33]); o.w = pk2(s[6 * 33], s[7 * 33]);
        *(v4u*)(WT + (size_t)(dst_row + n) * K + k0 + 8 * c) = o; }
    LDS_WAIT(); asm volatile("" ::: "memory");
}
__device__ __forceinline__ void p0_transpose_item_fp8(const float* W, int ldw, int src_col, int K, unsigned char* WT, int dst_row, const float* kscale, float scale, LAS float* scr, int k0, int lane) {
#pragma unroll 8
    for (int i = 0; i < 32; ++i) { const int kk = 2 * i + (lane >> 5); const float v = W[(size_t)(k0 + kk) * ldw + src_col + (lane & 31)] * (kscale[k0 + kk] * scale); scr[kk * 33 + (lane & 31)] = v; }
    LDS_WAIT(); asm volatile("" ::: "memory");
    const int c = lane & 7;
#pragma unroll
    for (int j = 0; j < 4; ++j) { const int n = (lane >> 3) + 8 * j; const LAS float* s = scr + (8 * c) * 33 + n;
        v2u o; o.x = pg8::cvt_pk4_fp8(s[0 * 33], s[1 * 33], s[2 * 33], s[3 * 33]); o.y = pg8::cvt_pk4_fp8(s[4 * 33], s[5 * 33], s[6 * 33], s[7 * 33]);
        *(v2u*)(WT + (size_t)(dst_row + n) * K + k0 + 8 * c) = o; }
    LDS_WAIT(); asm volatile("" ::: "memory");
}
__device__ __forceinline__ int win_src_col(int r) { if (r >= 1024 && r < 3072) { const int q = r - 1024, i = q >> 8, rr = q & 255; return rr < 128 ? 2048 + 128 * i + rr : 3072 + 128 * i + (rr - 128); }
    return r < 1024 ? r : r < 5120 ? r + 1032 : r < 6144 ? r + 2056 : r < 7168 ? r - 5120 : r - 1016; }
__device__ __forceinline__ void p0_prologue(const Frame& F) {
    LAS float* scr = (LAS float*)(F.lds + F.wave * 16384);
    const int gw = F.bid * NWAVES + F.wave, NGW = F.G * NWAVES, lane = F.lane;
    for (int it = gw; it < 12544; it += NGW) {
        int r = it;
        if (r < 8192) { const int kb = r >> 8, nb = r & 255; p0_transpose_item(F.w_in, IN_COLS, win_src_col(nb * 32), DM, F.Wt_in, nb * 32, nullptr, scr, kb * 64, lane); continue; } r -= 8192;
        if (r < 2048) { const int kb = r >> 6, nb = r & 63; p0_transpose_item(F.w_out, DM, nb * 32, DM, F.WoT, nb * 32, nullptr, scr, kb * 64, lane); continue; } r -= 2048;
        if (r < 2048) { const int kb = r >> 6, nb = r & 63; p0_transpose_item_fp8(F.w_pg, DM, nb * 32, DM, (unsigned char*)F.WgT, nb * 32, F.pe_nw, WG_SCALE, scr, kb * 64, lane); continue; } r -= 2048;
        { const int kb = r >> 6, nb = r & 63; p0_transpose_item(F.w_pe, DM, nb * 32, PE, F.WeT, nb * 32, nullptr, scr, kb * 64, lane); }
    }
    for (int idx = F.bid * NTHR + F.tid; idx < M * PE / 4; idx += F.G * NTHR) { const f32x4 v = ((const f32x4*)F.p)[idx]; v2u o; o.x = pk2(v[0], v[1]); o.y = pk2(v[2], v[3]); ((v2u*)F.PB)[idx] = o; }
    __syncthreads();
    LAS float* Wg = (LAS float*)F.lds;
    for (int k = F.tid; k < DM; k += NTHR) { const f32x4 a = *(const f32x4*)(F.w_in + (size_t)k * IN_COLS + 4096), b = *(const f32x4*)(F.w_in + (size_t)k * IN_COLS + 4100);
        Wg[0 * DM + k] = a[0]; Wg[1 * DM + k] = a[1]; Wg[2 * DM + k] = a[2]; Wg[3 * DM + k] = a[3]; Wg[4 * DM + k] = b[0]; Wg[5 * DM + k] = b[1]; Wg[6 * DM + k] = b[2]; Wg[7 * DM + k] = b[3]; }
    __syncthreads();
    const f32x4* nwp = (const f32x4*)F.norm_w + lane;
    const float gbias = lane < 4 ? F.b_i[lane & 3] : F.b_f[lane & 3];
    for (int m = gw; m < M; m += NGW) {
        asm volatile("" ::: "memory");
        const f32x4* xr = (const f32x4*)(F.x + (size_t)m * DM) + lane;
        f32x4 t[8]; float ss = 0.f; float ga[8];
#pragma unroll
        for (int c = 0; c < 8; ++c) ga[c] = 0.f;
#pragma unroll
        for (int j = 0; j < 8; ++j) { const f32x4 v = __builtin_nontemporal_load(xr + 64 * j); ss += (v[0] * v[0] + v[1] * v[1]) + (v[2] * v[2] + v[3] * v[3]); t[j] = v * nwp[64 * j]; }
#pragma unroll
        for (int j = 0; j < 8; ++j)
#pragma unroll
            for (int c = 0; c < 8; ++c) { const f32x4 w = *(const LAS f32x4*)(Wg + c * DM + 4 * lane + 256 * j); ga[c] += (t[j][0] * w[0] + t[j][1] * w[1]) + (t[j][2] * w[2] + t[j][3] * w[3]); }
        ss = wave_sum(ss); const float rstd = 1.0f / sqrtf(ss * (1.0f / DM) + EPS);
#pragma unroll
        for (int c = 0; c < 8; ++c) ga[c] = wave_sum(ga[c]) * rstd;
        v2u* uo = (v2u*)(F.U + (size_t)m * DM) + lane;
#pragma unroll
        for (int j = 0; j < 8; ++j) { const f32x4 q = t[j] * rstd; v2u o; o.x = pk2(q[0], q[1]); o.y = pk2(q[2], q[3]); uo[64 * j] = o; }
        float gv = ga[0];
        gv = lane == 1 ? ga[1] : gv; gv = lane == 2 ? ga[2] : gv; gv = lane == 3 ? ga[3] : gv; gv = lane == 4 ? ga[4] : gv; gv = lane == 5 ? ga[5] : gv; gv = lane == 6 ? ga[6] : gv; gv = lane == 7 ? ga[7] : gv;
        if (lane < 8) F.gates[(size_t)m * 8 + lane] = gv + gbias;
        if (lane == 8) F.gates[(WS_RMS - WS_GATES) / 4 + m] = 1.0f / rstd;
    }
}
__device__ __forceinline__ v4u ld16(const bf16* p) { return __builtin_nontemporal_load((const v4u*)p); }
__device__ __forceinline__ void st_bf(LAS bf16* p, float v) { *p = (bf16)(pk2(v, v) & 0xffffu); }
__device__ __forceinline__ void conv_lds_16(const float (&cw)[5], const LAS bf16* col, float scale, float (&out)[16]) {
    float r0 = bf2f(col[0]), r1 = bf2f(col[136]), r2 = bf2f(col[272]);
#pragma unroll
    for (int jj = 0; jj < 16; ++jj) { const float xv = bf2f(col[(jj + 3) * 136]); const float cv = cw[4] + cw[0] * r0 + cw[1] * r1 + cw[2] * r2 + cw[3] * xv; r0 = r1; r1 = r2; r2 = xv; out[jj] = cv * sigm(cv) * scale; }
}
__device__ __forceinline__ void conv_inplace_32(const float (&cw)[5], LAS bf16* col, float t0, float t1, float t2, float scale) {
    float r0 = bf2f(col[0]), r1 = bf2f(col[136]), r2 = bf2f(col[272]);
#pragma unroll
    for (int jj = 0; jj < 32; ++jj) { const float xv = jj < 29 ? bf2f(col[(jj + 3) * 136]) : (jj == 29 ? t0 : jj == 30 ? t1 : t2); const float cv = cw[4] + cw[0] * r0 + cw[1] * r1 + cw[2] * r2 + cw[3] * xv; r0 = r1; r1 = r2; r2 = xv; st_bf(col + jj * 136, cv * sigm(cv) * scale); }
}
constexpr int NCH2 = SEQ / 128;
constexpr size_t ST_PAD = 2048 + 128, CM_US = 256 * 128 + ST_PAD, CH_US = 128 * 128 + ST_PAD;
constexpr int PA_KR = 0, PA_KT = 36864, PA_F32 = 71680;
struct PaM { v4u rk[4], hk; float ig[2], fp[2]; bf16x8 bfr[8]; float cwk[5]; };
__device__ __forceinline__ void pa_mlstm_load_vt(const Frame& F, int bh, int C, PaM& L) {
    const int b = bh >> 2, h = bh & 3, m0 = b * SEQ + C * 128, lane = opaque_i(F.lane), wave = F.wave, r32 = lane & 31, hi = lane >> 5;
    const bf16* vt = F.VT + vt_off(h * 256 + 32 * wave + r32, m0) + 8 * hi;
#pragma unroll
    for (int ks = 0; ks < 8; ++ks) L.bfr[ks] = *(const bf16x8*)(vt + 16 * ks);
}
template <bool WITH_VT = true>
__device__ __forceinline__ void pa_mlstm_load(const Frame& F, int bh, int C, PaM& L) {
    const int b = bh >> 2, h = bh & 3, m0 = b * SEQ + C * 128, tid = opaque_i(F.tid), lane = tid & 63, wave = F.wave, r32 = lane & 31, hi = lane >> 5;
    L.hk = (v4u){0u, 0u, 0u, 0u}; L.ig[0] = 0.f; L.ig[1] = 0.f; L.fp[0] = 0.f; L.fp[1] = 0.f;
#pragma unroll
    for (int i = 0; i < 4; ++i) { const int idx = tid + 512 * i, row = idx >> 4, ch = idx & 15; L.rk[i] = ld16(F.PROJ + proj_off(m0 + row, PC_K + h * 128) + ch * 8); }
    if (tid < 48 && C != 0) { const int row = tid >> 4, ch = tid & 15; L.hk = ld16(F.PROJ + proj_off(m0 - 3 + row, PC_K + h * 128) + ch * 8); }
    if (wave == 0) {
#pragma unroll
        for (int hf = 0; hf < 2; ++hf) { L.ig[hf] = F.gates[(size_t)(m0 + 64 * hf + lane) * 8 + h]; L.fp[hf] = F.gates[(size_t)(m0 + 64 * hf + lane) * 8 + 4 + h]; } }
    if (WITH_VT) { const bf16* vt = F.VT + vt_off(h * 256 + 32 * wave + r32, m0) + 8 * hi;
#pragma unroll
      for (int ks = 0; ks < 8; ++ks) L.bfr[ks] = *(const bf16x8*)(vt + 16 * ks); }
    const int chk = 512 + h * 128 + (tid & 127);
#pragma unroll
    for (int i = 0; i < 4; ++i) L.cwk[i] = F.conv_w[i * 1024 + chk];
    L.cwk[4] = F.conv_b[chk];
}
__device__ __forceinline__ void pa_mlstm_fill(const Frame& F, const PaM& L) {
    const int tid = opaque_i(F.tid);
    LAS bf16* KR = (LAS bf16*)(F.lds + PA_KR);
#pragma unroll
    for (int i = 0; i < 4; ++i) { const int idx = tid + 512 * i, row = idx >> 4, ch = idx & 15; *(LAS v4u*)(KR + (row + 3) * 136 + ch * 8) = L.rk[i]; }
    if (tid < 48) { const int row = tid >> 4, ch = tid & 15; *(LAS v4u*)(KR + row * 136 + ch * 8) = L.hk; }
}
__device__ __forceinline__ void pa_mlstm_gates(const Frame& F, int bh, int C, const PaM& L) {
    const int unit = bh * NCH2 + C, lane = opaque_i(F.lane);
    LAS float* wl = (LAS float*)(F.lds + PA_F32);
    if (F.wave == 0) {
        const float lf0 = fminf(L.fp[0], 0.f) - flog(1.0f + fexp(-fabsf(L.fp[0]))), lf1 = fminf(L.fp[1], 0.f) - flog(1.0f + fexp(-fabsf(L.fp[1])));
        const float b0 = wave_scan_sum(lf0, lane), t0 = __shfl(b0, 63), b1 = t0 + wave_scan_sum(lf1, lane);
        const float g = __shfl(b1, 63);
        const float a0 = g - b0 + L.ig[0], a1 = g - b1 + L.ig[1];
        const float ml = wave_max(fmaxf(a0, a1));
        wl[lane] = fexp(a0 - ml); wl[64 + lane] = fexp(a1 - ml);
        F.bcum[(size_t)bh * SEQ + C * 128 + lane] = b0; F.bcum[(size_t)bh * SEQ + C * 128 + 64 + lane] = b1;
        if (lane == 0) { F.msc[unit * 4 + 0] = g; F.msc[unit * 4 + 1] = ml; }
    }
}
__device__ __forceinline__ void pa_mlstm_compute(const Frame& F, int bh, int C, const PaM& L, int nbh, int nC, PaM& NX) {
    const int unit = bh * NCH2 + C, tid = opaque_i(F.tid), lane = tid & 63, wave = F.wave, r32 = lane & 31, hi = lane >> 5;
    LAS bf16 *KR = (LAS bf16*)(F.lds + PA_KR), *kT = (LAS bf16*)(F.lds + PA_KT);
    LAS float* wl = (LAS float*)(F.lds + PA_F32); LAS float* nsum = wl + 128;
    const int d = tid & 127, jq = tid >> 7;
    float ns = 0.f;
    __syncthreads();
#pragma unroll
    for (int s = 0; s < 2; ++s) {
        float kv[16];
        conv_lds_16(L.cwk, KR + (32 * jq + 16 * s) * 136 + d, 0.08838834764831845f, kv);
        unsigned pk[8];
#pragma unroll
        for (int jj = 0; jj < 16; ++jj) { kv[jj] *= wl[32 * jq + 16 * s + jj]; ns += kv[jj]; }
#pragma unroll
        for (int i = 0; i < 8; ++i) pk[i] = pk2(kv[2 * i], kv[2 * i + 1]);
        LAS v4u* dst = (LAS v4u*)(kT + d * 136 + 32 * jq + 16 * s);
        dst[0] = (v4u){pk[0], pk[1], pk[2], pk[3]}; dst[1] = (v4u){pk[4], pk[5], pk[6], pk[7]};
    }
    nsum[jq * 128 + d] = ns;
    __syncthreads();
    pa_mlstm_load_vt(F, nbh, nC, NX);
    if (tid < 128) F.nst[(size_t)unit * 128 + tid] = (nsum[tid] + nsum[128 + tid]) + (nsum[256 + tid] + nsum[384 + tid]);
    {
        f32x16 acc[4];
#pragma unroll
        for (int i = 0; i < 4; ++i) acc[i] = zero16();
#pragma unroll
        for (int ks = 0; ks < 8; ++ks)
#pragma unroll
            for (int dt = 0; dt < 4; ++dt) { const bf16x8 afr = *(const LAS bf16x8*)(kT + (32 * dt + r32) * 136 + 16 * ks + 8 * hi); acc[dt] = mfma32(afr, L.bfr[ks], acc[dt]); }
        LAS bf16* pt = (LAS bf16*)(F.lds + PA_KR) + wave * (32 * 72);
        bf16* dst = F.Cm + (size_t)unit * CM_US + (32 * wave) * 128;
#pragma unroll
        for (int rd = 0; rd < 2; ++rd) {
#pragma unroll
            for (int i = 0; i < 2; ++i)
#pragma unroll
                for (int q = 0; q < 4; ++q) { const int dt = 2 * rd + i; v2u w; w.x = pk2(acc[dt][4 * q], acc[dt][4 * q + 1]); w.y = pk2(acc[dt][4 * q + 2], acc[dt][4 * q + 3]); *(LAS v2u*)(pt + r32 * 72 + 32 * i + 8 * q + 4 * hi) = w; }
            LDS_WAIT();
#pragma unroll
            for (int k = 0; k < 4; ++k) { const int row = 8 * k + (lane >> 3), ch = lane & 7; *(v4u*)(dst + (size_t)row * 128 + 64 * rd + ch * 8) = *(const LAS v4u*)(pt + row * 72 + ch * 8); }
            LDS_WAIT();
        }
    }
    __syncthreads();
}
constexpr int PH_FR = 0, PH_KT = 34816, PH_F32 = 69632, PH_PATCH = 73728;
struct PaH { v4u rf[4]; bf16x8 bfr[8]; float lb0, lb1; };
__device__ __forceinline__ void pa_hgrn2_load_vt(const Frame& F, int bh, int C, PaH& L) {
    const int b = bh >> 3, h = bh & 7, m0 = b * SEQ + C * 128, lane = opaque_i(F.lane), wave = F.wave, r32 = lane & 31, hi = lane >> 5, vt_i = wave & 3;
    const bf16* vt = F.VT + vt_off(1024 + h * 128 + 32 * vt_i + r32, m0) + 8 * hi;
#pragma unroll
    for (int ks = 0; ks < 8; ++ks) L.bfr[ks] = *(const bf16x8*)(vt + 16 * ks);
}
template <bool WITH_VT = true>
__device__ __forceinline__ void pa_hgrn2_load(const Frame& F, int bh, int C, PaH& L) {
    const int b = bh >> 3, h = bh & 7, m0 = b * SEQ + C * 128, tid = opaque_i(F.tid), lane = tid & 63, wave = F.wave, r32 = lane & 31, hi = lane >> 5, vt_i = wave & 3;
#pragma unroll
    for (int i = 0; i < 4; ++i) { const int idx = tid + 512 * i, row = idx >> 4, ch = idx & 15; L.rf[i] = ld16(F.PROJ + proj_off(m0 + row, PC_HF + h * 128) + ch * 8); }
    if (WITH_VT) { const bf16* vt = F.VT + vt_off(1024 + h * 128 + 32 * vt_i + r32, m0) + 8 * hi;
#pragma unroll
      for (int ks = 0; ks < 8; ++ks) L.bfr[ks] = *(const bf16x8*)(vt + 16 * ks); }
    const int e = 2 * (tid & 63);
    L.lb0 = F.hg_lb[1024 + h * 128 + e] - F.hg_lb[h * 128 + e]; L.lb1 = F.hg_lb[1024 + h * 128 + e + 1] - F.hg_lb[h * 128 + e + 1];
}
__device__ __forceinline__ void pa_hgrn2_fill(const Frame& F, const PaH& L) {
    const int tid = opaque_i(F.tid);
    LAS bf16* FR = (LAS bf16*)(F.lds + PH_FR);
#pragma unroll
    for (int i = 0; i < 4; ++i) { const int idx = tid + 512 * i, row = idx >> 4, ch = idx & 15; *(LAS v4u*)(FR + row * 136 + ch * 8) = L.rf[i]; }
}
__device__ __forceinline__ void pa_hgrn2_compute(const Frame& F, int bh, int C, const PaH& L, int nbh, int nC, PaH& NX) {
    const int unit = bh * NCH2 + C, tid = opaque_i(F.tid), lane = tid & 63, wave = F.wave, r32 = lane & 31, hi = lane >> 5;
    LAS bf16 *FR = (LAS bf16*)(F.lds + PH_FR), *kT = (LAS bf16*)(F.lds + PH_KT);
    LAS float* seg = (LAS float*)(F.lds + PH_F32);
    const int vt_i = wave & 3, et0 = 2 * (wave >> 2);
    const int e = 2 * (tid & 63), g8 = tid >> 6;
    const float lb0 = frcp(1.0f + fexp(L.lb0)), lb1 = frcp(1.0f + fexp(L.lb1));
    __syncthreads();
    float k0[16], k1[16]; float suf0 = 1.0f, suf1 = 1.0f;
#pragma unroll
    for (int jj = 0; jj < 16; ++jj) { const unsigned w = *(const LAS unsigned*)(FR + (16 * g8 + jj) * 136 + e); k0[jj] = lb0 + (1.0f - lb0) * sigm(blo(w)); k1[jj] = lb1 + (1.0f - lb1) * sigm(bhi(w)); }
#pragma unroll
    for (int jj = 15; jj >= 0; --jj) { const float f0 = k0[jj], f1 = k1[jj]; k0[jj] = (1.0f - f0) * suf0; k1[jj] = (1.0f - f1) * suf1; suf0 *= f0; suf1 *= f1; }
    *(LAS v2f*)(seg + g8 * 128 + e) = (v2f){suf0, suf1};
    __syncthreads();
    pa_hgrn2_load_vt(F, nbh, nC, NX);
    {
        float la0 = 1.0f, la1 = 1.0f, tot0 = 1.0f, tot1 = 1.0f, br0 = 1.0f, br1 = 1.0f;
#pragma unroll
        for (int g = 0; g < 8; ++g) { const v2f sv = *(const LAS v2f*)(seg + g * 128 + e); tot0 *= sv[0]; tot1 *= sv[1]; if (g < 4) { br0 *= sv[0]; br1 *= sv[1]; } if (g > g8) { la0 *= sv[0]; la1 *= sv[1]; } }
#pragma unroll
        for (int c = 0; c < 2; ++c) { LAS v4u* dst = (LAS v4u*)(kT + (e + c) * 136 + 16 * g8); const float la = c ? la1 : la0;
#pragma unroll
            for (int i4 = 0; i4 < 2; ++i4) { unsigned pk[4];
#pragma unroll
                for (int i = 0; i < 4; ++i) { const int j0 = 8 * i4 + 2 * i; pk[i] = c ? pk2(k1[j0] * la, k1[j0 + 1] * la) : pk2(k0[j0] * la, k0[j0 + 1] * la); }
                dst[i4] = (v4u){pk[0], pk[1], pk[2], pk[3]}; } }
        if (g8 == 0) { *(v2f*)(F.gdec + (size_t)unit * 128 + e) = (v2f){tot0, tot1}; *(v2f*)(F.ebr + (size_t)unit * 128 + e) = (v2f){br0, br1}; }
    }
    __syncthreads();
    {
        f32x16 acc[2]; acc[0] = zero16(); acc[1] = zero16();
#pragma unroll
        for (int ks = 0; ks < 8; ++ks)
#pragma unroll
            for (int i = 0; i < 2; ++i) { const bf16x8 afr = *(const LAS bf16x8*)(kT + (32 * (et0 + i) + r32) * 136 + 16 * ks + 8 * hi); acc[i] = mfma32(afr, L.bfr[ks], acc[i]); }
        LAS bf16* pt = (LAS bf16*)(F.lds + PH_PATCH) + wave * (32 * 72);
#pragma unroll
        for (int i = 0; i < 2; ++i)
#pragma unroll
            for (int q = 0; q < 4; ++q) { v2u w; w.x = pk2(acc[i][4 * q], acc[i][4 * q + 1]); w.y = pk2(acc[i][4 * q + 2], acc[i][4 * q + 3]); *(LAS v2u*)(pt + r32 * 72 + 32 * i + 8 * q + 4 * hi) = w; }
        LDS_WAIT();
        bf16* dst = F.Ch + (size_t)unit * CH_US + (32 * vt_i) * 128 + 32 * et0;
#pragma unroll
        for (int k = 0; k < 4; ++k) { const int row = 8 * k + (lane >> 3), ch = lane & 7; *(v4u*)(dst + (size_t)row * 128 + ch * 8) = *(const LAS v4u*)(pt + row * 72 + ch * 8); }
    }
    __syncthreads();
}
constexpr int NSLAB = 1, CPS = NCH / NSLAB, CPS_SH = 8;
static_assert(CPS == (1 << CPS_SH) && NSLAB == 1, "slab size; the 128-token HGRN2 units are written for one slab");
__device__ __forceinline__ void pa_phase(const Frame& F, int c_lo, volatile LAS unsigned long long* tsl) {
    { PaM cur; int id = F.bid; pa_mlstm_load(F, id >> 7, id & 127, cur);
      for (; id < 8 * NCH2; id += F.G) { const int nid = (id + F.G < 8 * NCH2) ? id + F.G : id;
          pa_mlstm_fill(F, cur); pa_mlstm_gates(F, id >> 7, id & 127, cur);
          PaM nxt; pa_mlstm_load<false>(F, nid >> 7, nid & 127, nxt);
          pa_mlstm_compute(F, id >> 7, id & 127, cur, nid >> 7, nid & 127, nxt); cur = nxt; } }
    if (PROBE_TS >= 0 && F.tid == 0) tsl[9] = __builtin_amdgcn_s_memrealtime();
    { PaH cur; int id = F.bid; pa_hgrn2_load(F, id >> 7, id & 127, cur);
      for (; id < 16 * NCH2; id += F.G) { const int nid = (id + F.G < 16 * NCH2) ? id + F.G : id;
          pa_hgrn2_fill(F, cur);
          PaH nxt; pa_hgrn2_load<false>(F, nid >> 7, nid & 127, nxt);
          pa_hgrn2_compute(F, id >> 7, id & 127, cur, nid >> 7, nid & 127, nxt); cur = nxt; } }
}
__device__ __forceinline__ void unpack8(const v4u k, float (&o)[8]) { o[0] = blo(k.x); o[1] = bhi(k.x); o[2] = blo(k.y); o[3] = bhi(k.y); o[4] = blo(k.z); o[5] = bhi(k.z); o[6] = blo(k.w); o[7] = bhi(k.w); }
__device__ __forceinline__ v4u pack8(const float (&s)[8]) { v4u o; o.x = pk2(s[0], s[1]); o.y = pk2(s[2], s[3]); o.z = pk2(s[4], s[5]); o.w = pk2(s[6], s[7]); return o; }
__device__ __forceinline__ void scan_phase(const Frame& F, int c_lo, int c_hi) {
    typedef float f32x2 __attribute__((ext_vector_type(2)));
    constexpr int SB = 16;
    const int lane_ = opaque_i(F.lane);
    const int item = ((F.bid * 4 + (F.wave >> 1)) << 6) + lane_;
    const int gt = (F.wave & 1) ? 65536 + item : item;
    LAS float* Dl = (LAS float*)F.lds; LAS float* El = Dl + NCH2 * 128; LAS v2f* Gl = (LAS v2f*)(F.lds + LDSCTL_OFF + 1024); LAS float* Nl = (LAS float*)(F.lds + LDSCTL_OFF + 2048);
    if (c_lo == 0 && c_hi == NCH) {
        const int bhh = (F.bid * 4 * 64) >> 12, tid_ = opaque_i(F.tid);
        const f32x4* gsrc = (const f32x4*)(F.gdec + (size_t)bhh * NCH2 * 128); const f32x4* esrc = (const f32x4*)(F.ebr + (size_t)bhh * NCH2 * 128);
#pragma unroll
        for (int i = 0; i < 8; ++i) { const int q = tid_ + 512 * i; const f32x4 a = gsrc[q], b2 = esrc[q]; *(LAS f32x4*)(Dl + 4 * q) = a; *(LAS f32x4*)(El + 4 * q) = b2; }
        if (tid_ < NCH2) { const int bhm = (F.bid * 4 * 64) >> 13; Gl[tid_] = *(const v2f*)(F.msc + ((size_t)bhm * NCH2 + tid_) * 4); }
        { const int bhm = (F.bid * 4 * 64) >> 13, ch = tid_ >> 2, k = tid_ & 3;
          Nl[k * NCH2 + ch] = F.nst[((size_t)bhm * NCH2 + ch) * 128 + ((F.bid * 4 + k) & 127)]; }
        __syncthreads();
    }
    if ((F.wave & 1) == 0) {
        const int bh = gt >> 13, v = (gt >> 5) & 255, dg = gt & 31;
        bf16* ptr = F.Cm + (size_t)(bh * NCH2) * CM_US + v * 128 + dg * 4;
        float* ms = F.msc + (size_t)bh * NCH2 * 4;
        const int wq = (item >> 6) & 127;
        float* np = F.nst + (size_t)bh * NCH2 * 128 + wq;
        const bool nth = (lane_ == 0);
        bf16* ptr_s = ptr; asm volatile("" : "+v"(ptr_s));
        float C0 = 0.f, C1 = 0.f, C2 = 0.f, C3 = 0.f, n0 = 0.f, m = 0.f;
        float* cr = F.carry + (size_t)gt * 12;
        if (c_lo != 0) { const f32x4 a = *(const f32x4*)cr; C0 = a[0]; C1 = a[1]; C2 = a[2]; C3 = a[3]; n0 = cr[4]; m = cr[8]; }
        for (int c0 = c_lo >> 1; c0 < (c_hi >> 1); c0 += SB) {
            v2u K[SB]; f32x2 gm[SB]; float nl[SB];
#pragma unroll
            for (int i = 0; i < SB; ++i) K[i] = *(const v2u*)(ptr + (size_t)(c0 + i) * CM_US);
#pragma unroll
            for (int i = 0; i < SB; ++i) { const v2f t2 = Gl[c0 + i]; gm[i] = (f32x2){t2[0], t2[1]}; }
            if (nth) {
#pragma unroll
                for (int i = 0; i < SB; ++i) nl[i] = Nl[(F.wave >> 1) * NCH2 + c0 + i];
            }
#pragma unroll
            for (int i = 0; i < SB; ++i) { const int c = c0 + i;
                const float g = gm[i][0], ml = gm[i][1];
                const float mn = fmaxf(g + m, ml), ws = fexp(g + m - mn), fl = fexp(ml - mn);
                v2u o; o.x = pk2(C0, C1); o.y = pk2(C2, C3); *(v2u*)(ptr_s + (size_t)c * CM_US) = o;
                C0 = ws * C0 + fl * blo(K[i].x); C1 = ws * C1 + fl * bhi(K[i].x); C2 = ws * C2 + fl * blo(K[i].y); C3 = ws * C3 + fl * bhi(K[i].y);
                if (nth) {
                    np[c * 128] = n0;
                    n0 = ws * n0 + fl * nl[i];
                    if (wq == 0) ms[c * 4 + 2] = m;
                }
                m = mn; }
        }
        if (c_hi != NCH) { *(f32x4*)cr = (f32x4){C0, C1, C2, C3}; cr[4] = n0; cr[8] = m; }
    } else {
        const int g2 = gt - 65536, bh = g2 >> 12, v = (g2 >> 5) & 127, eg = g2 & 31;
        bf16* ptr = F.Ch + (size_t)(bh * NCH2) * CH_US + v * 128 + eg * 4;
        const float* gd = F.gdec + (size_t)bh * NCH2 * 128 + eg * 4;
        const float* eb = F.ebr + (size_t)bh * NCH2 * 128 + eg * 4;
        bf16* ptr_s = ptr; asm volatile("" : "+v"(ptr_s));
        float S0 = 0.f, S1 = 0.f, S2 = 0.f, S3 = 0.f;
        float* cr = F.carry + (size_t)gt * 12;
        if (c_lo != 0) { const f32x4 a = *(const f32x4*)cr; S0 = a[0]; S1 = a[1]; S2 = a[2]; S3 = a[3]; }
        for (int c0 = c_lo >> 1; c0 < (c_hi >> 1); c0 += SB) {
            v2u K[SB]; f32x4 D[SB], E[SB];
#pragma unroll
            for (int i = 0; i < SB; ++i) K[i] = *(const v2u*)(ptr + (size_t)(c0 + i) * CH_US);
#pragma unroll
            for (int i = 0; i < SB; ++i) { D[i] = *(const LAS f32x4*)(Dl + (c0 + i) * 128 + eg * 4); E[i] = *(const LAS f32x4*)(El + (c0 + i) * 128 + eg * 4); }
#pragma unroll
            for (int i = 0; i < SB; ++i) { const int c = c0 + i;
                v2u o; o.x = pk2(S0 * E[i][0], S1 * E[i][1]); o.y = pk2(S2 * E[i][2], S3 * E[i][3]); *(v2u*)(ptr_s + (size_t)c * CH_US) = o;
                S0 = D[i][0] * S0 + blo(K[i].x); S1 = D[i][1] * S1 + bhi(K[i].x); S2 = D[i][2] * S2 + blo(K[i].y); S3 = D[i][3] * S3 + bhi(K[i].y); }
        }
        if (c_hi != NCH) *(f32x4*)cr = (f32x4){S0, S1, S2, S3};
    }
}
template <int MODE>
__device__ __forceinline__ void score_tiles(const Frame& F, const LAS bf16* Kt, const LAS bf16* Qt, LAS bf16* Sc, const LAS float* bm, const LAS float* uu, LAS float* dnA, LAS float* dnB) {
    const int wave = F.wave, lane = opaque_i(F.lane), r32 = lane & 31, hi = lane >> 5;
    if (wave < 3) {
        const int jt = (wave == 2) ? 1 : 0, tt = (wave >= 1) ? 1 : 0;
        f32x16 acc = zero16();
#pragma unroll
        for (int ks = 0; ks < 8; ++ks) { const bf16x8 a = *(const LAS bf16x8*)(Kt + (32 * jt + r32) * 136 + 16 * ks + 8 * hi), bq = *(const LAS bf16x8*)(Qt + (32 * tt + r32) * 136 + 16 * ks + 8 * hi); acc = mfma32(a, bq, acc); }
        const int t = 32 * tt + r32; float rs = 0.f; float bmt = 0.f; if (MODE == 1) bmt = bm[t];
#pragma unroll
        for (int q = 0; q < 4; ++q) { const int j0 = 32 * jt + 8 * q + 4 * hi; float vv[4];
            f32x4 u4 = (f32x4){0.f, 0.f, 0.f, 0.f}; if (MODE == 1) u4 = *(const LAS f32x4*)(uu + j0);
#pragma unroll
            for (int i = 0; i < 4; ++i) { float val = acc[4 * q + i]; if (MODE == 1) val *= __expf(fminf(bmt + u4[i], 0.f)); val = (j0 + i <= t) ? val : 0.f; vv[i] = val; rs += val; }
            v2u w; w.x = pk2(vv[0], vv[1]); w.y = pk2(vv[2], vv[3]); *(LAS v2u*)(Sc + t * 72 + j0) = w; }
        if (MODE == 1) { rs += __shfl_xor(rs, 32); if (hi == 0) { if (jt == 0) dnA[t] = rs; else dnB[t] = rs; } }
    } else if (wave == 3) {
        for (int idx = lane; idx < 128; idx += 64) { const int t = idx >> 2, part = idx & 3; *(LAS v4u*)(Sc + t * 72 + 32 + 8 * part) = (v4u){0u, 0u, 0u, 0u}; }
        if (MODE == 1 && lane < 32) dnB[lane] = 0.f;
    }
}
constexpr int RM_KS = 0, RM_QS = 35840, RM_SC = 71680, RM_OT = 89088, RM_F32 = 122880;
struct RmH { v4u hq, hk; };
struct RmA { v4u rq[4], rk[4]; float bj0, bj1, ig0, ig1, mc, ncv; };
struct RmB { bf16x8 avt[8], acs[8]; v4u ro[2][4]; };
__device__ __forceinline__ void r2m_loadA(const Frame& F, int bh, int C, RmA& L) {
    const int b = bh >> 2, h = bh & 3, m0 = b * SEQ + C * 128, unit = bh * NCH2 + C, tid = opaque_i(F.tid), lane = tid & 63, wave = F.wave;
#pragma unroll
    for (int i = 0; i < 4; ++i) { const int idx = tid + 512 * i, row = idx >> 4, ch = idx & 15;
        L.rq[i] = ld16(F.PROJ + proj_off(m0 + row, PC_Q + h * 128) + ch * 8); L.rk[i] = ld16(F.PROJ + proj_off(m0 + row, PC_K + h * 128) + ch * 8); }
    L.bj0 = 0.f; L.bj1 = 0.f; L.ig0 = 0.f; L.ig1 = 0.f; L.mc = 0.f; L.ncv = 0.f;
    if (wave == 0) { L.bj0 = F.bcum[(size_t)bh * SEQ + C * 128 + lane]; L.bj1 = F.bcum[(size_t)bh * SEQ + C * 128 + 64 + lane]; L.ig0 = F.gates[(size_t)(m0 + lane) * 8 + h]; L.ig1 = F.gates[(size_t)(m0 + 64 + lane) * 8 + h]; L.mc = F.msc[unit * 4 + 2]; }
    else if (wave < 3) L.ncv = F.nst[(size_t)unit * 128 + tid - 64];
}
template <int PART>
__device__ __forceinline__ void r2m_loadA_part(const Frame& F, int bh, int C, RmA& L) {
    const int b = bh >> 2, h = bh & 3, m0 = b * SEQ + C * 128, unit = bh * NCH2 + C, tid = opaque_i(F.tid), lane = tid & 63, wave = F.wave;
#pragma unroll
    for (int i = 0; i < 4; ++i) { const int idx = tid + 512 * i, row = idx >> 4, ch = idx & 15;
        if (PART == 0) L.rq[i] = ld16(F.PROJ + proj_off(m0 + row, PC_Q + h * 128) + ch * 8);
        if (PART == 1) L.rk[i] = ld16(F.PROJ + proj_off(m0 + row, PC_K + h * 128) + ch * 8); }
    if (PART == 0) {
        L.bj0 = 0.f; L.bj1 = 0.f; L.ig0 = 0.f; L.ig1 = 0.f; L.mc = 0.f; L.ncv = 0.f;
        if (wave == 0) { L.bj0 = F.bcum[(size_t)bh * SEQ + C * 128 + lane]; L.bj1 = F.bcum[(size_t)bh * SEQ + C * 128 + 64 + lane]; L.ig0 = F.gates[(size_t)(m0 + lane) * 8 + h]; L.ig1 = F.gates[(size_t)(m0 + 64 + lane) * 8 + h]; L.mc = F.msc[unit * 4 + 2]; }
        else if (wave < 3) L.ncv = F.nst[(size_t)unit * 128 + tid - 64]; }
}
template <int PART>
__device__ __forceinline__ void r2m_loadB_part(const Frame& F, int bh, int C, RmB& L) {
    const int b = bh >> 2, h = bh & 3, m0 = b * SEQ + C * 128, unit = bh * NCH2 + C, tid = opaque_i(F.tid), lane = tid & 63, wave = F.wave, r32 = lane & 31, hi = lane >> 5;
    if (PART == 0) {
#pragma unroll
        for (int th = 0; th < 2; ++th)
#pragma unroll
            for (int i = 0; i < 4; ++i) { const int idx = tid + 512 * i, row = idx >> 5, ch = idx & 31;
                L.ro[th][i] = ld16(F.PROJ + proj_off(m0 + 64 * th + row, PC_OZ + 512 * h + 256 * (ch >> 4)) + (ch & 15) * 8); }
    } else {
        const bf16* vt = F.VT + vt_off(h * 256 + 32 * wave + r32, m0) + 8 * hi;
#pragma unroll
        for (int ks = 0; ks < 8; ++ks) L.avt[ks] = *(const bf16x8*)(vt + 16 * ks);
        const bf16* cs = F.Cm + (size_t)unit * CM_US + (32 * wave + r32) * 128 + 8 * hi;
#pragma unroll
        for (int ks = 0; ks < 8; ++ks) L.acs[ks] = *(const bf16x8*)(cs + 16 * ks);
    }
}
__device__ __forceinline__ void r2m_loadH(const Frame& F, int bh, int C, RmH& L) {
    const int b = bh >> 2, h = bh & 3, m0 = b * SEQ + C * 128, tid = opaque_i(F.tid);
    L.hq = (v4u){0u, 0u, 0u, 0u}; L.hk = (v4u){0u, 0u, 0u, 0u};
    if (tid < 48 && C != 0) { const int row = tid >> 4, ch = tid & 15; L.hq = ld16(F.PROJ + proj_off(m0 - 3 + row, PC_Q + h * 128) + ch * 8); L.hk = ld16(F.PROJ + proj_off(m0 - 3 + row, PC_K + h * 128) + ch * 8); }
}
__device__ __forceinline__ void r2m_loadB(const Frame& F, int bh, int C, RmB& L) {
    const int b = bh >> 2, h = bh & 3, m0 = b * SEQ + C * 128, unit = bh * NCH2 + C, tid = opaque_i(F.tid), lane = tid & 63, wave = F.wave, r32 = lane & 31, hi = lane >> 5;
#pragma unroll
    for (int th = 0; th < 2; ++th)
#pragma unroll
        for (int i = 0; i < 4; ++i) { const int idx = tid + 512 * i, row = idx >> 5, ch = idx & 31;
            L.ro[th][i] = ld16(F.PROJ + proj_off(m0 + 64 * th + row, PC_OZ + 512 * h + 256 * (ch >> 4)) + (ch & 15) * 8); }
    const bf16* vt = F.VT + vt_off(h * 256 + 32 * wave + r32, m0) + 8 * hi;
#pragma unroll
    for (int ks = 0; ks < 8; ++ks) L.avt[ks] = *(const bf16x8*)(vt + 16 * ks);
    const bf16* cs = F.Cm + (size_t)unit * CM_US + (32 * wave + r32) * 128 + 8 * hi;
#pragma unroll
    for (int ks = 0; ks < 8; ++ks) L.acs[ks] = *(const bf16x8*)(cs + 16 * ks);
}
__device__ __forceinline__ void r2m_unit(const Frame& F, int bh, int C, const RmA& A, const RmB& B, const RmH& H, int nbh, int nC, RmA& NA, RmB& NB, RmH& NH) {
    const int b = bh >> 2, h = bh & 3, m0 = b * SEQ + C * 128, tid = opaque_i(F.tid), lane = tid & 63, wave = F.wave, r32 = lane & 31, hi = lane >> 5;
    LAS bf16 *Ks = (LAS bf16*)(F.lds + RM_KS), *Qs = (LAS bf16*)(F.lds + RM_QS), *Sc = (LAS bf16*)(F.lds + RM_SC), *OT = (LAS bf16*)(F.lds + RM_OT);
    LAS float* fb = (LAS float*)(F.lds + RM_F32);
    LAS float *bm = fb, *uu = fb + 128, *wi = fb + 256, *emt = fb + 384, *qn = fb + 512, *dn = fb + 640, *nc = fb + 896, *hn = fb + 1024;
    bf16x8 avt[8], acs[8]; v4u ro1[4];
#pragma unroll
    for (int ks = 0; ks < 8; ++ks) { avt[ks] = B.avt[ks]; acs[ks] = B.acs[ks]; }
#pragma unroll
    for (int q = 0; q < 4; ++q) ro1[q] = B.ro[1][q];
    const float bj0 = A.bj0, bj1 = A.bj1, ig0 = A.ig0, ig1 = A.ig1, mc = A.mc, ncv = A.ncv;
#pragma unroll
    for (int i = 0; i < 4; ++i) { const int idx = tid + 512 * i, row = idx >> 4, ch = idx & 15; *(LAS v4u*)(Qs + (row + 3) * 136 + ch * 8) = A.rq[i]; *(LAS v4u*)(Ks + (row + 3) * 136 + ch * 8) = A.rk[i]; }
    if (tid < 48) { const int row = tid >> 4, ch = tid & 15; *(LAS v4u*)(Qs + row * 136 + ch * 8) = H.hq; *(LAS v4u*)(Ks + row * 136 + ch * 8) = H.hk; }
#pragma unroll
    for (int i = 0; i < 4; ++i) { const int idx = tid + 512 * i, row = idx >> 5, ch = idx & 31; *(LAS v4u*)(OT + row * 264 + ch * 8) = B.ro[0][i]; }
    if (wave == 0) {
        const float u0 = ig0 - bj0, u1 = ig1 - bj1;
        const float p0 = wave_scan_max(u0, lane), p1 = fmaxf(__shfl(p0, 63), wave_scan_max(u1, lane));
        const float mt0 = bj0 + fmaxf(mc, p0), mt1 = bj1 + fmaxf(mc, p1);
        bm[lane] = bj0 - mt0; uu[lane] = u0; wi[lane] = fexp(bj0 + mc - mt0); emt[lane] = fexp(-mt0);
        bm[64 + lane] = bj1 - mt1; uu[64 + lane] = u1; wi[64 + lane] = fexp(bj1 + mc - mt1); emt[64 + lane] = fexp(-mt1);
    } else if (wave < 3) nc[tid - 64] = ncv;
    r2m_loadA_part<0>(F, nbh, nC, NA);
    __syncthreads();
    {
        const int d = tid & 127, jq = tid >> 7;
        float cwq[5], cwk[5];
        { const int chq = h * 128 + d, chk = 512 + chq;
#pragma unroll
          for (int i = 0; i < 4; ++i) { cwq[i] = F.conv_w[i * 1024 + chq]; cwk[i] = F.conv_w[i * 1024 + chk]; }
          cwq[4] = F.conv_b[chq]; cwk[4] = F.conv_b[chk]; }
        LAS bf16 *qc = Qs + (32 * jq) * 136 + d, *kc = Ks + (32 * jq) * 136 + d;
        const float tq0 = bf2f(qc[32 * 136]), tq1 = bf2f(qc[33 * 136]), tq2 = bf2f(qc[34 * 136]), tk0 = bf2f(kc[32 * 136]), tk1 = bf2f(kc[33 * 136]), tk2 = bf2f(kc[34 * 136]);
        __syncthreads();
        conv_inplace_32(cwq, qc, tq0, tq1, tq2, 1.0f);
        conv_inplace_32(cwk, kc, tk0, tk1, tk2, 0.08838834764831845f);
    }
    __syncthreads();
    r2m_loadA_part<1>(F, nbh, nC, NA);
    {
        const int t = tid >> 2, part = tid & 3; float dot = 0.f;
#pragma unroll
        for (int i = 0; i < 4; ++i) { const int d0 = 32 * part + 8 * i; const v4u qv = *(const LAS v4u*)(Qs + t * 136 + d0); float qf[8]; unpack8(qv, qf);
#pragma unroll
            for (int k = 0; k < 8; ++k) dot += qf[k] * nc[d0 + k]; }
        dot += __shfl_xor(dot, 1); dot += __shfl_xor(dot, 2); if (part == 0) qn[t] = dot;
    }
#pragma unroll
    for (int th = 0; th < 2; ++th) {
        {
            int jt, st; bool zero = false, act = true;
            if (th == 0) { jt = (wave == 2) ? 1 : 0; st = (wave >= 1) ? 1 : 0; zero = (wave == 3); act = (wave < 4); if (zero) { jt = 1; st = 0; } }
            else { jt = (wave < 4) ? (wave >> 1) : (wave < 6 ? 2 : 3); st = (wave < 4) ? (wave & 1) : (wave == 4 ? 0 : 1); zero = (wave == 7); if (zero) { jt = 3; st = 0; } }
            if (act && !zero) {
                f32x16 acc = zero16();
#pragma unroll
                for (int ks = 0; ks < 8; ++ks) { const bf16x8 a = *(const LAS bf16x8*)(Ks + (32 * jt + r32) * 136 + 16 * ks + 8 * hi), bq = *(const LAS bf16x8*)(Qs + (64 * th + 32 * st + r32) * 136 + 16 * ks + 8 * hi); acc = mfma32(a, bq, acc); }
                const int tl = 32 * st + r32, tg = 64 * th + tl; const float bmt = bm[tg]; float rs = 0.f;
#pragma unroll
                for (int q = 0; q < 4; ++q) { const int j0 = 32 * jt + 8 * q + 4 * hi; float vv[4]; const f32x4 u4 = *(const LAS f32x4*)(uu + j0);
#pragma unroll
                    for (int i = 0; i < 4; ++i) { const float val = (j0 + i <= tg) ? acc[4 * q + i] * __expf(fminf(bmt + u4[i], 0.f)) : 0.f; vv[i] = val; rs += val; }
                    v2u w; w.x = pk2(vv[0], vv[1]); w.y = pk2(vv[2], vv[3]); *(LAS v2u*)(Sc + tl * 136 + j0) = w; }
                rs += __shfl_xor(rs, 32); if (hi == 0) dn[jt * 64 + tl] = rs;
            } else if (act) {
                for (int idx = lane; idx < 128; idx += 64) { const int tl = 32 * st + (idx >> 2), part = idx & 3; *(LAS v4u*)(Sc + tl * 136 + 32 * jt + 8 * part) = (v4u){0u, 0u, 0u, 0u}; }
                if (lane < 32) dn[jt * 64 + 32 * st + lane] = 0.f;
            }
            if (th == 0 && wave >= 4 && wave < 6) dn[(wave - 2) * 64 + lane] = 0.f;
        }
        __syncthreads();
        f32x4 nw[4];
        { const float* nwp = F.ml_nw + h * 256 + 32 * wave + 4 * hi;
          asm volatile("" ::: "memory");
#pragma unroll
          for (int q = 0; q < 4; ++q) nw[q] = *(const f32x4*)(nwp + 8 * q); }
        f32x16 accA[2], accB[2]; accA[0] = zero16(); accA[1] = zero16(); accB[0] = zero16(); accB[1] = zero16();
#pragma unroll
        for (int ks = 0; ks < 8; ++ks) if (ks < 4 * (th + 1))
#pragma unroll
            for (int tt = 0; tt < 2; ++tt) { const bf16x8 bq = *(const LAS bf16x8*)(Sc + (32 * tt + r32) * 136 + 16 * ks + 8 * hi); accA[tt] = mfma32(avt[ks], bq, accA[tt]); }
#pragma unroll
        for (int ks = 0; ks < 8; ++ks)
#pragma unroll
            for (int tt = 0; tt < 2; ++tt) { const bf16x8 bq = *(const LAS bf16x8*)(Qs + (64 * th + 32 * tt + r32) * 136 + 16 * ks + 8 * hi); accB[tt] = mfma32(acs[ks], bq, accB[tt]); }
        if (th == 1) r2m_loadB_part<1>(F, nbh, nC, NB);
#pragma unroll
        for (int tt = 0; tt < 2; ++tt) { const int tl = 32 * tt + r32, tg = 64 * th + tl; const float wit = wi[tg];
            const float den = (dn[tl] + dn[64 + tl]) + (dn[128 + tl] + dn[192 + tl]) + wit * qn[tg]; const float inv = frcp(fmaxf(fabsf(den), emt[tg])); float ssp = 0.f;
#pragma unroll
            for (int r = 0; r < 16; ++r) { const float hv = (accA[tt][r] + wit * accB[tt][r]) * inv; accA[tt][r] = hv; ssp += hv * hv; }
            ssp += __shfl_xor(ssp, 32); if (hi == 0) hn[wave * 64 + tl] = ssp; }
        __syncthreads();
        if (th == 1) r2m_loadH(F, nbh, nC, NH);
#pragma unroll
        for (int tt = 0; tt < 2; ++tt) { const int tl = 32 * tt + r32; float tot = 0.f;
#pragma unroll
            for (int w = 0; w < 8; ++w) tot += hn[w * 64 + tl];
            const float rstd = frsq(tot * (1.0f / 256.0f) + EPS);
            const int v0 = 32 * wave + 4 * hi;
#pragma unroll
            for (int q = 0; q < 4; ++q) { LAS v2u* op = (LAS v2u*)(OT + tl * 264 + v0 + 8 * q); const v2u o4 = *op;
                const float y0 = accA[tt][4 * q] * rstd * nw[q][0] * blo(o4.x), y1 = accA[tt][4 * q + 1] * rstd * nw[q][1] * bhi(o4.x);
                const float y2 = accA[tt][4 * q + 2] * rstd * nw[q][2] * blo(o4.y), y3 = accA[tt][4 * q + 3] * rstd * nw[q][3] * bhi(o4.y);
                v2u w; w.x = pk2(y0, y1); w.y = pk2(y2, y3); *op = w; } }
        __syncthreads();
#pragma unroll
        for (int i = 0; i < 4; ++i) { const int idx = tid + 512 * i, row = idx >> 5, ch = idx & 31; *(v4u*)(F.Y + (size_t)(m0 + 64 * th + row) * DM + h * 256 + ch * 8) = *(const LAS v4u*)(OT + row * 264 + ch * 8); }
        __syncthreads();
        if (th == 0) {
#pragma unroll
            for (int i = 0; i < 4; ++i) { const int idx = tid + 512 * i, row = idx >> 5, ch = idx & 31; *(LAS v4u*)(OT + row * 264 + ch * 8) = ro1[i]; }
            r2m_loadB_part<0>(F, nbh, nC, NB);
        }
    }
}
constexpr int RH_QT = 0, RH_KT = 34816, RH_GT = 69632, RH_SC = 104448, RH_F32 = 121856;
struct RhL { v4u rq[4], rf[4], rg[4]; float lbd0, lbd1; };
__device__ __forceinline__ void r2h_load(const Frame& F, int bh, int C, RhL& L) {
    const int b = bh >> 3, h = bh & 7, m0 = b * SEQ + C * 128, tid = opaque_i(F.tid);
#pragma unroll
    for (int i = 0; i < 4; ++i) { const int idx = tid + 512 * i, row = idx >> 4, ch = idx & 15;
        L.rq[i] = ld16(F.PROJ + proj_off(m0 + row, PC_HQ + h * 128) + ch * 8); L.rf[i] = ld16(F.PROJ + proj_off(m0 + row, PC_HF + h * 128) + ch * 8); L.rg[i] = ld16(F.PROJ + proj_off(m0 + row, PC_HG + h * 128) + ch * 8); }
    { const int e = 2 * (tid & 63); L.lbd0 = F.hg_lb[1024 + h * 128 + e] - F.hg_lb[h * 128 + e]; L.lbd1 = F.hg_lb[1024 + h * 128 + e + 1] - F.hg_lb[h * 128 + e + 1]; }
}
template <int PART>
__device__ __forceinline__ void r2h_load_part(const Frame& F, int bh, int C, RhL& L) {
    const int b = bh >> 3, h = bh & 7, m0 = b * SEQ + C * 128, tid = opaque_i(F.tid);
#pragma unroll
    for (int i = 0; i < 4; ++i) { const int idx = tid + 512 * i, row = idx >> 4, ch = idx & 15;
        if (PART == 0) L.rq[i] = ld16(F.PROJ + proj_off(m0 + row, PC_HQ + h * 128) + ch * 8);
        if (PART == 1) L.rf[i] = ld16(F.PROJ + proj_off(m0 + row, PC_HF + h * 128) + ch * 8);
        if (PART == 2) L.rg[i] = ld16(F.PROJ + proj_off(m0 + row, PC_HG + h * 128) + ch * 8); }
    if (PART == 0) { const int e = 2 * (tid & 63); L.lbd0 = F.hg_lb[1024 + h * 128 + e] - F.hg_lb[h * 128 + e]; L.lbd1 = F.hg_lb[1024 + h * 128 + e + 1] - F.hg_lb[h * 128 + e + 1]; }
}
__device__ __forceinline__ void r2h_fill(const Frame& F, const RhL& L) {
    const int tid = opaque_i(F.tid);
    LAS bf16 *Qt = (LAS bf16*)(F.lds + RH_QT), *Kt = (LAS bf16*)(F.lds + RH_KT), *GT = (LAS bf16*)(F.lds + RH_GT);
#pragma unroll
    for (int i = 0; i < 4; ++i) { const int idx = tid + 512 * i, row = idx >> 4, ch = idx & 15; const int lo = row * 136 + ch * 8;
        *(LAS v4u*)(Qt + lo) = L.rq[i]; *(LAS v4u*)(Kt + lo) = L.rf[i]; *(LAS v4u*)(GT + lo) = L.rg[i]; }
}
__device__ __forceinline__ void r2h_compute(const Frame& F, int bh, int C, float lbd0, float lbd1, int nbh, int nC, RhL& NX) {
    const int b = bh >> 3, h = bh & 7, m0 = b * SEQ + C * 128, unit = bh * NCH2 + C, tid = opaque_i(F.tid), lane = tid & 63, wave = F.wave, r32 = lane & 31, hi = lane >> 5;
    LAS bf16 *Qt = (LAS bf16*)(F.lds + RH_QT), *Kt = (LAS bf16*)(F.lds + RH_KT), *GT = (LAS bf16*)(F.lds + RH_GT), *Sc = (LAS bf16*)(F.lds + RH_SC);
    LAS float* hn = (LAS float*)(F.lds + RH_F32);
    LAS float* seg = hn + 256;
    const int vt_i = wave & 3, tt = wave >> 2, t = 32 * tt + r32;
    bf16x8 avt[8], ast[8]; f32x4 nw[4];
    { const bf16* vt = F.VT + vt_off(1024 + h * 128 + 32 * vt_i + r32, m0) + 8 * hi;
#pragma unroll
      for (int ks = 0; ks < 8; ++ks) avt[ks] = *(const bf16x8*)(vt + 16 * ks);
      const float* nwp = F.hg_nw + h * 128 + 32 * vt_i + 4 * hi;
#pragma unroll
      for (int q = 0; q < 4; ++q) nw[q] = *(const f32x4*)(nwp + 8 * q); }
    __syncthreads();
    {
        const int e = 2 * (tid & 63), g8 = tid >> 6;
        const float lb0 = frcp(1.0f + fexp(lbd0)), lb1 = frcp(1.0f + fexp(lbd1));
        float y0[16], y1[16], f0[16], f1[16];
#pragma unroll
        for (int jj = 0; jj < 16; ++jj) { const unsigned w = *(const LAS unsigned*)(Kt + (16 * g8 + jj) * 136 + e); f0[jj] = lb0 + (1.0f - lb0) * sigm(blo(w)); f1[jj] = lb1 + (1.0f - lb1) * sigm(bhi(w)); }
        float run0 = 1.0f, run1 = 1.0f;
        if (g8 < 4) {
#pragma unroll
            for (int jj = 15; jj >= 0; --jj) { y0[jj] = run0; y1[jj] = run1; run0 *= f0[jj]; run1 *= f1[jj]; }
        } else {
#pragma unroll
            for (int jj = 0; jj < 16; ++jj) { run0 *= f0[jj]; run1 *= f1[jj]; y0[jj] = run0; y1[jj] = run1; }
        }
        *(LAS v2f*)(seg + g8 * 128 + e) = (v2f){run0, run1};
        __syncthreads();
        { const bf16* cs = F.Ch + (size_t)unit * CH_US + (32 * vt_i + r32) * 128 + 8 * hi;
#pragma unroll
          for (int ks = 0; ks < 8; ++ks) ast[ks] = *(const bf16x8*)(cs + 16 * ks); }
        r2h_load_part<0>(F, nbh, nC, NX);
        float o0 = 1.0f, o1 = 1.0f;
#pragma unroll
        for (int g = 1; g < 7; ++g) { const bool use = (g8 < 4) ? (g > g8 && g < 4) : (g >= 4 && g < g8); if (use) { const v2f sv = *(const LAS v2f*)(seg + g * 128 + e); o0 *= sv[0]; o1 *= sv[1]; } }
#pragma unroll
        for (int jj = 0; jj < 16; ++jj) { const int j = 16 * g8 + jj; const float ya = y0[jj] * o0, yb = y1[jj] * o1, ra = frcp(ya), rb = frcp(yb);
            const unsigned qw = *(const LAS unsigned*)(Qt + j * 136 + e);
            *(LAS unsigned*)(Qt + j * 136 + e) = pk2(blo(qw) * (g8 < 4 ? ra : ya), bhi(qw) * (g8 < 4 ? rb : yb));
            *(LAS unsigned*)(Kt + j * 136 + e) = pk2((1.0f - f0[jj]) * (g8 < 4 ? ya : ra), (1.0f - f1[jj]) * (g8 < 4 ? yb : rb)); }
    }
    __syncthreads();
    r2h_load_part<1>(F, nbh, nC, NX);
#pragma unroll
    for (int th = 0; th < 2; ++th) {
        {
            int jt, st; bool zero = false, act = true;
            if (th == 0) { jt = (wave == 2) ? 1 : 0; st = (wave >= 1) ? 1 : 0; zero = (wave == 3); act = (wave < 4); if (zero) { jt = 1; st = 0; } }
            else { jt = (wave < 4) ? (wave >> 1) : (wave < 6 ? 2 : 3); st = (wave < 4) ? (wave & 1) : (wave == 4 ? 0 : 1); zero = (wave == 7); if (zero) { jt = 3; st = 0; } }
            if (act && !zero) {
                f32x16 acc = zero16();
#pragma unroll
                for (int ks = 0; ks < 8; ++ks) { const bf16x8 a = *(const LAS bf16x8*)(Kt + (32 * jt + r32) * 136 + 16 * ks + 8 * hi), bq = *(const LAS bf16x8*)(Qt + (64 * th + 32 * st + r32) * 136 + 16 * ks + 8 * hi); acc = mfma32(a, bq, acc); }
                const int tl = 32 * st + r32, tg = 64 * th + tl;
#pragma unroll
                for (int q = 0; q < 4; ++q) { const int j0 = 32 * jt + 8 * q + 4 * hi; float vv[4];
#pragma unroll
                    for (int i = 0; i < 4; ++i) vv[i] = (j0 + i <= tg) ? acc[4 * q + i] : 0.f;
                    v2u w; w.x = pk2(vv[0], vv[1]); w.y = pk2(vv[2], vv[3]); *(LAS v2u*)(Sc + tl * 136 + j0) = w; }
            } else if (act) {
                for (int idx = lane; idx < 128; idx += 64) { const int tl = 32 * st + (idx >> 2), part = idx & 3; *(LAS v4u*)(Sc + tl * 136 + 32 * jt + 8 * part) = (v4u){0u, 0u, 0u, 0u}; }
            }
        }
        __syncthreads();
        f32x16 acc = zero16();
#pragma unroll
        for (int ks = 0; ks < 8; ++ks) if (ks < 4 * (th + 1)) { const bf16x8 bq = *(const LAS bf16x8*)(Sc + t * 136 + 16 * ks + 8 * hi); acc = mfma32(avt[ks], bq, acc); }
#pragma unroll
        for (int ks = 0; ks < 8; ++ks) { const bf16x8 bq = *(const LAS bf16x8*)(Qt + (64 * th + t) * 136 + 16 * ks + 8 * hi); acc = mfma32(ast[ks], bq, acc); }
        { float ssp = 0.f;
#pragma unroll
          for (int r = 0; r < 16; ++r) ssp += acc[r] * acc[r];
          ssp += __shfl_xor(ssp, 32); if (hi == 0) hn[vt_i * 64 + t] = ssp; }
        __syncthreads();
        LAS bf16* YT = Qt + 64 * th * 136;
        {
            const float tot = (hn[t] + hn[64 + t]) + (hn[128 + t] + hn[192 + t]);
            const float rstd = frsq(tot * (1.0f / 128.0f) + EPS);
            const int v0 = 32 * vt_i + 4 * hi;
#pragma unroll
            for (int q = 0; q < 4; ++q) { const v2u g4 = *(const LAS v2u*)(GT + (64 * th + t) * 136 + v0 + 8 * q);
                const float g0 = blo(g4.x), g1 = bhi(g4.x), g2 = blo(g4.y), g3 = bhi(g4.y);
                const float y0 = acc[4 * q] * rstd * nw[q][0] * g0, y1 = acc[4 * q + 1] * rstd * nw[q][1] * g1;
                const float y2 = acc[4 * q + 2] * rstd * nw[q][2] * g2, y3 = acc[4 * q + 3] * rstd * nw[q][3] * g3;
                v2u w; w.x = pk2(y0, y1); w.y = pk2(y2, y3); *(LAS v2u*)(YT + t * 136 + v0 + 8 * q) = w; }
        }
        __syncthreads();
#pragma unroll
        for (int i = 0; i < 2; ++i) { const int idx = tid + 512 * i, row = idx >> 4, ch = idx & 15; *(v4u*)(F.Y + (size_t)(m0 + 64 * th + row) * DM + 1024 + h * 128 + ch * 8) = *(const LAS v4u*)(YT + row * 136 + ch * 8); }
        __syncthreads();
        if (th == 0) r2h_load_part<2>(F, nbh, nC, NX);
    }
}
__device__ __forceinline__ void r2_phase(const Frame& F, int c_lo, volatile LAS unsigned long long* tsl) {
#define R2_BH(id) ((id) >> CPS_SH)
#define R2_C(id) (c_lo + ((id) & (CPS - 1)))
    { RmA curA; RmB curB; RmH curH; int id = F.bid; r2m_loadA(F, id >> 7, id & 127, curA); r2m_loadH(F, id >> 7, id & 127, curH); r2m_loadB(F, id >> 7, id & 127, curB);
      for (; id < 8 * NCH2; id += F.G) { const int nid = (id + F.G < 8 * NCH2) ? id + F.G : id;
          RmA nxtA; RmB nxtB; RmH nxtH; r2m_unit(F, id >> 7, id & 127, curA, curB, curH, nid >> 7, nid & 127, nxtA, nxtB, nxtH); curA = nxtA; curB = nxtB; curH = nxtH; } }
    if (PROBE_TS >= 0 && F.tid == 0) tsl[8] = __builtin_amdgcn_s_memrealtime();
    { RhL cur; int id = F.bid; r2h_load(F, id >> 7, id & 127, cur);
      for (; id < 16 * NCH2; id += F.G) { const int nid = (id + F.G < 16 * NCH2) ? id + F.G : id;
          r2h_fill(F, cur); const float lbd0 = cur.lbd0, lbd1 = cur.lbd1;
          RhL nxt;
          r2h_compute(F, id >> 7, id & 127, lbd0, lbd1, nid >> 7, nid & 127, nxt); cur = nxt; } }
#undef R2_BH
#undef R2_C
}
template <bool NTL, bool NTS, bool PF>
__device__ __forceinline__ void final_norm_v(const Frame& F, float oscale) {
    int lane; asm volatile("v_mbcnt_lo_u32_b32 %0, -1, 0\n\tv_mbcnt_hi_u32_b32 %0, -1, %0" : "=v"(lane));
    const int gw = F.bid * NWAVES + F.wave, NGW = F.G * NWAVES;
    const int sub = lane >> 5, l8 = (lane & 31) * 8;
    v4u gn[4];
    { const int m = gw; const size_t base = (((size_t)(m >> 8) * 8) << 16) + (size_t)(m & 255) * 256 + l8;
#pragma unroll
      for (int i = 0; i < 4; ++i) { const v4u* p = (const v4u*)(F.EB + base + ((size_t)(2 * i + sub) << 16)); gn[i] = NTL ? __builtin_nontemporal_load(p) : *p; } }
    for (int m = gw; m < M; m += NGW) {
        float hv[4][8]; float ss = 0.f;
        v4u g4[4];
#pragma unroll
        for (int i = 0; i < 4; ++i) g4[i] = gn[i];
        const int mn = (m + NGW < M) ? m + NGW : m; const size_t basen = (((size_t)(mn >> 8) * 8) << 16) + (size_t)(mn & 255) * 256 + l8;
        if (PF) {
#pragma unroll
            for (int i = 0; i < 4; ++i) { const v4u* p = (const v4u*)(F.EB + basen + ((size_t)(2 * i + sub) << 16)); gn[i] = NTL ? __builtin_nontemporal_load(p) : *p; } }
#pragma unroll
        for (int i = 0; i < 4; ++i) { const v4u g = g4[i];
            hv[i][0] = blo(g.x); hv[i][1] = bhi(g.x); hv[i][2] = blo(g.y); hv[i][3] = bhi(g.y);
            hv[i][4] = blo(g.z); hv[i][5] = bhi(g.z); hv[i][6] = blo(g.w); hv[i][7] = bhi(g.w);
#pragma unroll
            for (int k = 0; k < 8; ++k) ss += hv[i][k] * hv[i][k]; }
        ss = wave_sum(ss);
        const float rstd = oscale / sqrtf(ss * (1.0f / DM) + EPS);
#pragma unroll
        for (int i = 0; i < 4; ++i) { const int col = (2 * i + sub) * 256 + l8; const f32x4 w0 = *(const f32x4*)(F.fin_nw + col), w1 = *(const f32x4*)(F.fin_nw + col + 4);
            float* o = F.out + (size_t)m * DM + col;
            const f32x4 o0 = (f32x4){hv[i][0] * rstd * w0[0], hv[i][1] * rstd * w0[1], hv[i][2] * rstd * w0[2], hv[i][3] * rstd * w0[3]}, o1 = (f32x4){hv[i][4] * rstd * w1[0], hv[i][5] * rstd * w1[1], hv[i][6] * rstd * w1[2], hv[i][7] * rstd * w1[3]};
            if (NTS) { __builtin_nontemporal_store(o0, (f32x4*)o); __builtin_nontemporal_store(o1, (f32x4*)(o + 4)); } else { *(f32x4*)o = o0; *(f32x4*)(o + 4) = o1; } }
        if (!PF) {
#pragma unroll
            for (int i = 0; i < 4; ++i) { const v4u* p = (const v4u*)(F.EB + basen + ((size_t)(2 * i + sub) << 16)); gn[i] = NTL ? __builtin_nontemporal_load(p) : *p; } }
    }
}
__device__ __forceinline__ void final_norm(const Frame& F, float oscale) { final_norm_v<P7_NTL, P7_NTS, P7_PF>(F, oscale); }
struct Args { const float* in[16]; float* out; unsigned char* ws; int ph_lo, ph_hi, li, pad; };
__global__ void __launch_bounds__(NWAVES * 64, 2) hymba_fwd(Args args) {
    extern __shared__ __attribute__((aligned(16))) unsigned char lds[];
    Frame F;
    F.lds = (LAS unsigned char*)lds;
    F.tid = threadIdx.x; F.lane = F.tid & 63; F.wave = __builtin_amdgcn_readfirstlane(F.tid >> 6); F.G = gridDim.x; F.bid = blockIdx.x;
    unsigned char* ws = args.ws;
    gu32* ctl = (gu32*)(ws + WS_CTL);
    F.x = args.in[0]; F.p = args.in[1]; F.norm_w = args.in[2]; F.w_in = args.in[3]; F.conv_w = args.in[4]; F.conv_b = args.in[5]; F.b_i = args.in[6]; F.b_f = args.in[7];
    F.ml_nw = args.in[8]; F.hg_lb = args.in[9]; F.hg_nw = args.in[10]; F.w_out = args.in[11]; F.pe_nw = args.in[12]; F.w_pg = args.in[13]; F.w_pe = args.in[14]; F.fin_nw = args.in[15];
    F.out = args.out;
    F.Wt_in = (bf16*)(ws + WS_WIN); F.WoT = (bf16*)(ws + WS_WO); F.WgT = (bf16*)(ws + WS_WG); F.WeT = (bf16*)(ws + WS_WE); F.PB = (bf16*)(ws + WS_PB);
    F.U = (bf16*)(ws + WS_U); F.Y = (bf16*)(ws + WS_Y); F.PROJ = (bf16*)(ws + WS_PROJ); F.HB = (bf16*)(ws + WS_PROJ); F.EB = (bf16*)(ws + WS_PROJ + 128 * MiB); F.VT = (bf16*)(ws + WS_VT);
    F.Cm = (bf16*)args.out; F.Ch = (bf16*)args.out + (size_t)64 * MiB;
    F.gates = (float*)(ws + WS_GATES); F.bcum = (float*)(ws + WS_BCUM); F.msc = (float*)(ws + WS_MSC); F.nst = (float*)(ws + WS_NST); F.gdec = (float*)(ws + WS_GDEC); F.ebr = (float*)(ws + WS_EBR); F.carry = (float*)(ws + WS_CARRY);
    F.ssqh = (float*)(ws + WS_SSQH); F.ssq2 = (float*)(ws + WS_SSQ2); F.QC = (bf16*)(ws + WS_QC); F.KC = (bf16*)(ws + WS_KC); F.HQT = (bf16*)(ws + WS_HQT); F.HKT = (bf16*)(ws + WS_HKT); F.HQ2 = (bf16*)(ws + WS_HQ2);
    for (int u = F.tid; u < (LDS_BYTES - LDSCTL_OFF) / 4; u += NWAVES * 64) ((LAS unsigned*)(F.lds + LDSCTL_OFF))[u] = 0u;
    __syncthreads();
    XcdBarrier bar; bar.bar = (unsigned*)(ctl + CW_BAR); bar.x = 0; bar.st = nullptr;
    if (N_LAUNCHES != PER_PHASE) bar = xcd_barrier_post((unsigned*)(ctl + CW_BAR), (volatile LAS unsigned*)(F.lds + MISC_OFF) + 8);
#define GRID_BAR() do { if (N_LAUNCHES == PER_PHASE) { if (F.tid == 0) __hip_atomic_store(ctl + CW_TMO, 0xBADBA0u, RLX_AGENT); } else { xcd_barrier(bar); } } while (0)
    const int lo = args.ph_lo, hi = args.ph_hi;
#ifndef PROBE_TS
#define PROBE_TS (-1)
#endif
#ifndef PROBE_TB
#define PROBE_TB (PROBE_TS + 1)
#endif
    volatile LAS unsigned long long* tsl = (volatile LAS unsigned long long*)(F.lds + LDSCTL_OFF + 512);
#define STAMP(k) do { if (PROBE_TS >= 0 && F.tid == 0) tsl[k] = __builtin_amdgcn_s_memrealtime(); } while (0)
    STAMP(0);
#define IN(k) (lo <= (k) && (k) < hi)
#define BOTH(k) (IN(k) && IN((k) + 1))
#ifndef GEMM_ALIGN
#define GEMM_ALIGN true
#endif
#ifndef GEMM_SP2
#define GEMM_SP2 true
#endif
#ifndef PROBE_KIND
#define PROBE_KIND 0
#endif
#ifndef PROBE_DOUBLE
#define PROBE_DOUBLE 0
#endif
    if (IN(0)) { p0_prologue(F);
#if PROBE_DOUBLE & 1
        __syncthreads(); p0_prologue(F);
#endif
        if (BOTH(0)) { STAMP(17); GRID_BAR(); STAMP(1); } }
    int vcu = F.bid;
    if (N_LAUNCHES != PER_PHASE && lo == 0) { volatile LAS unsigned* st = (volatile LAS unsigned*)(F.lds + MISC_OFF) + 8; if (st[2] != 0u && F.G == 256) vcu = (int)(st[3] * 8u + bar.x); }
    if (IN(1)) {
#if PROBE_KIND == 10
        { pg8::Gemm g{F.U, F.Wt_in, M, NNAT, DM}; pg8::StaticOrder S; S.init(M, NNAT, F.G, vcu); pg8::EpiNull E;
          pg8::gemm_phase<pg8::EpiNull, pg8::StaticOrder, true, true, false, 0, false, false, true>(F.lds, g, S, E); }
#elif PROBE_KIND == 12
        { pg8::Gemm g{F.U, F.Wt_in, M, NNAT, DM}; pg8::StaticOrder S; S.init(M, NNAT, F.G, vcu); pg8::EpiNull E;
          pg8::gemm_phase<pg8::EpiNull, pg8::StaticOrder, true, true, false, 0, true, false, false, true>(F.lds, g, S, E); }
#elif PROBE_KIND == 13
        { f32x16 acc[8]; bf16x8 a, b;
#pragma unroll
          for (int i = 0; i < 8; ++i) acc[i] = zero16();
#pragma unroll
          for (int i = 0; i < 8; ++i) { a[i] = (short)(F.tid + i); b[i] = (short)(F.lane * 3 + i); }
          for (int it = 0; it < 12 * 32 * 8; ++it) {
#pragma unroll
              for (int i = 0; i < 8; ++i) acc[i] = mfma32(a, b, acc[i]);
          }
#pragma unroll
          for (int i = 0; i < 8; ++i) asm volatile("" :: "v"(acc[i])); }
#elif PROBE_KIND == 11
        { pg8::Gemm g{F.U, F.Wt_in, M, NNAT, DM}; pg8::StaticOrder S; S.init(M, NNAT, F.G, vcu); pg8::EpiNull E;
          pg8::gemm_phase<pg8::EpiNull, pg8::StaticOrder, true, true>(F.lds, g, S, E); }
#endif
#if PROBE_DOUBLE & 2
        { pg8::Gemm g{F.U, F.Wt_in, M, NNAT, DM}; pg8::StaticOrder S; S.init(M, NNAT, F.G, vcu);
          pg8::EpiProj E{F.PROJ, NNAT / 256, PC_OZ / 256, PC_OZ / 256 + 8, PC_HG / 256};
          pg8::gemm_phase<pg8::EpiProj, pg8::StaticOrder, GEMM_ALIGN, GEMM_SP2>(F.lds, g, S, E); }
        { pg8::Gemm g{F.Wt_in + (size_t)NNAT * DM, F.U, NTR, M, DM}; pg8::StaticOrder S; S.init(NTR, M, F.G, vcu);
          pg8::EpiBf16T E{F.VT, M / 256};
          pg8::gemm_phase<pg8::EpiBf16T, pg8::StaticOrder, GEMM_ALIGN, GEMM_SP2>(F.lds, g, S, E); }
#endif
        { pg8::Gemm g{F.U, F.Wt_in, M, NNAT, DM}; pg8::StaticOrder S; S.init(M, NNAT, F.G, vcu);
          pg8::EpiProj E{F.PROJ, NNAT / 256, PC_OZ / 256, PC_OZ / 256 + 8, PC_HG / 256};
          pg8::gemm_phase<pg8::EpiProj, pg8::StaticOrder, GEMM_ALIGN, GEMM_SP2>(F.lds, g, S, E); }
        { pg8::Gemm g{F.Wt_in + (size_t)NNAT * DM, F.U, NTR, M, DM}; pg8::StaticOrder S; S.init(NTR, M, F.G, vcu);
          pg8::EpiBf16TS E{F.VT, M / 256};
          pg8::gemm_phase<pg8::EpiBf16TS, pg8::StaticOrder, GEMM_ALIGN, GEMM_SP2>(F.lds, g, S, E); }
        if (BOTH(1)) { STAMP(14); GRID_BAR(); STAMP(2); if (PROBE_TS == 2 && PROBE_TB == 18) { for (int r = 0; r < 8; ++r) GRID_BAR(); STAMP(18); } }
    }
    if (N_LAUNCHES == PER_PHASE) {
        if (IN(2)) for (int sl = 0; sl < NSLAB; ++sl) pa_phase(F, sl * CPS, tsl);
        if (IN(3)) scan_phase(F, 0, NCH);
        if (IN(4)) for (int sl = 0; sl < NSLAB; ++sl) r2_phase(F, sl * CPS, tsl);
    } else if (IN(2)) {
        for (int sl = 0; sl < NSLAB; ++sl) {
            pa_phase(F, sl * CPS, tsl); STAMP(10); GRID_BAR(); STAMP(11);
            scan_phase(F, sl * CPS, (sl + 1) * CPS); STAMP(12); GRID_BAR(); STAMP(13);
            r2_phase(F, sl * CPS, tsl); if (sl + 1 < NSLAB) GRID_BAR();
        }
        STAMP(3); STAMP(4);
        GRID_BAR(); STAMP(5);
    }
    if (IN(5)) {
        { pg8::Gemm g{F.Y, F.WoT, M, DM, DM}; pg8::StaticOrder S; S.init(M, DM, F.G, vcu);
          pg8::EpiRes E{F.U, F.gates + (WS_RMS - WS_GATES) / 4, F.norm_w, F.HB, (unsigned char*)F.HB + HB8_OFF, F.ssqh, DM, DM / 256};
          pg8::gemm_phase<pg8::EpiRes, pg8::StaticOrder, GEMM_ALIGN, GEMM_SP2>(F.lds, g, S, E); }
        { pg8::Gemm g{F.PB, F.WeT, M, DM, PE}; pg8::StaticOrder S; S.init(M, DM, F.G, vcu);
          pg8::EpiBf16T E{F.EB, DM / 256};
          pg8::gemm_phase<pg8::EpiBf16T, pg8::StaticOrder, GEMM_ALIGN, GEMM_SP2>(F.lds, g, S, E); }
        if (BOTH(5)) { STAMP(15); GRID_BAR(); STAMP(6); }
    }
    if (IN(6)) {
        pg8::Gemm g{(const bf16*)((const unsigned char*)F.HB + HB8_OFF), F.WgT, M, DM, DM / 2}; pg8::StaticOrder S; S.init(M, DM, F.G, vcu);
        pg8::EpiGate E{F.EB, F.HB, F.ssqh, DM / 256, 1.0f / DM, EPS, 1.0f / (WG_SCALE * HB8_SCALE)};
        pg8::gemm_phase<pg8::EpiGate, pg8::StaticOrder, GEMM_ALIGN, GEMM_SP2, false, 0, false, 2, false, false, true>(F.lds, g, S, E);
        if (BOTH(6)) { STAMP(16); GRID_BAR(); STAMP(7); }
    }
    float oscale = 1.0f;
    if (PROBE_TS >= 0) { __syncthreads(); const float f = (float)(tsl[PROBE_TB] - tsl[PROBE_TS]) / (float)(tsl[7] - tsl[0]); oscale = 1.0f + sqrtf(fmaxf(f - PROBE_F0, 0.f) * 1e-3f); }
    if (PROBE_P7W) {
        final_norm(F, 1.0f); STAMP(19); GRID_BAR(); STAMP(20);
        __syncthreads(); const float f7 = (float)(tsl[20] - tsl[7]) / (float)(tsl[7] - tsl[0]); oscale = 1.0f + sqrtf(fmaxf(f7 - PROBE_F0, 0.f) * 1e-3f);
        final_norm_v<true, true, false>(F, oscale);
    } else
    if (IN(7)) final_norm(F, oscale);
#undef IN
#undef BOTH
}

#ifdef DBG_DUMP_AFTER
__global__ void dbg_dump(const unsigned char* wsb, float* out, int mode) {
    const unsigned short* a = (const unsigned short*)(wsb + (mode == 0 ? WS_PROJ : WS_U)); const unsigned short* b = (const unsigned short*)(wsb + WS_VT);
    size_t i = (size_t)blockIdx.x * blockDim.x + threadIdx.x;
    const size_t n = (size_t)M * DM;
    for (; i < n; i += (size_t)gridDim.x * blockDim.x) {
        float v;
        if (mode == 0) v = bf2f(a[3 * i]) + bf2f(a[3 * i + 1]) + bf2f(a[3 * i + 2]) + bf2f(b[i]);
        else v = bf2f(a[i]);
        out[i] = v;
    }
}
#endif
extern "C" void kernel_launch(void* const* d_in, const int* in_sizes, int n_in, void* d_out, int out_size, void* d_ws, size_t ws_size, hipStream_t stream) {
    static int grid = 0;
    if (grid == 0) {
        if (n_in != 16 || in_sizes[0] != M * DM || out_size != M * DM || ws_size < WS_END) { fprintf(stderr, "kernel_launch: unexpected shapes (n_in %d, in0 %d, out %d, ws %zu); nothing launched\n", n_in, n_in > 0 ? in_sizes[0] : -1, out_size, ws_size); grid = -1; return; }
        int dev = 0, cus = 0, per_cu = 0;
        if (hipGetDevice(&dev) != hipSuccess || hipDeviceGetAttribute(&cus, hipDeviceAttributeMultiprocessorCount, dev) != hipSuccess) { grid = -1; return; }
        if (hipFuncSetAttribute((const void*)hymba_fwd, hipFuncAttributeMaxDynamicSharedMemorySize, LDS_BYTES) != hipSuccess) { fprintf(stderr, "kernel_launch: hipFuncSetAttribute failed\n"); grid = -1; return; }
        if (hipOccupancyMaxActiveBlocksPerMultiprocessor(&per_cu, (const void*)hymba_fwd, NWAVES * 64, LDS_BYTES) != hipSuccess || per_cu < 1)
            fprintf(stderr, "kernel_launch: note: occupancy query reports %d workgroups per CU\n", per_cu);
        (void)hipGetLastError();
        grid = cus < 256 ? cus : 256;
        if (grid != 256) fprintf(stderr, "kernel_launch: %d CUs: this kernel is written for a 256-CU device; results will be wrong\n", cus);
    }
    if (grid < 0) return;
    if (hipMemsetAsync((char*)d_ws + WS_CTL, 0, CTL_ZERO_BYTES, stream) != hipSuccess) { fprintf(stderr, "kernel_launch: hipMemsetAsync failed\n"); return; }
    Args a{};
    for (int i = 0; i < 16; ++i) a.in[i] = (const float*)d_in[i];
    a.out = (float*)d_out; a.ws = (unsigned char*)d_ws;
    for (int li = 0; li < N_LAUNCHES; ++li) {
#ifdef DBG_DUMP_AFTER
        if (li > DBG_DUMP_AFTER) { if (DBG_DUMP_AFTER != 2 && DBG_DUMP_AFTER != 3) hipLaunchKernelGGL(dbg_dump, dim3(2048), dim3(256), 0, stream, (const unsigned char*)d_ws, (float*)d_out, DBG_DUMP_AFTER == 1 ? 0 : 1);
            break; }
#endif
        a.ph_lo = (N_LAUNCHES == PER_PHASE) ? li : 0; a.ph_hi = (N_LAUNCHES == PER_PHASE) ? li + 1 : PER_PHASE; a.li = li;
        hipLaunchKernelGGL(hymba_fwd, dim3(grid), dim3(NWAVES * 64), LDS_BYTES, stream, a);
        const hipError_t le = hipPeekAtLastError();
        if (le != hipSuccess) { fprintf(stderr, "kernel_launch: launch %d failed: %s\n", li, hipGetErrorName(le)); break; }
    }
}
```
